# Optimizing an MI355X kernel written in HIP

```python
import jax, jax.numpy as jnp
from jax import lax
import numpy as np

D_MODEL = 2048
BATCH = 8
SEQ = 2048
DEPTH = 2

D_MIX = D_MODEL
GROUP_W = D_MIX // 4
MOBA_HEAD_DIM = 64
MOBA_HEADS = GROUP_W // MOBA_HEAD_DIM
MOBA_BLOCK = 256
MOBA_TOPK = 3
MOBA_Q_CHUNK = 32
MLSTM_HEADS = 4
MLSTM_HEAD_DIM = GROUP_W // MLSTM_HEADS
MLSTM_CHUNK = 64
MLSTM_CONV = 4
MLSTM_GATE_CAP = 15.0
SWA_HEAD_DIM = 64
SWA_HEADS = (D_MIX - 2 * GROUP_W) // SWA_HEAD_DIM
SWA_KV_HEADS = SWA_HEADS // 8
SWA_WINDOW = 128
D_FF = 5632
N_EXPERTS = 8
TOP_K = 2
D_FF_EXPERT = D_FF // 2
RMS_EPS = 1e-6

MOBA_W = MOBA_HEADS * MOBA_HEAD_DIM
MLSTM_W = MLSTM_HEADS * MLSTM_HEAD_DIM
SWA_W = SWA_HEADS * SWA_HEAD_DIM
SWA_KV_W = SWA_KV_HEADS * SWA_HEAD_DIM
IN_SPLIT = (MOBA_W, MOBA_W, MOBA_W, MLSTM_W, MLSTM_W, MLSTM_W, MLSTM_W, MLSTM_HEADS, MLSTM_HEADS, SWA_W, SWA_KV_W, SWA_KV_W)
N_IN = sum(IN_SPLIT)
N_DENSE = (DEPTH + 1) // 2
N_MOE = DEPTH // 2

kernel_name = 'hymba_moba_mlstm_swa_moe_block'


def rms_norm(x, g):
    x32 = x.astype(jnp.float32)
    y = x32 * lax.rsqrt(jnp.mean(x32 * x32, axis=-1, keepdims=True) + RMS_EPS)
    return (y * g.astype(jnp.float32)).astype(x.dtype)


def causal_depthwise_conv(x, w, b):
    K, C = w.shape
    y = lax.conv_general_dilated(x, w[:, None, :].astype(x.dtype), window_strides=(1,), padding=[(K - 1, 0)], dimension_numbers=('NWC', 'WIO', 'NWC'), feature_group_count=C)
    return y + b


def moba_attention(q, k, v):
    B, S, H, Dh = q.shape
    n_blk = -(-S // MOBA_BLOCK)
    s_pad = n_blk * MOBA_BLOCK
    k_sel = min(MOBA_TOPK, n_blk - 1)
    n_chunk = S // MOBA_Q_CHUNK
    scale = Dh ** -0.5
    pad = ((0, 0), (0, s_pad - S), (0, 0), (0, 0))
    kb = jnp.pad(k, pad).reshape(B, n_blk, MOBA_BLOCK, H, Dh).transpose(0, 3, 1, 2, 4)
    vb = jnp.pad(v, pad).reshape(B, n_blk, MOBA_BLOCK, H, Dh).transpose(0, 3, 1, 2, 4)
    q_bh = q.transpose(0, 2, 1, 3)
    q_c = q_bh.reshape(B, H, n_chunk, MOBA_Q_CHUNK, Dh).transpose(2, 0, 1, 3, 4)
    if k_sel > 0:
        k_mean = jnp.mean(kb.astype(jnp.float32), axis=3)
        gate = jnp.einsum('bhsd,bhnd->bhsn', q_bh.astype(jnp.float32), k_mean)
        fully_past = jnp.arange(n_blk)[None, :] < (jnp.arange(S) // MOBA_BLOCK)[:, None]
        gate = jnp.where(fully_past, gate, -jnp.inf)
        _, idx = lax.top_k(gate, k_sel)
    else:
        idx = jnp.zeros((B, H, S, 0), jnp.int32)
    idx_c = idx.reshape(B, H, n_chunk, MOBA_Q_CHUNK, k_sel).transpose(2, 0, 1, 3, 4)
    b_ix = jnp.arange(B)[:, None, None, None]
    h_ix = jnp.arange(H)[None, :, None, None]

    def chunk(args):
        ci, qc, ic = args
        q0 = ci * MOBA_Q_CHUNK
        own = q0 // MOBA_BLOCK
        q_pos = q0 + jnp.arange(MOBA_Q_CHUNK)
        k_pos = own * MOBA_BLOCK + jnp.arange(MOBA_BLOCK)
        k_own = lax.dynamic_index_in_dim(kb, own, axis=2, keepdims=False)
        v_own = lax.dynamic_index_in_dim(vb, own, axis=2, keepdims=False)
        s_own = jnp.einsum('bhqd,bhkd->bhqk', qc, k_own).astype(jnp.float32) * scale
        s_own = jnp.where(k_pos[None, :] <= q_pos[:, None], s_own, -jnp.inf)
        if k_sel == 0:
            p = jax.nn.softmax(s_own, axis=-1).astype(v.dtype)
            return jnp.einsum('bhqk,bhkd->bhqd', p, v_own)
        k_g = kb[b_ix, h_ix, ic]
        v_g = vb[b_ix, h_ix, ic]
        s_g = jnp.einsum('bhqd,bhqnkd->bhqnk', qc, k_g).astype(jnp.float32) * scale
        slot_ok = jnp.arange(k_sel) < own
        s_g = jnp.where(slot_ok[:, None], s_g, -jnp.inf)
        n_g = k_sel * MOBA_BLOCK
        logits = jnp.concatenate([s_g.reshape(B, H, MOBA_Q_CHUNK, n_g), s_own], axis=-1)
        p = jax.nn.softmax(logits, axis=-1).astype(v.dtype)
        p_g = p[..., :n_g].reshape(B, H, MOBA_Q_CHUNK, k_sel, MOBA_BLOCK)
        return jnp.einsum('bhqnk,bhqnkd->bhqd', p_g, v_g) + jnp.einsum('bhqk,bhkd->bhqd', p[..., n_g:], v_own)

    out = lax.map(chunk, (jnp.arange(n_chunk), q_c, idx_c))
    return out.transpose(1, 0, 3, 2, 4).reshape(B, S, H * Dh)


def mlstm_chunkwise(q, k, v, log_i, log_f):
    B, S, H, Dh = q.shape
    L = MLSTM_CHUNK
    nc = S // L
    f32 = jnp.float32

    def chunks(t):
        return t.astype(f32).reshape(B, nc, L, H, -1).transpose(0, 3, 1, 2, 4)

    qc = chunks(q)
    kc = chunks(k) * (Dh ** -0.5)
    vc = chunks(v)
    li = chunks(log_i[..., None])[..., 0]
    lf = chunks(log_f[..., None])[..., 0]
    b = jnp.cumsum(lf, axis=-1)
    b_last = b[..., -1]
    causal = jnp.tril(jnp.ones((L, L), dtype=bool))
    d_log = jnp.where(causal, b[..., :, None] - b[..., None, :] + li[..., None, :], -jnp.inf)
    a = b_last[..., None] - b + li
    a_max = jnp.max(a, axis=-1)
    w_a = jnp.exp(a - a_max[..., None])
    c_chunk = jnp.einsum('bhcs,bhcsd,bhcse->bhcde', w_a, kc, vc)
    n_chunk = jnp.einsum('bhcs,bhcsd->bhcd', w_a, kc)

    def step(carry, xs):
        c_st, n_st, m_st = carry
        c_in, n_in, a_mx, b_l = xs
        m_new = jnp.maximum(b_l + m_st, a_mx)
        decay = jnp.exp(b_l + m_st - m_new)
        inject = jnp.exp(a_mx - m_new)
        c_new = decay[..., None, None] * c_st + inject[..., None, None] * c_in
        n_new = decay[..., None] * n_st + inject[..., None] * n_in
        return (c_new, n_new, m_new), (c_st, n_st, m_st)

    init = (jnp.zeros((B, H, Dh, Dh), f32), jnp.zeros((B, H, Dh), f32), jnp.zeros((B, H), f32))
    xs = (jnp.moveaxis(c_chunk, 2, 0), jnp.moveaxis(n_chunk, 2, 0), jnp.moveaxis(a_max, 2, 0), jnp.moveaxis(b_last, 2, 0))
    _, (c_prev, n_prev, m_prev) = lax.scan(step, init, xs)
    c_prev = jnp.moveaxis(c_prev, 0, 2)
    n_prev = jnp.moveaxis(n_prev, 0, 2)
    m_prev = jnp.moveaxis(m_prev, 0, 2)
    inter_log = b + m_prev[..., None]
    m_out = jnp.maximum(inter_log, jnp.max(d_log, axis=-1))
    w_inter = jnp.exp(inter_log - m_out)
    qk = jnp.einsum('bhctd,bhcsd->bhcts', qc, kc) * jnp.exp(d_log - m_out[..., None])
    num = jnp.einsum('bhcts,bhcse->bhcte', qk, vc) + w_inter[..., None] * jnp.einsum('bhctd,bhcde->bhcte', qc, c_prev)
    den = jnp.sum(qk, axis=-1) + w_inter * jnp.einsum('bhctd,bhcd->bhct', qc, n_prev)
    h = num / jnp.maximum(jnp.abs(den), jnp.exp(-m_out))[..., None]
    return h.transpose(0, 2, 3, 1, 4).reshape(B, S, H, Dh)


def swa_sink_attention(q, k, v, sinks):
    B, S, Hq, Dh = q.shape
    Hkv = k.shape[2]
    G = Hq // Hkv
    W = SWA_WINDOW
    nb = S // W
    scale = Dh ** -0.5
    qb = q.reshape(B, nb, W, Hkv, G, Dh)
    pad = ((0, 0), (W, 0), (0, 0), (0, 0))
    kp = jnp.pad(k, pad).reshape(B, nb + 1, W, Hkv, Dh)
    vp = jnp.pad(v, pad).reshape(B, nb + 1, W, Hkv, Dh)
    k_band = jnp.concatenate([kp[:, :-1], kp[:, 1:]], axis=2)
    v_band = jnp.concatenate([vp[:, :-1], vp[:, 1:]], axis=2)
    s = jnp.einsum('bnqkgd,bnskd->bnkgqs', qb, k_band).astype(jnp.float32) * scale
    qi = jnp.arange(W)[:, None]
    si = jnp.arange(2 * W)[None, :]
    k_abs = jnp.arange(nb)[:, None, None] * W - W + si
    allowed = (si > qi) & (si <= qi + W) & (k_abs >= 0)
    s = jnp.where(allowed[None, :, None, None], s, -jnp.inf)
    sink = jnp.broadcast_to(sinks.astype(jnp.float32).reshape(1, 1, Hkv, G, 1, 1), s.shape[:-1] + (1,))
    p = jax.nn.softmax(jnp.concatenate([s, sink], axis=-1), axis=-1)[..., :-1].astype(v.dtype)
    o = jnp.einsum('bnkgqs,bnskd->bnqkgd', p, v_band)
    return o.reshape(B, S, Hq * Dh)


def token_mixer(h, w_in, w_out, conv_w, conv_b, igate_b, fgate_b, mlstm_norm_w, swa_sinks):
    B, S, _ = h.shape
    proj = h @ w_in
    offs = []
    o = 0
    for w in IN_SPLIT[:-1]:
        o += w
        offs.append(o)
    mb_q, mb_k, mb_v, ml_q, ml_k, ml_v, ml_o, ml_i, ml_f, sw_q, sw_k, sw_v = jnp.split(proj, offs, axis=-1)
    hd = (B, S, MOBA_HEADS, MOBA_HEAD_DIM)
    y_moba = moba_attention(mb_q.reshape(hd), mb_k.reshape(hd), mb_v.reshape(hd))
    qk = jax.nn.silu(causal_depthwise_conv(jnp.concatenate([ml_q, ml_k], axis=-1), conv_w, conv_b))
    ml_q, ml_k = jnp.split(qk, 2, axis=-1)
    cap = MLSTM_GATE_CAP
    log_i = cap * jnp.tanh((ml_i + igate_b).astype(jnp.float32) / cap)
    log_f = jax.nn.log_sigmoid(cap * jnp.tanh((ml_f + fgate_b).astype(jnp.float32) / cap))
    hm_shape = (B, S, MLSTM_HEADS, MLSTM_HEAD_DIM)
    hm = mlstm_chunkwise(ml_q.reshape(hm_shape), ml_k.reshape(hm_shape), ml_v.reshape(hm_shape), log_i, log_f)
    hm = rms_norm(hm, mlstm_norm_w.reshape(MLSTM_HEADS, MLSTM_HEAD_DIM)).astype(h.dtype)
    y_mlstm = jax.nn.sigmoid(ml_o) * hm.reshape(B, S, MLSTM_W)
    y_swa = swa_sink_attention(sw_q.reshape(B, S, SWA_HEADS, SWA_HEAD_DIM), sw_k.reshape(B, S, SWA_KV_HEADS, SWA_HEAD_DIM), sw_v.reshape(B, S, SWA_KV_HEADS, SWA_HEAD_DIM), swa_sinks)
    return jnp.concatenate([y_moba, y_mlstm, y_swa], axis=-1) @ w_out


def swiglu(h, w_gate, w_up, w_down):
    return (jax.nn.silu(h @ w_gate) * (h @ w_up)) @ w_down


def moe_swiglu(h, w_router, w_gate, w_up, w_down):
    B, S, D = h.shape
    xt = h.reshape(B * S, D)
    logits = (xt @ w_router).astype(jnp.float32)
    top_v, top_i = lax.top_k(logits, TOP_K)
    top_w = jax.nn.softmax(top_v, axis=-1)
    combine = jnp.sum(jax.nn.one_hot(top_i, N_EXPERTS, dtype=jnp.float32) * top_w[..., None], axis=1).astype(h.dtype)
    out = jnp.zeros_like(xt)
    for e in range(N_EXPERTS):
        out = out + combine[:, e:e + 1] * swiglu(xt, w_gate[e], w_up[e], w_down[e])
    return out.reshape(B, S, D)


def setup_inputs(seed: int = 0) -> dict:
    key = jax.random.key(seed)
    ks = jax.random.split(key, 24)
    f32 = jnp.float32
    D = D_MODEL

    def nrm(k, shape, std):
        return jax.random.normal(k, shape, f32) * std

    return {
        'x': nrm(ks[0], (BATCH, SEQ, D), 1.0),
        'c': nrm(ks[1], (BATCH, D), 1.0),
        'ada_w': nrm(ks[2], (DEPTH, D, 6 * D), D ** -0.5),
        'ada_b': nrm(ks[3], (DEPTH, 6 * D), 0.02),
        'g_pre_mix': 1.0 + nrm(ks[4], (DEPTH, D), 0.02),
        'g_post_mix': 1.0 + nrm(ks[5], (DEPTH, D), 0.02),
        'g_pre_ffn': 1.0 + nrm(ks[6], (DEPTH, D), 0.02),
        'g_post_ffn': 1.0 + nrm(ks[7], (DEPTH, D), 0.02),
        'w_in': nrm(ks[8], (DEPTH, D, N_IN), D ** -0.5),
        'w_out': nrm(ks[9], (DEPTH, D_MIX, D), D_MIX ** -0.5),
        'conv_w': nrm(ks[10], (DEPTH, MLSTM_CONV, 2 * MLSTM_W), MLSTM_CONV ** -0.5),
        'conv_b': nrm(ks[11], (DEPTH, 2 * MLSTM_W), 0.02),
        'igate_b': nrm(ks[12], (DEPTH, MLSTM_HEADS), 0.1),
        'fgate_b': 3.0 + nrm(ks[13], (DEPTH, MLSTM_HEADS), 0.5),
        'mlstm_norm_w': 1.0 + nrm(ks[14], (DEPTH, MLSTM_W), 0.02),
        'swa_sinks': nrm(ks[15], (DEPTH, SWA_HEADS), 0.5),
        'ffn_w_gate': nrm(ks[16], (N_DENSE, D, D_FF), D ** -0.5),
        'ffn_w_up': nrm(ks[17], (N_DENSE, D, D_FF), D ** -0.5),
        'ffn_w_down': nrm(ks[18], (N_DENSE, D_FF, D), D_FF ** -0.5),
        'moe_router': nrm(ks[19], (N_MOE, D, N_EXPERTS), D ** -0.5),
        'moe_w_gate': nrm(ks[20], (N_MOE, N_EXPERTS, D, D_FF_EXPERT), D ** -0.5),
        'moe_w_up': nrm(ks[21], (N_MOE, N_EXPERTS, D, D_FF_EXPERT), D ** -0.5),
        'moe_w_down': nrm(ks[22], (N_MOE, N_EXPERTS, D_FF_EXPERT, D), D_FF_EXPERT ** -0.5),
    }


def reference(x, c, ada_w, ada_b, g_pre_mix, g_post_mix, g_pre_ffn, g_post_ffn, w_in, w_out, conv_w, conv_b, igate_b, fgate_b, mlstm_norm_w, swa_sinks, ffn_w_gate, ffn_w_up, ffn_w_down, moe_router, moe_w_gate, moe_w_up, moe_w_down):
    cond = jax.nn.silu(c)
    for l in range(DEPTH):
        mod = (cond @ ada_w[l] + ada_b[l])[:, None, :]
        sh_m, sc_m, gt_m, sh_f, sc_f, gt_f = jnp.split(mod, 6, axis=-1)
        h = rms_norm(x, g_pre_mix[l]) * (1.0 + sc_m) + sh_m
        y = token_mixer(h, w_in[l], w_out[l], conv_w[l], conv_b[l], igate_b[l], fgate_b[l], mlstm_norm_w[l], swa_sinks[l])
        x = x + gt_m * rms_norm(y, g_post_mix[l])
        h = rms_norm(x, g_pre_ffn[l]) * (1.0 + sc_f) + sh_f
        j = l // 2
        if l % 2 == 0:
            y = swiglu(h, ffn_w_gate[j], ffn_w_up[j], ffn_w_down[j])
        else:
            y = moe_swiglu(h, moe_router[j], moe_w_gate[j], moe_w_up[j], moe_w_down[j])
        x = x + gt_f * rms_norm(y, g_post_ffn[l])
    return x
```

```cpp
#include <hip/hip_runtime.h>
#include <cstdio>
#include <cstdint>

#ifndef MK_N_LAUNCHES
#define MK_N_LAUNCHES 1
#endif

#define LAS __attribute__((address_space(3)))
#define GAS __attribute__((address_space(1)))
typedef unsigned short bf16_t;
typedef short bf16x8 __attribute__((ext_vector_type(8)));
typedef float f32x4 __attribute__((ext_vector_type(4)));
typedef float f32x2 __attribute__((ext_vector_type(2)));
typedef float f32x16 __attribute__((ext_vector_type(16)));
typedef unsigned u32x4 __attribute__((ext_vector_type(4)));
typedef unsigned u32x2 __attribute__((ext_vector_type(2)));
typedef __bf16 bf16x2_t __attribute__((ext_vector_type(2)));

constexpr int NB = 8, SEQ = 2048, D = 2048, M = NB * SEQ;
constexpr int NIN_SRC = 4872, NIN = 4864;
constexpr int C_MQ = 0, C_MK = 512, C_MV = 1024, C_LQ = 1536, C_LK = 2048, C_LV = 2560, C_LO = 3072, C_SQ = 3584, C_SK = 4608, C_SV = 4736;
constexpr int SRC_GATE = 3584;
constexpr int DFF = 5632, DFE = 2816, NE = 8, ECAP = M;
constexpr float RMS_EPS = 1e-6f;
constexpr int NWAVES = 8, NTHR = 512;

constexpr size_t MiB = 1u << 20;
constexpr size_t WS_CTL = 0, CTL_ZERO_BYTES = 1 * MiB;
constexpr size_t WS_MOD = 1 * MiB;
constexpr size_t WS_GATES = 2 * MiB;
constexpr size_t WS_ROWMAX = 4 * MiB;
constexpr size_t WS_RMSLOT = 4 * MiB + 131072;
constexpr size_t WS_TOK = 3 * MiB;
constexpr size_t WS_WIN = 8 * MiB;
constexpr size_t WS_WOUT = 48 * MiB;
constexpr size_t WS_WGU = 64 * MiB;
constexpr size_t WS_WD = 108 * MiB;
constexpr size_t WS_MGU = 130 * MiB;
constexpr size_t WS_MD = 306 * MiB;
constexpr size_t WS_XN = 394 * MiB;
constexpr size_t WS_PROJ = 458 * MiB;
constexpr size_t WS_YMIX = 610 * MiB;
constexpr size_t WS_ACT = 458 * MiB;
constexpr size_t WS_YB = 674 * MiB;
constexpr size_t WS_XB = 810 * MiB;
constexpr size_t WS_CC = 874 * MiB;
constexpr size_t WS_CP = 906 * MiB;
constexpr size_t WS_NC = 938 * MiB, WS_NP = 939 * MiB, WS_SC = 940 * MiB;
constexpr size_t WS_END = 941 * MiB;
constexpr int CW_TMO = 0, CW_CODE = 1;
constexpr int CW_CNT = 64;
constexpr int CW_WQ = 128;
constexpr int CW_BAR = 4096;
constexpr size_t KMEAN_OFF = 262144;


__device__ __forceinline__ unsigned cvtpk(float lo, float hi) { f32x2 v = {lo, hi}; bf16x2_t b = __builtin_convertvector(v, bf16x2_t); return __builtin_bit_cast(unsigned, b); }
__device__ __forceinline__ float bflo(unsigned u) { return __uint_as_float(u << 16); }
__device__ __forceinline__ float bfhi(unsigned u) { return __uint_as_float(u & 0xffff0000u); }
__device__ __forceinline__ float bf1(bf16_t u) { return __uint_as_float(((unsigned)u) << 16); }
template <bool MAX>
__device__ __forceinline__ float scan64(float v) {
    constexpr int ident = MAX ? (int)0xff800000 : 0;
#define SCAN_STEP(ctrl, rm) { const float tf = __int_as_float(__builtin_amdgcn_update_dpp(ident, __float_as_int(v), ctrl, rm, 0xf, false)); v = MAX ? fmaxf(v, tf) : v + tf; }
    SCAN_STEP(0x111, 0xf) SCAN_STEP(0x112, 0xf) SCAN_STEP(0x114, 0xf) SCAN_STEP(0x118, 0xf) SCAN_STEP(0x142, 0xa) SCAN_STEP(0x143, 0xc)
#undef SCAN_STEP
    return v;
}
__device__ __forceinline__ float lane63(float v) { return __int_as_float(__builtin_amdgcn_readlane(__float_as_int(v), 63)); }
__device__ __forceinline__ float wave_sum(float v) { return lane63(scan64<false>(v)); }
__device__ __forceinline__ float wave_max(float v) { return lane63(scan64<true>(v)); }
#define LBAR() do { asm volatile("s_waitcnt lgkmcnt(0)" ::: "memory"); __builtin_amdgcn_s_barrier(); asm volatile("" ::: "memory"); } while (0)
__device__ __forceinline__ float silu_f(float x) { return x / (1.f + __expf(-x)); }
__device__ __forceinline__ float sigmoid_f(float x) { return 1.f / (1.f + __expf(-x)); }

namespace pg8 {
constexpr int BM = 256, BK = 64, HALF = 128, HTB = HALF * BK * 2, STAGE_BYTES = 8 * HTB, NXCD = 8, WGM = 8;
__host__ __device__ __forceinline__ int lds_byte(int r, int c) { const int st = (r >> 4) * 2 + (c >> 5), rr = r & 15, cc = c & 31, ob = rr * 64 + cc * 2; return st * 1024 + (ob ^ (((ob >> 9) & 1) << 5)); }
__host__ __device__ __forceinline__ void stage_rc(int b, int& R, int& C) { const int st = b / 1024, sb = b % 1024, swz = sb ^ (((sb >> 9) & 1) << 5); R = (st >> 1) * 16 + swz / 64; C = (st & 1) * 32 + (swz % 64) / 2; }
__host__ __device__ __forceinline__ int perm32(int rho) { const int n = rho >> 4, i = rho & 15; return 8 * (i >> 2) + 4 * n + (i & 3); }

struct Unit { int pm, pn, e; };
__device__ __forceinline__ unsigned pack_fp8x4(float a, float b, float c, float d) {
    a = fminf(fmaxf(a, -448.f), 448.f); b = fminf(fmaxf(b, -448.f), 448.f); c = fminf(fmaxf(c, -448.f), 448.f); d = fminf(fmaxf(d, -448.f), 448.f);
    int p = __builtin_amdgcn_cvt_pk_fp8_f32(a, b, 0, false); p = __builtin_amdgcn_cvt_pk_fp8_f32(c, d, p, true); return (unsigned)p;
}


__device__ __forceinline__ bool static_next(int i, int G, int c, int nM, int nN, int& pm, int& pn) {
    const int nwg = nM * nN; const long L = (long)i * G + c; if (L >= nwg) return false;
    int wgid = (int)L; { const int q = nwg / NXCD, r = nwg % NXCD, xcd = wgid % NXCD, off = wgid / NXCD; wgid = (xcd < r ? xcd * (q + 1) : r * (q + 1) + (xcd - r) * q) + off; }
    const int nig = WGM * nN, gid = wgid / nig, fm = gid * WGM, gsz = (nM - fm) < WGM ? (nM - fm) : WGM;
    pm = fm + ((wgid % nig) % gsz); pn = (wgid % nig) / gsz; return true;
}

struct DenseSched {
    static constexpr bool GATHER = false;
    const char* A; const char* Bt; int KB  , nM, nN, G, c;
    __device__ __forceinline__ bool next(int i, Unit& u) const { u.e = 0; return static_next(i, G, c, nM, nN, u.pm, u.pn); }
    __device__ __forceinline__ const char* a_base() const { return A; }
    __device__ __forceinline__ void a_offsets(const Unit& u, const int (&Rr)[2], const int (&Cc)[2], unsigned (&off)[2][2]) const {
#pragma unroll
        for (int h = 0; h < 2; ++h)
#pragma unroll
            for (int i = 0; i < 2; ++i) off[h][i] = (unsigned)((u.pm * BM + h * HALF + Rr[i]) * KB + Cc[i] * 2);
    }
    __device__ __forceinline__ const char* b_base(const Unit& u) const { return Bt + (size_t)u.pn * BM * KB; }
};
template <bool GATHER_>
struct MoeSched {
    static constexpr bool GATHER = GATHER_;
    const char* A; const char* W; const int* idx; const LAS int* tab  ; int KB, nN, G, c, wrows  , ntile;
    __device__ __forceinline__ bool next(int i, Unit& u) const { if (!static_next(i, G, c, ntile, nN, u.pm, u.pn)) return false; int e = 0;
#pragma unroll
        for (int j = 1; j < NE; ++j) e += (u.pm >= tab[8 + j]) ? 1 : 0;
        u.e = e; return true; }
    __device__ __forceinline__ const char* a_base() const { return A; }
    __device__ __forceinline__ void a_offsets(const Unit& u, const int (&Rr)[2], const int (&Cc)[2], unsigned (&off)[2][2]) const {
        const int cume = tab[8 + u.e], cnte = tab[u.e];
#pragma unroll
        for (int h = 0; h < 2; ++h)
#pragma unroll
            for (int i = 0; i < 2; ++i) {
                if (GATHER_) { const int rl = (u.pm - cume) * BM + h * HALF + Rr[i]; const int tok = (rl < cnte) ? idx[u.e * ECAP + rl] : 0; off[h][i] = (unsigned)(tok * KB + Cc[i] * 2); }
                else off[h][i] = (unsigned)((u.pm * BM + h * HALF + Rr[i]) * KB + Cc[i] * 2);
            }
    }
    __device__ __forceinline__ const char* b_base(const Unit& u) const { return W + ((size_t)u.e * wrows + (size_t)u.pn * BM) * KB; }
};

struct EpiBf16 {
    static constexpr bool PERM = true;
    bf16_t* O; int ldc; float sc;
    __device__ __forceinline__ void operator()(const f32x4 (&acc)[2][2][4][2], const Unit& u, int wr, int wc, int fr, int fq) const {
        const int row0 = u.pm * BM + wr * 64 + fr, col0 = u.pn * BM + wc * 32 + 8 * fq;
#pragma unroll
        for (int ai = 0; ai < 2; ++ai)
#pragma unroll
            for (int m = 0; m < 4; ++m) { bf16_t* rowp = O + (size_t)(row0 + ai * HALF + m * 16) * ldc + col0;
#pragma unroll
                for (int bj = 0; bj < 2; ++bj) { const f32x4 v0 = acc[ai][bj][m][0] * sc, v1 = acc[ai][bj][m][1] * sc;
                    u32x4 w; w.x = cvtpk(v0[0], v0[1]); w.y = cvtpk(v0[2], v0[3]); w.z = cvtpk(v1[0], v1[1]); w.w = cvtpk(v1[2], v1[3]);
                    *(u32x4*)(rowp + bj * HALF) = w; } }
    }
};
struct EpiInProjI8 {
    static constexpr bool PERM = true;
    bf16_t* O; int ldc; float* kmean; const float* rowmax; const float* colmax;
    __device__ __forceinline__ void operator()(const f32x4 (&acc)[2][2][4][2], const Unit& u, int wr, int wc, int fr, int fq) const {
        typedef int i32x4_ __attribute__((ext_vector_type(4)));
        const int row0 = u.pm * BM + wr * 64 + fr, col0 = u.pn * BM + wc * 32 + 8 * fq;
        const float qsc = (u.pn < 2 || (u.pn >= 14 && u.pn < 18)) ? 0.125f * 1.4426950408889634f : 1.f;
        f32x4 cmv[2][2], cs[2][2];
#pragma unroll
        for (int bj = 0; bj < 2; ++bj)
#pragma unroll
            for (int n = 0; n < 2; ++n) { cmv[bj][n] = *(const f32x4*)(colmax + col0 + bj * HALF + 4 * n) * (qsc / (127.f * 127.f)); cs[bj][n] = (f32x4){0.f, 0.f, 0.f, 0.f}; }
#pragma unroll
        for (int ai = 0; ai < 2; ++ai)
#pragma unroll
            for (int m = 0; m < 4; ++m) { const int r = row0 + ai * HALF + m * 16; bf16_t* rowp = O + (size_t)r * ldc + col0; const float sa = rowmax[r];
#pragma unroll
                for (int bj = 0; bj < 2; ++bj) { f32x4 v[2];
#pragma unroll
                    for (int n = 0; n < 2; ++n) { const i32x4_ iv = __builtin_bit_cast(i32x4_, acc[ai][bj][m][n]);
                        v[n] = (f32x4){(float)iv[0], (float)iv[1], (float)iv[2], (float)iv[3]} * (cmv[bj][n] * sa); cs[bj][n] += v[n]; }
                    u32x4 w; w.x = cvtpk(v[0][0], v[0][1]); w.y = cvtpk(v[0][2], v[0][3]); w.z = cvtpk(v[1][0], v[1][1]); w.w = cvtpk(v[1][2], v[1][3]);
                    *(u32x4*)(rowp + bj * HALF) = w; } }
        if (u.pn == 2 || u.pn == 3) {
#pragma unroll
            for (int bj = 0; bj < 2; ++bj)
#pragma unroll
                for (int n = 0; n < 2; ++n) {
#pragma unroll
                    for (int j = 0; j < 4; ++j) { float v = cs[bj][n][j]; v += __shfl_xor(v, 1); v += __shfl_xor(v, 2); v += __shfl_xor(v, 4); v += __shfl_xor(v, 8); cs[bj][n][j] = v; }
                    if (fr == 0) { float* kp = kmean + (size_t)u.pm * 512 + (u.pn - 2) * BM + bj * HALF + wc * 32 + 8 * fq + 4 * n;
#pragma unroll
                        for (int j = 0; j < 4; ++j) atomicAdd(kp + j, cs[bj][n][j] * (1.f / 256.f)); } }
        }
    }
};
typedef int i32x8 __attribute__((ext_vector_type(8)));
typedef int i32x4 __attribute__((ext_vector_type(4)));
struct EpiSwiGLUI8 {
    static constexpr bool PERM = true;
    unsigned char* O; int ldc; const float* rowmax; const float* colmax  ; const int* rowidx  ; const LAS int* tab;
    __device__ __forceinline__ void operator()(const f32x4 (&acc)[2][2][4][2], const Unit& u, int wr, int wc, int fr, int fq) const {
        const int row0 = u.pm * BM + wr * 64 + fr, col0 = u.pn * HALF + wc * 32 + 8 * fq;
        const float* cm = colmax + (size_t)u.e * 2 * ldc + u.pn * BM + wc * 32 + 8 * fq;
        const f32x4 cg0 = *(const f32x4*)(cm), cg1 = *(const f32x4*)(cm + 4), cu0 = *(const f32x4*)(cm + HALF), cu1 = *(const f32x4*)(cm + HALF + 4);
        const float cg[8] = {cg0[0], cg0[1], cg0[2], cg0[3], cg1[0], cg1[1], cg1[2], cg1[3]}, cu[8] = {cu0[0], cu0[1], cu0[2], cu0[3], cu1[0], cu1[1], cu1[2], cu1[3]};
        int cume = 0, cnte = 0x7fffffff; if (rowidx) { cume = tab[8 + u.e]; cnte = tab[u.e]; }
#pragma unroll
        for (int ai = 0; ai < 2; ++ai)
#pragma unroll
            for (int m = 0; m < 4; ++m) { const int r = row0 + ai * HALF + m * 16; unsigned char* rowp = O + (size_t)r * ldc + col0;
                float sa; if (rowidx) { const int rl = r - cume * BM; sa = (rl < cnte) ? rowmax[u.e * ECAP + rl] : 0.f; } else sa = rowmax[r];
                sa *= (1.f / (127.f * 127.f));
                float o[8];
#pragma unroll
                for (int n = 0; n < 2; ++n)
#pragma unroll
                    for (int j = 0; j < 4; ++j) { const float g = (float)__builtin_bit_cast(i32x4, acc[ai][0][m][n])[j] * (sa * cg[n * 4 + j]), up = (float)__builtin_bit_cast(i32x4, acc[ai][1][m][n])[j] * (sa * cu[n * 4 + j]);
                        o[n * 4 + j] = g * __builtin_amdgcn_rcpf(1.f + __builtin_amdgcn_exp2f(-1.4426950408889634f * g)) * up; }
                u32x2 w; w.x = pack_fp8x4(o[0], o[1], o[2], o[3]); w.y = pack_fp8x4(o[4], o[5], o[6], o[7]);
                *(u32x2*)rowp = w; }
    }
};

struct EpiSwiGLU8 {
    static constexpr bool PERM = true;
    unsigned char* O; int ldc; float sc;
    __device__ __forceinline__ void operator()(const f32x4 (&acc)[2][2][4][2], const Unit& u, int wr, int wc, int fr, int fq) const {
        const int row0 = u.pm * BM + wr * 64 + fr, col0 = u.pn * HALF + wc * 32 + 8 * fq;
#pragma unroll
        for (int ai = 0; ai < 2; ++ai)
#pragma unroll
            for (int m = 0; m < 4; ++m) { unsigned char* rowp = O + (size_t)(row0 + ai * HALF + m * 16) * ldc + col0;
                float r[8];
#pragma unroll
                for (int n = 0; n < 2; ++n)
#pragma unroll
                    for (int j = 0; j < 4; ++j) { const float g = acc[ai][0][m][n][j] * sc, up = acc[ai][1][m][n][j] * sc;
                        r[n * 4 + j] = g * __builtin_amdgcn_rcpf(1.f + __builtin_amdgcn_exp2f(-1.4426950408889634f * g)) * up; }
                u32x2 w; w.x = pack_fp8x4(r[0], r[1], r[2], r[3]); w.y = pack_fp8x4(r[4], r[5], r[6], r[7]);
                *(u32x2*)rowp = w; }
    }
};

template <class Epi, class Sched, bool ALIGN_EPI, int DT>
__device__ __forceinline__ void gemm_phase(LAS unsigned char* lds, const int KB, const Sched& S, const Epi& E) {
    const int tid = threadIdx.x, wid = __builtin_amdgcn_readfirstlane(tid >> 6), lane = tid & 63, wr = wid >> 2, wc = wid & 3, fr = lane & 15, fq = lane >> 4;
    const int nt = KB / 128;
    int Rr[2], Cc[2]; unsigned voffB[2];
#pragma unroll
    for (int i = 0; i < 2; ++i) { int R, C; stage_rc(tid * 16 + i * 8192, R, C); Rr[i] = R; Cc[i] = C; const int Rb = Epi::PERM ? ((R & ~31) + perm32(R & 31)) : R; voffB[i] = (unsigned)(Rb * KB + C * 2); }
    const size_t kstep = (size_t)(BK * 2);
    const size_t hstep = (size_t)HALF * KB;
    const unsigned ldsw = (unsigned)wid * 1024u;
    const int aoff = lds_byte(wr * 64 + fr, fq * 8), boff = lds_byte(wc * 32 + fr, fq * 8);
#define PG8_SA(b, h) (((b) * 2 + (h)) * HTB)
#define PG8_SB(b, h) ((4 + (b) * 2 + (h)) * HTB)
#define PG8_STAGE(bufoff, gbase, voff) do { _Pragma("unroll") for (int _i = 0; _i < 2; ++_i) \
        __builtin_amdgcn_global_load_lds((const unsigned*)((const char*)(gbase) + (voff)[_i]), (LAS unsigned*)(lds + (bufoff) + ldsw + _i * 8192), 16, 0, 0); } while (0)
#define PG8_LD32(p) __builtin_shufflevector(*(const LAS i32x4*)(p), *(const LAS i32x4*)((p) + 1024), 0, 1, 2, 3, 4, 5, 6, 7)
#define PG8_LDA(dst, b, h) do { _Pragma("unroll") for (int m = 0; m < 4; ++m) dst[m] = PG8_LD32(lds + PG8_SA(b, h) + aoff + m * 2048); } while (0)
#define PG8_LDB(dst, b, h) do { _Pragma("unroll") for (int n = 0; n < 2; ++n) dst[n] = PG8_LD32(lds + PG8_SB(b, h) + boff + n * 2048); } while (0)
#define PG8_LO(x) __builtin_bit_cast(bf16x8, __builtin_shufflevector((x), (x), 0, 1, 2, 3))
#define PG8_HI(x) __builtin_bit_cast(bf16x8, __builtin_shufflevector((x), (x), 4, 5, 6, 7))
#define PG8_MMA(ai, bj, At, Bt) do { __builtin_amdgcn_s_setprio(1); \
        if constexpr (DT == 2) { _Pragma("unroll") for (int m = 0; m < 4; ++m) _Pragma("unroll") for (int n = 0; n < 2; ++n) { \
            i32x4 _c = __builtin_bit_cast(i32x4, acc[ai][bj][m][n]); \
            _c = __builtin_amdgcn_mfma_i32_16x16x64_i8(__builtin_shufflevector(Bt[n], Bt[n], 0, 1, 2, 3), __builtin_shufflevector(At[m], At[m], 0, 1, 2, 3), _c, 0, 0, 0); \
            _c = __builtin_amdgcn_mfma_i32_16x16x64_i8(__builtin_shufflevector(Bt[n], Bt[n], 4, 5, 6, 7), __builtin_shufflevector(At[m], At[m], 4, 5, 6, 7), _c, 0, 0, 0); \
            acc[ai][bj][m][n] = __builtin_bit_cast(f32x4, _c); } } \
        else if constexpr (DT == 1) { _Pragma("unroll") for (int m = 0; m < 4; ++m) _Pragma("unroll") for (int n = 0; n < 2; ++n) \
            asm volatile("v_mfma_scale_f32_16x16x128_f8f6f4 %0, %1, %2, %0, %3, %3 op_sel_hi:[0,0,0]" : "+v"(acc[ai][bj][m][n]) : "v"(Bt[n]), "v"(At[m]), "v"(scv)); } \
        else { _Pragma("unroll") for (int m = 0; m < 4; ++m) _Pragma("unroll") for (int n = 0; n < 2; ++n) { \
            acc[ai][bj][m][n] = __builtin_amdgcn_mfma_f32_16x16x32_bf16(PG8_LO(Bt[n]), PG8_LO(At[m]), acc[ai][bj][m][n], 0, 0, 0); \
            acc[ai][bj][m][n] = __builtin_amdgcn_mfma_f32_16x16x32_bf16(PG8_HI(Bt[n]), PG8_HI(At[m]), acc[ai][bj][m][n], 0, 0, 0); } } \
        __builtin_amdgcn_s_setprio(0); } while (0)
#define PG8_WAIT_V(n) asm volatile("s_waitcnt vmcnt(" #n ")" ::: "memory")
#define PG8_WAIT_L(n) asm volatile("s_waitcnt lgkmcnt(" #n ")" ::: "memory")
#define PG8_BAR __builtin_amdgcn_s_barrier()
#define PG8_SCHED __builtin_amdgcn_sched_barrier(0)
    Unit cur, nxt; int ui = 0;
    if (!S.next(0, cur)) return;
    f32x4 acc[2][2][4][2];
#pragma unroll
    for (int a = 0; a < 2; ++a)
#pragma unroll
        for (int b = 0; b < 2; ++b)
#pragma unroll
            for (int m = 0; m < 4; ++m)
#pragma unroll
                for (int n = 0; n < 2; ++n) acc[a][b][m][n] = (f32x4){0.f, 0.f, 0.f, 0.f};
    i32x8 At[4], B0[2], B1[2];
    int scv = 0x7F7F7F7F; asm volatile("" : "+v"(scv));
    unsigned curA[2][2], nxtA[2][2], voffA[2];
    const char* const Ab = S.a_base(); const char* cA = Ab; const char* nA = Ab;
    if constexpr (Sched::GATHER) S.a_offsets(cur, Rr, Cc, curA);
    else {
#pragma unroll
        for (int i = 0; i < 2; ++i) voffA[i] = (unsigned)(Rr[i] * KB + Cc[i] * 2);
        cA = Ab + (size_t)cur.pm * 2 * hstep; }
    const char* cB = S.b_base(cur);
#define PG8_STA(bufoff, nextflag, h, koff) do { if constexpr (Sched::GATHER) { unsigned _o[2]; _o[0] = (nextflag) ? nxtA[h][0] : curA[h][0]; _o[1] = (nextflag) ? nxtA[h][1] : curA[h][1]; PG8_STAGE(bufoff, Ab + (koff), _o); } \
        else { PG8_STAGE(bufoff, ((nextflag) ? nA : cA) + (size_t)(h) * hstep + (koff), voffA); } } while (0)
    PG8_STAGE(PG8_SB(0, 0), cB, voffB); PG8_STAGE(PG8_SB(0, 1), cB + hstep, voffB); PG8_STA(PG8_SA(0, 0), false, 0, 0); PG8_STA(PG8_SA(0, 1), false, 1, 0);
    if (wr == 1) PG8_BAR;
    PG8_WAIT_V(2); PG8_BAR;
    PG8_STAGE(PG8_SB(1, 0), cB + kstep, voffB); PG8_STA(PG8_SA(1, 0), false, 0, kstep); PG8_STAGE(PG8_SB(1, 1), cB + hstep + kstep, voffB);
    PG8_WAIT_V(6); PG8_BAR;
    for (;;) {
        const bool has_next = S.next(ui + 1, nxt);
        if constexpr (Sched::GATHER) {
            if (has_next) S.a_offsets(nxt, Rr, Cc, nxtA);
            else {
#pragma unroll
                for (int h = 0; h < 2; ++h)
#pragma unroll
                    for (int i = 0; i < 2; ++i) nxtA[h][i] = curA[h][i]; }
        } else nA = has_next ? Ab + (size_t)nxt.pm * 2 * hstep : cA;
        const char* nB = has_next ? S.b_base(nxt) : cB;
        for (int t = 0; t < nt; t += 2) {
            const bool last = (t == nt - 2);
            const size_t k1 = (size_t)(t + 1) * kstep, k2 = last ? 0 : (size_t)(t + 2) * kstep, k3 = k2 + kstep;
            const char* b2 = last ? nB : cB + (size_t)(t + 2) * kstep; const char* b3 = b2 + kstep;
            PG8_LDB(B0, 0, 0); PG8_LDB(B1, 0, 1); PG8_SCHED; PG8_LDA(At, 0, 0); PG8_STA(PG8_SA(1, 1), false, 1, k1);
            PG8_WAIT_V(8); PG8_WAIT_L(0); PG8_BAR; PG8_MMA(0, 0, At, B0); PG8_MMA(0, 1, At, B1); PG8_BAR; PG8_SCHED;
            PG8_LDA(At, 0, 1); PG8_STAGE(PG8_SB(0, 0), b2, voffB); PG8_STAGE(PG8_SB(0, 1), b2 + hstep, voffB); PG8_STA(PG8_SA(0, 0), last, 0, k2);
            PG8_WAIT_V(8); PG8_WAIT_L(0); PG8_BAR; PG8_MMA(1, 0, At, B0); PG8_MMA(1, 1, At, B1); PG8_BAR; PG8_SCHED;
            PG8_LDB(B0, 1, 0); PG8_LDB(B1, 1, 1); PG8_SCHED; PG8_LDA(At, 1, 0); PG8_STA(PG8_SA(0, 1), last, 1, k2);
            PG8_WAIT_V(8); PG8_WAIT_L(0); PG8_BAR; PG8_MMA(0, 0, At, B0); PG8_MMA(0, 1, At, B1); PG8_BAR; PG8_SCHED;
            PG8_LDA(At, 1, 1); PG8_STAGE(PG8_SB(1, 0), b3, voffB); PG8_STAGE(PG8_SB(1, 1), b3 + hstep, voffB); PG8_STA(PG8_SA(1, 0), last, 0, k3);
            PG8_WAIT_V(8); PG8_WAIT_L(0); PG8_BAR; PG8_MMA(1, 0, At, B0); PG8_MMA(1, 1, At, B1); PG8_BAR; PG8_SCHED;
        }
        if constexpr (ALIGN_EPI) { if (wr == 0) PG8_BAR; }
        if constexpr (DT == 1) asm volatile("s_nop 15\n\ts_nop 15" ::: "memory");
        E(acc, cur, wr, wc, fr, fq);
        if (!has_next) break;
#pragma unroll
        for (int a = 0; a < 2; ++a)
#pragma unroll
            for (int b = 0; b < 2; ++b)
#pragma unroll
                for (int m = 0; m < 4; ++m)
#pragma unroll
                    for (int n = 0; n < 2; ++n) acc[a][b][m][n] = (f32x4){0.f, 0.f, 0.f, 0.f};
        cur = nxt; cB = nB; cA = nA; ++ui;
        if constexpr (Sched::GATHER) {
#pragma unroll
            for (int h = 0; h < 2; ++h)
#pragma unroll
                for (int i = 0; i < 2; ++i) curA[h][i] = nxtA[h][i]; }
        if constexpr (ALIGN_EPI) { if (wr == 1) PG8_BAR; }
    }
    PG8_WAIT_V(0);
    if constexpr (!ALIGN_EPI) { if (wr == 0) PG8_BAR; }
    PG8_BAR;
#undef PG8_SA
#undef PG8_SB
#undef PG8_STAGE
#undef PG8_STA
#undef PG8_LDA
#undef PG8_LDB
#undef PG8_MMA
#undef PG8_LD32
#undef PG8_LO
#undef PG8_HI
#undef PG8_WAIT_V
#undef PG8_WAIT_L
#undef PG8_BAR
#undef PG8_SCHED
}
}

#define XB_TMO      128
#define XB_XCNT(j)  (256  + 64 * (j))
#define XB_XSUB(j)  (1280 + 64 * (j))
#define XB_XGEN(j)  (2304 + 64 * (j))
#define XB_TOP      3328
#define XB_TOPGEN   3392
#define XCD_BAR_WORDS 3456
#define XB_SPIN_CAP (1u << 18)
__device__ __forceinline__ unsigned xb_ld(unsigned* p)              { return __hip_atomic_load(p, __ATOMIC_RELAXED, __HIP_MEMORY_SCOPE_AGENT); }
__device__ __forceinline__ unsigned xb_add(unsigned* p, unsigned v) { return __hip_atomic_fetch_add(p, v, __ATOMIC_RELAXED, __HIP_MEMORY_SCOPE_AGENT); }
__device__ __forceinline__ unsigned xb_xcc_id() { return (unsigned)__builtin_amdgcn_s_getreg((3 << 11) | 20) & 0xFu; }
#define XB_SPIN(cond, bar) do { unsigned _sp = 0; while (cond) { __builtin_amdgcn_s_sleep(1); \
    if ((++_sp & 255u) == 0u) { if (xb_ld(&(bar)[XB_TMO])) break; if (_sp > XB_SPIN_CAP) { atomicAdd(&(bar)[XB_TMO], 1u); break; } } } } while (0)
struct XcdBarrier { unsigned* bar; unsigned x; volatile LAS unsigned* st; };
__device__ __forceinline__ XcdBarrier xcd_barrier_post(unsigned* bar, volatile LAS unsigned* st) {
    XcdBarrier b; b.bar = bar; b.x = xb_xcc_id(); b.st = st;
    if (threadIdx.x == 0) (void)xb_add(&bar[XB_XCNT(b.x)], 1u);
    return b;
}
__device__ __forceinline__ void xcd_barrier_complete(unsigned* bar, unsigned x, unsigned& nloc, unsigned& nx) {
    const unsigned G = gridDim.x * gridDim.y * gridDim.z;
    unsigned sum, cnt, mine, sp = 0u;
    for (;;) {
        sum = 0u; cnt = 0u; mine = 0u;
#pragma unroll
        for (unsigned j = 0; j < 16; ++j) { const unsigned c = xb_ld(&bar[XB_XCNT(j)]); sum += c; cnt += (c > 0u) ? 1u : 0u; mine = (j == x) ? c : mine; }
        if (sum == G) break;
        __builtin_amdgcn_s_sleep(1);
        if ((++sp & 255u) == 0u) { if (xb_ld(&bar[XB_TMO])) break; if (sp > XB_SPIN_CAP) { atomicAdd(&bar[XB_TMO], 1u); break; } }
    }
    nloc = mine > 0u ? mine : 1u; nx = cnt > 0u ? cnt : 1u;
}
__device__ __forceinline__ void xcd_barrier(const XcdBarrier& b) {
    asm volatile("s_waitcnt vmcnt(0)" ::: "memory");
    __syncthreads();
    if (threadIdx.x == 0) {
        unsigned* bar = b.bar;
        __builtin_amdgcn_s_waitcnt(0);
        unsigned nloc = b.st[0], nx = b.st[1];
        if (nloc == 0u) { xcd_barrier_complete(bar, b.x, nloc, nx); b.st[0] = nloc; b.st[1] = nx; }
        const unsigned old = xb_add(&bar[XB_XSUB(b.x)], 1u);
        const unsigned gen = old / nloc;
        if (old + 1u == (gen + 1u) * nloc) {
            __builtin_amdgcn_fence(__ATOMIC_RELEASE, "agent");
            asm volatile("s_waitcnt vmcnt(0)" ::: "memory");
            const unsigned og = xb_add(&bar[XB_TOP], 1u);
            const unsigned tg = og / nx;
            if (og + 1u == (tg + 1u) * nx) xb_add(&bar[XB_TOPGEN], 1u);
            else XB_SPIN(xb_ld(&bar[XB_TOPGEN]) == tg, bar);
            __builtin_amdgcn_fence(__ATOMIC_ACQUIRE, "agent");
            xb_add(&bar[XB_XGEN(b.x)], 1u);
            asm volatile("s_waitcnt vmcnt(0)" ::: "memory");
        } else {
            XB_SPIN(xb_ld(&bar[XB_XGEN(b.x)]) == gen, bar);
            __builtin_amdgcn_fence(__ATOMIC_ACQUIRE, "agent");
            asm volatile("s_waitcnt vmcnt(0)" ::: "memory");
        }
    }
    __syncthreads();
}

constexpr int RING_BYTES = 131072, LDSCTL_OFF = RING_BYTES, MISC_OFF = LDSCTL_OFF + 320, LDS_BYTES = 147456;
enum { IN_X = 0, IN_C, IN_ADAW, IN_ADAB, IN_GPREM, IN_GPOSTM, IN_GPREF, IN_GPOSTF, IN_WIN, IN_WOUT, IN_CONVW, IN_CONVB, IN_IGB, IN_FGB, IN_MNW, IN_SINK,
       IN_FG, IN_FU, IN_FD, IN_ROUTER, IN_MG, IN_MU, IN_MD, N_INPUTS };
struct Args { const float* in[N_INPUTS]; float* out; unsigned char* ws; int ph_lo, ph_hi; };
struct Frame {
    LAS unsigned char* lds; unsigned char* glds; unsigned* ctl; unsigned char* ws;
    int tid, lane, wave, G, gw, NGW;
};

__device__ __forceinline__ void p0_ada(Frame& F, const float* c, const float* ada_w, const float* ada_b, float* mod) {
    float* cond = (float*)F.glds;
    float* part = (float*)(F.glds + 65536);
    for (int i = F.tid; i < NB * D; i += NTHR) { const int b = i / D, k = i % D; cond[k * 8 + b] = silu_f(c[i]); }
    __syncthreads();
    const int cq = F.lane & 15, ks = F.lane >> 4;
    for (int u = blockIdx.x; u < 384; u += F.G) {
        const int l = u / 192, cb = u % 192;
        const float* W = ada_w + (size_t)l * D * 6 * D + cb * 64 + cq * 4;
        f32x4 acc[8];
#pragma unroll
        for (int b = 0; b < 8; ++b) acc[b] = (f32x4){0.f, 0.f, 0.f, 0.f};
        const int kbase = F.wave * 256 + ks;
#pragma unroll 4
        for (int it = 0; it < 64; ++it) {
            const int k = kbase + 4 * it;
            const f32x4 w = __builtin_nontemporal_load((const f32x4*)(W + (size_t)k * 6 * D));
            const f32x4 c0 = *(const f32x4*)(cond + k * 8), c1 = *(const f32x4*)(cond + k * 8 + 4);
            acc[0] += w * c0[0]; acc[1] += w * c0[1]; acc[2] += w * c0[2]; acc[3] += w * c0[3];
            acc[4] += w * c1[0]; acc[5] += w * c1[1]; acc[6] += w * c1[2]; acc[7] += w * c1[3];
        }
#pragma unroll
        for (int b = 0; b < 8; ++b)
#pragma unroll
            for (int j = 0; j < 4; ++j) { float v = acc[b][j]; v += __shfl_xor(v, 16); v += __shfl_xor(v, 32); acc[b][j] = v; }
        if (F.lane < 16) {
#pragma unroll
            for (int b = 0; b < 8; ++b) *(f32x4*)(part + (F.wave * 8 + b) * 64 + cq * 4) = acc[b];
        }
        __syncthreads();
        { const int b = F.tid >> 6, col = F.tid & 63; float s = ada_b[(size_t)l * 6 * D + cb * 64 + col];
#pragma unroll
          for (int w = 0; w < 8; ++w) s += part[(w * 8 + b) * 64 + col];
          mod[((size_t)l * NB + b) * 6 * D + cb * 64 + col] = s; }
        __syncthreads();
    }
}
__device__ __forceinline__ void cvt_item(const float* src, int ld, int k0, int c0, bf16_t* dst, int Kd, int drow0, unsigned char* scr, int lane) {
    const int c = lane & 15, q = lane >> 4;
    f32x4 v[4][4];
#pragma unroll
    for (int g = 0; g < 4; ++g)
#pragma unroll
        for (int j = 0; j < 4; ++j) v[g][j] = __builtin_nontemporal_load((const f32x4*)(src + (size_t)(k0 + 16 * g + 4 * q + j) * ld + c0 + 4 * c));
#pragma unroll
    for (int g = 0; g < 4; ++g)
#pragma unroll
        for (int i = 0; i < 4; ++i) { u32x2 w; w.x = cvtpk(v[g][0][i], v[g][1][i]); w.y = cvtpk(v[g][2][i], v[g][3][i]);
            *(u32x2*)(scr + (4 * c + i) * 136 + (16 * g + 4 * q) * 2) = w; }
    asm volatile("s_waitcnt lgkmcnt(0)" ::: "memory");
#pragma unroll
    for (int r = 0; r < 8; ++r) { const int n = 8 * r + (lane >> 3), ch = lane & 7;
        const u32x2 a = *(const u32x2*)(scr + n * 136 + ch * 16), b = *(const u32x2*)(scr + n * 136 + ch * 16 + 8);
        u32x4 o; o.x = a.x; o.y = a.y; o.z = b.x; o.w = b.y;
        *(u32x4*)(dst + (size_t)(drow0 + n) * Kd + k0 + 8 * ch) = o; }
    asm volatile("s_waitcnt lgkmcnt(0)" ::: "memory");
}
constexpr float WSC = 64.f, WSC_INV = 1.f / 64.f;
__device__ __forceinline__ void cvt_item8(const float* src, int ld, int k0, int c0, unsigned char* dst, int Kd, int drow0, unsigned char* scr, int lane) {
    const int c = lane & 7, q = lane >> 3;
    f32x4 v[4][4];
#pragma unroll
    for (int g = 0; g < 4; ++g)
#pragma unroll
        for (int j = 0; j < 4; ++j) v[g][j] = __builtin_nontemporal_load((const f32x4*)(src + (size_t)(k0 + 32 * g + 4 * q + j) * ld + c0 + 4 * c));
#pragma unroll
    for (int g = 0; g < 4; ++g)
#pragma unroll
        for (int i = 0; i < 4; ++i) *(unsigned*)(scr + (4 * c + i) * 132 + 32 * g + 4 * q) = pg8::pack_fp8x4(v[g][0][i] * WSC, v[g][1][i] * WSC, v[g][2][i] * WSC, v[g][3][i] * WSC);
    asm volatile("s_waitcnt lgkmcnt(0)" ::: "memory");
#pragma unroll
    for (int r = 0; r < 4; ++r) { const int n = 8 * r + (lane >> 3), ch = lane & 7; const unsigned char* p = scr + n * 132 + ch * 16;
        u32x4 o; o.x = *(const unsigned*)(p); o.y = *(const unsigned*)(p + 4); o.z = *(const unsigned*)(p + 8); o.w = *(const unsigned*)(p + 12);
        *(u32x4*)(dst + (size_t)(drow0 + n) * Kd + k0 + 16 * ch) = o; }
    asm volatile("s_waitcnt lgkmcnt(0)" ::: "memory");
}
__device__ __forceinline__ const float* inptr(const Frame& F, int i);
constexpr int CMS_KB = 2;
constexpr float CMS_F = 1.4f;
constexpr size_t COLMAX_OFF = 524288;
__device__ __forceinline__ void colmax_item(const float* src, int ld, int k0, int c0, float* cmx  , int lane) {
    const int c = lane & 7, q = lane >> 3;
    f32x4 mx = (f32x4){0.f, 0.f, 0.f, 0.f};
#pragma unroll
    for (int g = 0; g < 4; ++g)
#pragma unroll
        for (int j = 0; j < 4; ++j) { const f32x4 v = *(const f32x4*)(src + (size_t)(k0 + 32 * g + 4 * q + j) * ld + c0 + 4 * c);
            mx[0] = fmaxf(mx[0], fabsf(v[0])); mx[1] = fmaxf(mx[1], fabsf(v[1])); mx[2] = fmaxf(mx[2], fabsf(v[2])); mx[3] = fmaxf(mx[3], fabsf(v[3])); }
#pragma unroll
    for (int i = 0; i < 4; ++i) { float v = mx[i]; v = fmaxf(v, __shfl_xor(v, 8)); v = fmaxf(v, __shfl_xor(v, 16)); v = fmaxf(v, __shfl_xor(v, 32)); mx[i] = v; }
    if (q == 0) {
#pragma unroll
        for (int i = 0; i < 4; ++i) atomicMax((unsigned*)(cmx + 4 * c + i), __float_as_uint(mx[i] * CMS_F)); }
}
__device__ __forceinline__ unsigned pack_i8x4(float a, float b, float c, float d) {
    const int ia = (int)rintf(fminf(fmaxf(a, -127.f), 127.f)), ib = (int)rintf(fminf(fmaxf(b, -127.f), 127.f)), ic = (int)rintf(fminf(fmaxf(c, -127.f), 127.f)), id = (int)rintf(fminf(fmaxf(d, -127.f), 127.f));
    return (unsigned)(ia & 0xff) | ((unsigned)(ib & 0xff) << 8) | ((unsigned)(ic & 0xff) << 16) | ((unsigned)(id & 0xff) << 24);
}
__device__ __forceinline__ void cvt_item_i8(const float* src, int ld, int k0, int c0, unsigned char* dst, int Kd, int drow0, const float* cmx  , unsigned char* scr, int lane) {
    const int c = lane & 7, q = lane >> 3;
    const f32x4 cm = *(const f32x4*)(cmx + 4 * c);
    f32x4 inv; inv[0] = cm[0] > 0.f ? 127.f / cm[0] : 0.f; inv[1] = cm[1] > 0.f ? 127.f / cm[1] : 0.f; inv[2] = cm[2] > 0.f ? 127.f / cm[2] : 0.f; inv[3] = cm[3] > 0.f ? 127.f / cm[3] : 0.f;
    f32x4 v[4][4];
#pragma unroll
    for (int g = 0; g < 4; ++g)
#pragma unroll
        for (int j = 0; j < 4; ++j) v[g][j] = __builtin_nontemporal_load((const f32x4*)(src + (size_t)(k0 + 32 * g + 4 * q + j) * ld + c0 + 4 * c));
#pragma unroll
    for (int g = 0; g < 4; ++g)
#pragma unroll
        for (int i = 0; i < 4; ++i) *(unsigned*)(scr + (4 * c + i) * 132 + 32 * g + 4 * q) = pack_i8x4(v[g][0][i] * inv[i], v[g][1][i] * inv[i], v[g][2][i] * inv[i], v[g][3][i] * inv[i]);
    asm volatile("s_waitcnt lgkmcnt(0)" ::: "memory");
#pragma unroll
    for (int r = 0; r < 4; ++r) { const int n = 8 * r + (lane >> 3), ch = lane & 7; const unsigned char* p = scr + n * 132 + ch * 16;
        u32x4 o; o.x = *(const unsigned*)(p); o.y = *(const unsigned*)(p + 4); o.z = *(const unsigned*)(p + 8); o.w = *(const unsigned*)(p + 12);
        *(u32x4*)(dst + (size_t)(drow0 + n) * Kd + k0 + 16 * ch) = o; }
    asm volatile("s_waitcnt lgkmcnt(0)" ::: "memory");
}
constexpr int CI_WI = 16 * 152  , CI_WO = 16 * 64, CI_FD = 44 * 64, CI_FGU = 2 * 16 * 176, CI_MD = 8 * 22 * 64, CI_MGU = 16 * 16 * 88;
constexpr int CS_WI = CMS_KB * 152, CS_FGU = 2 * CMS_KB * 176, CS_MGU = 16 * CMS_KB * 88;
constexpr int CONV_N0 = CS_WI + CI_WO + CI_FD + CS_FGU, CONV_N1 = CI_WI + CI_FGU, CONV_N2 = CS_WI + CI_WO + CI_MD + CS_MGU, CONV_N3 = CI_MGU, CONV_N4 = CI_WI;
constexpr int CMX_WIN = 2 * DFF + 16 * DFE;
template <int GRP>
__device__ __forceinline__ void conv_item(Frame& F, int r) {
    unsigned char* scr = F.glds + F.wave * 8704; unsigned char* ws = F.ws;
    float* cmx = (float*)(ws + WS_CTL + COLMAX_OFF);
    if (GRP == 0 || GRP == 1 || GRP == 2 || GRP == 4) {
        constexpr int l = (GRP == 2 || GRP == 4) ? 1 : 0;
        constexpr bool QUANT = (GRP == 1 || GRP == 4); constexpr int NI = QUANT ? CI_WI : CS_WI;
        if (r < NI) { const int kb = r / 152, nb = r % 152, c0 = (nb < 112) ? nb * 32 : SRC_GATE + 8 + (nb - 112) * 32, drow = nb * 32;
            if (QUANT) cvt_item_i8(inptr(F, IN_WIN) + (size_t)l * D * NIN_SRC, NIN_SRC, kb * 128, c0, ws + WS_WIN + (size_t)l * NIN * D, D, drow, cmx + CMX_WIN + l * NIN + drow, scr, F.lane);
            else colmax_item(inptr(F, IN_WIN) + (size_t)l * D * NIN_SRC, NIN_SRC, kb * 128, c0, cmx + CMX_WIN + l * NIN + drow, F.lane);
            return; }
        r -= NI;
    }
    if (GRP == 0 || GRP == 2) {
        constexpr int l = (GRP == 2) ? 1 : 0;
        if (r < CI_WO) { const int kb = r / 64, nb = r % 64;
            cvt_item8(inptr(F, IN_WOUT) + (size_t)l * D * D, D, kb * 128, nb * 32, ws + WS_WOUT + (size_t)l * D * D, D, nb * 32, scr, F.lane); return; }
        r -= CI_WO;
        if (GRP == 0) {
            if (r < CI_FD) { const int kb = r / 64, nb = r % 64; cvt_item8(inptr(F, IN_FD), D, kb * 128, nb * 32, ws + WS_WD, DFF, nb * 32, scr, F.lane); return; }
            r -= CI_FD;
        } else {
            if (r < CI_MD) { const int e = r / (22 * 64); r %= (22 * 64); const int kb = r / 64, nb = r % 64;
                cvt_item8(inptr(F, IN_MD) + (size_t)e * DFE * D, D, kb * 128, nb * 32, ws + WS_MD + (size_t)e * D * DFE, DFE, nb * 32, scr, F.lane); return; }
            r -= CI_MD;
        }
    }
    if (GRP == 0 || GRP == 1) { constexpr int KBN = (GRP == 1) ? 16 : CMS_KB, I_F = KBN * 176; const int up = r / I_F; r %= I_F; const int kb = r / 176, nb = r % 176, n0 = nb * 32, drow = (n0 >> 7) * 256 + up * 128 + (n0 & 127);
        if (GRP == 1) cvt_item_i8(inptr(F, up ? IN_FU : IN_FG), DFF, kb * 128, n0, ws + WS_WGU, D, drow, cmx + drow, scr, F.lane);
        else colmax_item(inptr(F, up ? IN_FU : IN_FG), DFF, kb * 128, n0, cmx + drow, F.lane); }
    else { constexpr int KBN = (GRP == 3) ? 16 : CMS_KB, I_E = KBN * 88; const int up = r / (8 * I_E); r %= (8 * I_E); const int e = r / I_E; r %= I_E; const int kb = r / 88, nb = r % 88, n0 = nb * 32, drow = (n0 >> 7) * 256 + up * 128 + (n0 & 127);
        if (GRP == 3) cvt_item_i8(inptr(F, up ? IN_MU : IN_MG) + (size_t)e * D * DFE, DFE, kb * 128, n0, ws + WS_MGU + (size_t)e * 2 * DFE * D, D, drow, cmx + 2 * DFF + e * 2 * DFE + drow, scr, F.lane);
        else colmax_item(inptr(F, up ? IN_MU : IN_MG) + (size_t)e * D * DFE, DFE, kb * 128, n0, cmx + 2 * DFF + e * 2 * DFE + drow, F.lane); }
}
template <int GRP>
__device__ __forceinline__ void conv_all(Frame& F, int first = 0) {
    constexpr int N = (GRP == 0) ? CONV_N0 : (GRP == 1) ? CONV_N1 : (GRP == 2) ? CONV_N2 : (GRP == 3) ? CONV_N3 : CONV_N4;
    for (int it = first + F.gw; it < N; it += F.NGW) conv_item<GRP>(F, it);
}
template <int YMODE, int EXTRA, bool NORM_OUT, bool XN8  , bool XIN_BF = false  , bool XOUT_BF = false  >
__device__ __forceinline__ void row_phase(Frame& F, const float* xin, float* xout, const bf16_t* ybuf, const float* gpost, const float* gt  ,
                                          const float* gpre, const float* sc, const float* sh, bf16_t* XN,
                                          const float* wex, int ldw, const float* bi, const float* bfg, float* gates_out,
                                          const uint4* tok_in, uint4* tok_out, int* idx_out, unsigned* cntw, float* rowmax = nullptr) {
    LAS float* we = (LAS float*)F.lds;
    LAS float* vA = (LAS float*)(F.lds + 65536);
    LAS float* vB = (LAS float*)(F.lds + 73728);
    LAS float* vC = (LAS float*)(F.lds + 81920);
    LAS float* route = (LAS float*)(F.lds + 90112);
    LAS int* routei = (LAS int*)route;
    LAS int* cumt = (LAS int*)(F.lds + 90112 + 2048);
    if (EXTRA) {
        for (int k = F.tid; k < D; k += NTHR) { const f32x4 a = *(const f32x4*)(wex + (size_t)k * ldw), b = *(const f32x4*)(wex + (size_t)k * ldw + 4);
            we[0 * D + k] = a[0]; we[1 * D + k] = a[1]; we[2 * D + k] = a[2]; we[3 * D + k] = a[3]; we[4 * D + k] = b[0]; we[5 * D + k] = b[1]; we[6 * D + k] = b[2]; we[7 * D + k] = b[3]; }
    }
    if (YMODE == 2) { if (F.tid == 0) { int cum = 0; for (int e = 0; e < NE; ++e) { cumt[e] = cum; cum += (int)((__hip_atomic_load(cntw + e, __ATOMIC_RELAXED, __HIP_MEMORY_SCOPE_AGENT) + 255u) >> 8); } } }
    for (int blk = blockIdx.x; blk < M / 64; blk += F.G) {
        const int b = (blk * 64) / SEQ;
        __syncthreads();
        { const int col = 4 * F.tid;
            if (YMODE) { const f32x4 g = *(const f32x4*)(gt + (size_t)b * 6 * D + col), p = *(const f32x4*)(gpost + col); *(LAS f32x4*)(vA + col) = g * p; }
            if (NORM_OUT) { const f32x4 g = *(const f32x4*)(gpre + col), s = *(const f32x4*)(sc + (size_t)b * 6 * D + col); *(LAS f32x4*)(vB + col) = g * (1.f + s); *(LAS f32x4*)(vC + col) = *(const f32x4*)(sh + (size_t)b * 6 * D + col); } }
        __syncthreads();
        f32x4 xr[8]; u32x2 xrb[8], yr[8], yr2[8]; float w1n = 0.f, w2n = 0.f;
#define RP_LOAD(rr_) do { const size_t row_ = (size_t)blk * 64 + F.wave * 8 + (((rr_) + blk) & 7);   \
            if (XIN_BF) { _Pragma("unroll") for (int j = 0; j < 8; ++j) xrb[j] = __builtin_nontemporal_load((const u32x2*)((const bf16_t*)xin + row_ * D + 256 * j + 4 * F.lane)); } \
            else { _Pragma("unroll") for (int j = 0; j < 8; ++j) xr[j] = __builtin_nontemporal_load((const f32x4*)(xin + row_ * D + 256 * j + 4 * F.lane)); } \
            if (YMODE == 1) { _Pragma("unroll") for (int j = 0; j < 8; ++j) yr[j] = __builtin_nontemporal_load((const u32x2*)(ybuf + row_ * D + 256 * j + 4 * F.lane)); } \
            if (YMODE == 2) { const uint4 ti = tok_in[row_]; \
                const int e1 = (int)(ti.x >> 16), k1 = (int)(ti.x & 0xffffu), e2 = (int)(ti.y >> 16), k2 = (int)(ti.y & 0xffffu); \
                const size_t r1 = (size_t)cumt[e1] * 256 + k1, r2 = (size_t)cumt[e2] * 256 + k2; w1n = __uint_as_float(ti.z); w2n = __uint_as_float(ti.w); \
                _Pragma("unroll") for (int j = 0; j < 8; ++j) { yr[j] = __builtin_nontemporal_load((const u32x2*)(ybuf + r1 * D + 256 * j + 4 * F.lane)); yr2[j] = __builtin_nontemporal_load((const u32x2*)(ybuf + r2 * D + 256 * j + 4 * F.lane)); } } } while (0)
        RP_LOAD(0);
#pragma unroll 1
        for (int rr = 0; rr < 8; ++rr) {
            const int rl = F.wave * 8 + ((rr + blk) & 7); const size_t row = (size_t)blk * 64 + rl;
            asm volatile("" ::: "memory");
            f32x4 x[8];
#pragma unroll
            for (int j = 0; j < 8; ++j) x[j] = XIN_BF ? (f32x4){bflo(xrb[j].x), bfhi(xrb[j].x), bflo(xrb[j].y), bfhi(xrb[j].y)} : xr[j];
            f32x4 y[8];
            if (YMODE == 1) {
#pragma unroll
                for (int j = 0; j < 8; ++j) y[j] = (f32x4){bflo(yr[j].x), bfhi(yr[j].x), bflo(yr[j].y), bfhi(yr[j].y)};
            }
            if (YMODE == 2) {
#pragma unroll
                for (int j = 0; j < 8; ++j) y[j] = (f32x4){bflo(yr[j].x), bfhi(yr[j].x), bflo(yr[j].y), bfhi(yr[j].y)} * w1n + (f32x4){bflo(yr2[j].x), bfhi(yr2[j].x), bflo(yr2[j].y), bfhi(yr2[j].y)} * w2n;
            }
            if (rr < 7) RP_LOAD(rr + 1);
            if (YMODE) {
                float ss = 0.f;
#pragma unroll
                for (int j = 0; j < 8; ++j) ss += (y[j][0] * y[j][0] + y[j][1] * y[j][1]) + (y[j][2] * y[j][2] + y[j][3] * y[j][3]);
                const float r = 1.f / sqrtf(wave_sum(ss) * (1.f / D) + RMS_EPS);
#pragma unroll
                for (int j = 0; j < 8; ++j) { x[j] += *(const LAS f32x4*)(vA + 256 * j + 4 * F.lane) * (y[j] * r);
                    if (XOUT_BF) { u32x2 w; w.x = cvtpk(x[j][0], x[j][1]); w.y = cvtpk(x[j][2], x[j][3]); *(u32x2*)((bf16_t*)xout + row * D + 256 * j + 4 * F.lane) = w; }
                    else __builtin_nontemporal_store(x[j], (f32x4*)(xout + row * D + 256 * j + 4 * F.lane)); }
            }
            if (NORM_OUT) {
                float ss = 0.f;
#pragma unroll
                for (int j = 0; j < 8; ++j) ss += (x[j][0] * x[j][0] + x[j][1] * x[j][1]) + (x[j][2] * x[j][2] + x[j][3] * x[j][3]);
                const float r = 1.f / sqrtf(wave_sum(ss) * (1.f / D) + RMS_EPS);
#pragma unroll
                for (int j = 0; j < 8; ++j) x[j] = (x[j] * r) * *(const LAS f32x4*)(vB + 256 * j + 4 * F.lane) + *(const LAS f32x4*)(vC + 256 * j + 4 * F.lane);
                if (XN8) {
                    float am = 0.f;
#pragma unroll
                    for (int j = 0; j < 8; ++j) am = fmaxf(fmaxf(am, fmaxf(fabsf(x[j][0]), fabsf(x[j][1]))), fmaxf(fabsf(x[j][2]), fabsf(x[j][3])));
                    am = wave_max(am);
                    const float inv = am > 0.f ? 127.f / am : 0.f;
                    if (F.lane == 0) { rowmax[row] = am; if (EXTRA == 2) route[384 + rl] = am; }
#pragma unroll
                    for (int j = 0; j < 8; ++j) *(unsigned*)((unsigned char*)XN + row * D + 256 * j + 4 * F.lane) = pack_i8x4(x[j][0] * inv, x[j][1] * inv, x[j][2] * inv, x[j][3] * inv);
                } else {
#pragma unroll
                    for (int j = 0; j < 8; ++j) { u32x2 w; w.x = cvtpk(x[j][0], x[j][1]); w.y = cvtpk(x[j][2], x[j][3]); *(u32x2*)(XN + row * D + 256 * j + 4 * F.lane) = w; }
                }
                if (EXTRA) {
                    float d8[8];
#pragma unroll
                    for (int e = 0; e < 8; ++e) { float s = 0.f;
#pragma unroll
                        for (int j = 0; j < 8; ++j) { const f32x4 w = *(const LAS f32x4*)(we + e * D + 256 * j + 4 * F.lane); s += (x[j][0] * w[0] + x[j][1] * w[1]) + (x[j][2] * w[2] + x[j][3] * w[3]); }
                        d8[e] = wave_sum(s); asm volatile("" ::: "memory"); }
                    if (EXTRA == 1) {
                        float v = 0.f;
#pragma unroll
                        for (int e = 0; e < 8; ++e) v = (F.lane == e) ? d8[e] : v;
                        if (F.lane < 8) { const float bb = (F.lane < 4) ? bi[F.lane] : bfg[F.lane - 4]; const float z = 15.f * tanhf((v + bb) * (1.f / 15.f));
                            const float o = (F.lane < 4) ? z : (fminf(z, 0.f) - log1pf(expf(-fabsf(z)))); gates_out[row * 8 + F.lane] = o; }
                    } else {
                        int e1 = 0; float v1 = d8[0];
#pragma unroll
                        for (int e = 1; e < 8; ++e) if (d8[e] > v1) { v1 = d8[e]; e1 = e; }
                        int e2 = -1; float v2 = -3.0e38f;
#pragma unroll
                        for (int e = 0; e < 8; ++e) if (e != e1 && d8[e] > v2) { v2 = d8[e]; e2 = e; }
                        const float w1 = 1.f / (1.f + expf(v2 - v1));
                        if (F.lane == 0) { routei[rl * 4 + 0] = e1; routei[rl * 4 + 1] = e2; route[rl * 4 + 2] = w1; route[rl * 4 + 3] = 1.f - w1; }
                    }
                }
            }
        }
#undef RP_LOAD
        if (EXTRA == 2) {
            __syncthreads();
            if (F.tid < NE) { const int e = F.tid; int c = 0;
                for (int r = 0; r < 64; ++r) c += (routei[r * 4] == e) + (routei[r * 4 + 1] == e);
                int base = (int)__hip_atomic_fetch_add(cntw + e, (unsigned)c, __ATOMIC_RELAXED, __HIP_MEMORY_SCOPE_AGENT);
                float* rms = rowmax + (WS_RMSLOT - WS_ROWMAX) / 4;
                for (int r = 0; r < 64; ++r) { if (routei[r * 4] == e) { idx_out[e * ECAP + base] = blk * 64 + r; rms[e * ECAP + base] = route[384 + r]; routei[256 + r * 2] = base; ++base; }
                                               if (routei[r * 4 + 1] == e) { idx_out[e * ECAP + base] = blk * 64 + r; rms[e * ECAP + base] = route[384 + r]; routei[256 + r * 2 + 1] = base; ++base; } } }
            __syncthreads();
            if (F.tid < 64) { const int r = F.tid; uint4 ti; ti.x = ((unsigned)routei[r * 4] << 16) | (unsigned)routei[256 + r * 2]; ti.y = ((unsigned)routei[r * 4 + 1] << 16) | (unsigned)routei[256 + r * 2 + 1];
                ti.z = __float_as_uint(route[r * 4 + 2]); ti.w = __float_as_uint(route[r * 4 + 3]); tok_out[(size_t)blk * 64 + r] = ti; }
        }
    }
    __syncthreads();
}

namespace att {
constexpr int KROW = 144, VROW = 520, K_OFF = 0, V_OFF = 256 * KROW, KM_OFF = V_OFF + 64 * VROW;
constexpr float C2 = 0.125f * 1.4426950408889634f, NEG = -3.0e38f;
__device__ __forceinline__ void stage_kv(LAS unsigned char* lds, const bf16_t* kcol, const bf16_t* vcol, size_t grow0, int nk, int kc0, int tid) {
    for (int c = tid; c < nk * 8; c += NTHR) { const int key = c >> 3, part = c & 7;
        const u32x4 v = *(const u32x4*)(kcol + (grow0 + key) * NIN + part * 8);
        *(LAS u32x4*)(lds + K_OFF + (kc0 + key) * KROW + part * 16) = v; }
    const int np = nk >> 1;
    for (int it = tid; it < np * 8; it += NTHR) { const int kp = it % np, dp = it / np;
        const u32x4 a = *(const u32x4*)(vcol + (grow0 + 2 * kp) * NIN + dp * 8), b = *(const u32x4*)(vcol + (grow0 + 2 * kp + 1) * NIN + dp * 8);
        LAS unsigned char* dst = lds + V_OFF + (dp * 8) * VROW + (kc0 + 2 * kp) * 2;
        *(LAS unsigned*)(dst + 0 * VROW) = (a.x & 0xffffu) | (b.x << 16); *(LAS unsigned*)(dst + 1 * VROW) = (a.x >> 16) | (b.x & 0xffff0000u);
        *(LAS unsigned*)(dst + 2 * VROW) = (a.y & 0xffffu) | (b.y << 16); *(LAS unsigned*)(dst + 3 * VROW) = (a.y >> 16) | (b.y & 0xffff0000u);
        *(LAS unsigned*)(dst + 4 * VROW) = (a.z & 0xffffu) | (b.z << 16); *(LAS unsigned*)(dst + 5 * VROW) = (a.z >> 16) | (b.z & 0xffff0000u);
        *(LAS unsigned*)(dst + 6 * VROW) = (a.w & 0xffffu) | (b.w << 16); *(LAS unsigned*)(dst + 7 * VROW) = (a.w >> 16) | (b.w & 0xffff0000u); }
}
struct KVRegs { u32x4 k[4], va[2], vb[2]; };
__device__ __forceinline__ void kv_load(KVRegs& R, const bf16_t* kcol, const bf16_t* vcol, size_t grow0, int tid) {
#pragma unroll
    for (int i = 0; i < 4; ++i) { const int c = tid + i * NTHR, key = c >> 3, part = c & 7; R.k[i] = *(const u32x4*)(kcol + (grow0 + key) * NIN + part * 8); }
#pragma unroll
    for (int i = 0; i < 2; ++i) { const int it = tid + i * NTHR, kp = it & 127, dp = it >> 7;
        R.va[i] = *(const u32x4*)(vcol + (grow0 + 2 * kp) * NIN + dp * 8); R.vb[i] = *(const u32x4*)(vcol + (grow0 + 2 * kp + 1) * NIN + dp * 8); }
}
__device__ __forceinline__ void kv_store(LAS unsigned char* lds, const KVRegs& R, int tid) {
#pragma unroll
    for (int i = 0; i < 4; ++i) { const int c = tid + i * NTHR, key = c >> 3, part = c & 7; *(LAS u32x4*)(lds + K_OFF + key * KROW + part * 16) = R.k[i]; }
#pragma unroll
    for (int i = 0; i < 2; ++i) { const int it = tid + i * NTHR, kp = it & 127, dp = it >> 7; const u32x4 a = R.va[i], b = R.vb[i];
        LAS unsigned char* dst = lds + V_OFF + (dp * 8) * VROW + (2 * kp) * 2;
        *(LAS unsigned*)(dst + 0 * VROW) = (a.x & 0xffffu) | (b.x << 16); *(LAS unsigned*)(dst + 1 * VROW) = (a.x >> 16) | (b.x & 0xffff0000u);
        *(LAS unsigned*)(dst + 2 * VROW) = (a.y & 0xffffu) | (b.y << 16); *(LAS unsigned*)(dst + 3 * VROW) = (a.y >> 16) | (b.y & 0xffff0000u);
        *(LAS unsigned*)(dst + 4 * VROW) = (a.z & 0xffffu) | (b.z << 16); *(LAS unsigned*)(dst + 5 * VROW) = (a.z >> 16) | (b.z & 0xffff0000u);
        *(LAS unsigned*)(dst + 6 * VROW) = (a.w & 0xffffu) | (b.w << 16); *(LAS unsigned*)(dst + 7 * VROW) = (a.w >> 16) | (b.w & 0xffff0000u); }
}
struct State { f32x16 o0, o1, negm; float m, l; };
constexpr float THR = 5.f, M0 = -1000.f;
__device__ __forceinline__ void init(State& st) {
#pragma unroll
    for (int r = 0; r < 16; ++r) { st.o0[r] = 0.f; st.o1[r] = 0.f; st.negm[r] = -M0; }
    st.m = M0; st.l = 0.f;
}
__device__ __forceinline__ float xhalf_max(float v) { auto rr = __builtin_amdgcn_permlane32_swap(__float_as_uint(v), __float_as_uint(v), false, false); return fmaxf(__uint_as_float(rr[0]), __uint_as_float(rr[1])); }
__device__ __forceinline__ float xhalf_sum(float v) { auto rr = __builtin_amdgcn_permlane32_swap(__float_as_uint(v), __float_as_uint(v), false, false); return __uint_as_float(rr[0]) + __uint_as_float(rr[1]); }
__device__ __forceinline__ void block_mask(State& st, bool lane_ok) {
#pragma unroll
    for (int r = 0; r < 16; ++r) st.negm[r] = lane_ok ? -st.m : NEG;
}
template <int MODE>
__device__ __forceinline__ void tile(LAS unsigned char* lds, int kt, const bf16x8 (&qf)[4], State& st, int lane) {
    const int r32 = lane & 31, h = lane >> 5;
    f32x16 S;
    if (MODE == 3) S = st.negm;
    else {
#pragma unroll
        for (int r = 0; r < 16; ++r) { const int ko = (r & 3) + 8 * (r >> 2) + 4 * h; const bool ok = (MODE == 1) ? (ko <= r32) : (ko > r32); S[r] = ok ? st.negm[r] : NEG; } }
    const LAS unsigned char* kp = lds + K_OFF + (kt * 32 + r32) * KROW + h * 16;
#pragma unroll
    for (int s = 0; s < 4; ++s) { const bf16x8 a = *(const LAS bf16x8*)(kp + s * 32); S = __builtin_amdgcn_mfma_f32_32x32x16_bf16(a, qf[s], S, 0, 0, 0); }
    float tmax;
    asm volatile("s_nop 15\n\ts_nop 7" : "+v"(S));
    { float m0, m1, m2, m3, m4;
      asm("v_max3_f32 %0, %1, %2, %3" : "=v"(m0) : "v"(S[0]), "v"(S[1]), "v"(S[2]));    asm("v_max3_f32 %0, %1, %2, %3" : "=v"(m1) : "v"(S[3]), "v"(S[4]), "v"(S[5]));
      asm("v_max3_f32 %0, %1, %2, %3" : "=v"(m2) : "v"(S[6]), "v"(S[7]), "v"(S[8]));    asm("v_max3_f32 %0, %1, %2, %3" : "=v"(m3) : "v"(S[9]), "v"(S[10]), "v"(S[11]));
      asm("v_max3_f32 %0, %1, %2, %3" : "=v"(m4) : "v"(S[12]), "v"(S[13]), "v"(S[14])); asm("v_max3_f32 %0, %1, %2, %3" : "=v"(m0) : "v"(m0), "v"(m1), "v"(S[15]));
      asm("v_max3_f32 %0, %1, %2, %3" : "=v"(m2) : "v"(m2), "v"(m3), "v"(m4));          asm("v_max_f32 %0, %1, %2" : "=v"(tmax) : "v"(m0), "v"(m2)); }
    tmax = xhalf_max(tmax);
    if (__any(tmax > THR)) {
        const float d = tmax > THR ? tmax : 0.f, alpha = __builtin_amdgcn_exp2f(-d);
        st.m += d; st.l *= alpha;
#pragma unroll
        for (int r = 0; r < 16; ++r) { S[r] -= d; st.negm[r] -= d; st.o0[r] *= alpha; st.o1[r] *= alpha; }
    }
    float ls0 = 0.f, ls1 = 0.f;
#pragma unroll
    for (int r = 0; r < 16; r += 2) { const float p0 = __builtin_amdgcn_exp2f(S[r]), p1 = __builtin_amdgcn_exp2f(S[r + 1]); S[r] = p0; S[r + 1] = p1; ls0 += p0; ls1 += p1; }
    st.l += ls0 + ls1;
    const LAS unsigned char* vp = lds + V_OFF + r32 * VROW + kt * 64 + h * 8;
#pragma unroll
    for (int s = 0; s < 2; ++s) {
        u32x4 pw; pw.x = cvtpk(S[8 * s + 0], S[8 * s + 1]); pw.y = cvtpk(S[8 * s + 2], S[8 * s + 3]); pw.z = cvtpk(S[8 * s + 4], S[8 * s + 5]); pw.w = cvtpk(S[8 * s + 6], S[8 * s + 7]);
        const bf16x8 pf = __builtin_bit_cast(bf16x8, pw);
        { const u32x2 lo = *(const LAS u32x2*)(vp + s * 32), hi = *(const LAS u32x2*)(vp + s * 32 + 16); u32x4 aw; aw.x = lo.x; aw.y = lo.y; aw.z = hi.x; aw.w = hi.y;
          st.o0 = __builtin_amdgcn_mfma_f32_32x32x16_bf16(__builtin_bit_cast(bf16x8, aw), pf, st.o0, 0, 0, 0); }
        { const u32x2 lo = *(const LAS u32x2*)(vp + 32 * VROW + s * 32), hi = *(const LAS u32x2*)(vp + 32 * VROW + s * 32 + 16); u32x4 aw; aw.x = lo.x; aw.y = lo.y; aw.z = hi.x; aw.w = hi.y;
          st.o1 = __builtin_amdgcn_mfma_f32_32x32x16_bf16(__builtin_bit_cast(bf16x8, aw), pf, st.o1, 0, 0, 0); }
    }
}
constexpr float YSC = 16.f;
__device__ __forceinline__ void store_out(const State& st, float inv, unsigned char* orow  , int lane) {
    const int h = lane >> 5;
#pragma unroll
    for (int g = 0; g < 4; ++g) {
        *(unsigned*)(orow + 8 * g + 4 * h) = pg8::pack_fp8x4(st.o0[4 * g] * inv, st.o0[4 * g + 1] * inv, st.o0[4 * g + 2] * inv, st.o0[4 * g + 3] * inv);
        *(unsigned*)(orow + 32 + 8 * g + 4 * h) = pg8::pack_fp8x4(st.o1[4 * g] * inv, st.o1[4 * g + 1] * inv, st.o1[4 * g + 2] * inv, st.o1[4 * g + 3] * inv); }
}
__device__ __forceinline__ void moba_unit(Frame& F, const bf16_t* proj, const float* kmean, unsigned char* Y, int b, int h, int j) {
    LAS unsigned char* lds = F.lds; const int lane = F.lane, r32 = lane & 31, hh = lane >> 5, w = F.wave;
    const size_t rb = (size_t)b * SEQ; const int t = j * 256 + w * 32 + r32;
    bf16x8 qf[4];
    { const bf16_t* qrow = proj + (rb + t) * NIN + C_MQ + h * 64 + hh * 8;
#pragma unroll
      for (int s = 0; s < 4; ++s) qf[s] = *(const bf16x8*)(qrow + s * 16); }
    LBAR();
    LAS float* km = (LAS float*)(lds + KM_OFF);
    if (F.tid < j * 64) km[F.tid] = kmean[(size_t)(b * 8 + (F.tid >> 6)) * 512 + h * 64 + (F.tid & 63)];
    LBAR();
    unsigned sel;
    if (j <= 3) sel = (1u << j) - 1u;
    else {
        float g[7];
#pragma unroll
        for (int n = 0; n < 7; ++n) { g[n] = NEG;
            if (n < j) { float a = 0.f;
#pragma unroll
                for (int s = 0; s < 4; ++s)
#pragma unroll
                    for (int jj = 0; jj < 8; ++jj) a += bf1((bf16_t)qf[s][jj]) * km[n * 64 + 16 * s + 8 * hh + jj];
                a += __shfl_xor(a, 32); g[n] = a; } }
        sel = 0u;
#pragma unroll
        for (int r = 0; r < 3; ++r) { float best = NEG; int bi = 0;
#pragma unroll
            for (int n = 0; n < 7; ++n) if (n < j && !((sel >> n) & 1u) && g[n] > best) { best = g[n]; bi = n; }
            sel |= 1u << bi; }
    }
    State st; init(st);
    const bf16_t* kcol = proj + C_MK + h * 64; const bf16_t* vcol = proj + C_MV + h * 64;
    KVRegs R; kv_load(R, kcol, vcol, rb, F.tid);
    for (int n = 0; n <= j; ++n) {
        LBAR();
        kv_store(lds, R, F.tid);
        if (n < j) kv_load(R, kcol, vcol, rb + (size_t)(n + 1) * 256, F.tid);
        LBAR();
        if (n < j) { const bool ok = (sel >> n) & 1u;
            if (__any(ok)) { block_mask(st, ok); for (int kt = 0; kt < 8; ++kt) tile<3>(lds, kt, qf, st, lane); } }
        else { block_mask(st, true); for (int kt = 0; kt < w; ++kt) tile<3>(lds, kt, qf, st, lane);
               tile<1>(lds, w, qf, st, lane); }
    }
    const float lt = xhalf_sum(st.l);
    store_out(st, YSC / lt, Y + (rb + t) * D + h * 64, lane);
}
__device__ __forceinline__ void swa_unit(Frame& F, const bf16_t* proj, const float* sinks, unsigned char* Y, int b, int kvh, int qb) {
    LAS unsigned char* lds = F.lds; int lane = F.lane; asm volatile("" : "+v"(lane));
    const int r32 = lane & 31, hh = lane >> 5, w = F.wave, hq = kvh * 8 + w;
    const size_t rb = (size_t)b * SEQ;
    const bf16_t* kcol = proj + C_SK + kvh * 64; const bf16_t* vcol = proj + C_SV + kvh * 64;
    LBAR();
    if (qb > 0) stage_kv(lds, kcol, vcol, rb + (size_t)qb * 128 - 128, 256, 0, F.tid);
    else        stage_kv(lds, kcol, vcol, rb, 128, 128, F.tid);
    LBAR();
    const float sk = sinks[hq] * 1.4426950408889634f;
    for (int sb = 0; sb < 4; ++sb) {
        const int t = qb * 128 + sb * 32 + r32;
        bf16x8 qf[4];
        { const bf16_t* qrow = proj + (rb + t) * NIN + C_SQ + hq * 64 + hh * 8;
#pragma unroll
          for (int s = 0; s < 4; ++s) qf[s] = *(const bf16x8*)(qrow + s * 16); }
        State st; init(st);
        int kt0 = sb; if (qb == 0 && kt0 < 4) kt0 = 4;
        if (kt0 == sb) tile<2>(lds, sb, qf, st, lane);
        for (int kt = (kt0 > sb + 1 ? kt0 : sb + 1); kt < sb + 4; ++kt) tile<3>(lds, kt, qf, st, lane);
        tile<1>(lds, sb + 4, qf, st, lane);
        const float lt = xhalf_sum(st.l) + __builtin_amdgcn_exp2f(sk - st.m);
        store_out(st, YSC / lt, Y + (rb + t) * D + 1024 + hq * 64, lane);
    }
}
}

#include <hip/hip_bf16.h>
#include <cmath>
namespace mob {
using bf16=__hip_bfloat16;
using bf16x8=__attribute__((ext_vector_type(8)))short;
using s16x4=__attribute__((ext_vector_type(4)))short;
using f32x16=__attribute__((ext_vector_type(16)))float;
using u32x4=__attribute__((ext_vector_type(4)))unsigned;
constexpr int SEQ=2048,D=64,DM=4864;
constexpr int NW=8,QBLK=32,QB=QBLK*NW,KVBLK=64,NQB=SEQ/QB;
__device__ __forceinline__ int crow(int r,int hi){return (r&3)+8*(r>>2)+4*hi;}
#define SBAR() __builtin_amdgcn_sched_barrier(0)
__device__ __forceinline__ void cmask(f32x16&p0,f32x16&p1,int jb,int qrel,int hi){
  const float NEG=-INFINITY; int kb=64*jb+4*hi;
  #pragma unroll
  for(int r=0;r<16;++r){int kv=kb+(r&3)+8*(r>>2); if(kv>qrel)p0[r]=NEG; if(kv+32>qrel)p1[r]=NEG;}
}

constexpr int NSLOT=3, SLOTB=8192;
constexpr int LDS_K=0, LDS_V=NSLOT*SLOTB, LDS_WS=2*NSLOT*SLOTB, LDS_OST=LDS_WS+NW*64*4, LDS_BYTES=LDS_OST+NW*4096, LDS_KM=LDS_BYTES  ;
constexpr float NEGB=-3.0e38f, YSC=16.f;
constexpr float C2=0.125f*1.4426950408889634f;
__device__ __forceinline__ void glds16(const void*sbase,unsigned voff,unsigned lds_dst){unsigned keep;
  asm volatile("s_mov_b32 %0, m0\n\ts_mov_b32 m0, %2\n\ts_nop 0\n\tglobal_load_lds_dwordx4 %1, %3\n\ts_mov_b32 m0, %0":"=&s"(keep):"v"(voff),"s"(lds_dst),"s"(sbase):"memory");}
__device__ __forceinline__ float max3f(float a,float b,float c){float r;asm("v_max3_f32 %0, %1, %2, %3":"=v"(r):"v"(a),"v"(b),"v"(c));return r;}
__device__ __forceinline__ float max2f(float a,float b){float r;asm("v_max_f32_e32 %0, %1, %2":"=v"(r):"v"(a),"v"(b));return r;}
__device__ __forceinline__ float fadd_s(float a,float b){float r;asm("v_add_f32_e32 %0, %1, %2":"=v"(r):"v"(a),"v"(b));return r;}
__device__ __forceinline__ float fsub_s(float a,float b){float r;asm("v_sub_f32_e32 %0, %1, %2":"=v"(r):"v"(a),"v"(b));return r;}
typedef float f32x2_t __attribute__((ext_vector_type(2))); typedef __bf16 bf16x2_t __attribute__((ext_vector_type(2)));
__device__ __forceinline__ unsigned cvtpk_s(float lo,float hi){f32x2_t v={lo,hi};bf16x2_t b=__builtin_convertvector(v,bf16x2_t);return __builtin_bit_cast(unsigned,b);}
#define WAIT_BAR(N) asm volatile("s_waitcnt vmcnt(" #N ") lgkmcnt(0)\n\ts_barrier":::"memory")

__device__ __forceinline__ void qkt(f32x16&p0,f32x16&p1,const char*Kslot,const bf16x8*qr,const f32x16&negm,int r32,int hi){
  const char*kb=Kslot+hi*1024+r32*16;
  #pragma unroll
  for(int d0=0;d0<4;++d0){
    const bf16x8 b0=*reinterpret_cast<const bf16x8*>(kb+d0*2048);
    const bf16x8 b1=*reinterpret_cast<const bf16x8*>(kb+d0*2048+512);
    if(d0==0){p0=__builtin_amdgcn_mfma_f32_32x32x16_bf16(b0,qr[0],negm,0,0,0);p1=__builtin_amdgcn_mfma_f32_32x32x16_bf16(b1,qr[0],negm,0,0,0);}
    else{p0=__builtin_amdgcn_mfma_f32_32x32x16_bf16(b0,qr[d0],p0,0,0,0);p1=__builtin_amdgcn_mfma_f32_32x32x16_bf16(b1,qr[d0],p1,0,0,0);}}
}
typedef __attribute__((address_space(3))) const char* lds_cptr;
typedef short v4i16_t __attribute__((ext_vector_type(4)));
__device__ __forceinline__ void kload8(bf16x8*kf,lds_cptr kp){
  kf[0]=*(const __attribute__((address_space(3))) bf16x8*)(kp);      kf[1]=*(const __attribute__((address_space(3))) bf16x8*)(kp+512);
  kf[2]=*(const __attribute__((address_space(3))) bf16x8*)(kp+2048); kf[3]=*(const __attribute__((address_space(3))) bf16x8*)(kp+2560);
  kf[4]=*(const __attribute__((address_space(3))) bf16x8*)(kp+4096); kf[5]=*(const __attribute__((address_space(3))) bf16x8*)(kp+4608);
  kf[6]=*(const __attribute__((address_space(3))) bf16x8*)(kp+6144); kf[7]=*(const __attribute__((address_space(3))) bf16x8*)(kp+6656);
}
__device__ __forceinline__ void kload2(bf16x8*kf,lds_cptr kp,int j){ kf[2*j]=*(const __attribute__((address_space(3))) bf16x8*)(kp+j*2048); kf[2*j+1]=*(const __attribute__((address_space(3))) bf16x8*)(kp+j*2048+512); }
__device__ __forceinline__ s16x4 vtr(lds_cptr p){ return __builtin_bit_cast(s16x4,__builtin_amdgcn_ds_read_tr16_b64_v4i16((__attribute__((address_space(3))) v4i16_t*)p)); }
__device__ __forceinline__ float rowmax(const f32x16&p0,const f32x16&p1){
  float a=max3f(p0[0],p0[1],p1[0]),b=max3f(p0[2],p0[3],p1[1]);a=max3f(a,p1[2],p1[3]);
  #pragma unroll
  for(int r=4;r<16;r+=4){a=max3f(a,p0[r],p0[r+1]);b=max3f(b,p0[r+2],p0[r+3]);a=max3f(a,p1[r],p1[r+1]);b=max3f(b,p1[r+2],p1[r+3]);}
  const float m=max2f(a,b);
  auto rr=__builtin_amdgcn_permlane32_swap(__float_as_uint(m),__float_as_uint(m),false,false);
  return max2f(__uint_as_float(rr[0]),__uint_as_float(rr[1]));
}
__device__ __forceinline__ void pv(f32x16*o,int vb,bf16x8 pa0,bf16x8 pa1,bf16x8 pa2,bf16x8 pa3){
  #pragma unroll
  for(int d0=0;d0<2;++d0){s16x4 lo[4],hi[4];
    #pragma unroll
    for(int ks=0;ks<4;++ks){
      asm volatile("ds_read_b64_tr_b16 %0,%1 offset:%c2":"=&v"(lo[ks]):"v"(vb),"i"(d0*4096+ks*1024):"memory");
      asm volatile("ds_read_b64_tr_b16 %0,%1 offset:%c2":"=&v"(hi[ks]):"v"(vb),"i"(d0*4096+ks*1024+512):"memory");}
    asm volatile("s_waitcnt lgkmcnt(0)":::"memory");SBAR();
    #define PK(k) (bf16x8){lo[k][0],lo[k][1],lo[k][2],lo[k][3],hi[k][0],hi[k][1],hi[k][2],hi[k][3]}
    o[d0]=__builtin_amdgcn_mfma_f32_32x32x16_bf16(pa0,PK(0),o[d0],0,0,0);
    o[d0]=__builtin_amdgcn_mfma_f32_32x32x16_bf16(pa1,PK(1),o[d0],0,0,0);
    o[d0]=__builtin_amdgcn_mfma_f32_32x32x16_bf16(pa2,PK(2),o[d0],0,0,0);
    o[d0]=__builtin_amdgcn_mfma_f32_32x32x16_bf16(pa3,PK(3),o[d0],0,0,0);
    #undef PK
  }
}

#ifndef ATTN_STORE16
#define ATTN_STORE16(p,v) (*(u32x4*)(p)=(v))
#endif
template<int THRL> __device__ __forceinline__ void attn_unit(int b,int h,int qb,const bf16*Q,const bf16*__restrict__ K,const bf16*__restrict__ V,unsigned char*Y,const float*kmean,char*shm){
  const int tid=threadIdx.x,lane=tid&63,r32=lane&31,hi=lane>>5; const int wid=__builtin_amdgcn_readfirstlane(tid>>6);
  const long rowbase=(long)b*SEQ; const int q0=qb*QB;
  const bf16*Qw=Q+(rowbase+q0+wid*QBLK)*DM+h*D;
  const bf16*Kh=K+rowbase*DM+h*D,*Vh=V+rowbase*DM+h*D;
  const unsigned lds0=(unsigned)(uintptr_t)shm;
  float*wsf=(float*)(shm+LDS_WS)+wid*64;
  const unsigned koff=(unsigned)((lane*DM+wid*8)*2);
  const unsigned voff=(unsigned)(((16*(wid&3)+(lane>>2))*DM+(wid>>2)*32+(lane&3)*8)*2);
  const unsigned kdst=lds0+LDS_K+wid*1024, vdst=lds0+LDS_V+wid*1024;
  #define DMA_K(t,slot) glds16(Kh+(long)(t)*KVBLK*DM,koff,(unsigned)__builtin_amdgcn_readfirstlane(kdst+(slot)))
  #define DMA_V(t,slot) glds16(Vh+(long)(t)*KVBLK*DM,voff,(unsigned)__builtin_amdgcn_readfirstlane(vdst+(slot)))
  const char*Kbase=shm+LDS_K; bf16x8 kf[8];
  const lds_cptr shm3=(lds_cptr)shm; const lds_cptr kp0=shm3+LDS_K+hi*1024+r32*16; const lds_cptr vp0=shm3+LDS_V+((lane>>4)&1)*32+(lane&3)*8+(4*hi+((lane&15)>>2))*64;
  const int NT=(q0+QB)/KVBLK;
  DMA_K(0,0);DMA_V(0,0);DMA_K(1,SLOTB);
  bf16x8 qr[4];
  #pragma unroll
  for(int d0=0;d0<4;++d0)qr[d0]=*reinterpret_cast<const bf16x8*>(&Qw[(long)r32*DM+d0*16+hi*8]);
  unsigned sel;
  if(qb<=3) sel=(1u<<qb)-1u;
  else{
    float*km=(float*)(shm+LDS_KM);
    if(tid<qb*64) km[tid]=kmean[(size_t)(b*8+(tid>>6))*512+h*64+(tid&63)];
    asm volatile("s_waitcnt vmcnt(0) lgkmcnt(0)\n\ts_barrier":::"memory");
    float g[7];
    #pragma unroll
    for(int n=0;n<7;++n){ g[n]=NEGB;
      if(n<qb){ float a=0.f;
        #pragma unroll
        for(int s=0;s<4;++s)
          #pragma unroll
          for(int jj=0;jj<8;++jj) a+=__uint_as_float((unsigned)(unsigned short)qr[s][jj]<<16)*km[n*64+16*s+8*hi+jj];
        a+=__shfl_xor(a,32); g[n]=a; } }
    sel=0u;
    #pragma unroll
    for(int r=0;r<3;++r){ float best=NEGB; int bi=0;
      #pragma unroll
      for(int n=0;n<7;++n) if(n<qb&&!((sel>>n)&1u)&&g[n]>best){best=g[n];bi=n;}
      sel|=1u<<bi; }
  }
  #define OKB(n) (((n)>=qb)||(((sel>>(n))&1u)!=0u))
  float mhat=0.f,l_reg=0.f;f32x16 o[2];o[0]=f32x16{};o[1]=f32x16{};f32x16 negm;
  { const bool ok0=OKB(0);
    #pragma unroll
    for(int r=0;r<16;++r)negm[r]=ok0?0.f:NEGB; }
  asm volatile("":"+v"(negm));
  const int qrel=wid*QBLK+r32;
  #define CMASK(P0,P1,t) do{int jb_=(t)-(NT-4); if(jb_>=0)cmask(P0,P1,jb_,qrel,hi);}while(0)
  bool resc=false;
  #define START(P0,P1) do{ const float rm=rowmax(P0,P1); resc=false; \
    { const bool ok0_=OKB(0); const float dl=ok0_?rm:0.f; mhat=fadd_s(mhat,dl); \
      _Pragma("unroll") for(int r=0;r<16;++r){P0[r]=fsub_s(P0[r],dl);P1[r]=fsub_s(P1[r],dl);} \
      _Pragma("unroll") for(int r=0;r<16;++r)negm[r]=ok0_?-mhat:NEGB; asm volatile("":"+v"(negm)); } \
    _Pragma("unroll") for(int r=0;r<16;++r)P0[r]=__builtin_amdgcn_exp2f(P0[r]); }while(0)
  #define RESC() do{ if(resc){ asm volatile("s_waitcnt lgkmcnt(0)":::"memory"); \
      _Pragma("unroll") for(int d_=0;d_<2;++d_) _Pragma("unroll") for(int r=0;r<16;++r)o[d_][r]*=wsf[crow(r,hi)]; } }while(0)
  f32x16 pA0,pA1,pB0,pB1;
  int sl_prev=0,sl_cur=0,sl_next=SLOTB;
  #define ROT() do{sl_prev=sl_cur;sl_cur=sl_next;sl_next=(sl_next==(NSLOT-1)*SLOTB)?0:sl_next+SLOTB;}while(0)
  DMA_K(2,2*SLOTB);
  WAIT_BAR(3);
  qkt(pA0,pA1,Kbase,qr,negm,r32,hi);asm volatile("s_nop 15\n\ts_nop 7":"+v"(pA0),"+v"(pA1));CMASK(pA0,pA1,0);
  START(pA0,pA1);
  _Pragma("unroll") for(int r=0;r<16;++r)pA1[r]=__builtin_amdgcn_exp2f(pA1[r]);
  WAIT_BAR(0);
  DMA_K(3,0);DMA_V(1,SLOTB);
  ROT();
  kload8(kf,kp0+sl_cur);
  WAIT_BAR(2);
  s16x4 vlo[8],vhi[8]; u32x4 pw0,pw1,pw2,pw3;
  #define PKW(P,B) cvtpk_s(P[B],P[B+1])
  #define PAF(k) __builtin_bit_cast(bf16x8,pw##k)
  #define VFR(i) (bf16x8){vlo[i][0],vlo[i][1],vlo[i][2],vlo[i][3],vhi[i][0],vhi[i][1],vhi[i][2],vhi[i][3]}
  #define PIN(x) asm volatile("":"+v"(x))
  #define MX3(a,b,c) __builtin_fmaxf(__builtin_fmaxf((a),(b)),(c))
  #define GAPA(MF,A0,A1,A2,A3,W0,W1,PW) do{ MF; sacc+=A0; sacc+=A1; sacc+=A2; sacc+=A3; PIN(sacc); W0; W1; PIN(PW); SBAR(); }while(0)
  #define EX(v) __builtin_amdgcn_exp2f(v)
  #define GAPB(MF,X,B) do{ MF; X[B]=EX(X[B]); X[B+1]=EX(X[B+1]); X[B+2]=EX(X[B+2]); X[B+3]=EX(X[B+3]); PIN(X); SBAR(); }while(0)
  #define VRD(i) do{ vlo[i]=vtr(vp_+(((i)>>2)*4096+((i)&3)*1024)); vhi[i]=vtr(vp_+(((i)>>2)*4096+((i)&3)*1024+512)); }while(0)
  #define KRD(G,j) do{ if(G){ kload2(kf,kp0+sl_next,j); SBAR(); } }while(0)
  #define STEP(C0,C1,P0,P1,t,GK,GV,GL) do{ SBAR(); \
    const lds_cptr vp_=vp0+sl_prev; \
    VRD(0); SBAR(); float sacc=(P0[0]+P0[1]); \
    GAPA(C0=__builtin_amdgcn_mfma_f32_32x32x16_bf16(kf[0],qr[0],negm,0,0,0), P0[2],P0[3],P0[4],P0[5],     pw0[0]=PKW(P0,0), pw0[1]=PKW(P0,2), pw0); \
    VRD(4); SBAR(); GAPA(C1=__builtin_amdgcn_mfma_f32_32x32x16_bf16(kf[1],qr[0],negm,0,0,0), P0[6],P0[7],P0[8],P0[9],     pw0[2]=PKW(P0,4), pw0[3]=PKW(P0,6), pw0); \
    VRD(1); SBAR(); GAPA(C0=__builtin_amdgcn_mfma_f32_32x32x16_bf16(kf[2],qr[1],C0,0,0,0),   P0[10],P0[11],P0[12],P0[13], pw1[0]=PKW(P0,8), pw1[1]=PKW(P0,10), pw1); \
    VRD(5); SBAR(); GAPA(C1=__builtin_amdgcn_mfma_f32_32x32x16_bf16(kf[3],qr[1],C1,0,0,0),   P0[14],P0[15],P1[0],P1[1],   pw1[2]=PKW(P0,12),pw1[3]=PKW(P0,14), pw1); \
    VRD(2); SBAR(); GAPA(C0=__builtin_amdgcn_mfma_f32_32x32x16_bf16(kf[4],qr[2],C0,0,0,0),   P1[2],P1[3],P1[4],P1[5],     pw2[0]=PKW(P1,0), pw2[1]=PKW(P1,2), pw2); \
    VRD(6); SBAR(); GAPA(C1=__builtin_amdgcn_mfma_f32_32x32x16_bf16(kf[5],qr[2],C1,0,0,0),   P1[6],P1[7],P1[8],P1[9],     pw2[2]=PKW(P1,4), pw2[3]=PKW(P1,6), pw2); \
    VRD(3); SBAR(); GAPA(C0=__builtin_amdgcn_mfma_f32_32x32x16_bf16(kf[6],qr[3],C0,0,0,0),   P1[10],P1[11],P1[12],P1[13], pw3[0]=PKW(P1,8), pw3[1]=PKW(P1,10), pw3); \
    VRD(7); SBAR(); GAPA(C1=__builtin_amdgcn_mfma_f32_32x32x16_bf16(kf[7],qr[3],C1,0,0,0),   P1[14],P1[15],0.f,0.f,       pw3[2]=PKW(P1,12),pw3[3]=PKW(P1,14), pw3); \
    l_reg+=sacc; \
    if(GK){DMA_K((t)+3,sl_cur);} if(GV){DMA_V((t)+1,sl_next);} \
    CMASK(C0,C1,t); \
    { float a=MX3(C0[0],C0[1],C1[0]),b=MX3(C0[2],C0[3],C1[1]); a=MX3(a,C1[2],C1[3]); \
      _Pragma("unroll") for(int r=4;r<16;r+=4){a=MX3(a,C0[r],C0[r+1]);b=MX3(b,C0[r+2],C0[r+3]);a=MX3(a,C1[r],C1[r+1]);b=MX3(b,C1[r+2],C1[r+3]);} \
      float rm=__builtin_fmaxf(a,b); { auto rr=__builtin_amdgcn_permlane32_swap(__float_as_uint(rm),__float_as_uint(rm),false,false); rm=__builtin_fmaxf(__uint_as_float(rr[0]),__uint_as_float(rr[1])); } \
      resc=false; \
      if(__builtin_expect(__any(rm>(float)THRL),0)){ const float dl=__builtin_fmaxf(rm,0.f); mhat+=dl; \
        _Pragma("unroll") for(int r=0;r<16;++r){C0[r]-=dl;C1[r]-=dl;} \
        const float f=__builtin_amdgcn_exp2f(-dl); l_reg*=f; if(hi==0)wsf[r32]=f; resc=true; } \
      if(resc||((((t)+1)&3)==0)){ const bool okn_=OKB(((t)+1)>>2);   \
        _Pragma("unroll") for(int r=0;r<16;++r)negm[r]=okn_?-mhat:NEGB; asm volatile("":"+v"(negm)); } } \
    SBAR(); \
    GAPB(o[0]=__builtin_amdgcn_mfma_f32_32x32x16_bf16(PAF(0),VFR(0),o[0],0,0,0), C0,0); \
    GAPB(o[1]=__builtin_amdgcn_mfma_f32_32x32x16_bf16(PAF(0),VFR(4),o[1],0,0,0), C0,4); \
    KRD(GL,0); GAPB(o[0]=__builtin_amdgcn_mfma_f32_32x32x16_bf16(PAF(1),VFR(1),o[0],0,0,0), C0,8); \
    KRD(GL,1); GAPB(o[1]=__builtin_amdgcn_mfma_f32_32x32x16_bf16(PAF(1),VFR(5),o[1],0,0,0), C0,12); \
    KRD(GL,2); GAPB(o[0]=__builtin_amdgcn_mfma_f32_32x32x16_bf16(PAF(2),VFR(2),o[0],0,0,0), C1,0); \
    KRD(GL,3); GAPB(o[1]=__builtin_amdgcn_mfma_f32_32x32x16_bf16(PAF(2),VFR(6),o[1],0,0,0), C1,4); \
    GAPB(o[0]=__builtin_amdgcn_mfma_f32_32x32x16_bf16(PAF(3),VFR(3),o[0],0,0,0), C1,8); \
    GAPB(o[1]=__builtin_amdgcn_mfma_f32_32x32x16_bf16(PAF(3),VFR(7),o[1],0,0,0), C1,12); \
    }while(0)
  int t=1;
  #undef CMASK
  #define CMASK(P0,P1,t) do{}while(0)
  for(;t+5<NT;t+=2){
    STEP(pB0,pB1,pA0,pA1,t,true,true,true);     WAIT_BAR(2); RESC(); ROT();
    STEP(pA0,pA1,pB0,pB1,t+1,true,true,true);   WAIT_BAR(2); RESC(); ROT();
  }
  #undef CMASK
  const int lane_b=(int)__builtin_amdgcn_mbcnt_hi(~0u,__builtin_amdgcn_mbcnt_lo(~0u,0u)), hi_b=lane_b>>5, qrel_b=wid*QBLK+(lane_b&31);
  #define CMASK(P0,P1,t) do{int jb_=(t)-(NT-4); if(jb_>=0)cmask(P0,P1,jb_,qrel_b,hi_b);}while(0)
  #define ENDW(tt) do{ if((tt)+3<NT){WAIT_BAR(2);} else if((tt)+2<NT){WAIT_BAR(1);} else {WAIT_BAR(0);} }while(0)
  for(;t+1<NT;t+=2){
    STEP(pB0,pB1,pA0,pA1,t,(t+3<NT),(t+1<NT),(t+1<NT));       ENDW(t);   RESC(); ROT();
    STEP(pA0,pA1,pB0,pB1,t+1,(t+4<NT),(t+2<NT),(t+2<NT));     ENDW(t+1); RESC(); ROT();
  }
  STEP(pB0,pB1,pA0,pA1,NT-1,false,false,false); RESC();
  { float sacc=pB0[0]+pB0[1]; _Pragma("unroll") for(int r=2;r<16;++r)sacc+=pB0[r]; _Pragma("unroll") for(int r=0;r<16;++r)sacc+=pB1[r]; l_reg+=sacc;
    pw0=(u32x4){PKW(pB0,0),PKW(pB0,2),PKW(pB0,4),PKW(pB0,6)};pw1=(u32x4){PKW(pB0,8),PKW(pB0,10),PKW(pB0,12),PKW(pB0,14)};pw2=(u32x4){PKW(pB1,0),PKW(pB1,2),PKW(pB1,4),PKW(pB1,6)};pw3=(u32x4){PKW(pB1,8),PKW(pB1,10),PKW(pB1,12),PKW(pB1,14)};
    const int vb0=(int)(lds0+LDS_V)+((lane>>4)&1)*32+(lane&3)*8+(4*hi+((lane&15)>>2))*64;
    SBAR(); pv(o,vb0+sl_cur,PAF(0),PAF(1),PAF(2),PAF(3)); }
  #undef PKW
  #undef PAF
  #undef VFR
  #undef PIN
  #undef MX3
  #undef GAPA
  #undef GAPB
  #undef EX
  #undef VRD
  #undef KRD
  #undef STEP
  #undef ENDW
  {auto rr=__builtin_amdgcn_permlane32_swap(__float_as_uint(l_reg),__float_as_uint(l_reg),false,false);l_reg=__uint_as_float(rr[0])+__uint_as_float(rr[1]);}
  if(hi==0)wsf[32+r32]=l_reg;asm volatile("s_waitcnt lgkmcnt(0)":::"memory");
  float rli[16];
  #pragma unroll
  for(int r=0;r<16;++r)rli[r]=__builtin_amdgcn_rcpf(wsf[32+crow(r,hi)])*YSC;
  unsigned char*Yw=Y+(size_t)(rowbase+q0+wid*QBLK)*2048+h*D;
  { unsigned char*stg=(unsigned char*)(shm+LDS_OST)+wid*4096;
    #pragma unroll
    for(int r=0;r<16;++r){const int orow=crow(r,hi);
      const float a0=__builtin_fminf(__builtin_fmaxf(o[0][r]*rli[r],-448.f),448.f),a1=__builtin_fminf(__builtin_fmaxf(o[1][r]*rli[r],-448.f),448.f);
      const unsigned pk=(unsigned)__builtin_amdgcn_cvt_pk_fp8_f32(a0,a1,0,false);
      stg[orow*64+r32]=(unsigned char)(pk&0xffu); stg[orow*64+32+r32]=(unsigned char)((pk>>8)&0xffu);}
    asm volatile("s_waitcnt lgkmcnt(0)":::"memory");
    #pragma unroll
    for(int i=0;i<2;++i){const int row=i*16+(lane>>2),ch=lane&3; const u32x4 v=*(const u32x4*)(stg+row*64+ch*16); *(u32x4*)(Yw+(size_t)row*2048+ch*16)=v;} }
  asm volatile("s_waitcnt lgkmcnt(0)\n\ts_barrier":::"memory");
  #undef DMA_K
  #undef DMA_V
  #undef CMASK
  #undef START
  #undef RESC
  #undef ROT
  #undef OKB
}
#undef SBAR
#undef WAIT_BAR
#ifdef ATTN_STORE16
#undef ATTN_STORE16
#endif
}

namespace mls {
constexpr int RS = 272, TS = 144;
constexpr float CSC = 8.f, CSC_INV = 0.125f;
struct MW { unsigned char* CC; unsigned char* CP; float* NC; float* NP; float* SC; float* MP; };
__device__ __forceinline__ int cslot(int bh, int c) { return (c + bh) & 31; }
__device__ __forceinline__ float fsilu(float x) { return x * __builtin_amdgcn_rcpf(1.f + __builtin_amdgcn_exp2f(-1.4426950408889634f * x)); }
__device__ __forceinline__ void vt_write(LAS unsigned char* dst, const u32x4 a, const u32x4 bq) {
    *(LAS unsigned*)(dst + 0 * TS) = (a.x & 0xffffu) | (bq.x << 16); *(LAS unsigned*)(dst + 1 * TS) = (a.x >> 16) | (bq.x & 0xffff0000u);
    *(LAS unsigned*)(dst + 2 * TS) = (a.y & 0xffffu) | (bq.y << 16); *(LAS unsigned*)(dst + 3 * TS) = (a.y >> 16) | (bq.y & 0xffff0000u);
    *(LAS unsigned*)(dst + 4 * TS) = (a.z & 0xffffu) | (bq.z << 16); *(LAS unsigned*)(dst + 5 * TS) = (a.z >> 16) | (bq.z & 0xffff0000u);
    *(LAS unsigned*)(dst + 6 * TS) = (a.w & 0xffffu) | (bq.w << 16); *(LAS unsigned*)(dst + 7 * TS) = (a.w >> 16) | (bq.w & 0xffff0000u);
}
constexpr int XKWT = 0, XVT = 18432, XCW = 36864;
__device__ __forceinline__ void x_setup(Frame& F, const float* conv_w, const float* conv_b) {
    __syncthreads();
    for (int i = F.tid; i < 5 * 512; i += NTHR) { const int j = i >> 9, ch = i & 511; ((LAS float*)(F.lds + XCW))[i] = (j < 4) ? conv_w[j * 1024 + 512 + ch] : conv_b[512 + ch]; }
    __syncthreads();
}
struct XL { u32x4 raw[5], vr0, vr1; float li, lf; };
__device__ __forceinline__ void x_load(XL& L, const Frame& F, const bf16_t* proj, const float* gates, int u) {
    const int tid = F.tid, c = u & 31, bh = u >> 5, b = bh >> 2, h = bh & 3; const size_t rb = (size_t)b * SEQ;
    const int cc = tid & 15, rp = tid >> 4, tp = tid & 31, ec = tid >> 5;
#pragma unroll
    for (int i = 0; i < 5; ++i) { const int pos = c * 64 + 2 * rp - 3 + i;
        if (pos >= 0) L.raw[i] = *(const u32x4*)(proj + (rb + pos) * NIN + C_LK + h * 128 + 8 * cc); else L.raw[i] = (u32x4){0u, 0u, 0u, 0u}; }
    L.vr0 = *(const u32x4*)(proj + (rb + c * 64 + 2 * tp) * NIN + C_LV + h * 128 + 8 * ec); L.vr1 = *(const u32x4*)(proj + (rb + c * 64 + 2 * tp + 1) * NIN + C_LV + h * 128 + 8 * ec);
    L.li = gates[(rb + c * 64 + F.lane) * 8 + h]; L.lf = gates[(rb + c * 64 + F.lane) * 8 + 4 + h];
}
__device__ __forceinline__ void x_unit(Frame& F, const bf16_t* proj, const float* gates, const MW& W, int u, XL& cur, XL& nxt, bool has_next, int un) {
    LAS unsigned char* lds = F.lds; const int tid = F.tid, lane = F.lane, r32 = lane & 31, hh = lane >> 5, w = F.wave;
    const int bh = u >> 5, h = bh & 3;
    const int cc = tid & 15, rp = tid >> 4, tp = tid & 31, ec = tid >> 5;
    u32x4 raw[5];
#pragma unroll
    for (int i = 0; i < 5; ++i) raw[i] = cur.raw[i];
    const u32x4 vr0 = cur.vr0, vr1 = cur.vr1; const float li = cur.li, lf = cur.lf;
    const float bcs = scan64<false>(lf), cs = li - bcs, pm = scan64<true>(cs);
    const float blast = lane63(bcs), amax = blast + lane63(pm);
    const float wa = __expf(blast + cs - amax);
    LBAR();
    {   const LAS float* cw = (const LAS float*)(lds + XCW) + h * 128 + 8 * cc;
        u32x4 pk[2];
#pragma unroll
        for (int r = 0; r < 2; ++r) {
            f32x4 oa = *(const LAS f32x4*)(cw + 4 * 512), ob = *(const LAS f32x4*)(cw + 4 * 512 + 4);
#pragma unroll
            for (int j = 0; j < 4; ++j) { const u32x4 uu = raw[r + j]; const f32x4 wa4 = *(const LAS f32x4*)(cw + j * 512), wb4 = *(const LAS f32x4*)(cw + j * 512 + 4);
                oa += wa4 * (f32x4){bflo(uu.x), bfhi(uu.x), bflo(uu.y), bfhi(uu.y)}; ob += wb4 * (f32x4){bflo(uu.z), bfhi(uu.z), bflo(uu.w), bfhi(uu.w)}; }
            const float ws = __shfl(wa, 2 * rp + r) * 0.08838834764831845f;
#pragma unroll
            for (int i = 0; i < 4; ++i) { oa[i] = fsilu(oa[i]) * ws; ob[i] = fsilu(ob[i]) * ws; }
            pk[r].x = cvtpk(oa[0], oa[1]); pk[r].y = cvtpk(oa[2], oa[3]); pk[r].z = cvtpk(ob[0], ob[1]); pk[r].w = cvtpk(ob[2], ob[3]);
        }
#pragma unroll
        for (int i = 0; i < 8; ++i) { const int sh = 16 * (i & 1); const unsigned e0 = (pk[0][i >> 1] >> sh) & 0xffffu, e1 = (pk[1][i >> 1] >> sh) & 0xffffu;
            *(LAS unsigned*)(lds + XKWT + (8 * cc + i) * TS + (2 * rp) * 2) = e0 | (e1 << 16); }
        vt_write(lds + XVT + (8 * ec) * TS + (2 * tp) * 2, vr0, vr1);
    }
    if (has_next) x_load(nxt, F, proj, gates, un);
    LBAR();
#pragma unroll
    for (int i = 0; i < 2; ++i) { const int T = 2 * w + i, dt = T >> 2, e2 = T & 3;
        f32x16 acc;
#pragma unroll
        for (int r = 0; r < 16; ++r) acc[r] = 0.f;
#pragma unroll
        for (int k = 0; k < 4; ++k) { const bf16x8 a = *(const LAS bf16x8*)(lds + XKWT + (32 * dt + r32) * TS + (16 * k + 8 * hh) * 2);
            const bf16x8 bv = *(const LAS bf16x8*)(lds + XVT + (32 * e2 + r32) * TS + (16 * k + 8 * hh) * 2);
            acc = __builtin_amdgcn_mfma_f32_32x32x16_bf16(a, bv, acc, 0, 0, 0); }
        unsigned char* dst = W.CC + (size_t)((u & ~31) + cslot(u >> 5, u & 31)) * 16384 + (size_t)(32 * e2 + r32) * 128 + 32 * dt + 4 * hh;
#pragma unroll
        for (int g = 0; g < 4; ++g) *(unsigned*)(dst + 8 * g) = pg8::pack_fp8x4(acc[4 * g] * CSC, acc[4 * g + 1] * CSC, acc[4 * g + 2] * CSC, acc[4 * g + 3] * CSC); }
    if (tid < 128) { float sN = 0.f;
#pragma unroll
        for (int k = 0; k < 8; ++k) { const u32x4 uu = *(const LAS u32x4*)(lds + XKWT + tid * TS + k * 16);
            sN += (bflo(uu.x) + bfhi(uu.x)) + (bflo(uu.y) + bfhi(uu.y)) + (bflo(uu.z) + bfhi(uu.z)) + (bflo(uu.w) + bfhi(uu.w)); }
        W.NC[(size_t)u * 128 + tid] = sN; }
    if (tid == 0) { W.SC[u * 2] = blast; W.SC[u * 2 + 1] = amax; }
}
constexpr int YK = 5, CONV_Y = YK * 4 * 256;
template <int GRP>
__device__ __forceinline__ void y_phase(Frame& F, const MW& W) {
    for (int base = blockIdx.x * 256; base < 32 * 2048; base += F.G * 256) {
        if (F.tid >= 256) {
            if (base == (int)blockIdx.x * 256 && F.G == 256) {
#pragma unroll 1
                for (int k = 0; k < YK; ++k) conv_item<GRP>(F, (int)blockIdx.x * 4 + (F.wave - 4) + k * 1024);
            }
            continue; }
        const int bh = base >> 11, g = (base & 2047) + F.tid, e = g >> 4, d8 = (g & 15) * 8;
        const float* sc = W.SC + (size_t)bh * 64;
        const size_t off = (size_t)bh * 32 * 16384 + (size_t)e * 128 + d8;
        u32x2 v[32];
#pragma unroll
        for (int c = 0; c < 32; ++c) v[c] = __builtin_nontemporal_load((const u32x2*)(W.CC + off + (size_t)cslot(bh, c) * 16384));
        const bool nsc = (g < 32);
        f32x4 nv[32];
        if (nsc) {
#pragma unroll
            for (int c = 0; c < 32; ++c) nv[c] = *(const f32x4*)(W.NC + ((size_t)bh * 32 + c) * 128 + g * 4); }
        float C[8];
#pragma unroll
        for (int i = 0; i < 8; ++i) C[i] = 0.f;
        float m = 0.f;
#pragma unroll
        for (int c = 0; c < 32; ++c) {
            u32x2 o; o.x = pg8::pack_fp8x4(C[0], C[1], C[2], C[3]); o.y = pg8::pack_fp8x4(C[4], C[5], C[6], C[7]); *(u32x2*)(W.CP + off + (size_t)cslot(bh, c) * 16384) = o;
            const float bl = sc[2 * c], am = sc[2 * c + 1], mn = fmaxf(bl + m, am), dec = __expf(bl + m - mn), inj = __expf(am - mn);
            const auto x0 = __builtin_amdgcn_cvt_pk_f32_fp8((int)v[c].x, false), x1 = __builtin_amdgcn_cvt_pk_f32_fp8((int)v[c].x, true), x2 = __builtin_amdgcn_cvt_pk_f32_fp8((int)v[c].y, false), x3 = __builtin_amdgcn_cvt_pk_f32_fp8((int)v[c].y, true);
            C[0] = C[0] * dec + x0[0] * inj; C[1] = C[1] * dec + x0[1] * inj; C[2] = C[2] * dec + x1[0] * inj; C[3] = C[3] * dec + x1[1] * inj;
            C[4] = C[4] * dec + x2[0] * inj; C[5] = C[5] * dec + x2[1] * inj; C[6] = C[6] * dec + x3[0] * inj; C[7] = C[7] * dec + x3[1] * inj; m = mn; }
        if (nsc) {
            f32x4 N = (f32x4){0.f, 0.f, 0.f, 0.f}; float mm = 0.f;
#pragma unroll
            for (int c = 0; c < 32; ++c) {
                *(f32x4*)(W.NP + ((size_t)bh * 32 + c) * 128 + g * 4) = N; if (g == 0) W.MP[bh * 32 + c] = mm;
                const float bl = sc[2 * c], am = sc[2 * c + 1], mn = fmaxf(bl + mm, am), dec = __expf(bl + mm - mn), inj = __expf(am - mn);
                N = N * dec + nv[c] * inj; mm = mn; }
        }
    }
}
constexpr int QS = 0, QW = 17408, KS = 34816, ZCW = 52224  , VT = 72704, CB = 91136, NS = 125952, CSO = 126464, SSQ = 126720, ZNW = 127744  ;
struct Pre { u32x4 raw[7]; u32x4 vr[2]; float li, lf; };
__device__ __forceinline__ void prefetch(Pre& P, const bf16_t* proj, const float* gates, size_t rb, int c, int h, int tid, int lane) {
    const int cc = tid & 31, rg = tid >> 5;
    const int col = (cc < 16) ? (C_LQ + h * 128 + 8 * cc) : (C_LK + h * 128 + 8 * (cc - 16));
#pragma unroll
    for (int i = 0; i < 7; ++i) { const int pos = c * 64 + 4 * rg - 3 + i;
        if (pos >= 0) P.raw[i] = *(const u32x4*)(proj + (rb + pos) * NIN + col); else P.raw[i] = (u32x4){0u, 0u, 0u, 0u}; }
    const int tp = tid & 31, ec = tid >> 5;
    P.vr[0] = *(const u32x4*)(proj + (rb + c * 64 + 2 * tp) * NIN + C_LV + h * 128 + 8 * ec);
    P.vr[1] = *(const u32x4*)(proj + (rb + c * 64 + 2 * tp + 1) * NIN + C_LV + h * 128 + 8 * ec);
    P.li = gates[(rb + c * 64 + lane) * 8 + h]; P.lf = gates[(rb + c * 64 + lane) * 8 + 4 + h];
}
__device__ __forceinline__ void z_setup(Frame& F, const float* conv_w, const float* conv_b, const float* normw) {
    __syncthreads();
    for (int i = F.tid; i < 5 * 1024; i += NTHR) { const int j = i >> 10, ch = i & 1023; ((LAS float*)(F.lds + ZCW))[i] = (j < 4) ? conv_w[j * 1024 + ch] : conv_b[ch]; }
    ((LAS float*)(F.lds + ZNW))[F.tid] = normw[F.tid];
    __syncthreads();
}
struct ZL { Pre P; u32x4 cpv[2]; float npv, mprev; u32x2 og[4]; };
__device__ __forceinline__ void z_load(ZL& L, const Frame& F, const bf16_t* proj, const float* gates, const MW& W, int u) {
    const int tid = F.tid, lane = F.lane, r32 = lane & 31, hh = lane >> 5, w = F.wave, et = w & 3, tt = w >> 2;
    const int c = u & 31, bh = u >> 5, b = bh >> 2, h = bh & 3; const size_t rb = (size_t)b * SEQ, r0 = rb + (size_t)c * 64; const int trow = 32 * tt + r32;
    prefetch(L.P, proj, gates, rb, c, h, tid, lane);
#pragma unroll
    for (int i = 0; i < 2; ++i) L.cpv[i] = __builtin_nontemporal_load((const u32x4*)(W.CP + (size_t)((u & ~31) + cslot(u >> 5, u & 31)) * 16384 + (size_t)(tid + i * NTHR) * 16));
    L.npv = (tid < 128) ? W.NP[(size_t)u * 128 + tid] : 0.f; L.mprev = W.MP[u];
#pragma unroll
    for (int g = 0; g < 4; ++g) L.og[g] = *(const u32x2*)(proj + (r0 + trow) * NIN + C_LO + h * 128 + 32 * et + 8 * g + 4 * hh);
}
__device__ __forceinline__ void z_unit(Frame& F, const bf16_t* proj, const float* gates, const MW& W, unsigned char* Y, int u, ZL& cur, ZL& nxt, bool has_next, int un) {
    LAS unsigned char* lds = F.lds; const int tid = F.tid, lane = F.lane, r32 = lane & 31, hh = lane >> 5, w = F.wave, et = w & 3, tt = w >> 2;
    const int c = u & 31, bh = u >> 5, b = bh >> 2, h = bh & 3; const size_t rb = (size_t)b * SEQ, r0 = rb + (size_t)c * 64;
    const int trow = 32 * tt + r32;
    const Pre P = cur.P;
    u32x4 cpv[2];
#pragma unroll
    for (int i = 0; i < 2; ++i) cpv[i] = cur.cpv[i];
    const float npv = cur.npv, mprev = cur.mprev;
    u32x2 og[4];
#pragma unroll
    for (int g = 0; g < 4; ++g) og[g] = cur.og[g];
    const float bcs = scan64<false>(P.lf), cs = P.li - bcs, pm = scan64<true>(cs);
    const float il = bcs + mprev, mo = fmaxf(il, bcs + pm), wi = __expf(il - mo);
    const float rt = __shfl(bcs - mo, trow), eo = __shfl(__expf(-mo), trow);
    LBAR();
    if (w == 0) ((LAS float*)(lds + CSO))[lane] = cs;
#pragma unroll
    for (int i = 0; i < 2; ++i) { const int ci = tid + i * NTHR, e = ci >> 3, part = ci & 7;
        unsigned wv[8];
#pragma unroll
        for (int q = 0; q < 4; ++q) { const int uq = (int)cpv[i][q]; const auto lo = __builtin_amdgcn_cvt_pk_f32_fp8(uq, false), hi = __builtin_amdgcn_cvt_pk_f32_fp8(uq, true);
            wv[2 * q] = cvtpk(lo[0] * CSC_INV, lo[1] * CSC_INV); wv[2 * q + 1] = cvtpk(hi[0] * CSC_INV, hi[1] * CSC_INV); }
        u32x4 w0, w1; w0.x = wv[0]; w0.y = wv[1]; w0.z = wv[2]; w0.w = wv[3]; w1.x = wv[4]; w1.y = wv[5]; w1.z = wv[6]; w1.w = wv[7];
        *(LAS u32x4*)(lds + CB + e * RS + part * 32) = w0; *(LAS u32x4*)(lds + CB + e * RS + part * 32 + 16) = w1; }
    if (tid < 128) ((LAS float*)(lds + NS))[tid] = npv;
    {
        const int cc = tid & 31, rg = tid >> 5; const bool isk = cc >= 16; const int dcol = 8 * (cc & 15);
        const LAS float* cw = (const LAS float*)(lds + ZCW) + (isk ? 512 : 0) + h * 128 + dcol;
        const float ksc = isk ? 0.08838834764831845f : 1.f;
#pragma unroll
        for (int r = 0; r < 4; ++r) {
            f32x4 oa = *(const LAS f32x4*)(cw + 4 * 1024), ob = *(const LAS f32x4*)(cw + 4 * 1024 + 4);
#pragma unroll
            for (int j = 0; j < 4; ++j) { const u32x4 uu = P.raw[r + j]; const f32x4 wa4 = *(const LAS f32x4*)(cw + j * 1024), wb4 = *(const LAS f32x4*)(cw + j * 1024 + 4);
                oa += wa4 * (f32x4){bflo(uu.x), bfhi(uu.x), bflo(uu.y), bfhi(uu.y)}; ob += wb4 * (f32x4){bflo(uu.z), bfhi(uu.z), bflo(uu.w), bfhi(uu.w)}; }
#pragma unroll
            for (int i = 0; i < 4; ++i) { oa[i] = fsilu(oa[i]) * ksc; ob[i] = fsilu(ob[i]) * ksc; }
            const int t = 4 * rg + r; const float ws = __shfl(wi, t);
            u32x4 wv; wv.x = cvtpk(oa[0], oa[1]); wv.y = cvtpk(oa[2], oa[3]); wv.z = cvtpk(ob[0], ob[1]); wv.w = cvtpk(ob[2], ob[3]);
            *(LAS u32x4*)(lds + (isk ? KS : QS) + t * RS + dcol * 2) = wv;
            if (!isk) { u32x4 v; v.x = cvtpk(oa[0] * ws, oa[1] * ws); v.y = cvtpk(oa[2] * ws, oa[3] * ws); v.z = cvtpk(ob[0] * ws, ob[1] * ws); v.w = cvtpk(ob[2] * ws, ob[3] * ws);
                *(LAS u32x4*)(lds + QW + t * RS + dcol * 2) = v; }
            asm volatile("" ::: "memory");
        }
        vt_write(lds + VT + (8 * (tid >> 5)) * TS + (2 * (tid & 31)) * 2, P.vr[0], P.vr[1]);
    }
    if (has_next) z_load(nxt, F, proj, gates, W, un);
    LBAR();
    f32x16 acc;
#pragma unroll
    for (int r = 0; r < 16; ++r) acc[r] = 0.f;
    float den = 0.f;
    for (int st = 0; st <= tt; ++st) {
        f32x16 S;
#pragma unroll
        for (int r = 0; r < 16; ++r) S[r] = 0.f;
#pragma unroll
        for (int k = 0; k < 8; ++k) { const bf16x8 a = *(const LAS bf16x8*)(lds + KS + (32 * st + r32) * RS + (16 * k + 8 * hh) * 2); const bf16x8 qk = *(const LAS bf16x8*)(lds + QS + trow * RS + (16 * k + 8 * hh) * 2); S = __builtin_amdgcn_mfma_f32_32x32x16_bf16(a, qk, S, 0, 0, 0); }
        const LAS float* csp = (const LAS float*)(lds + CSO) + 32 * st + 4 * hh;
#pragma unroll
        for (int r = 0; r < 16; ++r) { const int so = (r & 3) + 8 * (r >> 2); const float cv = csp[so];
            const bool ok = (st < tt) || (so + 4 * hh <= r32);
            const float p = ok ? S[r] * __expf(rt + cv) : 0.f; S[r] = p; den += p; }
#pragma unroll
        for (int k2 = 0; k2 < 2; ++k2) {
            u32x4 pw; pw.x = cvtpk(S[8 * k2 + 0], S[8 * k2 + 1]); pw.y = cvtpk(S[8 * k2 + 2], S[8 * k2 + 3]); pw.z = cvtpk(S[8 * k2 + 4], S[8 * k2 + 5]); pw.w = cvtpk(S[8 * k2 + 6], S[8 * k2 + 7]);
            const LAS unsigned char* vp = lds + VT + (32 * et + r32) * TS + (32 * st + 16 * k2 + 4 * hh) * 2;
            const u32x2 lo = *(const LAS u32x2*)vp, hi = *(const LAS u32x2*)(vp + 16); u32x4 aw; aw.x = lo.x; aw.y = lo.y; aw.z = hi.x; aw.w = hi.y;
            acc = __builtin_amdgcn_mfma_f32_32x32x16_bf16(__builtin_bit_cast(bf16x8, aw), __builtin_bit_cast(bf16x8, pw), acc, 0, 0, 0); }
    }
    {
        const LAS float* nsp = (const LAS float*)(lds + NS);
#pragma unroll
        for (int k = 0; k < 8; ++k) {
            const bf16x8 a = *(const LAS bf16x8*)(lds + CB + (32 * et + r32) * RS + (16 * k + 8 * hh) * 2);
            const bf16x8 bq = *(const LAS bf16x8*)(lds + QW + trow * RS + (16 * k + 8 * hh) * 2);
            acc = __builtin_amdgcn_mfma_f32_32x32x16_bf16(a, bq, acc, 0, 0, 0);
            const f32x4 n0 = *(const LAS f32x4*)(nsp + 16 * k + 8 * hh), n1 = *(const LAS f32x4*)(nsp + 16 * k + 8 * hh + 4);
            den += bf1((bf16_t)bq[0]) * n0[0] + bf1((bf16_t)bq[1]) * n0[1] + bf1((bf16_t)bq[2]) * n0[2] + bf1((bf16_t)bq[3]) * n0[3]
                 + bf1((bf16_t)bq[4]) * n1[0] + bf1((bf16_t)bq[5]) * n1[1] + bf1((bf16_t)bq[6]) * n1[2] + bf1((bf16_t)bq[7]) * n1[3]; }
    }
    den += __shfl_xor(den, 32);
    const float hinv = 1.f / fmaxf(fabsf(den), eo);
    float ssq = 0.f;
#pragma unroll
    for (int r = 0; r < 16; ++r) { acc[r] *= hinv; ssq += acc[r] * acc[r]; }
    ssq += __shfl_xor(ssq, 32);
    if (hh == 0) ((LAS float*)(lds + SSQ))[et * 64 + trow] = ssq;
    LBAR();
    {
        const LAS float* sq = (const LAS float*)(lds + SSQ) + trow;
        const float tot = (sq[0] + sq[64]) + (sq[128] + sq[192]);
        const float rn = att::YSC / sqrtf(tot * (1.f / 128.f) + RMS_EPS);
        unsigned char* yrow = Y + (r0 + trow) * D + 512 + h * 128 + 32 * et + 4 * hh;
#pragma unroll
        for (int g = 0; g < 4; ++g) { const f32x4 nwg = *(const LAS f32x4*)(lds + ZNW + (h * 128 + 32 * et + 8 * g + 4 * hh) * 4); const float o0 = bflo(og[g].x), o1 = bfhi(og[g].x), o2 = bflo(og[g].y), o3 = bfhi(og[g].y);
            *(unsigned*)(yrow + 8 * g) = pg8::pack_fp8x4(acc[4 * g] * rn * nwg[0] * sigmoid_f(o0), acc[4 * g + 1] * rn * nwg[1] * sigmoid_f(o1), acc[4 * g + 2] * rn * nwg[2] * sigmoid_f(o2), acc[4 * g + 3] * rn * nwg[3] * sigmoid_f(o3)); }
    }
}
}

__device__ __forceinline__ int wq_pull(Frame& F, unsigned* qctr) {
    volatile LAS int* slot = (volatile LAS int*)(F.lds + LDSCTL_OFF + 256);
    __syncthreads();
    if (F.tid == 0) *slot = (int)__hip_atomic_fetch_add(qctr, 1u, __ATOMIC_RELAXED, __HIP_MEMORY_SCOPE_AGENT);
    __syncthreads();
    return __builtin_amdgcn_readfirstlane(*slot);
}
constexpr int N_PHASES = 18;
constexpr int N_LAUNCHES = MK_N_LAUNCHES;
constexpr int PTAB_OFF = LDSCTL_OFF + 512, MOETAB_OFF = LDSCTL_OFF + 64;
__device__ __forceinline__ const float* inptr(const Frame& F, int i) {
    const LAS unsigned* t = (const LAS unsigned*)(F.lds + PTAB_OFF) + 2 * i;
    const unsigned lo = __builtin_amdgcn_readfirstlane(t[0]), hi = __builtin_amdgcn_readfirstlane(t[1]);
    return (const float*)(((unsigned long long)hi << 32) | lo);
}
#define GRID_BAR() do { if (N_LAUNCHES == 1) xcd_barrier(bar); } while (0)
#define IN(k) (lo <= (k) && (k) < hi)
#define SEAM(k) do { if (IN(k) && IN((k) + 1)) GRID_BAR(); } while (0)
__device__ __forceinline__ void moe_table(Frame& F) {
    LAS int* tab = (LAS int*)(F.lds + MOETAB_OFF);
    __syncthreads();
    if (F.tid == 0) { int cum = 0; for (int e = 0; e < NE; ++e) { const int cn = (int)__hip_atomic_load(F.ctl + CW_CNT + e, __ATOMIC_RELAXED, __HIP_MEMORY_SCOPE_AGENT); tab[e] = cn; tab[8 + e] = cum; cum += (cn + 255) >> 8; } tab[16] = cum; }
    __syncthreads();
}
template <int GRP>
__device__ __forceinline__ void conv_part(Frame& F, int part) {
    constexpr int N = (GRP == 0) ? CONV_N0 : (GRP == 1) ? CONV_N1 : (GRP == 2) ? CONV_N2 : (GRP == 3) ? CONV_N3 : CONV_N4;
    const int niter = (N + F.NGW - 1) / F.NGW, i0 = part * niter / 3, i1 = (part + 1) * niter / 3;
#pragma unroll 1
    for (int i = i0; i < i1; ++i) { const int it = F.gw + i * F.NGW; if (it < N) conv_item<GRP>(F, it); }
}
template <int GRP>
__device__ __forceinline__ void conv_queue(Frame& F, unsigned* qctr) {
    constexpr int N = (GRP == 0) ? CONV_N0 : (GRP == 1) ? CONV_N1 : (GRP == 2) ? CONV_N2 : (GRP == 3) ? CONV_N3 : CONV_N4, BATCH = 32, NBATCH = (N + BATCH - 1) / BATCH;
    volatile LAS int* slot2 = (volatile LAS int*)(F.lds + LDSCTL_OFF + 264);
    int cur = wq_pull(F, qctr), par = 0;
    while (cur < NBATCH) {
        if (F.tid == 0) slot2[par] = (int)__hip_atomic_fetch_add(qctr, 1u, __ATOMIC_RELAXED, __HIP_MEMORY_SCOPE_AGENT);
#pragma unroll 1
        for (int i = F.wave; i < BATCH; i += NWAVES) { const int it = cur * BATCH + i; if (it < N) conv_item<GRP>(F, it); }
        __syncthreads();
        cur = __builtin_amdgcn_readfirstlane(slot2[par]); par ^= 1;
    }
}
template <int L>
__device__ __forceinline__ void layer(Frame& F, const XcdBarrier& bar, float* out, const int lo, const int hi) {
    constexpr int pb = 2 + 8 * L;
    unsigned char* ws = F.ws;
    float* mod = (float*)(ws + WS_MOD); float* gates = (float*)(ws + WS_GATES);
    uint4* tok = (uint4*)(ws + WS_TOK); int* idx = (int*)(ws + WS_TOK + 512 * 1024);
    bf16_t* XN = (bf16_t*)(ws + WS_XN); bf16_t* proj = (bf16_t*)(ws + WS_PROJ); unsigned char* ymix = ws + WS_YMIX; bf16_t* act = (bf16_t*)(ws + WS_ACT);
    bf16_t* yb = (bf16_t*)(ws + WS_YB);
    const float* modl = mod + (size_t)L * NB * 6 * D;
    if (IN(pb + 0)) {
        pg8::DenseSched S{(const char*)XN, (const char*)(ws + WS_WIN + (size_t)L * NIN * D), D, M / 256, NIN / 256, F.G, (int)blockIdx.x};
        pg8::EpiInProjI8 E{proj, NIN, (float*)(ws + WS_CTL + KMEAN_OFF + (size_t)L * 131072), (const float*)(ws + WS_ROWMAX), (const float*)(ws + WS_CTL + COLMAX_OFF) + CMX_WIN + L * NIN};
        pg8::gemm_phase<pg8::EpiInProjI8, pg8::DenseSched, true, 2>(F.lds, D, S, E);
    }
    SEAM(pb + 0);
    const mls::MW mw{ws + WS_CC, ws + WS_CP, (float*)(ws + WS_NC), (float*)(ws + WS_NP), (float*)(ws + WS_SC), (float*)(ws + WS_SC + 65536)};
    const float* km = (const float*)(ws + WS_CTL + KMEAN_OFF + (size_t)L * 131072);
    const int cls = (blockIdx.x >> 3) & 3; const bool odd = (cls & 1) != 0;
    if (IN(pb + 1)) {
        mls::x_setup(F, inptr(F, IN_CONVW) + (size_t)L * 4 * 1024, inptr(F, IN_CONVB) + (size_t)L * 1024);
        { int u = blockIdx.x; mls::XL xa; if (u < 1024) mls::x_load(xa, F, proj, gates, u);
          for (; u < 1024; u += F.G) { mls::XL xb; const bool hn = u + F.G < 1024; mls::x_unit(F, proj, gates, mw, u, xa, xb, hn, u + F.G); xa = xb; } }
        __syncthreads();
    }
    SEAM(pb + 1);
    if (IN(pb + 2)) {
        constexpr int GRP = (L == 0) ? 2 : 3;
        mls::y_phase<GRP>(F, mw);
        GRID_BAR();
        if (cls == 0) { conv_all<GRP>(F, (F.G == 256) ? mls::CONV_Y : 0); __syncthreads(); }
        if (odd) { for (int p = blockIdx.x; p < 256; p += F.G) { const int bh = p >> 2, jj = p & 3; mob::attn_unit<8>(bh >> 3, bh & 7, 7 - jj, (const mob::bf16*)(proj + C_MQ), (const mob::bf16*)(proj + C_MK), (const mob::bf16*)(proj + C_MV), ymix, km, (char*)F.glds); } }
        __syncthreads();
        if (cls == 1) { conv_all<GRP>(F, (F.G == 256) ? mls::CONV_Y : 0); __syncthreads(); }
        mls::z_setup(F, inptr(F, IN_CONVW) + (size_t)L * 4 * 1024, inptr(F, IN_CONVB) + (size_t)L * 1024, inptr(F, IN_MNW) + (size_t)L * 512);
        { int u = blockIdx.x; mls::ZL za; if (u < 1024) mls::z_load(za, F, proj, gates, mw, u);
          for (; u < 1024; u += F.G) { mls::ZL zb; const bool hn = u + F.G < 1024; mls::z_unit(F, proj, gates, mw, ymix, u, za, zb, hn, u + F.G); za = zb; } }
        __syncthreads();
        if (!odd) { for (int p = blockIdx.x; p < 256; p += F.G) { const int bh = p >> 2, jj = p & 3; mob::attn_unit<8>(bh >> 3, bh & 7, 7 - jj, (const mob::bf16*)(proj + C_MQ), (const mob::bf16*)(proj + C_MK), (const mob::bf16*)(proj + C_MV), ymix, km, (char*)F.glds); } }
        __syncthreads();
        if (cls == 2) { conv_all<GRP>(F, (F.G == 256) ? mls::CONV_Y : 0); __syncthreads(); }
        for (int p = blockIdx.x; p < 256; p += F.G) { const int bh = p >> 2, jj = p & 3; mob::attn_unit<8>(bh >> 3, bh & 7, jj, (const mob::bf16*)(proj + C_MQ), (const mob::bf16*)(proj + C_MK), (const mob::bf16*)(proj + C_MV), ymix, km, (char*)F.glds); }
        for (int u = blockIdx.x; u < 256; u += F.G) att::swa_unit(F, proj, inptr(F, IN_SINK) + L * 16, ymix, u >> 5, (u >> 4) & 1, u & 15);
        __syncthreads();
        if (cls == 3) { conv_all<GRP>(F, (F.G == 256) ? mls::CONV_Y : 0); __syncthreads(); }
    }
    SEAM(pb + 2);
    if (IN(pb + 3)) {
        pg8::DenseSched S{(const char*)ymix, (const char*)(ws + WS_WOUT + (size_t)L * D * D), D, M / 256, D / 256, F.G, (int)blockIdx.x};
        pg8::EpiBf16 E{yb, D, WSC_INV / att::YSC};
        pg8::gemm_phase<pg8::EpiBf16, pg8::DenseSched, true, 1>(F.lds, D, S, E);
    }
    SEAM(pb + 3);
    if (IN(pb + 4)) {
        float* xb = (float*)(ws + WS_XB);
        if constexpr (L == 0) row_phase<1, 0, true, true, false, true>(F, inptr(F, IN_X), xb, yb, inptr(F, IN_GPOSTM) + (size_t)L * D, modl + 2 * D, inptr(F, IN_GPREF) + (size_t)L * D, modl + 4 * D, modl + 3 * D, XN,
                                          nullptr, 0, nullptr, nullptr, nullptr, nullptr, nullptr, nullptr, nullptr, (float*)(ws + WS_ROWMAX));
        else        row_phase<1, 2, true, true, true, true>(F, xb, xb, yb, inptr(F, IN_GPOSTM) + (size_t)L * D, modl + 2 * D, inptr(F, IN_GPREF) + (size_t)L * D, modl + 4 * D, modl + 3 * D, XN,
                                          inptr(F, IN_ROUTER), 8, nullptr, nullptr, nullptr, nullptr, tok, idx, F.ctl + CW_CNT, (float*)(ws + WS_ROWMAX));
    }
    SEAM(pb + 4);
    if constexpr (L == 0) {
        if (IN(pb + 5)) {
            pg8::DenseSched S{(const char*)XN, (const char*)(ws + WS_WGU), D, M / 256, 2 * DFF / 256, F.G, (int)blockIdx.x};
            pg8::EpiSwiGLUI8 E{(unsigned char*)act, DFF, (const float*)(ws + WS_ROWMAX), (const float*)(ws + WS_CTL + COLMAX_OFF), nullptr, nullptr};
            pg8::gemm_phase<pg8::EpiSwiGLUI8, pg8::DenseSched, true, 2>(F.lds, D, S, E);
        }
        SEAM(pb + 5);
        if (IN(pb + 6)) {
            pg8::DenseSched S{(const char*)act, (const char*)(ws + WS_WD), DFF, M / 256, D / 256, F.G, (int)blockIdx.x};
            pg8::EpiBf16 E{yb, D, WSC_INV};
            pg8::gemm_phase<pg8::EpiBf16, pg8::DenseSched, true, 1>(F.lds, DFF, S, E);
        }
        SEAM(pb + 6);
        if (IN(pb + 7)) { float* xb = (float*)(ws + WS_XB); row_phase<1, 1, true, true, true, true>(F, xb, xb, yb, inptr(F, IN_GPOSTF), modl + 5 * D, inptr(F, IN_GPREM) + D, mod + (size_t)NB * 6 * D + 1 * D, mod + (size_t)NB * 6 * D + 0 * D, XN,
                                              inptr(F, IN_WIN) + (size_t)D * NIN_SRC + SRC_GATE, NIN_SRC, inptr(F, IN_IGB) + 4, inptr(F, IN_FGB) + 4, gates, nullptr, nullptr, nullptr, nullptr, (float*)(ws + WS_ROWMAX));
            conv_all<4>(F); }
        SEAM(pb + 7);
    } else {
        if (IN(pb + 5)) {
            moe_table(F);
            const LAS int* tab = (const LAS int*)(F.lds + MOETAB_OFF);
            pg8::MoeSched<true> S; S.A = (const char*)XN; S.W = (const char*)(ws + WS_MGU); S.idx = idx; S.tab = tab; S.KB = D; S.nN = 2 * DFE / 256; S.G = F.G; S.c = (int)blockIdx.x; S.wrows = 2 * DFE; S.ntile = tab[16];
            pg8::EpiSwiGLUI8 E{(unsigned char*)act, DFE, (const float*)(ws + WS_RMSLOT), (const float*)(ws + WS_CTL + COLMAX_OFF) + 2 * DFF, idx, tab};
            pg8::gemm_phase<pg8::EpiSwiGLUI8, pg8::MoeSched<true>, true, 2>(F.lds, D, S, E);
        }
        SEAM(pb + 5);
        if (IN(pb + 6)) {
            moe_table(F);
            const LAS int* tab = (const LAS int*)(F.lds + MOETAB_OFF);
            pg8::MoeSched<false> S; S.A = (const char*)act; S.W = (const char*)(ws + WS_MD); S.idx = idx; S.tab = tab; S.KB = DFE; S.nN = D / 256; S.G = F.G; S.c = (int)blockIdx.x; S.wrows = D; S.ntile = tab[16];
            pg8::EpiBf16 E{yb, D, WSC_INV};
            pg8::gemm_phase<pg8::EpiBf16, pg8::MoeSched<false>, true, 1>(F.lds, DFE, S, E);
        }
        SEAM(pb + 6);
        if (IN(pb + 7)) row_phase<2, 0, false, false, true, false>(F, (const float*)(ws + WS_XB), out, yb, inptr(F, IN_GPOSTF) + D, modl + 5 * D, nullptr, nullptr, nullptr, nullptr,
                                               nullptr, 0, nullptr, nullptr, nullptr, tok, nullptr, nullptr, F.ctl + CW_CNT);
    }
}
__global__ void __launch_bounds__(NTHR, 2) fwd(Args args) {
    extern __shared__ __attribute__((aligned(16))) unsigned char lds[];
    Frame F;
    F.lds = (LAS unsigned char*)lds; F.glds = lds; F.ws = args.ws; F.ctl = (unsigned*)(args.ws + WS_CTL);
    F.tid = threadIdx.x; F.lane = F.tid & 63; F.wave = __builtin_amdgcn_readfirstlane(F.tid >> 6);
    F.G = gridDim.x; F.gw = blockIdx.x * NWAVES + F.wave; F.NGW = F.G * NWAVES;
    volatile LAS unsigned* MISC = (volatile LAS unsigned*)(F.lds + MISC_OFF);
    for (int u = F.tid; u < (LDS_BYTES - LDSCTL_OFF) / 4; u += NTHR) ((LAS unsigned*)(F.lds + LDSCTL_OFF))[u] = 0u;
    __syncthreads();
    if (F.tid < N_INPUTS) { const unsigned long long p = (unsigned long long)args.in[F.tid]; LAS unsigned* t = (LAS unsigned*)(F.lds + PTAB_OFF) + 2 * F.tid; t[0] = (unsigned)p; t[1] = (unsigned)(p >> 32); }
    __syncthreads();
    XcdBarrier bar; bar.bar = F.ctl + CW_BAR; bar.x = 0; bar.st = nullptr;
    if (N_LAUNCHES == 1) bar = xcd_barrier_post(F.ctl + CW_BAR, MISC + 8);
    const int lo = args.ph_lo, hi = args.ph_hi;
    float* out = args.out;
    if (IN(0)) { p0_ada(F, inptr(F, IN_C), inptr(F, IN_ADAW), inptr(F, IN_ADAB), (float*)(F.ws + WS_MOD)); __syncthreads(); conv_all<0>(F); }
    SEAM(0);
    if (IN(1)) { float* mod = (float*)(F.ws + WS_MOD); const float* x = inptr(F, IN_X);
        row_phase<0, 1, true, true>(F, x, (float*)x  , nullptr, nullptr, nullptr, inptr(F, IN_GPREM), mod + 1 * D, mod + 0 * D, (bf16_t*)(F.ws + WS_XN),
                              inptr(F, IN_WIN) + SRC_GATE, NIN_SRC, inptr(F, IN_IGB), inptr(F, IN_FGB), (float*)(F.ws + WS_GATES), nullptr, nullptr, nullptr, nullptr, (float*)(F.ws + WS_ROWMAX));
        conv_all<1>(F); }
    SEAM(1);
    layer<0>(F, bar, out, lo, hi);
    layer<1>(F, bar, out, lo, hi);
}
#undef IN
#undef SEAM
#undef GRID_BAR

extern "C" void kernel_launch(void* const* d_in, const int* in_sizes, int n_in, void* d_out, int out_size, void* d_ws, size_t ws_size, hipStream_t stream) {
    static int grid = 0;
    if (grid == 0) {
        if (n_in != N_INPUTS || in_sizes[0] != M * D || out_size != M * D || ws_size < WS_END) { fprintf(stderr, "kernel_launch: unexpected problem (n_in %d, in0 %d, out %d, ws %zu); nothing launched\n", n_in, n_in > 0 ? in_sizes[0] : -1, out_size, ws_size); grid = -1; return; }
        int dev = 0, cus = 0, per_cu = 0;
        if (hipGetDevice(&dev) != hipSuccess || hipDeviceGetAttribute(&cus, hipDeviceAttributeMultiprocessorCount, dev) != hipSuccess) { grid = -1; return; }
        if (hipFuncSetAttribute((const void*)fwd, hipFuncAttributeMaxDynamicSharedMemorySize, LDS_BYTES) != hipSuccess) { fprintf(stderr, "kernel_launch: hipFuncSetAttribute failed\n"); grid = -1; return; }
        if (hipOccupancyMaxActiveBlocksPerMultiprocessor(&per_cu, (const void*)fwd, NTHR, LDS_BYTES) != hipSuccess || per_cu < 1) fprintf(stderr, "kernel_launch: occupancy query reports %d\n", per_cu);
        (void)hipGetLastError();
        grid = cus;
    }
    if (grid < 0) return;
    if (hipMemsetAsync((char*)d_ws + WS_CTL, 0, CTL_ZERO_BYTES, stream) != hipSuccess) return;
    Args a{};
    for (int i = 0; i < N_INPUTS; ++i) a.in[i] = (const float*)d_in[i];
    a.out = (float*)d_out; a.ws = (unsigned char*)d_ws;
    if (N_LAUNCHES == 1) { a.ph_lo = 0; a.ph_hi = N_PHASES; hipLaunchKernelGGL(fwd, dim3(grid), dim3(NTHR), LDS_BYTES, stream, a); }
    else for (int p = 0; p < N_PHASES; ++p) { a.ph_lo = p; a.ph_hi = p + 1; hipLaunchKernelGGL(fwd, dim3(grid), dim3(NTHR), LDS_BYTES, stream, a); }
}
```

```cpp
#include <hip/hip_runtime.h>
#include <cstdio>
#include <cstdint>

#ifndef MK_N_LAUNCHES
#define MK_N_LAUNCHES 1
#endif

#define LAS __attribute__((address_space(3)))
#define GAS __attribute__((address_space(1)))
typedef unsigned short bf16_t;
typedef short bf16x8 __attribute__((ext_vector_type(8)));
typedef float f32x4 __attribute__((ext_vector_type(4)));
typedef float f32x2 __attribute__((ext_vector_type(2)));
typedef float f32x16 __attribute__((ext_vector_type(16)));
typedef unsigned u32x4 __attribute__((ext_vector_type(4)));
typedef unsigned u32x2 __attribute__((ext_vector_type(2)));
typedef __bf16 bf16x2_t __attribute__((ext_vector_type(2)));

constexpr int NB = 8, SEQ = 2048, D = 2048, M = NB * SEQ;
constexpr int NIN_SRC = 4872, NIN = 4864;
constexpr int C_MQ = 0, C_MK = 512, C_MV = 1024, C_LQ = 1536, C_LK = 2048, C_LV = 2560, C_LO = 3072, C_SQ = 3584, C_SK = 4608, C_SV = 4736;
constexpr int SRC_GATE = 3584;
constexpr int DFF = 5632, DFE = 2816, NE = 8, ECAP = M;
constexpr float RMS_EPS = 1e-6f;
constexpr int NWAVES = 8, NTHR = 512;

constexpr size_t MiB = 1u << 20;
constexpr size_t WS_CTL = 0, CTL_ZERO_BYTES = 1 * MiB;
constexpr size_t WS_MOD = 1 * MiB;
constexpr size_t WS_GATES = 2 * MiB;
constexpr size_t WS_ROWMAX = 4 * MiB;
constexpr size_t WS_RMSLOT = 4 * MiB + 131072;
constexpr size_t WS_TOK = 3 * MiB;
constexpr size_t WS_WIN = 8 * MiB;
constexpr size_t WS_WOUT = 48 * MiB;
constexpr size_t WS_WGU = 64 * MiB;
constexpr size_t WS_WD = 108 * MiB;
constexpr size_t WS_MGU = 130 * MiB;
constexpr size_t WS_MD = 306 * MiB;
constexpr size_t WS_XN = 394 * MiB;
constexpr size_t WS_PROJ = 458 * MiB;
constexpr size_t WS_YMIX = 610 * MiB;
constexpr size_t WS_ACT = 458 * MiB;
constexpr size_t WS_YB = 674 * MiB;
constexpr size_t WS_XB = 810 * MiB;
constexpr size_t WS_CC = 874 * MiB;
constexpr size_t WS_CP = 906 * MiB;
constexpr size_t WS_NC = 938 * MiB, WS_NP = 939 * MiB, WS_SC = 940 * MiB;
constexpr size_t WS_END = 941 * MiB;
constexpr int CW_TMO = 0, CW_CODE = 1;
constexpr int CW_CNT = 64;
constexpr int CW_WQ = 128;
constexpr int CW_BAR = 4096;
constexpr size_t KMEAN_OFF = 262144;


__device__ __forceinline__ unsigned cvtpk(float lo, float hi) { f32x2 v = {lo, hi}; bf16x2_t b = __builtin_convertvector(v, bf16x2_t); return __builtin_bit_cast(unsigned, b); }
__device__ __forceinline__ float bflo(unsigned u) { return __uint_as_float(u << 16); }
__device__ __forceinline__ float bfhi(unsigned u) { return __uint_as_float(u & 0xffff0000u); }
__device__ __forceinline__ float bf1(bf16_t u) { return __uint_as_float(((unsigned)u) << 16); }
template <bool MAX>
__device__ __forceinline__ float scan64(float v) {
    constexpr int ident = MAX ? (int)0xff800000 : 0;
#define SCAN_STEP(ctrl, rm) { const float tf = __int_as_float(__builtin_amdgcn_update_dpp(ident, __float_as_int(v), ctrl, rm, 0xf, false)); v = MAX ? fmaxf(v, tf) : v + tf; }
    SCAN_STEP(0x111, 0xf) SCAN_STEP(0x112, 0xf) SCAN_STEP(0x114, 0xf) SCAN_STEP(0x118, 0xf) SCAN_STEP(0x142, 0xa) SCAN_STEP(0x143, 0xc)
#undef SCAN_STEP
    return v;
}
__device__ __forceinline__ float lane63(float v) { return __int_as_float(__builtin_amdgcn_readlane(__float_as_int(v), 63)); }
__device__ __forceinline__ float wave_sum(float v) { return lane63(scan64<false>(v)); }
__device__ __forceinline__ float wave_max(float v) { return lane63(scan64<true>(v)); }
#define LBAR() do { asm volatile("s_waitcnt lgkmcnt(0)" ::: "memory"); __builtin_amdgcn_s_barrier(); asm volatile("" ::: "memory"); } while (0)
__device__ __forceinline__ float silu_f(float x) { return x / (1.f + __expf(-x)); }
__device__ __forceinline__ float sigmoid_f(float x) { return 1.f / (1.f + __expf(-x)); }

namespace pg8 {
constexpr int BM = 256, BK = 64, HALF = 128, HTB = HALF * BK * 2, STAGE_BYTES = 8 * HTB, NXCD = 8, WGM = 8;
__host__ __device__ __forceinline__ int lds_byte(int r, int c) { const int st = (r >> 4) * 2 + (c >> 5), rr = r & 15, cc = c & 31, ob = rr * 64 + cc * 2; return st * 1024 + (ob ^ (((ob >> 9) & 1) << 5)); }
__host__ __device__ __forceinline__ void stage_rc(int b, int& R, int& C) { const int st = b / 1024, sb = b % 1024, swz = sb ^ (((sb >> 9) & 1) << 5); R = (st >> 1) * 16 + swz / 64; C = (st & 1) * 32 + (swz % 64) / 2; }
__host__ __device__ __forceinline__ int perm32(int rho) { const int n = rho >> 4, i = rho & 15; return 8 * (i >> 2) + 4 * n + (i & 3); }

struct Unit { int pm, pn, e; };
__device__ __forceinline__ unsigned pack_fp8x4(float a, float b, float c, float d) {
    a = fminf(fmaxf(a, -448.f), 448.f); b = fminf(fmaxf(b, -448.f), 448.f); c = fminf(fmaxf(c, -448.f), 448.f); d = fminf(fmaxf(d, -448.f), 448.f);
    int p = __builtin_amdgcn_cvt_pk_fp8_f32(a, b, 0, false); p = __builtin_amdgcn_cvt_pk_fp8_f32(c, d, p, true); return (unsigned)p;
}


__device__ __forceinline__ bool static_next(int i, int G, int c, int nM, int nN, int& pm, int& pn) {
    const int nwg = nM * nN; const long L = (long)i * G + c; if (L >= nwg) return false;
    int wgid = (int)L; { const int q = nwg / NXCD, r = nwg % NXCD, xcd = wgid % NXCD, off = wgid / NXCD; wgid = (xcd < r ? xcd * (q + 1) : r * (q + 1) + (xcd - r) * q) + off; }
    const int nig = WGM * nN, gid = wgid / nig, fm = gid * WGM, gsz = (nM - fm) < WGM ? (nM - fm) : WGM;
    pm = fm + ((wgid % nig) % gsz); pn = (wgid % nig) / gsz; return true;
}

struct DenseSched {
    static constexpr bool GATHER = false;
    const char* A; const char* Bt; int KB  , nM, nN, G, c;
    __device__ __forceinline__ bool next(int i, Unit& u) const { u.e = 0; return static_next(i, G, c, nM, nN, u.pm, u.pn); }
    __device__ __forceinline__ const char* a_base() const { return A; }
    __device__ __forceinline__ void a_offsets(const Unit& u, const int (&Rr)[2], const int (&Cc)[2], unsigned (&off)[2][2]) const {
#pragma unroll
        for (int h = 0; h < 2; ++h)
#pragma unroll
            for (int i = 0; i < 2; ++i) off[h][i] = (unsigned)((u.pm * BM + h * HALF + Rr[i]) * KB + Cc[i] * 2);
    }
    __device__ __forceinline__ const char* b_base(const Unit& u) const { return Bt + (size_t)u.pn * BM * KB; }
};
template <bool GATHER_>
struct MoeSched {
    static constexpr bool GATHER = GATHER_;
    const char* A; const char* W; const int* idx; const LAS int* tab  ; int KB, nN, G, c, wrows  , ntile;
    __device__ __forceinline__ bool next(int i, Unit& u) const { if (!static_next(i, G, c, ntile, nN, u.pm, u.pn)) return false; int e = 0;
#pragma unroll
        for (int j = 1; j < NE; ++j) e += (u.pm >= tab[8 + j]) ? 1 : 0;
        u.e = e; return true; }
    __device__ __forceinline__ const char* a_base() const { return A; }
    __device__ __forceinline__ void a_offsets(const Unit& u, const int (&Rr)[2], const int (&Cc)[2], unsigned (&off)[2][2]) const {
        const int cume = tab[8 + u.e], cnte = tab[u.e];
#pragma unroll
        for (int h = 0; h < 2; ++h)
#pragma unroll
            for (int i = 0; i < 2; ++i) {
                if (GATHER_) { const int rl = (u.pm - cume) * BM + h * HALF + Rr[i]; const int tok = (rl < cnte) ? idx[u.e * ECAP + rl] : 0; off[h][i] = (unsigned)(tok * KB + Cc[i] * 2); }
                else off[h][i] = (unsigned)((u.pm * BM + h * HALF + Rr[i]) * KB + Cc[i] * 2);
            }
    }
    __device__ __forceinline__ const char* b_base(const Unit& u) const { return W + ((size_t)u.e * wrows + (size_t)u.pn * BM) * KB; }
};

struct EpiBf16 {
    static constexpr bool PERM = true;
    bf16_t* O; int ldc; float sc;
    __device__ __forceinline__ void operator()(const f32x4 (&acc)[2][2][4][2], const Unit& u, int wr, int wc, int fr, int fq) const {
        const int row0 = u.pm * BM + wr * 64 + fr, col0 = u.pn * BM + wc * 32 + 8 * fq;
#pragma unroll
        for (int ai = 0; ai < 2; ++ai)
#pragma unroll
            for (int m = 0; m < 4; ++m) { bf16_t* rowp = O + (size_t)(row0 + ai * HALF + m * 16) * ldc + col0;
#pragma unroll
                for (int bj = 0; bj < 2; ++bj) { const f32x4 v0 = acc[ai][bj][m][0] * sc, v1 = acc[ai][bj][m][1] * sc;
                    u32x4 w; w.x = cvtpk(v0[0], v0[1]); w.y = cvtpk(v0[2], v0[3]); w.z = cvtpk(v1[0], v1[1]); w.w = cvtpk(v1[2], v1[3]);
                    *(u32x4*)(rowp + bj * HALF) = w; } }
    }
};
struct EpiInProjI8 {
    static constexpr bool PERM = true;
    bf16_t* O; int ldc; float* kmean; const float* rowmax; const float* colmax;
    __device__ __forceinline__ void operator()(const f32x4 (&acc)[2][2][4][2], const Unit& u, int wr, int wc, int fr, int fq) const {
        typedef int i32x4_ __attribute__((ext_vector_type(4)));
        const int row0 = u.pm * BM + wr * 64 + fr, col0 = u.pn * BM + wc * 32 + 8 * fq;
        const float qsc = (u.pn < 2 || (u.pn >= 14 && u.pn < 18)) ? 0.125f * 1.4426950408889634f : 1.f;
        f32x4 cmv[2][2], cs[2][2];
#pragma unroll
        for (int bj = 0; bj < 2; ++bj)
#pragma unroll
            for (int n = 0; n < 2; ++n) { cmv[bj][n] = *(const f32x4*)(colmax + col0 + bj * HALF + 4 * n) * (qsc / (127.f * 127.f)); cs[bj][n] = (f32x4){0.f, 0.f, 0.f, 0.f}; }
#pragma unroll
        for (int ai = 0; ai < 2; ++ai)
#pragma unroll
            for (int m = 0; m < 4; ++m) { const int r = row0 + ai * HALF + m * 16; bf16_t* rowp = O + (size_t)r * ldc + col0; const float sa = rowmax[r];
#pragma unroll
                for (int bj = 0; bj < 2; ++bj) { f32x4 v[2];
#pragma unroll
                    for (int n = 0; n < 2; ++n) { const i32x4_ iv = __builtin_bit_cast(i32x4_, acc[ai][bj][m][n]);
                        v[n] = (f32x4){(float)iv[0], (float)iv[1], (float)iv[2], (float)iv[3]} * (cmv[bj][n] * sa); cs[bj][n] += v[n]; }
                    u32x4 w; w.x = cvtpk(v[0][0], v[0][1]); w.y = cvtpk(v[0][2], v[0][3]); w.z = cvtpk(v[1][0], v[1][1]); w.w = cvtpk(v[1][2], v[1][3]);
                    *(u32x4*)(rowp + bj * HALF) = w; } }
        if (u.pn == 2 || u.pn == 3) {
#pragma unroll
            for (int bj = 0; bj < 2; ++bj)
#pragma unroll
                for (int n = 0; n < 2; ++n) {
#pragma unroll
                    for (int j = 0; j < 4; ++j) { float v = cs[bj][n][j]; v += __shfl_xor(v, 1); v += __shfl_xor(v, 2); v += __shfl_xor(v, 4); v += __shfl_xor(v, 8); cs[bj][n][j] = v; }
                    if (fr == 0) { float* kp = kmean + (size_t)u.pm * 512 + (u.pn - 2) * BM + bj * HALF + wc * 32 + 8 * fq + 4 * n;
#pragma unroll
                        for (int j = 0; j < 4; ++j) atomicAdd(kp + j, cs[bj][n][j] * (1.f / 256.f)); } }
        }
    }
};
typedef int i32x8 __attribute__((ext_vector_type(8)));
typedef int i32x4 __attribute__((ext_vector_type(4)));
struct EpiSwiGLUI8 {
    static constexpr bool PERM = true;
    unsigned char* O; int ldc; const float* rowmax; const float* colmax  ; const int* rowidx  ; const LAS int* tab;
    __device__ __forceinline__ void operator()(const f32x4 (&acc)[2][2][4][2], const Unit& u, int wr, int wc, int fr, int fq) const {
        const int row0 = u.pm * BM + wr * 64 + fr, col0 = u.pn * HALF + wc * 32 + 8 * fq;
        const float* cm = colmax + (size_t)u.e * 2 * ldc + u.pn * BM + wc * 32 + 8 * fq;
        const f32x4 cg0 = *(const f32x4*)(cm), cg1 = *(const f32x4*)(cm + 4), cu0 = *(const f32x4*)(cm + HALF), cu1 = *(const f32x4*)(cm + HALF + 4);
        const float cg[8] = {cg0[0], cg0[1], cg0[2], cg0[3], cg1[0], cg1[1], cg1[2], cg1[3]}, cu[8] = {cu0[0], cu0[1], cu0[2], cu0[3], cu1[0], cu1[1], cu1[2], cu1[3]};
        int cume = 0, cnte = 0x7fffffff; if (rowidx) { cume = tab[8 + u.e]; cnte = tab[u.e]; }
#pragma unroll
        for (int ai = 0; ai < 2; ++ai)
#pragma unroll
            for (int m = 0; m < 4; ++m) { const int r = row0 + ai * HALF + m * 16; unsigned char* rowp = O + (size_t)r * ldc + col0;
                float sa; if (rowidx) { const int rl = r - cume * BM; sa = (rl < cnte) ? rowmax[u.e * ECAP + rl] : 0.f; } else sa = rowmax[r];
                sa *= (1.f / (127.f * 127.f));
                float o[8];
#pragma unroll
                for (int n = 0; n < 2; ++n)
#pragma unroll
                    for (int j = 0; j < 4; ++j) { const float g = (float)__builtin_bit_cast(i32x4, acc[ai][0][m][n])[j] * (sa * cg[n * 4 + j]), up = (float)__builtin_bit_cast(i32x4, acc[ai][1][m][n])[j] * (sa * cu[n * 4 + j]);
                        o[n * 4 + j] = g * __builtin_amdgcn_rcpf(1.f + __builtin_amdgcn_exp2f(-1.4426950408889634f * g)) * up; }
                u32x2 w; w.x = pack_fp8x4(o[0], o[1], o[2], o[3]); w.y = pack_fp8x4(o[4], o[5], o[6], o[7]);
                *(u32x2*)rowp = w; }
    }
};

struct EpiSwiGLU8 {
    static constexpr bool PERM = true;
    unsigned char* O; int ldc; float sc;
    __device__ __forceinline__ void operator()(const f32x4 (&acc)[2][2][4][2], const Unit& u, int wr, int wc, int fr, int fq) const {
        const int row0 = u.pm * BM + wr * 64 + fr, col0 = u.pn * HALF + wc * 32 + 8 * fq;
#pragma unroll
        for (int ai = 0; ai < 2; ++ai)
#pragma unroll
            for (int m = 0; m < 4; ++m) { unsigned char* rowp = O + (size_t)(row0 + ai * HALF + m * 16) * ldc + col0;
                float r[8];
#pragma unroll
                for (int n = 0; n < 2; ++n)
#pragma unroll
                    for (int j = 0; j < 4; ++j) { const float g = acc[ai][0][m][n][j] * sc, up = acc[ai][1][m][n][j] * sc;
                        r[n * 4 + j] = g * __builtin_amdgcn_rcpf(1.f + __builtin_amdgcn_exp2f(-1.4426950408889634f * g)) * up; }
                u32x2 w; w.x = pack_fp8x4(r[0], r[1], r[2], r[3]); w.y = pack_fp8x4(r[4], r[5], r[6], r[7]);
                *(u32x2*)rowp = w; }
    }
};

template <class Epi, class Sched, bool ALIGN_EPI, int DT>
__device__ __forceinline__ void gemm_phase(LAS unsigned char* lds, const int KB, const Sched& S, const Epi& E) {
    const int tid = threadIdx.x, wid = __builtin_amdgcn_readfirstlane(tid >> 6), lane = tid & 63, wr = wid >> 2, wc = wid & 3, fr = lane & 15, fq = lane >> 4;
    const int nt = KB / 128;
    int Rr[2], Cc[2]; unsigned voffB[2];
#pragma unroll
    for (int i = 0; i < 2; ++i) { int R, C; stage_rc(tid * 16 + i * 8192, R, C); Rr[i] = R; Cc[i] = C; const int Rb = Epi::PERM ? ((R & ~31) + perm32(R & 31)) : R; voffB[i] = (unsigned)(Rb * KB + C * 2); }
    const size_t kstep = (size_t)(BK * 2);
    const size_t hstep = (size_t)HALF * KB;
    const unsigned ldsw = (unsigned)wid * 1024u;
    const int aoff = lds_byte(wr * 64 + fr, fq * 8), boff = lds_byte(wc * 32 + fr, fq * 8);
#define PG8_SA(b, h) (((b) * 2 + (h)) * HTB)
#define PG8_SB(b, h) ((4 + (b) * 2 + (h)) * HTB)
#define PG8_STAGE(bufoff, gbase, voff) do { _Pragma("unroll") for (int _i = 0; _i < 2; ++_i) \
        __builtin_amdgcn_global_load_lds((const unsigned*)((const char*)(gbase) + (voff)[_i]), (LAS unsigned*)(lds + (bufoff) + ldsw + _i * 8192), 16, 0, 0); } while (0)
#define PG8_LD32(p) __builtin_shufflevector(*(const LAS i32x4*)(p), *(const LAS i32x4*)((p) + 1024), 0, 1, 2, 3, 4, 5, 6, 7)
#define PG8_LDA(dst, b, h) do { _Pragma("unroll") for (int m = 0; m < 4; ++m) dst[m] = PG8_LD32(lds + PG8_SA(b, h) + aoff + m * 2048); } while (0)
#define PG8_LDB(dst, b, h) do { _Pragma("unroll") for (int n = 0; n < 2; ++n) dst[n] = PG8_LD32(lds + PG8_SB(b, h) + boff + n * 2048); } while (0)
#define PG8_LO(x) __builtin_bit_cast(bf16x8, __builtin_shufflevector((x), (x), 0, 1, 2, 3))
#define PG8_HI(x) __builtin_bit_cast(bf16x8, __builtin_shufflevector((x), (x), 4, 5, 6, 7))
#define PG8_MMA(ai, bj, At, Bt) do { __builtin_amdgcn_s_setprio(1); \
        if constexpr (DT == 2) { _Pragma("unroll") for (int m = 0; m < 4; ++m) _Pragma("unroll") for (int n = 0; n < 2; ++n) { \
            i32x4 _c = __builtin_bit_cast(i32x4, acc[ai][bj][m][n]); \
            _c = __builtin_amdgcn_mfma_i32_16x16x64_i8(__builtin_shufflevector(Bt[n], Bt[n], 0, 1, 2, 3), __builtin_shufflevector(At[m], At[m], 0, 1, 2, 3), _c, 0, 0, 0); \
            _c = __builtin_amdgcn_mfma_i32_16x16x64_i8(__builtin_shufflevector(Bt[n], Bt[n], 4, 5, 6, 7), __builtin_shufflevector(At[m], At[m], 4, 5, 6, 7), _c, 0, 0, 0); \
            acc[ai][bj][m][n] = __builtin_bit_cast(f32x4, _c); } } \
        else if constexpr (DT == 1) { _Pragma("unroll") for (int m = 0; m < 4; ++m) _Pragma("unroll") for (int n = 0; n < 2; ++n) \
            asm volatile("v_mfma_scale_f32_16x16x128_f8f6f4 %0, %1, %2, %0, %3, %3 op_sel_hi:[0,0,0]" : "+v"(acc[ai][bj][m][n]) : "v"(Bt[n]), "v"(At[m]), "v"(scv)); } \
        else { _Pragma("unroll") for (int m = 0; m < 4; ++m) _Pragma("unroll") for (int n = 0; n < 2; ++n) { \
            acc[ai][bj][m][n] = __builtin_amdgcn_mfma_f32_16x16x32_bf16(PG8_LO(Bt[n]), PG8_LO(At[m]), acc[ai][bj][m][n], 0, 0, 0); \
            acc[ai][bj][m][n] = __builtin_amdgcn_mfma_f32_16x16x32_bf16(PG8_HI(Bt[n]), PG8_HI(At[m]), acc[ai][bj][m][n], 0, 0, 0); } } \
        __builtin_amdgcn_s_setprio(0); } while (0)
#define PG8_WAIT_V(n) asm volatile("s_waitcnt vmcnt(" #n ")" ::: "memory")
#define PG8_WAIT_L(n) asm volatile("s_waitcnt lgkmcnt(" #n ")" ::: "memory")
#define PG8_BAR __builtin_amdgcn_s_barrier()
#define PG8_SCHED __builtin_amdgcn_sched_barrier(0)
    Unit cur, nxt; int ui = 0;
    if (!S.next(0, cur)) return;
    f32x4 acc[2][2][4][2];
#pragma unroll
    for (int a = 0; a < 2; ++a)
#pragma unroll
        for (int b = 0; b < 2; ++b)
#pragma unroll
            for (int m = 0; m < 4; ++m)
#pragma unroll
                for (int n = 0; n < 2; ++n) acc[a][b][m][n] = (f32x4){0.f, 0.f, 0.f, 0.f};
    i32x8 At[4], B0[2], B1[2];
    int scv = 0x7F7F7F7F; asm volatile("" : "+v"(scv));
    unsigned curA[2][2], nxtA[2][2], voffA[2];
    const char* const Ab = S.a_base(); const char* cA = Ab; const char* nA = Ab;
    if constexpr (Sched::GATHER) S.a_offsets(cur, Rr, Cc, curA);
    else {
#pragma unroll
        for (int i = 0; i < 2; ++i) voffA[i] = (unsigned)(Rr[i] * KB + Cc[i] * 2);
        cA = Ab + (size_t)cur.pm * 2 * hstep; }
    const char* cB = S.b_base(cur);
#define PG8_STA(bufoff, nextflag, h, koff) do { if constexpr (Sched::GATHER) { unsigned _o[2]; _o[0] = (nextflag) ? nxtA[h][0] : curA[h][0]; _o[1] = (nextflag) ? nxtA[h][1] : curA[h][1]; PG8_STAGE(bufoff, Ab + (koff), _o); } \
        else { PG8_STAGE(bufoff, ((nextflag) ? nA : cA) + (size_t)(h) * hstep + (koff), voffA); } } while (0)
    PG8_STAGE(PG8_SB(0, 0), cB, voffB); PG8_STAGE(PG8_SB(0, 1), cB + hstep, voffB); PG8_STA(PG8_SA(0, 0), false, 0, 0); PG8_STA(PG8_SA(0, 1), false, 1, 0);
    if (wr == 1) PG8_BAR;
    PG8_WAIT_V(2); PG8_BAR;
    PG8_STAGE(PG8_SB(1, 0), cB + kstep, voffB); PG8_STA(PG8_SA(1, 0), false, 0, kstep); PG8_STAGE(PG8_SB(1, 1), cB + hstep + kstep, voffB);
    PG8_WAIT_V(6); PG8_BAR;
    for (;;) {
        const bool has_next = S.next(ui + 1, nxt);
        if constexpr (Sched::GATHER) {
            if (has_next) S.a_offsets(nxt, Rr, Cc, nxtA);
            else {
#pragma unroll
                for (int h = 0; h < 2; ++h)
#pragma unroll
                    for (int i = 0; i < 2; ++i) nxtA[h][i] = curA[h][i]; }
        } else nA = has_next ? Ab + (size_t)nxt.pm * 2 * hstep : cA;
        const char* nB = has_next ? S.b_base(nxt) : cB;
        for (int t = 0; t < nt; t += 2) {
            const bool last = (t == nt - 2);
            const size_t k1 = (size_t)(t + 1) * kstep, k2 = last ? 0 : (size_t)(t + 2) * kstep, k3 = k2 + kstep;
            const char* b2 = last ? nB : cB + (size_t)(t + 2) * kstep; const char* b3 = b2 + kstep;
            PG8_LDB(B0, 0, 0); PG8_LDB(B1, 0, 1); PG8_SCHED; PG8_LDA(At, 0, 0); PG8_STA(PG8_SA(1, 1), false, 1, k1);
            PG8_WAIT_V(8); PG8_WAIT_L(0); PG8_BAR; PG8_MMA(0, 0, At, B0); PG8_MMA(0, 1, At, B1); PG8_BAR; PG8_SCHED;
            PG8_LDA(At, 0, 1); PG8_STAGE(PG8_SB(0, 0), b2, voffB); PG8_STAGE(PG8_SB(0, 1), b2 + hstep, voffB); PG8_STA(PG8_SA(0, 0), last, 0, k2);
            PG8_WAIT_V(8); PG8_WAIT_L(0); PG8_BAR; PG8_MMA(1, 0, At, B0); PG8_MMA(1, 1, At, B1); PG8_BAR; PG8_SCHED;
            PG8_LDB(B0, 1, 0); PG8_LDB(B1, 1, 1); PG8_SCHED; PG8_LDA(At, 1, 0); PG8_STA(PG8_SA(0, 1), last, 1, k2);
            PG8_WAIT_V(8); PG8_WAIT_L(0); PG8_BAR; PG8_MMA(0, 0, At, B0); PG8_MMA(0, 1, At, B1); PG8_BAR; PG8_SCHED;
            PG8_LDA(At, 1, 1); PG8_STAGE(PG8_SB(1, 0), b3, voffB); PG8_STAGE(PG8_SB(1, 1), b3 + hstep, voffB); PG8_STA(PG8_SA(1, 0), last, 0, k3);
            PG8_WAIT_V(8); PG8_WAIT_L(0); PG8_BAR; PG8_MMA(1, 0, At, B0); PG8_MMA(1, 1, At, B1); PG8_BAR; PG8_SCHED;
        }
        if constexpr (ALIGN_EPI) { if (wr == 0) PG8_BAR; }
        if constexpr (DT == 1) asm volatile("s_nop 15\n\ts_nop 15" ::: "memory");
        E(acc, cur, wr, wc, fr, fq);
        if (!has_next) break;
#pragma unroll
        for (int a = 0; a < 2; ++a)
#pragma unroll
            for (int b = 0; b < 2; ++b)
#pragma unroll
                for (int m = 0; m < 4; ++m)
#pragma unroll
                    for (int n = 0; n < 2; ++n) acc[a][b][m][n] = (f32x4){0.f, 0.f, 0.f, 0.f};
        cur = nxt; cB = nB; cA = nA; ++ui;
        if constexpr (Sched::GATHER) {
#pragma unroll
            for (int h = 0; h < 2; ++h)
#pragma unroll
                for (int i = 0; i < 2; ++i) curA[h][i] = nxtA[h][i]; }
        if constexpr (ALIGN_EPI) { if (wr == 1) PG8_BAR; }
    }
    PG8_WAIT_V(0);
    if constexpr (!ALIGN_EPI) { if (wr == 0) PG8_BAR; }
    PG8_BAR;
#undef PG8_SA
#undef PG8_SB
#undef PG8_STAGE
#undef PG8_STA
#undef PG8_LDA
#undef PG8_LDB
#undef PG8_MMA
#undef PG8_LD32
#undef PG8_LO
#undef PG8_HI
#undef PG8_WAIT_V
#undef PG8_WAIT_L
#undef PG8_BAR
#undef PG8_SCHED
}
}

#define XB_TMO      128
#define XB_XCNT(j)  (256  + 64 * (j))
#define XB_XSUB(j)  (1280 + 64 * (j))
#define XB_XGEN(j)  (2304 + 64 * (j))
#define XB_TOP      3328
#define XB_TOPGEN   3392
#define XCD_BAR_WORDS 3456
#define XB_SPIN_CAP (1u << 18)
__device__ __forceinline__ unsigned xb_ld(unsigned* p)              { return __hip_atomic_load(p, __ATOMIC_RELAXED, __HIP_MEMORY_SCOPE_AGENT); }
__device__ __forceinline__ unsigned xb_add(unsigned* p, unsigned v) { return __hip_atomic_fetch_add(p, v, __ATOMIC_RELAXED, __HIP_MEMORY_SCOPE_AGENT); }
__device__ __forceinline__ unsigned xb_xcc_id() { return (unsigned)__builtin_amdgcn_s_getreg((3 << 11) | 20) & 0xFu; }
#define XB_SPIN(cond, bar) do { unsigned _sp = 0; while (cond) { __builtin_amdgcn_s_sleep(1); \
    if ((++_sp & 255u) == 0u) { if (xb_ld(&(bar)[XB_TMO])) break; if (_sp > XB_SPIN_CAP) { atomicAdd(&(bar)[XB_TMO], 1u); break; } } } } while (0)
struct XcdBarrier { unsigned* bar; unsigned x; volatile LAS unsigned* st; };
__device__ __forceinline__ XcdBarrier xcd_barrier_post(unsigned* bar, volatile LAS unsigned* st) {
    XcdBarrier b; b.bar = bar; b.x = xb_xcc_id(); b.st = st;
    if (threadIdx.x == 0) (void)xb_add(&bar[XB_XCNT(b.x)], 1u);
    return b;
}
__device__ __forceinline__ void xcd_barrier_complete(unsigned* bar, unsigned x, unsigned& nloc, unsigned& nx) {
    const unsigned G = gridDim.x * gridDim.y * gridDim.z;
    unsigned sum, cnt, mine, sp = 0u;
    for (;;) {
        sum = 0u; cnt = 0u; mine = 0u;
#pragma unroll
        for (unsigned j = 0; j < 16; ++j) { const unsigned c = xb_ld(&bar[XB_XCNT(j)]); sum += c; cnt += (c > 0u) ? 1u : 0u; mine = (j == x) ? c : mine; }
        if (sum == G) break;
        __builtin_amdgcn_s_sleep(1);
        if ((++sp & 255u) == 0u) { if (xb_ld(&bar[XB_TMO])) break; if (sp > XB_SPIN_CAP) { atomicAdd(&bar[XB_TMO], 1u); break; } }
    }
    nloc = mine > 0u ? mine : 1u; nx = cnt > 0u ? cnt : 1u;
}
__device__ __forceinline__ void xcd_barrier(const XcdBarrier& b) {
    asm volatile("s_waitcnt vmcnt(0)" ::: "memory");
    __syncthreads();
    if (threadIdx.x == 0) {
        unsigned* bar = b.bar;
        __builtin_amdgcn_s_waitcnt(0);
        unsigned nloc = b.st[0], nx = b.st[1];
        if (nloc == 0u) { xcd_barrier_complete(bar, b.x, nloc, nx); b.st[0] = nloc; b.st[1] = nx; }
        const unsigned old = xb_add(&bar[XB_XSUB(b.x)], 1u);
        const unsigned gen = old / nloc;
        if (old + 1u == (gen + 1u) * nloc) {
            __builtin_amdgcn_fence(__ATOMIC_RELEASE, "agent");
            asm volatile("s_waitcnt vmcnt(0)" ::: "memory");
            const unsigned og = xb_add(&bar[XB_TOP], 1u);
            const unsigned tg = og / nx;
            if (og + 1u == (tg + 1u) * nx) xb_add(&bar[XB_TOPGEN], 1u);
            else XB_SPIN(xb_ld(&bar[XB_TOPGEN]) == tg, bar);
            __builtin_amdgcn_fence(__ATOMIC_ACQUIRE, "agent");
            xb_add(&bar[XB_XGEN(b.x)], 1u);
            asm volatile("s_waitcnt vmcnt(0)" ::: "memory");
        } else {
            XB_SPIN(xb_ld(&bar[XB_XGEN(b.x)]) == gen, bar);
            __builtin_amdgcn_fence(__ATOMIC_ACQUIRE, "agent");
            asm volatile("s_waitcnt vmcnt(0)" ::: "memory");
        }
    }
    __syncthreads();
}

constexpr int RING_BYTES = 131072, LDSCTL_OFF = RING_BYTES, MISC_OFF = LDSCTL_OFF + 320, LDS_BYTES = 147456;
enum { IN_X = 0, IN_C, IN_ADAW, IN_ADAB, IN_GPREM, IN_GPOSTM, IN_GPREF, IN_GPOSTF, IN_WIN, IN_WOUT, IN_CONVW, IN_CONVB, IN_IGB, IN_FGB, IN_MNW, IN_SINK,
       IN_FG, IN_FU, IN_FD, IN_ROUTER, IN_MG, IN_MU, IN_MD, N_INPUTS };
struct Args { const float* in[N_INPUTS]; float* out; unsigned char* ws; int ph_lo, ph_hi; };
struct Frame {
    LAS unsigned char* lds; unsigned char* glds; unsigned* ctl; unsigned char* ws;
    int tid, lane, wave, G, gw, NGW;
};

__device__ __forceinline__ void p0_ada(Frame& F, const float* c, const float* ada_w, const float* ada_b, float* mod) {
    float* cond = (float*)F.glds;
    float* part = (float*)(F.glds + 65536);
    for (int i = F.tid; i < NB * D; i += NTHR) { const int b = i / D, k = i % D; cond[k * 8 + b] = silu_f(c[i]); }
    __syncthreads();
    const int cq = F.lane & 15, ks = F.lane >> 4;
    for (int u = blockIdx.x; u < 384; u += F.G) {
        const int l = u / 192, cb = u % 192;
        const float* W = ada_w + (size_t)l * D * 6 * D + cb * 64 + cq * 4;
        f32x4 acc[8];
#pragma unroll
        for (int b = 0; b < 8; ++b) acc[b] = (f32x4){0.f, 0.f, 0.f, 0.f};
        const int kbase = F.wave * 256 + ks;
#pragma unroll 4
        for (int it = 0; it < 64; ++it) {
            const int k = kbase + 4 * it;
            const f32x4 w = __builtin_nontemporal_load((const f32x4*)(W + (size_t)k * 6 * D));
            const f32x4 c0 = *(const f32x4*)(cond + k * 8), c1 = *(const f32x4*)(cond + k * 8 + 4);
            acc[0] += w * c0[0]; acc[1] += w * c0[1]; acc[2] += w * c0[2]; acc[3] += w * c0[3];
            acc[4] += w * c1[0]; acc[5] += w * c1[1]; acc[6] += w * c1[2]; acc[7] += w * c1[3];
        }
#pragma unroll
        for (int b = 0; b < 8; ++b)
#pragma unroll
            for (int j = 0; j < 4; ++j) { float v = acc[b][j]; v += __shfl_xor(v, 16); v += __shfl_xor(v, 32); acc[b][j] = v; }
        if (F.lane < 16) {
#pragma unroll
            for (int b = 0; b < 8; ++b) *(f32x4*)(part + (F.wave * 8 + b) * 64 + cq * 4) = acc[b];
        }
        __syncthreads();
        { const int b = F.tid >> 6, col = F.tid & 63; float s = ada_b[(size_t)l * 6 * D + cb * 64 + col];
#pragma unroll
          for (int w = 0; w < 8; ++w) s += part[(w * 8 + b) * 64 + col];
          mod[((size_t)l * NB + b) * 6 * D + cb * 64 + col] = s; }
        __syncthreads();
    }
}
__device__ __forceinline__ void cvt_item(const float* src, int ld, int k0, int c0, bf16_t* dst, int Kd, int drow0, unsigned char* scr, int lane) {
    const int c = lane & 15, q = lane >> 4;
    f32x4 v[4][4];
#pragma unroll
    for (int g = 0; g < 4; ++g)
#pragma unroll
        for (int j = 0; j < 4; ++j) v[g][j] = __builtin_nontemporal_load((const f32x4*)(src + (size_t)(k0 + 16 * g + 4 * q + j) * ld + c0 + 4 * c));
#pragma unroll
    for (int g = 0; g < 4; ++g)
#pragma unroll
        for (int i = 0; i < 4; ++i) { u32x2 w; w.x = cvtpk(v[g][0][i], v[g][1][i]); w.y = cvtpk(v[g][2][i], v[g][3][i]);
            *(u32x2*)(scr + (4 * c + i) * 136 + (16 * g + 4 * q) * 2) = w; }
    asm volatile("s_waitcnt lgkmcnt(0)" ::: "memory");
#pragma unroll
    for (int r = 0; r < 8; ++r) { const int n = 8 * r + (lane >> 3), ch = lane & 7;
        const u32x2 a = *(const u32x2*)(scr + n * 136 + ch * 16), b = *(const u32x2*)(scr + n * 136 + ch * 16 + 8);
        u32x4 o; o.x = a.x; o.y = a.y; o.z = b.x; o.w = b.y;
        *(u32x4*)(dst + (size_t)(drow0 + n) * Kd + k0 + 8 * ch) = o; }
    asm volatile("s_waitcnt lgkmcnt(0)" ::: "memory");
}
constexpr float WSC = 64.f, WSC_INV = 1.f / 64.f;
__device__ __forceinline__ void cvt_item8(const float* src, int ld, int k0, int c0, unsigned char* dst, int Kd, int drow0, unsigned char* scr, int lane) {
    const int c = lane & 7, q = lane >> 3;
    f32x4 v[4][4];
#pragma unroll
    for (int g = 0; g < 4; ++g)
#pragma unroll
        for (int j = 0; j < 4; ++j) v[g][j] = __builtin_nontemporal_load((const f32x4*)(src + (size_t)(k0 + 32 * g + 4 * q + j) * ld + c0 + 4 * c));
#pragma unroll
    for (int g = 0; g < 4; ++g)
#pragma unroll
        for (int i = 0; i < 4; ++i) *(unsigned*)(scr + (4 * c + i) * 132 + 32 * g + 4 * q) = pg8::pack_fp8x4(v[g][0][i] * WSC, v[g][1][i] * WSC, v[g][2][i] * WSC, v[g][3][i] * WSC);
    asm volatile("s_waitcnt lgkmcnt(0)" ::: "memory");
#pragma unroll
    for (int r = 0; r < 4; ++r) { const int n = 8 * r + (lane >> 3), ch = lane & 7; const unsigned char* p = scr + n * 132 + ch * 16;
        u32x4 o; o.x = *(const unsigned*)(p); o.y = *(const unsigned*)(p + 4); o.z = *(const unsigned*)(p + 8); o.w = *(const unsigned*)(p + 12);
        *(u32x4*)(dst + (size_t)(drow0 + n) * Kd + k0 + 16 * ch) = o; }
    asm volatile("s_waitcnt lgkmcnt(0)" ::: "memory");
}
__device__ __forceinline__ const float* inptr(const Frame& F, int i);
constexpr int CMS_KB = 2;
constexpr float CMS_F = 1.4f;
constexpr size_t COLMAX_OFF = 524288;
__device__ __forceinline__ void colmax_item(const float* src, int ld, int k0, int c0, float* cmx  , int lane) {
    const int c = lane & 7, q = lane >> 3;
    f32x4 mx = (f32x4){0.f, 0.f, 0.f, 0.f};
#pragma unroll
    for (int g = 0; g < 4; ++g)
#pragma unroll
        for (int j = 0; j < 4; ++j) { const f32x4 v = *(const f32x4*)(src + (size_t)(k0 + 32 * g + 4 * q + j) * ld + c0 + 4 * c);
            mx[0] = fmaxf(mx[0], fabsf(v[0])); mx[1] = fmaxf(mx[1], fabsf(v[1])); mx[2] = fmaxf(mx[2], fabsf(v[2])); mx[3] = fmaxf(mx[3], fabsf(v[3])); }
#pragma unroll
    for (int i = 0; i < 4; ++i) { float v = mx[i]; v = fmaxf(v, __shfl_xor(v, 8)); v = fmaxf(v, __shfl_xor(v, 16)); v = fmaxf(v, __shfl_xor(v, 32)); mx[i] = v; }
    if (q == 0) {
#pragma unroll
        for (int i = 0; i < 4; ++i) atomicMax((unsigned*)(cmx + 4 * c + i), __float_as_uint(mx[i] * CMS_F)); }
}
__device__ __forceinline__ unsigned pack_i8x4(float a, float b, float c, float d) {
    const int ia = (int)rintf(fminf(fmaxf(a, -127.f), 127.f)), ib = (int)rintf(fminf(fmaxf(b, -127.f), 127.f)), ic = (int)rintf(fminf(fmaxf(c, -127.f), 127.f)), id = (int)rintf(fminf(fmaxf(d, -127.f), 127.f));
    return (unsigned)(ia & 0xff) | ((unsigned)(ib & 0xff) << 8) | ((unsigned)(ic & 0xff) << 16) | ((unsigned)(id & 0xff) << 24);
}
__device__ __forceinline__ void cvt_item_i8(const float* src, int ld, int k0, int c0, unsigned char* dst, int Kd, int drow0, const float* cmx  , unsigned char* scr, int lane) {
    const int c = lane & 7, q = lane >> 3;
    const f32x4 cm = *(const f32x4*)(cmx + 4 * c);
    f32x4 inv; inv[0] = cm[0] > 0.f ? 127.f / cm[0] : 0.f; inv[1] = cm[1] > 0.f ? 127.f / cm[1] : 0.f; inv[2] = cm[2] > 0.f ? 127.f / cm[2] : 0.f; inv[3] = cm[3] > 0.f ? 127.f / cm[3] : 0.f;
    f32x4 v[4][4];
#pragma unroll
    for (int g = 0; g < 4; ++g)
#pragma unroll
        for (int j = 0; j < 4; ++j) v[g][j] = __builtin_nontemporal_load((const f32x4*)(src + (size_t)(k0 + 32 * g + 4 * q + j) * ld + c0 + 4 * c));
#pragma unroll
    for (int g = 0; g < 4; ++g)
#pragma unroll
        for (int i = 0; i < 4; ++i) *(unsigned*)(scr + (4 * c + i) * 132 + 32 * g + 4 * q) = pack_i8x4(v[g][0][i] * inv[i], v[g][1][i] * inv[i], v[g][2][i] * inv[i], v[g][3][i] * inv[i]);
    asm volatile("s_waitcnt lgkmcnt(0)" ::: "memory");
#pragma unroll
    for (int r = 0; r < 4; ++r) { const int n = 8 * r + (lane >> 3), ch = lane & 7; const unsigned char* p = scr + n * 132 + ch * 16;
        u32x4 o; o.x = *(const unsigned*)(p); o.y = *(const unsigned*)(p + 4); o.z = *(const unsigned*)(p + 8); o.w = *(const unsigned*)(p + 12);
        *(u32x4*)(dst + (size_t)(drow0 + n) * Kd + k0 + 16 * ch) = o; }
    asm volatile("s_waitcnt lgkmcnt(0)" ::: "memory");
}
constexpr int CI_WI = 16 * 152  , CI_WO = 16 * 64, CI_FD = 44 * 64, CI_FGU = 2 * 16 * 176, CI_MD = 8 * 22 * 64, CI_MGU = 16 * 16 * 88;
constexpr int CS_WI = CMS_KB * 152, CS_FGU = 2 * CMS_KB * 176, CS_MGU = 16 * CMS_KB * 88;
constexpr int CONV_N0 = CS_WI + CI_WO + CI_FD + CS_FGU, CONV_N1 = CI_WI + CI_FGU, CONV_N2 = CS_WI + CI_WO + CI_MD + CS_MGU, CONV_N3 = CI_MGU, CONV_N4 = CI_WI;
constexpr int CMX_WIN = 2 * DFF + 16 * DFE;
template <int GRP>
__device__ __forceinline__ void conv_item(Frame& F, int r) {
    unsigned char* scr = F.glds + F.wave * 8704; unsigned char* ws = F.ws;
    float* cmx = (float*)(ws + WS_CTL + COLMAX_OFF);
    if (GRP == 0 || GRP == 1 || GRP == 2 || GRP == 4) {
        constexpr int l = (GRP == 2 || GRP == 4) ? 1 : 0;
        constexpr bool QUANT = (GRP == 1 || GRP == 4); constexpr int NI = QUANT ? CI_WI : CS_WI;
        if (r < NI) { const int kb = r / 152, nb = r % 152, c0 = (nb < 112) ? nb * 32 : SRC_GATE + 8 + (nb - 112) * 32, drow = nb * 32;
            if (QUANT) cvt_item_i8(inptr(F, IN_WIN) + (size_t)l * D * NIN_SRC, NIN_SRC, kb * 128, c0, ws + WS_WIN + (size_t)l * NIN * D, D, drow, cmx + CMX_WIN + l * NIN + drow, scr, F.lane);
            else colmax_item(inptr(F, IN_WIN) + (size_t)l * D * NIN_SRC, NIN_SRC, kb * 128, c0, cmx + CMX_WIN + l * NIN + drow, F.lane);
            return; }
        r -= NI;
    }
    if (GRP == 0 || GRP == 2) {
        constexpr int l = (GRP == 2) ? 1 : 0;
        if (r < CI_WO) { const int kb = r / 64, nb = r % 64;
            cvt_item8(inptr(F, IN_WOUT) + (size_t)l * D * D, D, kb * 128, nb * 32, ws + WS_WOUT + (size_t)l * D * D, D, nb * 32, scr, F.lane); return; }
        r -= CI_WO;
        if (GRP == 0) {
            if (r < CI_FD) { const int kb = r / 64, nb = r % 64; cvt_item8(inptr(F, IN_FD), D, kb * 128, nb * 32, ws + WS_WD, DFF, nb * 32, scr, F.lane); return; }
            r -= CI_FD;
        } else {
            if (r < CI_MD) { const int e = r / (22 * 64); r %= (22 * 64); const int kb = r / 64, nb = r % 64;
                cvt_item8(inptr(F, IN_MD) + (size_t)e * DFE * D, D, kb * 128, nb * 32, ws + WS_MD + (size_t)e * D * DFE, DFE, nb * 32, scr, F.lane); return; }
            r -= CI_MD;
        }
    }
    if (GRP == 0 || GRP == 1) { constexpr int KBN = (GRP == 1) ? 16 : CMS_KB, I_F = KBN * 176; const int up = r / I_F; r %= I_F; const int kb = r / 176, nb = r % 176, n0 = nb * 32, drow = (n0 >> 7) * 256 + up * 128 + (n0 & 127);
        if (GRP == 1) cvt_item_i8(inptr(F, up ? IN_FU : IN_FG), DFF, kb * 128, n0, ws + WS_WGU, D, drow, cmx + drow, scr, F.lane);
        else colmax_item(inptr(F, up ? IN_FU : IN_FG), DFF, kb * 128, n0, cmx + drow, F.lane); }
    else { constexpr int KBN = (GRP == 3) ? 16 : CMS_KB, I_E = KBN * 88; const int up = r / (8 * I_E); r %= (8 * I_E); const int e = r / I_E; r %= I_E; const int kb = r / 88, nb = r % 88, n0 = nb * 32, drow = (n0 >> 7) * 256 + up * 128 + (n0 & 127);
        if (GRP == 3) cvt_item_i8(inptr(F, up ? IN_MU : IN_MG) + (size_t)e * D * DFE, DFE, kb * 128, n0, ws + WS_MGU + (size_t)e * 2 * DFE * D, D, drow, cmx + 2 * DFF + e * 2 * DFE + drow, scr, F.lane);
        else colmax_item(inptr(F, up ? IN_MU : IN_MG) + (size_t)e * D * DFE, DFE, kb * 128, n0, cmx + 2 * DFF + e * 2 * DFE + drow, F.lane); }
}
template <int GRP>
__device__ __forceinline__ void conv_all(Frame& F, int first = 0) {
    constexpr int N = (GRP == 0) ? CONV_N0 : (GRP == 1) ? CONV_N1 : (GRP == 2) ? CONV_N2 : (GRP == 3) ? CONV_N3 : CONV_N4;
    for (int it = first + F.gw; it < N; it += F.NGW) conv_item<GRP>(F, it);
}
template <int YMODE, int EXTRA, bool NORM_OUT, bool XN8  , bool XIN_BF = false  , bool XOUT_BF = false  >
__device__ __forceinline__ void row_phase(Frame& F, const float* xin, float* xout, const bf16_t* ybuf, const float* gpost, const float* gt  ,
                                          const float* gpre, const float* sc, const float* sh, bf16_t* XN,
                                          const float* wex, int ldw, const float* bi, const float* bfg, float* gates_out,
                                          const uint4* tok_in, uint4* tok_out, int* idx_out, unsigned* cntw, float* rowmax = nullptr) {
    LAS float* we = (LAS float*)F.lds;
    LAS float* vA = (LAS float*)(F.lds + 65536);
    LAS float* vB = (LAS float*)(F.lds + 73728);
    LAS float* vC = (LAS float*)(F.lds + 81920);
    LAS float* route = (LAS float*)(F.lds + 90112);
    LAS int* routei = (LAS int*)route;
    LAS int* cumt = (LAS int*)(F.lds + 90112 + 2048);
    if (EXTRA) {
        for (int k = F.tid; k < D; k += NTHR) { const f32x4 a = *(const f32x4*)(wex + (size_t)k * ldw), b = *(const f32x4*)(wex + (size_t)k * ldw + 4);
            we[0 * D + k] = a[0]; we[1 * D + k] = a[1]; we[2 * D + k] = a[2]; we[3 * D + k] = a[3]; we[4 * D + k] = b[0]; we[5 * D + k] = b[1]; we[6 * D + k] = b[2]; we[7 * D + k] = b[3]; }
    }
    if (YMODE == 2) { if (F.tid == 0) { int cum = 0; for (int e = 0; e < NE; ++e) { cumt[e] = cum; cum += (int)((__hip_atomic_load(cntw + e, __ATOMIC_RELAXED, __HIP_MEMORY_SCOPE_AGENT) + 255u) >> 8); } } }
    for (int blk = blockIdx.x; blk < M / 64; blk += F.G) {
        const int b = (blk * 64) / SEQ;
        __syncthreads();
        { const int col = 4 * F.tid;
            if (YMODE) { const f32x4 g = *(const f32x4*)(gt + (size_t)b * 6 * D + col), p = *(const f32x4*)(gpost + col); *(LAS f32x4*)(vA + col) = g * p; }
            if (NORM_OUT) { const f32x4 g = *(const f32x4*)(gpre + col), s = *(const f32x4*)(sc + (size_t)b * 6 * D + col); *(LAS f32x4*)(vB + col) = g * (1.f + s); *(LAS f32x4*)(vC + col) = *(const f32x4*)(sh + (size_t)b * 6 * D + col); } }
        __syncthreads();
        f32x4 xr[8]; u32x2 xrb[8], yr[8], yr2[8]; float w1n = 0.f, w2n = 0.f;
#define RP_LOAD(rr_) do { const size_t row_ = (size_t)blk * 64 + F.wave * 8 + (((rr_) + blk) & 7);   \
            if (XIN_BF) { _Pragma("unroll") for (int j = 0; j < 8; ++j) xrb[j] = __builtin_nontemporal_load((const u32x2*)((const bf16_t*)xin + row_ * D + 256 * j + 4 * F.lane)); } \
            else { _Pragma("unroll") for (int j = 0; j < 8; ++j) xr[j] = __builtin_nontemporal_load((const f32x4*)(xin + row_ * D + 256 * j + 4 * F.lane)); } \
            if (YMODE == 1) { _Pragma("unroll") for (int j = 0; j < 8; ++j) yr[j] = __builtin_nontemporal_load((const u32x2*)(ybuf + row_ * D + 256 * j + 4 * F.lane)); } \
            if (YMODE == 2) { const uint4 ti = tok_in[row_]; \
                const int e1 = (int)(ti.x >> 16), k1 = (int)(ti.x & 0xffffu), e2 = (int)(ti.y >> 16), k2 = (int)(ti.y & 0xffffu); \
                const size_t r1 = (size_t)cumt[e1] * 256 + k1, r2 = (size_t)cumt[e2] * 256 + k2; w1n = __uint_as_float(ti.z); w2n = __uint_as_float(ti.w); \
                _Pragma("unroll") for (int j = 0; j < 8; ++j) { yr[j] = __builtin_nontemporal_load((const u32x2*)(ybuf + r1 * D + 256 * j + 4 * F.lane)); yr2[j] = __builtin_nontemporal_load((const u32x2*)(ybuf + r2 * D + 256 * j + 4 * F.lane)); } } } while (0)
        RP_LOAD(0);
#pragma unroll 1
        for (int rr = 0; rr < 8; ++rr) {
            const int rl = F.wave * 8 + ((rr + blk) & 7); const size_t row = (size_t)blk * 64 + rl;
            asm volatile("" ::: "memory");
            f32x4 x[8];
#pragma unroll
            for (int j = 0; j < 8; ++j) x[j] = XIN_BF ? (f32x4){bflo(xrb[j].x), bfhi(xrb[j].x), bflo(xrb[j].y), bfhi(xrb[j].y)} : xr[j];
            f32x4 y[8];
            if (YMODE == 1) {
#pragma unroll
                for (int j = 0; j < 8; ++j) y[j] = (f32x4){bflo(yr[j].x), bfhi(yr[j].x), bflo(yr[j].y), bfhi(yr[j].y)};
            }
            if (YMODE == 2) {
#pragma unroll
                for (int j = 0; j < 8; ++j) y[j] = (f32x4){bflo(yr[j].x), bfhi(yr[j].x), bflo(yr[j].y), bfhi(yr[j].y)} * w1n + (f32x4){bflo(yr2[j].x), bfhi(yr2[j].x), bflo(yr2[j].y), bfhi(yr2[j].y)} * w2n;
            }
            if (rr < 7) RP_LOAD(rr + 1);
            if (YMODE) {
                float ss = 0.f;
#pragma unroll
                for (int j = 0; j < 8; ++j) ss += (y[j][0] * y[j][0] + y[j][1] * y[j][1]) + (y[j][2] * y[j][2] + y[j][3] * y[j][3]);
                const float r = 1.f / sqrtf(wave_sum(ss) * (1.f / D) + RMS_EPS);
#pragma unroll
                for (int j = 0; j < 8; ++j) { x[j] += *(const LAS f32x4*)(vA + 256 * j + 4 * F.lane) * (y[j] * r);
                    if (XOUT_BF) { u32x2 w; w.x = cvtpk(x[j][0], x[j][1]); w.y = cvtpk(x[j][2], x[j][3]); *(u32x2*)((bf16_t*)xout + row * D + 256 * j + 4 * F.lane) = w; }
                    else __builtin_nontemporal_store(x[j], (f32x4*)(xout + row * D + 256 * j + 4 * F.lane)); }
            }
            if (NORM_OUT) {
                float ss = 0.f;
#pragma unroll
                for (int j = 0; j < 8; ++j) ss += (x[j][0] * x[j][0] + x[j][1] * x[j][1]) + (x[j][2] * x[j][2] + x[j][3] * x[j][3]);
                const float r = 1.f / sqrtf(wave_sum(ss) * (1.f / D) + RMS_EPS);
#pragma unroll
                for (int j = 0; j < 8; ++j) x[j] = (x[j] * r) * *(const LAS f32x4*)(vB + 256 * j + 4 * F.lane) + *(const LAS f32x4*)(vC + 256 * j + 4 * F.lane);
                if (XN8) {
                    float am = 0.f;
#pragma unroll
                    for (int j = 0; j < 8; ++j) am = fmaxf(fmaxf(am, fmaxf(fabsf(x[j][0]), fabsf(x[j][1]))), fmaxf(fabsf(x[j][2]), fabsf(x[j][3])));
                    am = wave_max(am);
                    const float inv = am > 0.f ? 127.f / am : 0.f;
                    if (F.lane == 0) { rowmax[row] = am; if (EXTRA == 2) route[384 + rl] = am; }
#pragma unroll
                    for (int j = 0; j < 8; ++j) *(unsigned*)((unsigned char*)XN + row * D + 256 * j + 4 * F.lane) = pack_i8x4(x[j][0] * inv, x[j][1] * inv, x[j][2] * inv, x[j][3] * inv);
                } else {
#pragma unroll
                    for (int j = 0; j < 8; ++j) { u32x2 w; w.x = cvtpk(x[j][0], x[j][1]); w.y = cvtpk(x[j][2], x[j][3]); *(u32x2*)(XN + row * D + 256 * j + 4 * F.lane) = w; }
                }
                if (EXTRA) {
                    float d8[8];
#pragma unroll
                    for (int e = 0; e < 8; ++e) { float s = 0.f;
#pragma unroll
                        for (int j = 0; j < 8; ++j) { const f32x4 w = *(const LAS f32x4*)(we + e * D + 256 * j + 4 * F.lane); s += (x[j][0] * w[0] + x[j][1] * w[1]) + (x[j][2] * w[2] + x[j][3] * w[3]); }
                        d8[e] = wave_sum(s); asm volatile("" ::: "memory"); }
                    if (EXTRA == 1) {
                        float v = 0.f;
#pragma unroll
                        for (int e = 0; e < 8; ++e) v = (F.lane == e) ? d8[e] : v;
                        if (F.lane < 8) { const float bb = (F.lane < 4) ? bi[F.lane] : bfg[F.lane - 4]; const float z = 15.f * tanhf((v + bb) * (1.f / 15.f));
                            const float o = (F.lane < 4) ? z : (fminf(z, 0.f) - log1pf(expf(-fabsf(z)))); gates_out[row * 8 + F.lane] = o; }
                    } else {
                        int e1 = 0; float v1 = d8[0];
#pragma unroll
                        for (int e = 1; e < 8; ++e) if (d8[e] > v1) { v1 = d8[e]; e1 = e; }
                        int e2 = -1; float v2 = -3.0e38f;
#pragma unroll
                        for (int e = 0; e < 8; ++e) if (e != e1 && d8[e] > v2) { v2 = d8[e]; e2 = e; }
                        const float w1 = 1.f / (1.f + expf(v2 - v1));
                        if (F.lane == 0) { routei[rl * 4 + 0] = e1; routei[rl * 4 + 1] = e2; route[rl * 4 + 2] = w1; route[rl * 4 + 3] = 1.f - w1; }
                    }
                }
            }
        }
#undef RP_LOAD
        if (EXTRA == 2) {
            __syncthreads();
            if (F.tid < NE) { const int e = F.tid; int c = 0;
                for (int r = 0; r < 64; ++r) c += (routei[r * 4] == e) + (routei[r * 4 + 1] == e);
                int base = (int)__hip_atomic_fetch_add(cntw + e, (unsigned)c, __ATOMIC_RELAXED, __HIP_MEMORY_SCOPE_AGENT);
                float* rms = rowmax + (WS_RMSLOT - WS_ROWMAX) / 4;
                for (int r = 0; r < 64; ++r) { if (routei[r * 4] == e) { idx_out[e * ECAP + base] = blk * 64 + r; rms[e * ECAP + base] = route[384 + r]; routei[256 + r * 2] = base; ++base; }
                                               if (routei[r * 4 + 1] == e) { idx_out[e * ECAP + base] = blk * 64 + r; rms[e * ECAP + base] = route[384 + r]; routei[256 + r * 2 + 1] = base; ++base; } } }
            __syncthreads();
            if (F.tid < 64) { const int r = F.tid; uint4 ti; ti.x = ((unsigned)routei[r * 4] << 16) | (unsigned)routei[256 + r * 2]; ti.y = ((unsigned)routei[r * 4 + 1] << 16) | (unsigned)routei[256 + r * 2 + 1];
                ti.z = __float_as_uint(route[r * 4 + 2]); ti.w = __float_as_uint(route[r * 4 + 3]); tok_out[(size_t)blk * 64 + r] = ti; }
        }
    }
    __syncthreads();
}

namespace att {
constexpr int KROW = 144, VROW = 520, K_OFF = 0, V_OFF = 256 * KROW, KM_OFF = V_OFF + 64 * VROW;
constexpr float C2 = 0.125f * 1.4426950408889634f, NEG = -3.0e38f;
__device__ __forceinline__ void stage_kv(LAS unsigned char* lds, const bf16_t* kcol, const bf16_t* vcol, size_t grow0, int nk, int kc0, int tid) {
    for (int c = tid; c < nk * 8; c += NTHR) { const int key = c >> 3, part = c & 7;
        const u32x4 v = *(const u32x4*)(kcol + (grow0 + key) * NIN + part * 8);
        *(LAS u32x4*)(lds + K_OFF + (kc0 + key) * KROW + part * 16) = v; }
    const int np = nk >> 1;
    for (int it = tid; it < np * 8; it += NTHR) { const int kp = it % np, dp = it / np;
        const u32x4 a = *(const u32x4*)(vcol + (grow0 + 2 * kp) * NIN + dp * 8), b = *(const u32x4*)(vcol + (grow0 + 2 * kp + 1) * NIN + dp * 8);
        LAS unsigned char* dst = lds + V_OFF + (dp * 8) * VROW + (kc0 + 2 * kp) * 2;
        *(LAS unsigned*)(dst + 0 * VROW) = (a.x & 0xffffu) | (b.x << 16); *(LAS unsigned*)(dst + 1 * VROW) = (a.x >> 16) | (b.x & 0xffff0000u);
        *(LAS unsigned*)(dst + 2 * VROW) = (a.y & 0xffffu) | (b.y << 16); *(LAS unsigned*)(dst + 3 * VROW) = (a.y >> 16) | (b.y & 0xffff0000u);
        *(LAS unsigned*)(dst + 4 * VROW) = (a.z & 0xffffu) | (b.z << 16); *(LAS unsigned*)(dst + 5 * VROW) = (a.z >> 16) | (b.z & 0xffff0000u);
        *(LAS unsigned*)(dst + 6 * VROW) = (a.w & 0xffffu) | (b.w << 16); *(LAS unsigned*)(dst + 7 * VROW) = (a.w >> 16) | (b.w & 0xffff0000u); }
}
struct KVRegs { u32x4 k[4], va[2], vb[2]; };
__device__ __forceinline__ void kv_load(KVRegs& R, const bf16_t* kcol, const bf16_t* vcol, size_t grow0, int tid) {
#pragma unroll
    for (int i = 0; i < 4; ++i) { const int c = tid + i * NTHR, key = c >> 3, part = c & 7; R.k[i] = *(const u32x4*)(kcol + (grow0 + key) * NIN + part * 8); }
#pragma unroll
    for (int i = 0; i < 2; ++i) { const int it = tid + i * NTHR, kp = it & 127, dp = it >> 7;
        R.va[i] = *(const u32x4*)(vcol + (grow0 + 2 * kp) * NIN + dp * 8); R.vb[i] = *(const u32x4*)(vcol + (grow0 + 2 * kp + 1) * NIN + dp * 8); }
}
__device__ __forceinline__ void kv_store(LAS unsigned char* lds, const KVRegs& R, int tid) {
#pragma unroll
    for (int i = 0; i < 4; ++i) { const int c = tid + i * NTHR, key = c >> 3, part = c & 7; *(LAS u32x4*)(lds + K_OFF + key * KROW + part * 16) = R.k[i]; }
#pragma unroll
    for (int i = 0; i < 2; ++i) { const int it = tid + i * NTHR, kp = it & 127, dp = it >> 7; const u32x4 a = R.va[i], b = R.vb[i];
        LAS unsigned char* dst = lds + V_OFF + (dp * 8) * VROW + (2 * kp) * 2;
        *(LAS unsigned*)(dst + 0 * VROW) = (a.x & 0xffffu) | (b.x << 16); *(LAS unsigned*)(dst + 1 * VROW) = (a.x >> 16) | (b.x & 0xffff0000u);
        *(LAS unsigned*)(dst + 2 * VROW) = (a.y & 0xffffu) | (b.y << 16); *(LAS unsigned*)(dst + 3 * VROW) = (a.y >> 16) | (b.y & 0xffff0000u);
        *(LAS unsigned*)(dst + 4 * VROW) = (a.z & 0xffffu) | (b.z << 16); *(LAS unsigned*)(dst + 5 * VROW) = (a.z >> 16) | (b.z & 0xffff0000u);
        *(LAS unsigned*)(dst + 6 * VROW) = (a.w & 0xffffu) | (b.w << 16); *(LAS unsigned*)(dst + 7 * VROW) = (a.w >> 16) | (b.w & 0xffff0000u); }
}
struct State { f32x16 o0, o1, negm; float m, l; };
constexpr float THR = 5.f, M0 = -1000.f;
__device__ __forceinline__ void init(State& st) {
#pragma unroll
    for (int r = 0; r < 16; ++r) { st.o0[r] = 0.f; st.o1[r] = 0.f; st.negm[r] = -M0; }
    st.m = M0; st.l = 0.f;
}
__device__ __forceinline__ float xhalf_max(float v) { auto rr = __builtin_amdgcn_permlane32_swap(__float_as_uint(v), __float_as_uint(v), false, false); return fmaxf(__uint_as_float(rr[0]), __uint_as_float(rr[1])); }
__device__ __forceinline__ float xhalf_sum(float v) { auto rr = __builtin_amdgcn_permlane32_swap(__float_as_uint(v), __float_as_uint(v), false, false); return __uint_as_float(rr[0]) + __uint_as_float(rr[1]); }
__device__ __forceinline__ void block_mask(State& st, bool lane_ok) {
#pragma unroll
    for (int r = 0; r < 16; ++r) st.negm[r] = lane_ok ? -st.m : NEG;
}
template <int MODE>
__device__ __forceinline__ void tile(LAS unsigned char* lds, int kt, const bf16x8 (&qf)[4], State& st, int lane) {
    const int r32 = lane & 31, h = lane >> 5;
    f32x16 S;
    if (MODE == 3) S = st.negm;
    else {
#pragma unroll
        for (int r = 0; r < 16; ++r) { const int ko = (r & 3) + 8 * (r >> 2) + 4 * h; const bool ok = (MODE == 1) ? (ko <= r32) : (ko > r32); S[r] = ok ? st.negm[r] : NEG; } }
    const LAS unsigned char* kp = lds + K_OFF + (kt * 32 + r32) * KROW + h * 16;
#pragma unroll
    for (int s = 0; s < 4; ++s) { const bf16x8 a = *(const LAS bf16x8*)(kp + s * 32); S = __builtin_amdgcn_mfma_f32_32x32x16_bf16(a, qf[s], S, 0, 0, 0); }
    float tmax;
    asm volatile("s_nop 15\n\ts_nop 7" : "+v"(S));
    { float m0, m1, m2, m3, m4;
      asm("v_max3_f32 %0, %1, %2, %3" : "=v"(m0) : "v"(S[0]), "v"(S[1]), "v"(S[2]));    asm("v_max3_f32 %0, %1, %2, %3" : "=v"(m1) : "v"(S[3]), "v"(S[4]), "v"(S[5]));
      asm("v_max3_f32 %0, %1, %2, %3" : "=v"(m2) : "v"(S[6]), "v"(S[7]), "v"(S[8]));    asm("v_max3_f32 %0, %1, %2, %3" : "=v"(m3) : "v"(S[9]), "v"(S[10]), "v"(S[11]));
      asm("v_max3_f32 %0, %1, %2, %3" : "=v"(m4) : "v"(S[12]), "v"(S[13]), "v"(S[14])); asm("v_max3_f32 %0, %1, %2, %3" : "=v"(m0) : "v"(m0), "v"(m1), "v"(S[15]));
      asm("v_max3_f32 %0, %1, %2, %3" : "=v"(m2) : "v"(m2), "v"(m3), "v"(m4));          asm("v_max_f32 %0, %1, %2" : "=v"(tmax) : "v"(m0), "v"(m2)); }
    tmax = xhalf_max(tmax);
    if (__any(tmax > THR)) {
        const float d = tmax > THR ? tmax : 0.f, alpha = __builtin_amdgcn_exp2f(-d);
        st.m += d; st.l *= alpha;
#pragma unroll
        for (int r = 0; r < 16; ++r) { S[r] -= d; st.negm[r] -= d; st.o0[r] *= alpha; st.o1[r] *= alpha; }
    }
    float ls0 = 0.f, ls1 = 0.f;
#pragma unroll
    for (int r = 0; r < 16; r += 2) { const float p0 = __builtin_amdgcn_exp2f(S[r]), p1 = __builtin_amdgcn_exp2f(S[r + 1]); S[r] = p0; S[r + 1] = p1; ls0 += p0; ls1 += p1; }
    st.l += ls0 + ls1;
    const LAS unsigned char* vp = lds + V_OFF + r32 * VROW + kt * 64 + h * 8;
#pragma unroll
    for (int s = 0; s < 2; ++s) {
        u32x4 pw; pw.x = cvtpk(S[8 * s + 0], S[8 * s + 1]); pw.y = cvtpk(S[8 * s + 2], S[8 * s + 3]); pw.z = cvtpk(S[8 * s + 4], S[8 * s + 5]); pw.w = cvtpk(S[8 * s + 6], S[8 * s + 7]);
        const bf16x8 pf = __builtin_bit_cast(bf16x8, pw);
        { const u32x2 lo = *(const LAS u32x2*)(vp + s * 32), hi = *(const LAS u32x2*)(vp + s * 32 + 16); u32x4 aw; aw.x = lo.x; aw.y = lo.y; aw.z = hi.x; aw.w = hi.y;
          st.o0 = __builtin_amdgcn_mfma_f32_32x32x16_bf16(__builtin_bit_cast(bf16x8, aw), pf, st.o0, 0, 0, 0); }
        { const u32x2 lo = *(const LAS u32x2*)(vp + 32 * VROW + s * 32), hi = *(const LAS u32x2*)(vp + 32 * VROW + s * 32 + 16); u32x4 aw; aw.x = lo.x; aw.y = lo.y; aw.z = hi.x; aw.w = hi.y;
          st.o1 = __builtin_amdgcn_mfma_f32_32x32x16_bf16(__builtin_bit_cast(bf16x8, aw), pf, st.o1, 0, 0, 0); }
    }
}
constexpr float YSC = 16.f;
__device__ __forceinline__ void store_out(const State& st, float inv, unsigned char* orow  , int lane) {
    const int h = lane >> 5;
#pragma unroll
    for (int g = 0; g < 4; ++g) {
        *(unsigned*)(orow + 8 * g + 4 * h) = pg8::pack_fp8x4(st.o0[4 * g] * inv, st.o0[4 * g + 1] * inv, st.o0[4 * g + 2] * inv, st.o0[4 * g + 3] * inv);
        *(unsigned*)(orow + 32 + 8 * g + 4 * h) = pg8::pack_fp8x4(st.o1[4 * g] * inv, st.o1[4 * g + 1] * inv, st.o1[4 * g + 2] * inv, st.o1[4 * g + 3] * inv); }
}
__device__ __forceinline__ void moba_unit(Frame& F, const bf16_t* proj, const float* kmean, unsigned char* Y, int b, int h, int j) {
    LAS unsigned char* lds = F.lds; const int lane = F.lane, r32 = lane & 31, hh = lane >> 5, w = F.wave;
    const size_t rb = (size_t)b * SEQ; const int t = j * 256 + w * 32 + r32;
    bf16x8 qf[4];
    { const bf16_t* qrow = proj + (rb + t) * NIN + C_MQ + h * 64 + hh * 8;
#pragma unroll
      for (int s = 0; s < 4; ++s) qf[s] = *(const bf16x8*)(qrow + s * 16); }
    LBAR();
    LAS float* km = (LAS float*)(lds + KM_OFF);
    if (F.tid < j * 64) km[F.tid] = kmean[(size_t)(b * 8 + (F.tid >> 6)) * 512 + h * 64 + (F.tid & 63)];
    LBAR();
    unsigned sel;
    if (j <= 3) sel = (1u << j) - 1u;
    else {
        float g[7];
#pragma unroll
        for (int n = 0; n < 7; ++n) { g[n] = NEG;
            if (n < j) { float a = 0.f;
#pragma unroll
                for (int s = 0; s < 4; ++s)
#pragma unroll
                    for (int jj = 0; jj < 8; ++jj) a += bf1((bf16_t)qf[s][jj]) * km[n * 64 + 16 * s + 8 * hh + jj];
                a += __shfl_xor(a, 32); g[n] = a; } }
        sel = 0u;
#pragma unroll
        for (int r = 0; r < 3; ++r) { float best = NEG; int bi = 0;
#pragma unroll
            for (int n = 0; n < 7; ++n) if (n < j && !((sel >> n) & 1u) && g[n] > best) { best = g[n]; bi = n; }
            sel |= 1u << bi; }
    }
    State st; init(st);
    const bf16_t* kcol = proj + C_MK + h * 64; const bf16_t* vcol = proj + C_MV + h * 64;
    KVRegs R; kv_load(R, kcol, vcol, rb, F.tid);
    for (int n = 0; n <= j; ++n) {
        LBAR();
        kv_store(lds, R, F.tid);
        if (n < j) kv_load(R, kcol, vcol, rb + (size_t)(n + 1) * 256, F.tid);
        LBAR();
        if (n < j) { const bool ok = (sel >> n) & 1u;
            if (__any(ok)) { block_mask(st, ok); for (int kt = 0; kt < 8; ++kt) tile<3>(lds, kt, qf, st, lane); } }
        else { block_mask(st, true); for (int kt = 0; kt < w; ++kt) tile<3>(lds, kt, qf, st, lane);
               tile<1>(lds, w, qf, st, lane); }
    }
    const float lt = xhalf_sum(st.l);
    store_out(st, YSC / lt, Y + (rb + t) * D + h * 64, lane);
}
__device__ __forceinline__ void swa_unit(Frame& F, const bf16_t* proj, const float* sinks, unsigned char* Y, int b, int kvh, int qb) {
    LAS unsigned char* lds = F.lds; int lane = F.lane; asm volatile("" : "+v"(lane));
    const int r32 = lane & 31, hh = lane >> 5, w = F.wave, hq = kvh * 8 + w;
    const size_t rb = (size_t)b * SEQ;
    const bf16_t* kcol = proj + C_SK + kvh * 64; const bf16_t* vcol = proj + C_SV + kvh * 64;
    LBAR();
    if (qb > 0) stage_kv(lds, kcol, vcol, rb + (size_t)qb * 128 - 128, 256, 0, F.tid);
    else        stage_kv(lds, kcol, vcol, rb, 128, 128, F.tid);
    LBAR();
    const float sk = sinks[hq] * 1.4426950408889634f;
    for (int sb = 0; sb < 4; ++sb) {
        const int t = qb * 128 + sb * 32 + r32;
        bf16x8 qf[4];
        { const bf16_t* qrow = proj + (rb + t) * NIN + C_SQ + hq * 64 + hh * 8;
#pragma unroll
          for (int s = 0; s < 4; ++s) qf[s] = *(const bf16x8*)(qrow + s * 16); }
        State st; init(st);
        int kt0 = sb; if (qb == 0 && kt0 < 4) kt0 = 4;
        if (kt0 == sb) tile<2>(lds, sb, qf, st, lane);
        for (int kt = (kt0 > sb + 1 ? kt0 : sb + 1); kt < sb + 4; ++kt) tile<3>(lds, kt, qf, st, lane);
        tile<1>(lds, sb + 4, qf, st, lane);
        const float lt = xhalf_sum(st.l) + __builtin_amdgcn_exp2f(sk - st.m);
        store_out(st, YSC / lt, Y + (rb + t) * D + 1024 + hq * 64, lane);
    }
}
}

#include <hip/hip_bf16.h>
#include <cmath>
namespace mob {
using bf16=__hip_bfloat16;
using bf16x8=__attribute__((ext_vector_type(8)))short;
using s16x4=__attribute__((ext_vector_type(4)))short;
using f32x16=__attribute__((ext_vector_type(16)))float;
using u32x4=__attribute__((ext_vector_type(4)))unsigned;
constexpr int SEQ=2048,D=64,DM=4864;
constexpr int NW=8,QBLK=32,QB=QBLK*NW,KVBLK=64,NQB=SEQ/QB;
__device__ __forceinline__ int crow(int r,int hi){return (r&3)+8*(r>>2)+4*hi;}
#define SBAR() __builtin_amdgcn_sched_barrier(0)
__device__ __forceinline__ void cmask(f32x16&p0,f32x16&p1,int jb,int qrel,int hi){
  const float NEG=-INFINITY; int kb=64*jb+4*hi;
  #pragma unroll
  for(int r=0;r<16;++r){int kv=kb+(r&3)+8*(r>>2); if(kv>qrel)p0[r]=NEG; if(kv+32>qrel)p1[r]=NEG;}
}

constexpr int NSLOT=3, SLOTB=8192;
constexpr int LDS_K=0, LDS_V=NSLOT*SLOTB, LDS_WS=2*NSLOT*SLOTB, LDS_OST=LDS_WS+NW*64*4, LDS_BYTES=LDS_OST+NW*4096, LDS_KM=LDS_BYTES  ;
constexpr float NEGB=-3.0e38f, YSC=16.f;
constexpr float C2=0.125f*1.4426950408889634f;
__device__ __forceinline__ void glds16(const void*sbase,unsigned voff,unsigned lds_dst){unsigned keep;
  asm volatile("s_mov_b32 %0, m0\n\ts_mov_b32 m0, %2\n\ts_nop 0\n\tglobal_load_lds_dwordx4 %1, %3\n\ts_mov_b32 m0, %0":"=&s"(keep):"v"(voff),"s"(lds_dst),"s"(sbase):"memory");}
__device__ __forceinline__ float max3f(float a,float b,float c){float r;asm("v_max3_f32 %0, %1, %2, %3":"=v"(r):"v"(a),"v"(b),"v"(c));return r;}
__device__ __forceinline__ float max2f(float a,float b){float r;asm("v_max_f32_e32 %0, %1, %2":"=v"(r):"v"(a),"v"(b));return r;}
__device__ __forceinline__ float fadd_s(float a,float b){float r;asm("v_add_f32_e32 %0, %1, %2":"=v"(r):"v"(a),"v"(b));return r;}
__device__ __forceinline__ float fsub_s(float a,float b){float r;asm("v_sub_f32_e32 %0, %1, %2":"=v"(r):"v"(a),"v"(b));return r;}
typedef float f32x2_t __attribute__((ext_vector_type(2))); typedef __bf16 bf16x2_t __attribute__((ext_vector_type(2)));
__device__ __forceinline__ unsigned cvtpk_s(float lo,float hi){f32x2_t v={lo,hi};bf16x2_t b=__builtin_convertvector(v,bf16x2_t);return __builtin_bit_cast(unsigned,b);}
#define WAIT_BAR(N) asm volatile("s_waitcnt vmcnt(" #N ") lgkmcnt(0)\n\ts_barrier":::"memory")

__device__ __forceinline__ void qkt(f32x16&p0,f32x16&p1,const char*Kslot,const bf16x8*qr,const f32x16&negm,int r32,int hi){
  const char*kb=Kslot+hi*1024+r32*16;
  #pragma unroll
  for(int d0=0;d0<4;++d0){
    const bf16x8 b0=*reinterpret_cast<const bf16x8*>(kb+d0*2048);
    const bf16x8 b1=*reinterpret_cast<const bf16x8*>(kb+d0*2048+512);
    if(d0==0){p0=__builtin_amdgcn_mfma_f32_32x32x16_bf16(b0,qr[0],negm,0,0,0);p1=__builtin_amdgcn_mfma_f32_32x32x16_bf16(b1,qr[0],negm,0,0,0);}
    else{p0=__builtin_amdgcn_mfma_f32_32x32x16_bf16(b0,qr[d0],p0,0,0,0);p1=__builtin_amdgcn_mfma_f32_32x32x16_bf16(b1,qr[d0],p1,0,0,0);}}
}
typedef __attribute__((address_space(3))) const char* lds_cptr;
typedef short v4i16_t __attribute__((ext_vector_type(4)));
__device__ __forceinline__ void kload8(bf16x8*kf,lds_cptr kp){
  kf[0]=*(const __attribute__((address_space(3))) bf16x8*)(kp);      kf[1]=*(const __attribute__((address_space(3))) bf16x8*)(kp+512);
  kf[2]=*(const __attribute__((address_space(3))) bf16x8*)(kp+2048); kf[3]=*(const __attribute__((address_space(3))) bf16x8*)(kp+2560);
  kf[4]=*(const __attribute__((address_space(3))) bf16x8*)(kp+4096); kf[5]=*(const __attribute__((address_space(3))) bf16x8*)(kp+4608);
  kf[6]=*(const __attribute__((address_space(3))) bf16x8*)(kp+6144); kf[7]=*(const __attribute__((address_space(3))) bf16x8*)(kp+6656);
}
__device__ __forceinline__ void kload2(bf16x8*kf,lds_cptr kp,int j){ kf[2*j]=*(const __attribute__((address_space(3))) bf16x8*)(kp+j*2048); kf[2*j+1]=*(const __attribute__((address_space(3))) bf16x8*)(kp+j*2048+512); }
__device__ __forceinline__ s16x4 vtr(lds_cptr p){ return __builtin_bit_cast(s16x4,__builtin_amdgcn_ds_read_tr16_b64_v4i16((__attribute__((address_space(3))) v4i16_t*)p)); }
__device__ __forceinline__ float rowmax(const f32x16&p0,const f32x16&p1){
  float a=max3f(p0[0],p0[1],p1[0]),b=max3f(p0[2],p0[3],p1[1]);a=max3f(a,p1[2],p1[3]);
  #pragma unroll
  for(int r=4;r<16;r+=4){a=max3f(a,p0[r],p0[r+1]);b=max3f(b,p0[r+2],p0[r+3]);a=max3f(a,p1[r],p1[r+1]);b=max3f(b,p1[r+2],p1[r+3]);}
  const float m=max2f(a,b);
  auto rr=__builtin_amdgcn_permlane32_swap(__float_as_uint(m),__float_as_uint(m),false,false);
  return max2f(__uint_as_float(rr[0]),__uint_as_float(rr[1]));
}
__device__ __forceinline__ void pv(f32x16*o,int vb,bf16x8 pa0,bf16x8 pa1,bf16x8 pa2,bf16x8 pa3){
  #pragma unroll
  for(int d0=0;d0<2;++d0){s16x4 lo[4],hi[4];
    #pragma unroll
    for(int ks=0;ks<4;++ks){
      asm volatile("ds_read_b64_tr_b16 %0,%1 offset:%c2":"=&v"(lo[ks]):"v"(vb),"i"(d0*4096+ks*1024):"memory");
      asm volatile("ds_read_b64_tr_b16 %0,%1 offset:%c2":"=&v"(hi[ks]):"v"(vb),"i"(d0*4096+ks*1024+512):"memory");}
    asm volatile("s_waitcnt lgkmcnt(0)":::"memory");SBAR();
    #define PK(k) (bf16x8){lo[k][0],lo[k][1],lo[k][2],lo[k][3],hi[k][0],hi[k][1],hi[k][2],hi[k][3]}
    o[d0]=__builtin_amdgcn_mfma_f32_32x32x16_bf16(pa0,PK(0),o[d0],0,0,0);
    o[d0]=__builtin_amdgcn_mfma_f32_32x32x16_bf16(pa1,PK(1),o[d0],0,0,0);
    o[d0]=__builtin_amdgcn_mfma_f32_32x32x16_bf16(pa2,PK(2),o[d0],0,0,0);
    o[d0]=__builtin_amdgcn_mfma_f32_32x32x16_bf16(pa3,PK(3),o[d0],0,0,0);
    #undef PK
  }
}

#ifndef ATTN_STORE16
#define ATTN_STORE16(p,v) (*(u32x4*)(p)=(v))
#endif
template<int THRL> __device__ __forceinline__ void attn_unit(int b,int h,int qb,const bf16*Q,const bf16*__restrict__ K,const bf16*__restrict__ V,unsigned char*Y,const float*kmean,char*shm){
  const int tid=threadIdx.x,lane=tid&63,r32=lane&31,hi=lane>>5; const int wid=__builtin_amdgcn_readfirstlane(tid>>6);
  const long rowbase=(long)b*SEQ; const int q0=qb*QB;
  const bf16*Qw=Q+(rowbase+q0+wid*QBLK)*DM+h*D;
  const bf16*Kh=K+rowbase*DM+h*D,*Vh=V+rowbase*DM+h*D;
  const unsigned lds0=(unsigned)(uintptr_t)shm;
  float*wsf=(float*)(shm+LDS_WS)+wid*64;
  const unsigned koff=(unsigned)((lane*DM+wid*8)*2);
  const unsigned voff=(unsigned)(((16*(wid&3)+(lane>>2))*DM+(wid>>2)*32+(lane&3)*8)*2);
  const unsigned kdst=lds0+LDS_K+wid*1024, vdst=lds0+LDS_V+wid*1024;
  #define DMA_K(t,slot) glds16(Kh+(long)(t)*KVBLK*DM,koff,(unsigned)__builtin_amdgcn_readfirstlane(kdst+(slot)))
  #define DMA_V(t,slot) glds16(Vh+(long)(t)*KVBLK*DM,voff,(unsigned)__builtin_amdgcn_readfirstlane(vdst+(slot)))
  const char*Kbase=shm+LDS_K; bf16x8 kf[8];
  const lds_cptr shm3=(lds_cptr)shm; const lds_cptr kp0=shm3+LDS_K+hi*1024+r32*16; const lds_cptr vp0=shm3+LDS_V+((lane>>4)&1)*32+(lane&3)*8+(4*hi+((lane&15)>>2))*64;
  const int NT=(q0+QB)/KVBLK;
  DMA_K(0,0);DMA_V(0,0);DMA_K(1,SLOTB);
  bf16x8 qr[4];
  #pragma unroll
  for(int d0=0;d0<4;++d0)qr[d0]=*reinterpret_cast<const bf16x8*>(&Qw[(long)r32*DM+d0*16+hi*8]);
  unsigned sel;
  if(qb<=3) sel=(1u<<qb)-1u;
  else{
    float*km=(float*)(shm+LDS_KM);
    if(tid<qb*64) km[tid]=kmean[(size_t)(b*8+(tid>>6))*512+h*64+(tid&63)];
    asm volatile("s_waitcnt vmcnt(0) lgkmcnt(0)\n\ts_barrier":::"memory");
    float g[7];
    #pragma unroll
    for(int n=0;n<7;++n){ g[n]=NEGB;
      if(n<qb){ float a=0.f;
        #pragma unroll
        for(int s=0;s<4;++s)
          #pragma unroll
          for(int jj=0;jj<8;++jj) a+=__uint_as_float((unsigned)(unsigned short)qr[s][jj]<<16)*km[n*64+16*s+8*hi+jj];
        a+=__shfl_xor(a,32); g[n]=a; } }
    sel=0u;
    #pragma unroll
    for(int r=0;r<3;++r){ float best=NEGB; int bi=0;
      #pragma unroll
      for(int n=0;n<7;++n) if(n<qb&&!((sel>>n)&1u)&&g[n]>best){best=g[n];bi=n;}
      sel|=1u<<bi; }
  }
  #define OKB(n) (((n)>=qb)||(((sel>>(n))&1u)!=0u))
  float mhat=0.f,l_reg=0.f;f32x16 o[2];o[0]=f32x16{};o[1]=f32x16{};f32x16 negm;
  { const bool ok0=OKB(0);
    #pragma unroll
    for(int r=0;r<16;++r)negm[r]=ok0?0.f:NEGB; }
  asm volatile("":"+v"(negm));
  const int qrel=wid*QBLK+r32;
  #define CMASK(P0,P1,t) do{int jb_=(t)-(NT-4); if(jb_>=0)cmask(P0,P1,jb_,qrel,hi);}while(0)
  bool resc=false;
  #define START(P0,P1) do{ const float rm=rowmax(P0,P1); resc=false; \
    { const bool ok0_=OKB(0); const float dl=ok0_?rm:0.f; mhat=fadd_s(mhat,dl); \
      _Pragma("unroll") for(int r=0;r<16;++r){P0[r]=fsub_s(P0[r],dl);P1[r]=fsub_s(P1[r],dl);} \
      _Pragma("unroll") for(int r=0;r<16;++r)negm[r]=ok0_?-mhat:NEGB; asm volatile("":"+v"(negm)); } \
    _Pragma("unroll") for(int r=0;r<16;++r)P0[r]=__builtin_amdgcn_exp2f(P0[r]); }while(0)
  #define RESC() do{ if(resc){ asm volatile("s_waitcnt lgkmcnt(0)":::"memory"); \
      _Pragma("unroll") for(int d_=0;d_<2;++d_) _Pragma("unroll") for(int r=0;r<16;++r)o[d_][r]*=wsf[crow(r,hi)]; } }while(0)
  f32x16 pA0,pA1,pB0,pB1;
  int sl_prev=0,sl_cur=0,sl_next=SLOTB;
  #define ROT() do{sl_prev=sl_cur;sl_cur=sl_next;sl_next=(sl_next==(NSLOT-1)*SLOTB)?0:sl_next+SLOTB;}while(0)
  DMA_K(2,2*SLOTB);
  WAIT_BAR(3);
  qkt(pA0,pA1,Kbase,qr,negm,r32,hi);asm volatile("s_nop 15\n\ts_nop 7":"+v"(pA0),"+v"(pA1));CMASK(pA0,pA1,0);
  START(pA0,pA1);
  _Pragma("unroll") for(int r=0;r<16;++r)pA1[r]=__builtin_amdgcn_exp2f(pA1[r]);
  WAIT_BAR(0);
  DMA_K(3,0);DMA_V(1,SLOTB);
  ROT();
  kload8(kf,kp0+sl_cur);
  WAIT_BAR(2);
  s16x4 vlo[8],vhi[8]; u32x4 pw0,pw1,pw2,pw3;
  #define PKW(P,B) cvtpk_s(P[B],P[B+1])
  #define PAF(k) __builtin_bit_cast(bf16x8,pw##k)
  #define VFR(i) (bf16x8){vlo[i][0],vlo[i][1],vlo[i][2],vlo[i][3],vhi[i][0],vhi[i][1],vhi[i][2],vhi[i][3]}
  #define PIN(x) asm volatile("":"+v"(x))
  #define MX3(a,b,c) __builtin_fmaxf(__builtin_fmaxf((a),(b)),(c))
  #define GAPA(MF,A0,A1,A2,A3,W0,W1,PW) do{ MF; sacc+=A0; sacc+=A1; sacc+=A2; sacc+=A3; PIN(sacc); W0; W1; PIN(PW); SBAR(); }while(0)
  #define EX(v) __builtin_amdgcn_exp2f(v)
  #define GAPB(MF,X,B) do{ MF; X[B]=EX(X[B]); X[B+1]=EX(X[B+1]); X[B+2]=EX(X[B+2]); X[B+3]=EX(X[B+3]); PIN(X); SBAR(); }while(0)
  #define VRD(i) do{ vlo[i]=vtr(vp_+(((i)>>2)*4096+((i)&3)*1024)); vhi[i]=vtr(vp_+(((i)>>2)*4096+((i)&3)*1024+512)); }while(0)
  #define KRD(G,j) do{ if(G){ kload2(kf,kp0+sl_next,j); SBAR(); } }while(0)
  #define STEP(C0,C1,P0,P1,t,GK,GV,GL) do{ SBAR(); \
    const lds_cptr vp_=vp0+sl_prev; \
    VRD(0); SBAR(); float sacc=(P0[0]+P0[1]); \
    GAPA(C0=__builtin_amdgcn_mfma_f32_32x32x16_bf16(kf[0],qr[0],negm,0,0,0), P0[2],P0[3],P0[4],P0[5],     pw0[0]=PKW(P0,0), pw0[1]=PKW(P0,2), pw0); \
    VRD(4); SBAR(); GAPA(C1=__builtin_amdgcn_mfma_f32_32x32x16_bf16(kf[1],qr[0],negm,0,0,0), P0[6],P0[7],P0[8],P0[9],     pw0[2]=PKW(P0,4), pw0[3]=PKW(P0,6), pw0); \
    VRD(1); SBAR(); GAPA(C0=__builtin_amdgcn_mfma_f32_32x32x16_bf16(kf[2],qr[1],C0,0,0,0),   P0[10],P0[11],P0[12],P0[13], pw1[0]=PKW(P0,8), pw1[1]=PKW(P0,10), pw1); \
    VRD(5); SBAR(); GAPA(C1=__builtin_amdgcn_mfma_f32_32x32x16_bf16(kf[3],qr[1],C1,0,0,0),   P0[14],P0[15],P1[0],P1[1],   pw1[2]=PKW(P0,12),pw1[3]=PKW(P0,14), pw1); \
    VRD(2); SBAR(); GAPA(C0=__builtin_amdgcn_mfma_f32_32x32x16_bf16(kf[4],qr[2],C0,0,0,0),   P1[2],P1[3],P1[4],P1[5],     pw2[0]=PKW(P1,0), pw2[1]=PKW(P1,2), pw2); \
    VRD(6); SBAR(); GAPA(C1=__builtin_amdgcn_mfma_f32_32x32x16_bf16(kf[5],qr[2],C1,0,0,0),   P1[6],P1[7],P1[8],P1[9],     pw2[2]=PKW(P1,4), pw2[3]=PKW(P1,6), pw2); \
    VRD(3); SBAR(); GAPA(C0=__builtin_amdgcn_mfma_f32_32x32x16_bf16(kf[6],qr[3],C0,0,0,0),   P1[10],P1[11],P1[12],P1[13], pw3[0]=PKW(P1,8), pw3[1]=PKW(P1,10), pw3); \
    VRD(7); SBAR(); GAPA(C1=__builtin_amdgcn_mfma_f32_32x32x16_bf16(kf[7],qr[3],C1,0,0,0),   P1[14],P1[15],0.f,0.f,       pw3[2]=PKW(P1,12),pw3[3]=PKW(P1,14), pw3); \
    l_reg+=sacc; \
    if(GK){DMA_K((t)+3,sl_cur);} if(GV){DMA_V((t)+1,sl_next);} \
    CMASK(C0,C1,t); \
    { float a=MX3(C0[0],C0[1],C1[0]),b=MX3(C0[2],C0[3],C1[1]); a=MX3(a,C1[2],C1[3]); \
      _Pragma("unroll") for(int r=4;r<16;r+=4){a=MX3(a,C0[r],C0[r+1]);b=MX3(b,C0[r+2],C0[r+3]);a=MX3(a,C1[r],C1[r+1]);b=MX3(b,C1[r+2],C1[r+3]);} \
      float rm=__builtin_fmaxf(a,b); { auto rr=__builtin_amdgcn_permlane32_swap(__float_as_uint(rm),__float_as_uint(rm),false,false); rm=__builtin_fmaxf(__uint_as_float(rr[0]),__uint_as_float(rr[1])); } \
      resc=false; \
      if(__builtin_expect(__any(rm>(float)THRL),0)){ const float dl=__builtin_fmaxf(rm,0.f); mhat+=dl; \
        _Pragma("unroll") for(int r=0;r<16;++r){C0[r]-=dl;C1[r]-=dl;} \
        const float f=__builtin_amdgcn_exp2f(-dl); l_reg*=f; if(hi==0)wsf[r32]=f; resc=true; } \
      if(resc||((((t)+1)&3)==0)){ const bool okn_=OKB(((t)+1)>>2);   \
        _Pragma("unroll") for(int r=0;r<16;++r)negm[r]=okn_?-mhat:NEGB; asm volatile("":"+v"(negm)); } } \
    SBAR(); \
    GAPB(o[0]=__builtin_amdgcn_mfma_f32_32x32x16_bf16(PAF(0),VFR(0),o[0],0,0,0), C0,0); \
    GAPB(o[1]=__builtin_amdgcn_mfma_f32_32x32x16_bf16(PAF(0),VFR(4),o[1],0,0,0), C0,4); \
    KRD(GL,0); GAPB(o[0]=__builtin_amdgcn_mfma_f32_32x32x16_bf16(PAF(1),VFR(1),o[0],0,0,0), C0,8); \
    KRD(GL,1); GAPB(o[1]=__builtin_amdgcn_mfma_f32_32x32x16_bf16(PAF(1),VFR(5),o[1],0,0,0), C0,12); \
    KRD(GL,2); GAPB(o[0]=__builtin_amdgcn_mfma_f32_32x32x16_bf16(PAF(2),VFR(2),o[0],0,0,0), C1,0); \
    KRD(GL,3); GAPB(o[1]=__builtin_amdgcn_mfma_f32_32x32x16_bf16(PAF(2),VFR(6),o[1],0,0,0), C1,4); \
    GAPB(o[0]=__builtin_amdgcn_mfma_f32_32x32x16_bf16(PAF(3),VFR(3),o[0],0,0,0), C1,8); \
    GAPB(o[1]=__builtin_amdgcn_mfma_f32_32x32x16_bf16(PAF(3),VFR(7),o[1],0,0,0), C1,12); \
    }while(0)
  int t=1;
  #undef CMASK
  #define CMASK(P0,P1,t) do{}while(0)
  for(;t+5<NT;t+=2){
    STEP(pB0,pB1,pA0,pA1,t,true,true,true);     WAIT_BAR(2); RESC(); ROT();
    STEP(pA0,pA1,pB0,pB1,t+1,true,true,true);   WAIT_BAR(2); RESC(); ROT();
  }
  #undef CMASK
  const int lane_b=(int)__builtin_amdgcn_mbcnt_hi(~0u,__builtin_amdgcn_mbcnt_lo(~0u,0u)), hi_b=lane_b>>5, qrel_b=wid*QBLK+(lane_b&31);
  #define CMASK(P0,P1,t) do{int jb_=(t)-(NT-4); if(jb_>=0)cmask(P0,P1,jb_,qrel_b,hi_b);}while(0)
  #define ENDW(tt) do{ if((tt)+3<NT){WAIT_BAR(2);} else if((tt)+2<NT){WAIT_BAR(1);} else {WAIT_BAR(0);} }while(0)
  for(;t+1<NT;t+=2){
    STEP(pB0,pB1,pA0,pA1,t,(t+3<NT),(t+1<NT),(t+1<NT));       ENDW(t);   RESC(); ROT();
    STEP(pA0,pA1,pB0,pB1,t+1,(t+4<NT),(t+2<NT),(t+2<NT));     ENDW(t+1); RESC(); ROT();
  }
  STEP(pB0,pB1,pA0,pA1,NT-1,false,false,false); RESC();
  { float sacc=pB0[0]+pB0[1]; _Pragma("unroll") for(int r=2;r<16;++r)sacc+=pB0[r]; _Pragma("unroll") for(int r=0;r<16;++r)sacc+=pB1[r]; l_reg+=sacc;
    pw0=(u32x4){PKW(pB0,0),PKW(pB0,2),PKW(pB0,4),PKW(pB0,6)};pw1=(u32x4){PKW(pB0,8),PKW(pB0,10),PKW(pB0,12),PKW(pB0,14)};pw2=(u32x4){PKW(pB1,0),PKW(pB1,2),PKW(pB1,4),PKW(pB1,6)};pw3=(u32x4){PKW(pB1,8),PKW(pB1,10),PKW(pB1,12),PKW(pB1,14)};
    const int vb0=(int)(lds0+LDS_V)+((lane>>4)&1)*32+(lane&3)*8+(4*hi+((lane&15)>>2))*64;
    SBAR(); pv(o,vb0+sl_cur,PAF(0),PAF(1),PAF(2),PAF(3)); }
  #undef PKW
  #undef PAF
  #undef VFR
  #undef PIN
  #undef MX3
  #undef GAPA
  #undef GAPB
  #undef EX
  #undef VRD
  #undef KRD
  #undef STEP
  #undef ENDW
  {auto rr=__builtin_amdgcn_permlane32_swap(__float_as_uint(l_reg),__float_as_uint(l_reg),false,false);l_reg=__uint_as_float(rr[0])+__uint_as_float(rr[1]);}
  if(hi==0)wsf[32+r32]=l_reg;asm volatile("s_waitcnt lgkmcnt(0)":::"memory");
  float rli[16];
  #pragma unroll
  for(int r=0;r<16;++r)rli[r]=__builtin_amdgcn_rcpf(wsf[32+crow(r,hi)])*YSC;
  unsigned char*Yw=Y+(size_t)(rowbase+q0+wid*QBLK)*2048+h*D;
  { unsigned char*stg=(unsigned char*)(shm+LDS_OST)+wid*4096;
    #pragma unroll
    for(int r=0;r<16;++r){const int orow=crow(r,hi);
      const float a0=__builtin_fminf(__builtin_fmaxf(o[0][r]*rli[r],-448.f),448.f),a1=__builtin_fminf(__builtin_fmaxf(o[1][r]*rli[r],-448.f),448.f);
      const unsigned pk=(unsigned)__builtin_amdgcn_cvt_pk_fp8_f32(a0,a1,0,false);
      stg[orow*64+r32]=(unsigned char)(pk&0xffu); stg[orow*64+32+r32]=(unsigned char)((pk>>8)&0xffu);}
    asm volatile("s_waitcnt lgkmcnt(0)":::"memory");
    #pragma unroll
    for(int i=0;i<2;++i){const int row=i*16+(lane>>2),ch=lane&3; const u32x4 v=*(const u32x4*)(stg+row*64+ch*16); *(u32x4*)(Yw+(size_t)row*2048+ch*16)=v;} }
  asm volatile("s_waitcnt lgkmcnt(0)\n\ts_barrier":::"memory");
  #undef DMA_K
  #undef DMA_V
  #undef CMASK
  #undef START
  #undef RESC
  #undef ROT
  #undef OKB
}
#undef SBAR
#undef WAIT_BAR
#ifdef ATTN_STORE16
#undef ATTN_STORE16
#endif
}

namespace mls {
constexpr int RS = 272, TS = 144;
constexpr float CSC = 8.f, CSC_INV = 0.125f;
struct MW { unsigned char* CC; unsigned char* CP; float* NC; float* NP; float* SC; float* MP; };
__device__ __forceinline__ int cslot(int bh, int c) { return (c + bh) & 31; }
__device__ __forceinline__ float fsilu(float x) { return x * __builtin_amdgcn_rcpf(1.f + __builtin_amdgcn_exp2f(-1.4426950408889634f * x)); }
__device__ __forceinline__ void vt_write(LAS unsigned char* dst, const u32x4 a, const u32x4 bq) {
    *(LAS unsigned*)(dst + 0 * TS) = (a.x & 0xffffu) | (bq.x << 16); *(LAS unsigned*)(dst + 1 * TS) = (a.x >> 16) | (bq.x & 0xffff0000u);
    *(LAS unsigned*)(dst + 2 * TS) = (a.y & 0xffffu) | (bq.y << 16); *(LAS unsigned*)(dst + 3 * TS) = (a.y >> 16) | (bq.y & 0xffff0000u);
    *(LAS unsigned*)(dst + 4 * TS) = (a.z & 0xffffu) | (bq.z << 16); *(LAS unsigned*)(dst + 5 * TS) = (a.z >> 16) | (bq.z & 0xffff0000u);
    *(LAS unsigned*)(dst + 6 * TS) = (a.w & 0xffffu) | (bq.w << 16); *(LAS unsigned*)(dst + 7 * TS) = (a.w >> 16) | (bq.w & 0xffff0000u);
}
constexpr int XKWT = 0, XVT = 18432, XCW = 36864;
__device__ __forceinline__ void x_setup(Frame& F, const float* conv_w, const float* conv_b) {
    __syncthreads();
    for (int i = F.tid; i < 5 * 512; i += NTHR) { const int j = i >> 9, ch = i & 511; ((LAS float*)(F.lds + XCW))[i] = (j < 4) ? conv_w[j * 1024 + 512 + ch] : conv_b[512 + ch]; }
    __syncthreads();
}
struct XL { u32x4 raw[5], vr0, vr1; float li, lf; };
__device__ __forceinline__ void x_load(XL& L, const Frame& F, const bf16_t* proj, const float* gates, int u) {
    const int tid = F.tid, c = u & 31, bh = u >> 5, b = bh >> 2, h = bh & 3; const size_t rb = (size_t)b * SEQ;
    const int cc = tid & 15, rp = tid >> 4, tp = tid & 31, ec = tid >> 5;
#pragma unroll
    for (int i = 0; i < 5; ++i) { const int pos = c * 64 + 2 * rp - 3 + i;
        if (pos >= 0) L.raw[i] = *(const u32x4*)(proj + (rb + pos) * NIN + C_LK + h * 128 + 8 * cc); else L.raw[i] = (u32x4){0u, 0u, 0u, 0u}; }
    L.vr0 = *(const u32x4*)(proj + (rb + c * 64 + 2 * tp) * NIN + C_LV + h * 128 + 8 * ec); L.vr1 = *(const u32x4*)(proj + (rb + c * 64 + 2 * tp + 1) * NIN + C_LV + h * 128 + 8 * ec);
    L.li = gates[(rb + c * 64 + F.lane) * 8 + h]; L.lf = gates[(rb + c * 64 + F.lane) * 8 + 4 + h];
}
__device__ __forceinline__ void x_unit(Frame& F, const bf16_t* proj, const float* gates, const MW& W, int u, XL& cur, XL& nxt, bool has_next, int un) {
    LAS unsigned char* lds = F.lds; const int tid = F.tid, lane = F.lane, r32 = lane & 31, hh = lane >> 5, w = F.wave;
    const int bh = u >> 5, h = bh & 3;
    const int cc = tid & 15, rp = tid >> 4, tp = tid & 31, ec = tid >> 5;
    u32x4 raw[5];
#pragma unroll
    for (int i = 0; i < 5; ++i) raw[i] = cur.raw[i];
    const u32x4 vr0 = cur.vr0, vr1 = cur.vr1; const float li = cur.li, lf = cur.lf;
    const float bcs = scan64<false>(lf), cs = li - bcs, pm = scan64<true>(cs);
    const float blast = lane63(bcs), amax = blast + lane63(pm);
    const float wa = __expf(blast + cs - amax);
    LBAR();
    {   const LAS float* cw = (const LAS float*)(lds + XCW) + h * 128 + 8 * cc;
        u32x4 pk[2];
#pragma unroll
        for (int r = 0; r < 2; ++r) {
            f32x4 oa = *(const LAS f32x4*)(cw + 4 * 512), ob = *(const LAS f32x4*)(cw + 4 * 512 + 4);
#pragma unroll
            for (int j = 0; j < 4; ++j) { const u32x4 uu = raw[r + j]; const f32x4 wa4 = *(const LAS f32x4*)(cw + j * 512), wb4 = *(const LAS f32x4*)(cw + j * 512 + 4);
                oa += wa4 * (f32x4){bflo(uu.x), bfhi(uu.x), bflo(uu.y), bfhi(uu.y)}; ob += wb4 * (f32x4){bflo(uu.z), bfhi(uu.z), bflo(uu.w), bfhi(uu.w)}; }
            const float ws = __shfl(wa, 2 * rp + r) * 0.08838834764831845f;
#pragma unroll
            for (int i = 0; i < 4; ++i) { oa[i] = fsilu(oa[i]) * ws; ob[i] = fsilu(ob[i]) * ws; }
            pk[r].x = cvtpk(oa[0], oa[1]); pk[r].y = cvtpk(oa[2], oa[3]); pk[r].z = cvtpk(ob[0], ob[1]); pk[r].w = cvtpk(ob[2], ob[3]);
        }
#pragma unroll
        for (int i = 0; i < 8; ++i) { const int sh = 16 * (i & 1); const unsigned e0 = (pk[0][i >> 1] >> sh) & 0xffffu, e1 = (pk[1][i >> 1] >> sh) & 0xffffu;
            *(LAS unsigned*)(lds + XKWT + (8 * cc + i) * TS + (2 * rp) * 2) = e0 | (e1 << 16); }
        vt_write(lds + XVT + (8 * ec) * TS + (2 * tp) * 2, vr0, vr1);
    }
    if (has_next) x_load(nxt, F, proj, gates, un);
    LBAR();
#pragma unroll
    for (int i = 0; i < 2; ++i) { const int T = 2 * w + i, dt = T >> 2, e2 = T & 3;
        f32x16 acc;
#pragma unroll
        for (int r = 0; r < 16; ++r) acc[r] = 0.f;
#pragma unroll
        for (int k = 0; k < 4; ++k) { const bf16x8 a = *(const LAS bf16x8*)(lds + XKWT + (32 * dt + r32) * TS + (16 * k + 8 * hh) * 2);
            const bf16x8 bv = *(const LAS bf16x8*)(lds + XVT + (32 * e2 + r32) * TS + (16 * k + 8 * hh) * 2);
            acc = __builtin_amdgcn_mfma_f32_32x32x16_bf16(a, bv, acc, 0, 0, 0); }
        unsigned char* dst = W.CC + (size_t)((u & ~31) + cslot(u >> 5, u & 31)) * 16384 + (size_t)(32 * e2 + r32) * 128 + 32 * dt + 4 * hh;
#pragma unroll
        for (int g = 0; g < 4; ++g) *(unsigned*)(dst + 8 * g) = pg8::pack_fp8x4(acc[4 * g] * CSC, acc[4 * g + 1] * CSC, acc[4 * g + 2] * CSC, acc[4 * g + 3] * CSC); }
    if (tid < 128) { float sN = 0.f;
#pragma unroll
        for (int k = 0; k < 8; ++k) { const u32x4 uu = *(const LAS u32x4*)(lds + XKWT + tid * TS + k * 16);
            sN += (bflo(uu.x) + bfhi(uu.x)) + (bflo(uu.y) + bfhi(uu.y)) + (bflo(uu.z) + bfhi(uu.z)) + (bflo(uu.w) + bfhi(uu.w)); }
        W.NC[(size_t)u * 128 + tid] = sN; }
    if (tid == 0) { W.SC[u * 2] = blast; W.SC[u * 2 + 1] = amax; }
}
constexpr int YK = 3, CONV_Y = YK * 4 * 256;
template <int GRP>
__device__ __forceinline__ void y_phase(Frame& F, const MW& W) {
    for (int base = blockIdx.x * 256; base < 32 * 2048; base += F.G * 256) {
        if (F.tid >= 256) {
            if (base == (int)blockIdx.x * 256 && F.G == 256) {
#pragma unroll 1
                for (int k = 0; k < YK; ++k) conv_item<GRP>(F, (int)blockIdx.x * 4 + (F.wave - 4) + k * 1024);
            }
            continue; }
        const int bh = base >> 11, g = (base & 2047) + F.tid, e = g >> 4, d8 = (g & 15) * 8;
        const float* sc = W.SC + (size_t)bh * 64;
        const size_t off = (size_t)bh * 32 * 16384 + (size_t)e * 128 + d8;
        u32x2 v[32];
#pragma unroll
        for (int c = 0; c < 32; ++c) v[c] = __builtin_nontemporal_load((const u32x2*)(W.CC + off + (size_t)cslot(bh, c) * 16384));
        const bool nsc = (g < 32);
        f32x4 nv[32];
        if (nsc) {
#pragma unroll
            for (int c = 0; c < 32; ++c) nv[c] = *(const f32x4*)(W.NC + ((size_t)bh * 32 + c) * 128 + g * 4); }
        float C[8];
#pragma unroll
        for (int i = 0; i < 8; ++i) C[i] = 0.f;
        float m = 0.f;
#pragma unroll
        for (int c = 0; c < 32; ++c) {
            u32x2 o; o.x = pg8::pack_fp8x4(C[0], C[1], C[2], C[3]); o.y = pg8::pack_fp8x4(C[4], C[5], C[6], C[7]); *(u32x2*)(W.CP + off + (size_t)cslot(bh, c) * 16384) = o;
            const float bl = sc[2 * c], am = sc[2 * c + 1], mn = fmaxf(bl + m, am), dec = __expf(bl + m - mn), inj = __expf(am - mn);
            const auto x0 = __builtin_amdgcn_cvt_pk_f32_fp8((int)v[c].x, false), x1 = __builtin_amdgcn_cvt_pk_f32_fp8((int)v[c].x, true), x2 = __builtin_amdgcn_cvt_pk_f32_fp8((int)v[c].y, false), x3 = __builtin_amdgcn_cvt_pk_f32_fp8((int)v[c].y, true);
            C[0] = C[0] * dec + x0[0] * inj; C[1] = C[1] * dec + x0[1] * inj; C[2] = C[2] * dec + x1[0] * inj; C[3] = C[3] * dec + x1[1] * inj;
            C[4] = C[4] * dec + x2[0] * inj; C[5] = C[5] * dec + x2[1] * inj; C[6] = C[6] * dec + x3[0] * inj; C[7] = C[7] * dec + x3[1] * inj; m = mn; }
        if (nsc) {
            f32x4 N = (f32x4){0.f, 0.f, 0.f, 0.f}; float mm = 0.f;
#pragma unroll
            for (int c = 0; c < 32; ++c) {
                *(f32x4*)(W.NP + ((size_t)bh * 32 + c) * 128 + g * 4) = N; if (g == 0) W.MP[bh * 32 + c] = mm;
                const float bl = sc[2 * c], am = sc[2 * c + 1], mn = fmaxf(bl + mm, am), dec = __expf(bl + mm - mn), inj = __expf(am - mn);
                N = N * dec + nv[c] * inj; mm = mn; }
        }
    }
}
constexpr int QS = 0, QW = 17408, KS = 34816, ZCW = 52224  , VT = 72704, CB = 91136, NS = 125952, CSO = 126464, SSQ = 126720, ZNW = 127744  ;
struct Pre { u32x4 raw[7]; u32x4 vr[2]; float li, lf; };
__device__ __forceinline__ void prefetch(Pre& P, const bf16_t* proj, const float* gates, size_t rb, int c, int h, int tid, int lane) {
    const int cc = tid & 31, rg = tid >> 5;
    const int col = (cc < 16) ? (C_LQ + h * 128 + 8 * cc) : (C_LK + h * 128 + 8 * (cc - 16));
#pragma unroll
    for (int i = 0; i < 7; ++i) { const int pos = c * 64 + 4 * rg - 3 + i;
        if (pos >= 0) P.raw[i] = *(const u32x4*)(proj + (rb + pos) * NIN + col); else P.raw[i] = (u32x4){0u, 0u, 0u, 0u}; }
    const int tp = tid & 31, ec = tid >> 5;
    P.vr[0] = *(const u32x4*)(proj + (rb + c * 64 + 2 * tp) * NIN + C_LV + h * 128 + 8 * ec);
    P.vr[1] = *(const u32x4*)(proj + (rb + c * 64 + 2 * tp + 1) * NIN + C_LV + h * 128 + 8 * ec);
    P.li = gates[(rb + c * 64 + lane) * 8 + h]; P.lf = gates[(rb + c * 64 + lane) * 8 + 4 + h];
}
__device__ __forceinline__ void z_setup(Frame& F, const float* conv_w, const float* conv_b, const float* normw) {
    __syncthreads();
    for (int i = F.tid; i < 5 * 1024; i += NTHR) { const int j = i >> 10, ch = i & 1023; ((LAS float*)(F.lds + ZCW))[i] = (j < 4) ? conv_w[j * 1024 + ch] : conv_b[ch]; }
    ((LAS float*)(F.lds + ZNW))[F.tid] = normw[F.tid];
    __syncthreads();
}
struct ZL { Pre P; u32x4 cpv[2]; float npv, mprev; u32x2 og[4]; };
__device__ __forceinline__ void z_load(ZL& L, const Frame& F, const bf16_t* proj, const float* gates, const MW& W, int u) {
    const int tid = F.tid, lane = F.lane, r32 = lane & 31, hh = lane >> 5, w = F.wave, et = w & 3, tt = w >> 2;
    const int c = u & 31, bh = u >> 5, b = bh >> 2, h = bh & 3; const size_t rb = (size_t)b * SEQ, r0 = rb + (size_t)c * 64; const int trow = 32 * tt + r32;
    prefetch(L.P, proj, gates, rb, c, h, tid, lane);
#pragma unroll
    for (int i = 0; i < 2; ++i) L.cpv[i] = __builtin_nontemporal_load((const u32x4*)(W.CP + (size_t)((u & ~31) + cslot(u >> 5, u & 31)) * 16384 + (size_t)(tid + i * NTHR) * 16));
    L.npv = (tid < 128) ? W.NP[(size_t)u * 128 + tid] : 0.f; L.mprev = W.MP[u];
#pragma unroll
    for (int g = 0; g < 4; ++g) L.og[g] = *(const u32x2*)(proj + (r0 + trow) * NIN + C_LO + h * 128 + 32 * et + 8 * g + 4 * hh);
}
__device__ __forceinline__ void z_unit(Frame& F, const bf16_t* proj, const float* gates, const MW& W, unsigned char* Y, int u, ZL& cur, ZL& nxt, bool has_next, int un) {
    LAS unsigned char* lds = F.lds; const int tid = F.tid, lane = F.lane, r32 = lane & 31, hh = lane >> 5, w = F.wave, et = w & 3, tt = w >> 2;
    const int c = u & 31, bh = u >> 5, b = bh >> 2, h = bh & 3; const size_t rb = (size_t)b * SEQ, r0 = rb + (size_t)c * 64;
    const int trow = 32 * tt + r32;
    const Pre P = cur.P;
    u32x4 cpv[2];
#pragma unroll
    for (int i = 0; i < 2; ++i) cpv[i] = cur.cpv[i];
    const float npv = cur.npv, mprev = cur.mprev;
    u32x2 og[4];
#pragma unroll
    for (int g = 0; g < 4; ++g) og[g] = cur.og[g];
    const float bcs = scan64<false>(P.lf), cs = P.li - bcs, pm = scan64<true>(cs);
    const float il = bcs + mprev, mo = fmaxf(il, bcs + pm), wi = __expf(il - mo);
    const float rt = __shfl(bcs - mo, trow), eo = __shfl(__expf(-mo), trow);
    LBAR();
    if (w == 0) ((LAS float*)(lds + CSO))[lane] = cs;
#pragma unroll
    for (int i = 0; i < 2; ++i) { const int ci = tid + i * NTHR, e = ci >> 3, part = ci & 7;
        unsigned wv[8];
#pragma unroll
        for (int q = 0; q < 4; ++q) { const int uq = (int)cpv[i][q]; const auto lo = __builtin_amdgcn_cvt_pk_f32_fp8(uq, false), hi = __builtin_amdgcn_cvt_pk_f32_fp8(uq, true);
            wv[2 * q] = cvtpk(lo[0] * CSC_INV, lo[1] * CSC_INV); wv[2 * q + 1] = cvtpk(hi[0] * CSC_INV, hi[1] * CSC_INV); }
        u32x4 w0, w1; w0.x = wv[0]; w0.y = wv[1]; w0.z = wv[2]; w0.w = wv[3]; w1.x = wv[4]; w1.y = wv[5]; w1.z = wv[6]; w1.w = wv[7];
        *(LAS u32x4*)(lds + CB + e * RS + part * 32) = w0; *(LAS u32x4*)(lds + CB + e * RS + part * 32 + 16) = w1; }
    if (tid < 128) ((LAS float*)(lds + NS))[tid] = npv;
    {
        const int cc = tid & 31, rg = tid >> 5; const bool isk = cc >= 16; const int dcol = 8 * (cc & 15);
        const LAS float* cw = (const LAS float*)(lds + ZCW) + (isk ? 512 : 0) + h * 128 + dcol;
        const float ksc = isk ? 0.08838834764831845f : 1.f;
#pragma unroll
        for (int r = 0; r < 4; ++r) {
            f32x4 oa = *(const LAS f32x4*)(cw + 4 * 1024), ob = *(const LAS f32x4*)(cw + 4 * 1024 + 4);
#pragma unroll
            for (int j = 0; j < 4; ++j) { const u32x4 uu = P.raw[r + j]; const f32x4 wa4 = *(const LAS f32x4*)(cw + j * 1024), wb4 = *(const LAS f32x4*)(cw + j * 1024 + 4);
                oa += wa4 * (f32x4){bflo(uu.x), bfhi(uu.x), bflo(uu.y), bfhi(uu.y)}; ob += wb4 * (f32x4){bflo(uu.z), bfhi(uu.z), bflo(uu.w), bfhi(uu.w)}; }
#pragma unroll
            for (int i = 0; i < 4; ++i) { oa[i] = fsilu(oa[i]) * ksc; ob[i] = fsilu(ob[i]) * ksc; }
            const int t = 4 * rg + r; const float ws = __shfl(wi, t);
            u32x4 wv; wv.x = cvtpk(oa[0], oa[1]); wv.y = cvtpk(oa[2], oa[3]); wv.z = cvtpk(ob[0], ob[1]); wv.w = cvtpk(ob[2], ob[3]);
            *(LAS u32x4*)(lds + (isk ? KS : QS) + t * RS + dcol * 2) = wv;
            if (!isk) { u32x4 v; v.x = cvtpk(oa[0] * ws, oa[1] * ws); v.y = cvtpk(oa[2] * ws, oa[3] * ws); v.z = cvtpk(ob[0] * ws, ob[1] * ws); v.w = cvtpk(ob[2] * ws, ob[3] * ws);
                *(LAS u32x4*)(lds + QW + t * RS + dcol * 2) = v; }
            asm volatile("" ::: "memory");
        }
        vt_write(lds + VT + (8 * (tid >> 5)) * TS + (2 * (tid & 31)) * 2, P.vr[0], P.vr[1]);
    }
    if (has_next) z_load(nxt, F, proj, gates, W, un);
    LBAR();
    f32x16 acc;
#pragma unroll
    for (int r = 0; r < 16; ++r) acc[r] = 0.f;
    float den = 0.f;
    for (int st = 0; st <= tt; ++st) {
        f32x16 S;
#pragma unroll
        for (int r = 0; r < 16; ++r) S[r] = 0.f;
#pragma unroll
        for (int k = 0; k < 8; ++k) { const bf16x8 a = *(const LAS bf16x8*)(lds + KS + (32 * st + r32) * RS + (16 * k + 8 * hh) * 2); const bf16x8 qk = *(const LAS bf16x8*)(lds + QS + trow * RS + (16 * k + 8 * hh) * 2); S = __builtin_amdgcn_mfma_f32_32x32x16_bf16(a, qk, S, 0, 0, 0); }
        const LAS float* csp = (const LAS float*)(lds + CSO) + 32 * st + 4 * hh;
#pragma unroll
        for (int r = 0; r < 16; ++r) { const int so = (r & 3) + 8 * (r >> 2); const float cv = csp[so];
            const bool ok = (st < tt) || (so + 4 * hh <= r32);
            const float p = ok ? S[r] * __expf(rt + cv) : 0.f; S[r] = p; den += p; }
#pragma unroll
        for (int k2 = 0; k2 < 2; ++k2) {
            u32x4 pw; pw.x = cvtpk(S[8 * k2 + 0], S[8 * k2 + 1]); pw.y = cvtpk(S[8 * k2 + 2], S[8 * k2 + 3]); pw.z = cvtpk(S[8 * k2 + 4], S[8 * k2 + 5]); pw.w = cvtpk(S[8 * k2 + 6], S[8 * k2 + 7]);
            const LAS unsigned char* vp = lds + VT + (32 * et + r32) * TS + (32 * st + 16 * k2 + 4 * hh) * 2;
            const u32x2 lo = *(const LAS u32x2*)vp, hi = *(const LAS u32x2*)(vp + 16); u32x4 aw; aw.x = lo.x; aw.y = lo.y; aw.z = hi.x; aw.w = hi.y;
            acc = __builtin_amdgcn_mfma_f32_32x32x16_bf16(__builtin_bit_cast(bf16x8, aw), __builtin_bit_cast(bf16x8, pw), acc, 0, 0, 0); }
    }
    {
        const LAS float* nsp = (const LAS float*)(lds + NS);
#pragma unroll
        for (int k = 0; k < 8; ++k) {
            const bf16x8 a = *(const LAS bf16x8*)(lds + CB + (32 * et + r32) * RS + (16 * k + 8 * hh) * 2);
            const bf16x8 bq = *(const LAS bf16x8*)(lds + QW + trow * RS + (16 * k + 8 * hh) * 2);
            acc = __builtin_amdgcn_mfma_f32_32x32x16_bf16(a, bq, acc, 0, 0, 0);
            const f32x4 n0 = *(const LAS f32x4*)(nsp + 16 * k + 8 * hh), n1 = *(const LAS f32x4*)(nsp + 16 * k + 8 * hh + 4);
            den += bf1((bf16_t)bq[0]) * n0[0] + bf1((bf16_t)bq[1]) * n0[1] + bf1((bf16_t)bq[2]) * n0[2] + bf1((bf16_t)bq[3]) * n0[3]
                 + bf1((bf16_t)bq[4]) * n1[0] + bf1((bf16_t)bq[5]) * n1[1] + bf1((bf16_t)bq[6]) * n1[2] + bf1((bf16_t)bq[7]) * n1[3]; }
    }
    den += __shfl_xor(den, 32);
    const float hinv = 1.f / fmaxf(fabsf(den), eo);
    float ssq = 0.f;
#pragma unroll
    for (int r = 0; r < 16; ++r) { acc[r] *= hinv; ssq += acc[r] * acc[r]; }
    ssq += __shfl_xor(ssq, 32);
    if (hh == 0) ((LAS float*)(lds + SSQ))[et * 64 + trow] = ssq;
    LBAR();
    {
        const LAS float* sq = (const LAS float*)(lds + SSQ) + trow;
        const float tot = (sq[0] + sq[64]) + (sq[128] + sq[192]);
        const float rn = att::YSC / sqrtf(tot * (1.f / 128.f) + RMS_EPS);
        unsigned char* yrow = Y + (r0 + trow) * D + 512 + h * 128 + 32 * et + 4 * hh;
#pragma unroll
        for (int g = 0; g < 4; ++g) { const f32x4 nwg = *(const LAS f32x4*)(lds + ZNW + (h * 128 + 32 * et + 8 * g + 4 * hh) * 4); const float o0 = bflo(og[g].x), o1 = bfhi(og[g].x), o2 = bflo(og[g].y), o3 = bfhi(og[g].y);
            *(unsigned*)(yrow + 8 * g) = pg8::pack_fp8x4(acc[4 * g] * rn * nwg[0] * sigmoid_f(o0), acc[4 * g + 1] * rn * nwg[1] * sigmoid_f(o1), acc[4 * g + 2] * rn * nwg[2] * sigmoid_f(o2), acc[4 * g + 3] * rn * nwg[3] * sigmoid_f(o3)); }
    }
}
}

__device__ __forceinline__ int wq_pull(Frame& F, unsigned* qctr) {
    volatile LAS int* slot = (volatile LAS int*)(F.lds + LDSCTL_OFF + 256);
    __syncthreads();
    if (F.tid == 0) *slot = (int)__hip_atomic_fetch_add(qctr, 1u, __ATOMIC_RELAXED, __HIP_MEMORY_SCOPE_AGENT);
    __syncthreads();
    return __builtin_amdgcn_readfirstlane(*slot);
}
constexpr int N_PHASES = 18;
constexpr int N_LAUNCHES = MK_N_LAUNCHES;
constexpr int PTAB_OFF = LDSCTL_OFF + 512, MOETAB_OFF = LDSCTL_OFF + 64;
__device__ __forceinline__ const float* inptr(const Frame& F, int i) {
    const LAS unsigned* t = (const LAS unsigned*)(F.lds + PTAB_OFF) + 2 * i;
    const unsigned lo = __builtin_amdgcn_readfirstlane(t[0]), hi = __builtin_amdgcn_readfirstlane(t[1]);
    return (const float*)(((unsigned long long)hi << 32) | lo);
}
#define GRID_BAR() do { if (N_LAUNCHES == 1) xcd_barrier(bar); } while (0)
#define IN(k) (lo <= (k) && (k) < hi)
#define SEAM(k) do { if (IN(k) && IN((k) + 1)) GRID_BAR(); } while (0)
__device__ __forceinline__ void moe_table(Frame& F) {
    LAS int* tab = (LAS int*)(F.lds + MOETAB_OFF);
    __syncthreads();
    if (F.tid == 0) { int cum = 0; for (int e = 0; e < NE; ++e) { const int cn = (int)__hip_atomic_load(F.ctl + CW_CNT + e, __ATOMIC_RELAXED, __HIP_MEMORY_SCOPE_AGENT); tab[e] = cn; tab[8 + e] = cum; cum += (cn + 255) >> 8; } tab[16] = cum; }
    __syncthreads();
}
template <int GRP>
__device__ __forceinline__ void conv_part(Frame& F, int part) {
    constexpr int N = (GRP == 0) ? CONV_N0 : (GRP == 1) ? CONV_N1 : (GRP == 2) ? CONV_N2 : (GRP == 3) ? CONV_N3 : CONV_N4;
    const int niter = (N + F.NGW - 1) / F.NGW, i0 = part * niter / 3, i1 = (part + 1) * niter / 3;
#pragma unroll 1
    for (int i = i0; i < i1; ++i) { const int it = F.gw + i * F.NGW; if (it < N) conv_item<GRP>(F, it); }
}
template <int GRP>
__device__ __forceinline__ void conv_queue(Frame& F, unsigned* qctr) {
    constexpr int N = (GRP == 0) ? CONV_N0 : (GRP == 1) ? CONV_N1 : (GRP == 2) ? CONV_N2 : (GRP == 3) ? CONV_N3 : CONV_N4, BATCH = 32, NBATCH = (N + BATCH - 1) / BATCH;
    volatile LAS int* slot2 = (volatile LAS int*)(F.lds + LDSCTL_OFF + 264);
    int cur = wq_pull(F, qctr), par = 0;
    while (cur < NBATCH) {
        if (F.tid == 0) slot2[par] = (int)__hip_atomic_fetch_add(qctr, 1u, __ATOMIC_RELAXED, __HIP_MEMORY_SCOPE_AGENT);
#pragma unroll 1
        for (int i = F.wave; i < BATCH; i += NWAVES) { const int it = cur * BATCH + i; if (it < N) conv_item<GRP>(F, it); }
        __syncthreads();
        cur = __builtin_amdgcn_readfirstlane(slot2[par]); par ^= 1;
    }
}
template <int L>
__device__ __forceinline__ void layer(Frame& F, const XcdBarrier& bar, float* out, const int lo, const int hi) {
    constexpr int pb = 2 + 8 * L;
    unsigned char* ws = F.ws;
    float* mod = (float*)(ws + WS_MOD); float* gates = (float*)(ws + WS_GATES);
    uint4* tok = (uint4*)(ws + WS_TOK); int* idx = (int*)(ws + WS_TOK + 512 * 1024);
    bf16_t* XN = (bf16_t*)(ws + WS_XN); bf16_t* proj = (bf16_t*)(ws + WS_PROJ); unsigned char* ymix = ws + WS_YMIX; bf16_t* act = (bf16_t*)(ws + WS_ACT);
    bf16_t* yb = (bf16_t*)(ws + WS_YB);
    const float* modl = mod + (size_t)L * NB * 6 * D;
    if (IN(pb + 0)) {
        pg8::DenseSched S{(const char*)XN, (const char*)(ws + WS_WIN + (size_t)L * NIN * D), D, M / 256, NIN / 256, F.G, (int)blockIdx.x};
        pg8::EpiInProjI8 E{proj, NIN, (float*)(ws + WS_CTL + KMEAN_OFF + (size_t)L * 131072), (const float*)(ws + WS_ROWMAX), (const float*)(ws + WS_CTL + COLMAX_OFF) + CMX_WIN + L * NIN};
        pg8::gemm_phase<pg8::EpiInProjI8, pg8::DenseSched, true, 2>(F.lds, D, S, E);
    }
    SEAM(pb + 0);
    const mls::MW mw{ws + WS_CC, ws + WS_CP, (float*)(ws + WS_NC), (float*)(ws + WS_NP), (float*)(ws + WS_SC), (float*)(ws + WS_SC + 65536)};
    const float* km = (const float*)(ws + WS_CTL + KMEAN_OFF + (size_t)L * 131072);
    const int cls = (blockIdx.x >> 3) & 3; const bool odd = (cls & 1) != 0;
    if (IN(pb + 1)) {
        mls::x_setup(F, inptr(F, IN_CONVW) + (size_t)L * 4 * 1024, inptr(F, IN_CONVB) + (size_t)L * 1024);
        { int u = blockIdx.x; mls::XL xa; if (u < 1024) mls::x_load(xa, F, proj, gates, u);
          for (; u < 1024; u += F.G) { mls::XL xb; const bool hn = u + F.G < 1024; mls::x_unit(F, proj, gates, mw, u, xa, xb, hn, u + F.G); xa = xb; } }
        __syncthreads();
    }
    SEAM(pb + 1);
    if (IN(pb + 2)) {
        constexpr int GRP = (L == 0) ? 2 : 3;
        mls::y_phase<GRP>(F, mw);
        GRID_BAR();
        if (cls == 0) { conv_all<GRP>(F, (F.G == 256) ? mls::CONV_Y : 0); __syncthreads(); }
        if (odd) { for (int p = blockIdx.x; p < 256; p += F.G) { const int bh = p >> 2, jj = p & 3; mob::attn_unit<8>(bh >> 3, bh & 7, 7 - jj, (const mob::bf16*)(proj + C_MQ), (const mob::bf16*)(proj + C_MK), (const mob::bf16*)(proj + C_MV), ymix, km, (char*)F.glds); } }
        __syncthreads();
        if (cls == 1) { conv_all<GRP>(F, (F.G == 256) ? mls::CONV_Y : 0); __syncthreads(); }
        mls::z_setup(F, inptr(F, IN_CONVW) + (size_t)L * 4 * 1024, inptr(F, IN_CONVB) + (size_t)L * 1024, inptr(F, IN_MNW) + (size_t)L * 512);
        { int u = blockIdx.x; mls::ZL za; if (u < 1024) mls::z_load(za, F, proj, gates, mw, u);
          for (; u < 1024; u += F.G) { mls::ZL zb; const bool hn = u + F.G < 1024; mls::z_unit(F, proj, gates, mw, ymix, u, za, zb, hn, u + F.G); za = zb; } }
        __syncthreads();
        if (!odd) { for (int p = blockIdx.x; p < 256; p += F.G) { const int bh = p >> 2, jj = p & 3; mob::attn_unit<8>(bh >> 3, bh & 7, 7 - jj, (const mob::bf16*)(proj + C_MQ), (const mob::bf16*)(proj + C_MK), (const mob::bf16*)(proj + C_MV), ymix, km, (char*)F.glds); } }
        __syncthreads();
        if (cls == 2) { conv_all<GRP>(F, (F.G == 256) ? mls::CONV_Y : 0); __syncthreads(); }
        for (int p = blockIdx.x; p < 256; p += F.G) { const int bh = p >> 2, jj = p & 3; mob::attn_unit<8>(bh >> 3, bh & 7, jj, (const mob::bf16*)(proj + C_MQ), (const mob::bf16*)(proj + C_MK), (const mob::bf16*)(proj + C_MV), ymix, km, (char*)F.glds); }
        for (int u = blockIdx.x; u < 256; u += F.G) att::swa_unit(F, proj, inptr(F, IN_SINK) + L * 16, ymix, u >> 5, (u >> 4) & 1, u & 15);
        __syncthreads();
        if (cls == 3) { conv_all<GRP>(F, (F.G == 256) ? mls::CONV_Y : 0); __syncthreads(); }
    }
    SEAM(pb + 2);
    if (IN(pb + 3)) {
        pg8::DenseSched S{(const char*)ymix, (const char*)(ws + WS_WOUT + (size_t)L * D * D), D, M / 256, D / 256, F.G, (int)blockIdx.x};
        pg8::EpiBf16 E{yb, D, WSC_INV / att::YSC};
        pg8::gemm_phase<pg8::EpiBf16, pg8::DenseSched, true, 1>(F.lds, D, S, E);
    }
    SEAM(pb + 3);
    if (IN(pb + 4)) {
        float* xb = (float*)(ws + WS_XB);
        if constexpr (L == 0) row_phase<1, 0, true, true, false, true>(F, inptr(F, IN_X), xb, yb, inptr(F, IN_GPOSTM) + (size_t)L * D, modl + 2 * D, inptr(F, IN_GPREF) + (size_t)L * D, modl + 4 * D, modl + 3 * D, XN,
                                          nullptr, 0, nullptr, nullptr, nullptr, nullptr, nullptr, nullptr, nullptr, (float*)(ws + WS_ROWMAX));
        else        row_phase<1, 2, true, true, true, true>(F, xb, xb, yb, inptr(F, IN_GPOSTM) + (size_t)L * D, modl + 2 * D, inptr(F, IN_GPREF) + (size_t)L * D, modl + 4 * D, modl + 3 * D, XN,
                                          inptr(F, IN_ROUTER), 8, nullptr, nullptr, nullptr, nullptr, tok, idx, F.ctl + CW_CNT, (float*)(ws + WS_ROWMAX));
    }
    SEAM(pb + 4);
    if constexpr (L == 0) {
        if (IN(pb + 5)) {
            pg8::DenseSched S{(const char*)XN, (const char*)(ws + WS_WGU), D, M / 256, 2 * DFF / 256, F.G, (int)blockIdx.x};
            pg8::EpiSwiGLUI8 E{(unsigned char*)act, DFF, (const float*)(ws + WS_ROWMAX), (const float*)(ws + WS_CTL + COLMAX_OFF), nullptr, nullptr};
            pg8::gemm_phase<pg8::EpiSwiGLUI8, pg8::DenseSched, true, 2>(F.lds, D, S, E);
        }
        SEAM(pb + 5);
        if (IN(pb + 6)) {
            pg8::DenseSched S{(const char*)act, (const char*)(ws + WS_WD), DFF, M / 256, D / 256, F.G, (int)blockIdx.x};
            pg8::EpiBf16 E{yb, D, WSC_INV};
            pg8::gemm_phase<pg8::EpiBf16, pg8::DenseSched, true, 1>(F.lds, DFF, S, E);
        }
        SEAM(pb + 6);
        if (IN(pb + 7)) { float* xb = (float*)(ws + WS_XB); row_phase<1, 1, true, true, true, true>(F, xb, xb, yb, inptr(F, IN_GPOSTF), modl + 5 * D, inptr(F, IN_GPREM) + D, mod + (size_t)NB * 6 * D + 1 * D, mod + (size_t)NB * 6 * D + 0 * D, XN,
                                              inptr(F, IN_WIN) + (size_t)D * NIN_SRC + SRC_GATE, NIN_SRC, inptr(F, IN_IGB) + 4, inptr(F, IN_FGB) + 4, gates, nullptr, nullptr, nullptr, nullptr, (float*)(ws + WS_ROWMAX));
            conv_all<4>(F); }
        SEAM(pb + 7);
    } else {
        if (IN(pb + 5)) {
            moe_table(F);
            const LAS int* tab = (const LAS int*)(F.lds + MOETAB_OFF);
            pg8::MoeSched<true> S; S.A = (const char*)XN; S.W = (const char*)(ws + WS_MGU); S.idx = idx; S.tab = tab; S.KB = D; S.nN = 2 * DFE / 256; S.G = F.G; S.c = (int)blockIdx.x; S.wrows = 2 * DFE; S.ntile = tab[16];
            pg8::EpiSwiGLUI8 E{(unsigned char*)act, DFE, (const float*)(ws + WS_RMSLOT), (const float*)(ws + WS_CTL + COLMAX_OFF) + 2 * DFF, idx, tab};
            pg8::gemm_phase<pg8::EpiSwiGLUI8, pg8::MoeSched<true>, true, 2>(F.lds, D, S, E);
        }
        SEAM(pb + 5);
        if (IN(pb + 6)) {
            moe_table(F);
            const LAS int* tab = (const LAS int*)(F.lds + MOETAB_OFF);
            pg8::MoeSched<false> S; S.A = (const char*)act; S.W = (const char*)(ws + WS_MD); S.idx = idx; S.tab = tab; S.KB = DFE; S.nN = D / 256; S.G = F.G; S.c = (int)blockIdx.x; S.wrows = D; S.ntile = tab[16];
            pg8::EpiBf16 E{yb, D, WSC_INV};
            pg8::gemm_phase<pg8::EpiBf16, pg8::MoeSched<false>, true, 1>(F.lds, DFE, S, E);
        }
        SEAM(pb + 6);
        if (IN(pb + 7)) row_phase<2, 0, false, false, true, false>(F, (const float*)(ws + WS_XB), out, yb, inptr(F, IN_GPOSTF) + D, modl + 5 * D, nullptr, nullptr, nullptr, nullptr,
                                               nullptr, 0, nullptr, nullptr, nullptr, tok, nullptr, nullptr, F.ctl + CW_CNT);
    }
}
__global__ void __launch_bounds__(NTHR, 2) fwd(Args args) {
    extern __shared__ __attribute__((aligned(16))) unsigned char lds[];
    Frame F;
    F.lds = (LAS unsigned char*)lds; F.glds = lds; F.ws = args.ws; F.ctl = (unsigned*)(args.ws + WS_CTL);
    F.tid = threadIdx.x; F.lane = F.tid & 63; F.wave = __builtin_amdgcn_readfirstlane(F.tid >> 6);
    F.G = gridDim.x; F.gw = blockIdx.x * NWAVES + F.wave; F.NGW = F.G * NWAVES;
    volatile LAS unsigned* MISC = (volatile LAS unsigned*)(F.lds + MISC_OFF);
    for (int u = F.tid; u < (LDS_BYTES - LDSCTL_OFF) / 4; u += NTHR) ((LAS unsigned*)(F.lds + LDSCTL_OFF))[u] = 0u;
    __syncthreads();
    if (F.tid < N_INPUTS) { const unsigned long long p = (unsigned long long)args.in[F.tid]; LAS unsigned* t = (LAS unsigned*)(F.lds + PTAB_OFF) + 2 * F.tid; t[0] = (unsigned)p; t[1] = (unsigned)(p >> 32); }
    __syncthreads();
    XcdBarrier bar; bar.bar = F.ctl + CW_BAR; bar.x = 0; bar.st = nullptr;
    if (N_LAUNCHES == 1) bar = xcd_barrier_post(F.ctl + CW_BAR, MISC + 8);
    const int lo = args.ph_lo, hi = args.ph_hi;
    float* out = args.out;
    if (IN(0)) { p0_ada(F, inptr(F, IN_C), inptr(F, IN_ADAW), inptr(F, IN_ADAB), (float*)(F.ws + WS_MOD)); __syncthreads(); conv_all<0>(F); }
    SEAM(0);
    if (IN(1)) { float* mod = (float*)(F.ws + WS_MOD); const float* x = inptr(F, IN_X);
        row_phase<0, 1, true, true>(F, x, (float*)x  , nullptr, nullptr, nullptr, inptr(F, IN_GPREM), mod + 1 * D, mod + 0 * D, (bf16_t*)(F.ws + WS_XN),
                              inptr(F, IN_WIN) + SRC_GATE, NIN_SRC, inptr(F, IN_IGB), inptr(F, IN_FGB), (float*)(F.ws + WS_GATES), nullptr, nullptr, nullptr, nullptr, (float*)(F.ws + WS_ROWMAX));
        conv_all<1>(F); }
    SEAM(1);
    layer<0>(F, bar, out, lo, hi);
    layer<1>(F, bar, out, lo, hi);
}
#undef IN
#undef SEAM
#undef GRID_BAR

extern "C" void kernel_launch(void* const* d_in, const int* in_sizes, int n_in, void* d_out, int out_size, void* d_ws, size_t ws_size, hipStream_t stream) {
    static int grid = 0;
    if (grid == 0) {
        if (n_in != N_INPUTS || in_sizes[0] != M * D || out_size != M * D || ws_size < WS_END) { fprintf(stderr, "kernel_launch: unexpected problem (n_in %d, in0 %d, out %d, ws %zu); nothing launched\n", n_in, n_in > 0 ? in_sizes[0] : -1, out_size, ws_size); grid = -1; return; }
        int dev = 0, cus = 0, per_cu = 0;
        if (hipGetDevice(&dev) != hipSuccess || hipDeviceGetAttribute(&cus, hipDeviceAttributeMultiprocessorCount, dev) != hipSuccess) { grid = -1; return; }
        if (hipFuncSetAttribute((const void*)fwd, hipFuncAttributeMaxDynamicSharedMemorySize, LDS_BYTES) != hipSuccess) { fprintf(stderr, "kernel_launch: hipFuncSetAttribute failed\n"); grid = -1; return; }
        if (hipOccupancyMaxActiveBlocksPerMultiprocessor(&per_cu, (const void*)fwd, NTHR, LDS_BYTES) != hipSuccess || per_cu < 1) fprintf(stderr, "kernel_launch: occupancy query reports %d\n", per_cu);
        (void)hipGetLastError();
        grid = cus;
    }
    if (grid < 0) return;
    if (hipMemsetAsync((char*)d_ws + WS_CTL, 0, CTL_ZERO_BYTES, stream) != hipSuccess) return;
    Args a{};
    for (int i = 0; i < N_INPUTS; ++i) a.in[i] = (const float*)d_in[i];
    a.out = (float*)d_out; a.ws = (unsigned char*)d_ws;
    if (N_LAUNCHES == 1) { a.ph_lo = 0; a.ph_hi = N_PHASES; hipLaunchKernelGGL(fwd, dim3(grid), dim3(NTHR), LDS_BYTES, stream, a); }
    else for (int p = 0; p < N_PHASES; ++p) { a.ph_lo = p; a.ph_hi = p + 1; hipLaunchKernelGGL(fwd, dim3(grid), dim3(NTHR), LDS_BYTES, stream, a); }
}
```

```cpp
#include <hip/hip_runtime.h>
#include <cstdio>
#include <cstdint>

#ifndef MK_N_LAUNCHES
#define MK_N_LAUNCHES 1
#endif

#define LAS __attribute__((address_space(3)))
#define GAS __attribute__((address_space(1)))
typedef unsigned short bf16_t;
typedef short bf16x8 __attribute__((ext_vector_type(8)));
typedef float f32x4 __attribute__((ext_vector_type(4)));
typedef float f32x2 __attribute__((ext_vector_type(2)));
typedef float f32x16 __attribute__((ext_vector_type(16)));
typedef unsigned u32x4 __attribute__((ext_vector_type(4)));
typedef unsigned u32x2 __attribute__((ext_vector_type(2)));
typedef __bf16 bf16x2_t __attribute__((ext_vector_type(2)));

constexpr int NB = 8, SEQ = 2048, D = 2048, M = NB * SEQ;
constexpr int NIN_SRC = 4872, NIN = 4864;
constexpr int C_MQ = 0, C_MK = 512, C_MV = 1024, C_LQ = 1536, C_LK = 2048, C_LV = 2560, C_LO = 3072, C_SQ = 3584, C_SK = 4608, C_SV = 4736;
constexpr int SRC_GATE = 3584;
constexpr int DFF = 5632, DFE = 2816, NE = 8, ECAP = M;
constexpr float RMS_EPS = 1e-6f;
constexpr int NWAVES = 8, NTHR = 512;

constexpr size_t MiB = 1u << 20;
constexpr size_t WS_CTL = 0, CTL_ZERO_BYTES = 1 * MiB;
constexpr size_t WS_MOD = 1 * MiB;
constexpr size_t WS_GATES = 2 * MiB;
constexpr size_t WS_ROWMAX = 4 * MiB;
constexpr size_t WS_RMSLOT = 4 * MiB + 131072;
constexpr size_t WS_TOK = 3 * MiB;
constexpr size_t WS_WIN = 8 * MiB;
constexpr size_t WS_WOUT = 48 * MiB;
constexpr size_t WS_WGU = 64 * MiB;
constexpr size_t WS_WD = 108 * MiB;
constexpr size_t WS_MGU = 130 * MiB;
constexpr size_t WS_MD = 306 * MiB;
constexpr size_t WS_XN = 394 * MiB;
constexpr size_t WS_PROJ = 458 * MiB;
constexpr size_t WS_YMIX = 610 * MiB;
constexpr size_t WS_ACT = 458 * MiB;
constexpr size_t WS_YB = 674 * MiB;
constexpr size_t WS_XB = 810 * MiB;
constexpr size_t WS_CC = 874 * MiB;
constexpr size_t WS_CP = 906 * MiB;
constexpr size_t WS_NC = 938 * MiB, WS_NP = 939 * MiB, WS_SC = 940 * MiB;
constexpr size_t WS_END = 941 * MiB;
constexpr int CW_TMO = 0, CW_CODE = 1;
constexpr int CW_CNT = 64;
constexpr int CW_WQ = 128;
constexpr int CW_BAR = 4096;
constexpr size_t KMEAN_OFF = 262144;


__device__ __forceinline__ unsigned cvtpk(float lo, float hi) { f32x2 v = {lo, hi}; bf16x2_t b = __builtin_convertvector(v, bf16x2_t); return __builtin_bit_cast(unsigned, b); }
__device__ __forceinline__ float bflo(unsigned u) { return __uint_as_float(u << 16); }
__device__ __forceinline__ float bfhi(unsigned u) { return __uint_as_float(u & 0xffff0000u); }
__device__ __forceinline__ float bf1(bf16_t u) { return __uint_as_float(((unsigned)u) << 16); }
template <bool MAX>
__device__ __forceinline__ float scan64(float v) {
    constexpr int ident = MAX ? (int)0xff800000 : 0;
#define SCAN_STEP(ctrl, rm) { const float tf = __int_as_float(__builtin_amdgcn_update_dpp(ident, __float_as_int(v), ctrl, rm, 0xf, false)); v = MAX ? fmaxf(v, tf) : v + tf; }
    SCAN_STEP(0x111, 0xf) SCAN_STEP(0x112, 0xf) SCAN_STEP(0x114, 0xf) SCAN_STEP(0x118, 0xf) SCAN_STEP(0x142, 0xa) SCAN_STEP(0x143, 0xc)
#undef SCAN_STEP
    return v;
}
__device__ __forceinline__ float lane63(float v) { return __int_as_float(__builtin_amdgcn_readlane(__float_as_int(v), 63)); }
__device__ __forceinline__ float wave_sum(float v) { return lane63(scan64<false>(v)); }
__device__ __forceinline__ float wave_max(float v) { return lane63(scan64<true>(v)); }
#define LBAR() do { asm volatile("s_waitcnt lgkmcnt(0)" ::: "memory"); __builtin_amdgcn_s_barrier(); asm volatile("" ::: "memory"); } while (0)
__device__ __forceinline__ float silu_f(float x) { return x / (1.f + __expf(-x)); }
__device__ __forceinline__ float sigmoid_f(float x) { return 1.f / (1.f + __expf(-x)); }

namespace pg8 {
constexpr int BM = 256, BK = 64, HALF = 128, HTB = HALF * BK * 2, STAGE_BYTES = 8 * HTB, NXCD = 8, WGM = 8;
__host__ __device__ __forceinline__ int lds_byte(int r, int c) { const int st = (r >> 4) * 2 + (c >> 5), rr = r & 15, cc = c & 31, ob = rr * 64 + cc * 2; return st * 1024 + (ob ^ (((ob >> 9) & 1) << 5)); }
__host__ __device__ __forceinline__ void stage_rc(int b, int& R, int& C) { const int st = b / 1024, sb = b % 1024, swz = sb ^ (((sb >> 9) & 1) << 5); R = (st >> 1) * 16 + swz / 64; C = (st & 1) * 32 + (swz % 64) / 2; }
__host__ __device__ __forceinline__ int perm32(int rho) { const int n = rho >> 4, i = rho & 15; return 8 * (i >> 2) + 4 * n + (i & 3); }

struct Unit { int pm, pn, e; };
__device__ __forceinline__ unsigned pack_fp8x4(float a, float b, float c, float d) {
    a = fminf(fmaxf(a, -448.f), 448.f); b = fminf(fmaxf(b, -448.f), 448.f); c = fminf(fmaxf(c, -448.f), 448.f); d = fminf(fmaxf(d, -448.f), 448.f);
    int p = __builtin_amdgcn_cvt_pk_fp8_f32(a, b, 0, false); p = __builtin_amdgcn_cvt_pk_fp8_f32(c, d, p, true); return (unsigned)p;
}


__device__ __forceinline__ bool static_next(int i, int G, int c, int nM, int nN, int& pm, int& pn) {
    const int nwg = nM * nN; const long L = (long)i * G + c; if (L >= nwg) return false;
    int wgid = (int)L; { const int q = nwg / NXCD, r = nwg % NXCD, xcd = wgid % NXCD, off = wgid / NXCD; wgid = (xcd < r ? xcd * (q + 1) : r * (q + 1) + (xcd - r) * q) + off; }
    const int nig = WGM * nN, gid = wgid / nig, fm = gid * WGM, gsz = (nM - fm) < WGM ? (nM - fm) : WGM;
    pm = fm + ((wgid % nig) % gsz); pn = (wgid % nig) / gsz; return true;
}

struct DenseSched {
    static constexpr bool GATHER = false;
    const char* A; const char* Bt; int KB  , nM, nN, G, c;
    __device__ __forceinline__ bool next(int i, Unit& u) const { u.e = 0; return static_next(i, G, c, nM, nN, u.pm, u.pn); }
    __device__ __forceinline__ const char* a_base() const { return A; }
    __device__ __forceinline__ void a_offsets(const Unit& u, const int (&Rr)[2], const int (&Cc)[2], unsigned (&off)[2][2]) const {
#pragma unroll
        for (int h = 0; h < 2; ++h)
#pragma unroll
            for (int i = 0; i < 2; ++i) off[h][i] = (unsigned)((u.pm * BM + h * HALF + Rr[i]) * KB + Cc[i] * 2);
    }
    __device__ __forceinline__ const char* b_base(const Unit& u) const { return Bt + (size_t)u.pn * BM * KB; }
};
template <bool GATHER_>
struct MoeSched {
    static constexpr bool GATHER = GATHER_;
    const char* A; const char* W; const int* idx; const LAS int* tab  ; int KB, nN, G, c, wrows  , ntile;
    __device__ __forceinline__ bool next(int i, Unit& u) const { if (!static_next(i, G, c, ntile, nN, u.pm, u.pn)) return false; int e = 0;
#pragma unroll
        for (int j = 1; j < NE; ++j) e += (u.pm >= tab[8 + j]) ? 1 : 0;
        u.e = e; return true; }
    __device__ __forceinline__ const char* a_base() const { return A; }
    __device__ __forceinline__ void a_offsets(const Unit& u, const int (&Rr)[2], const int (&Cc)[2], unsigned (&off)[2][2]) const {
        const int cume = tab[8 + u.e], cnte = tab[u.e];
#pragma unroll
        for (int h = 0; h < 2; ++h)
#pragma unroll
            for (int i = 0; i < 2; ++i) {
                if (GATHER_) { const int rl = (u.pm - cume) * BM + h * HALF + Rr[i]; const int tok = (rl < cnte) ? idx[u.e * ECAP + rl] : 0; off[h][i] = (unsigned)(tok * KB + Cc[i] * 2); }
                else off[h][i] = (unsigned)((u.pm * BM + h * HALF + Rr[i]) * KB + Cc[i] * 2);
            }
    }
    __device__ __forceinline__ const char* b_base(const Unit& u) const { return W + ((size_t)u.e * wrows + (size_t)u.pn * BM) * KB; }
};

struct EpiBf16 {
    static constexpr bool PERM = true;
    bf16_t* O; int ldc; float sc;
    __device__ __forceinline__ void operator()(const f32x4 (&acc)[2][2][4][2], const Unit& u, int wr, int wc, int fr, int fq) const {
        const int row0 = u.pm * BM + wr * 64 + fr, col0 = u.pn * BM + wc * 32 + 8 * fq;
#pragma unroll
        for (int ai = 0; ai < 2; ++ai)
#pragma unroll
            for (int m = 0; m < 4; ++m) { bf16_t* rowp = O + (size_t)(row0 + ai * HALF + m * 16) * ldc + col0;
#pragma unroll
                for (int bj = 0; bj < 2; ++bj) { const f32x4 v0 = acc[ai][bj][m][0] * sc, v1 = acc[ai][bj][m][1] * sc;
                    u32x4 w; w.x = cvtpk(v0[0], v0[1]); w.y = cvtpk(v0[2], v0[3]); w.z = cvtpk(v1[0], v1[1]); w.w = cvtpk(v1[2], v1[3]);
                    *(u32x4*)(rowp + bj * HALF) = w; } }
    }
};
struct EpiInProjI8 {
    static constexpr bool PERM = true;
    bf16_t* O; int ldc; float* kmean; const float* rowmax; const float* colmax;
    __device__ __forceinline__ void operator()(const f32x4 (&acc)[2][2][4][2], const Unit& u, int wr, int wc, int fr, int fq) const {
        typedef int i32x4_ __attribute__((ext_vector_type(4)));
        const int row0 = u.pm * BM + wr * 64 + fr, col0 = u.pn * BM + wc * 32 + 8 * fq;
        const float qsc = (u.pn < 2 || (u.pn >= 14 && u.pn < 18)) ? 0.125f * 1.4426950408889634f : 1.f;
        f32x4 cmv[2][2], cs[2][2];
#pragma unroll
        for (int bj = 0; bj < 2; ++bj)
#pragma unroll
            for (int n = 0; n < 2; ++n) { cmv[bj][n] = *(const f32x4*)(colmax + col0 + bj * HALF + 4 * n) * (qsc / (127.f * 127.f)); cs[bj][n] = (f32x4){0.f, 0.f, 0.f, 0.f}; }
#pragma unroll
        for (int ai = 0; ai < 2; ++ai)
#pragma unroll
            for (int m = 0; m < 4; ++m) { const int r = row0 + ai * HALF + m * 16; bf16_t* rowp = O + (size_t)r * ldc + col0; const float sa = rowmax[r];
#pragma unroll
                for (int bj = 0; bj < 2; ++bj) { f32x4 v[2];
#pragma unroll
                    for (int n = 0; n < 2; ++n) { const i32x4_ iv = __builtin_bit_cast(i32x4_, acc[ai][bj][m][n]);
                        v[n] = (f32x4){(float)iv[0], (float)iv[1], (float)iv[2], (float)iv[3]} * (cmv[bj][n] * sa); cs[bj][n] += v[n]; }
                    u32x4 w; w.x = cvtpk(v[0][0], v[0][1]); w.y = cvtpk(v[0][2], v[0][3]); w.z = cvtpk(v[1][0], v[1][1]); w.w = cvtpk(v[1][2], v[1][3]);
                    *(u32x4*)(rowp + bj * HALF) = w; } }
        if (u.pn == 2 || u.pn == 3) {
#pragma unroll
            for (int bj = 0; bj < 2; ++bj)
#pragma unroll
                for (int n = 0; n < 2; ++n) {
#pragma unroll
                    for (int j = 0; j < 4; ++j) { float v = cs[bj][n][j]; v += __shfl_xor(v, 1); v += __shfl_xor(v, 2); v += __shfl_xor(v, 4); v += __shfl_xor(v, 8); cs[bj][n][j] = v; }
                    if (fr == 0) { float* kp = kmean + (size_t)u.pm * 512 + (u.pn - 2) * BM + bj * HALF + wc * 32 + 8 * fq + 4 * n;
#pragma unroll
                        for (int j = 0; j < 4; ++j) atomicAdd(kp + j, cs[bj][n][j] * (1.f / 256.f)); } }
        }
    }
};
typedef int i32x8 __attribute__((ext_vector_type(8)));
typedef int i32x4 __attribute__((ext_vector_type(4)));
struct EpiSwiGLUI8 {
    static constexpr bool PERM = true;
    unsigned char* O; int ldc; const float* rowmax; const float* colmax  ; const int* rowidx  ; const LAS int* tab;
    __device__ __forceinline__ void operator()(const f32x4 (&acc)[2][2][4][2], const Unit& u, int wr, int wc, int fr, int fq) const {
        const int row0 = u.pm * BM + wr * 64 + fr, col0 = u.pn * HALF + wc * 32 + 8 * fq;
        const float* cm = colmax + (size_t)u.e * 2 * ldc + u.pn * BM + wc * 32 + 8 * fq;
        const f32x4 cg0 = *(const f32x4*)(cm), cg1 = *(const f32x4*)(cm + 4), cu0 = *(const f32x4*)(cm + HALF), cu1 = *(const f32x4*)(cm + HALF + 4);
        const float cg[8] = {cg0[0], cg0[1], cg0[2], cg0[3], cg1[0], cg1[1], cg1[2], cg1[3]}, cu[8] = {cu0[0], cu0[1], cu0[2], cu0[3], cu1[0], cu1[1], cu1[2], cu1[3]};
        int cume = 0, cnte = 0x7fffffff; if (rowidx) { cume = tab[8 + u.e]; cnte = tab[u.e]; }
#pragma unroll
        for (int ai = 0; ai < 2; ++ai)
#pragma unroll
            for (int m = 0; m < 4; ++m) { const int r = row0 + ai * HALF + m * 16; unsigned char* rowp = O + (size_t)r * ldc + col0;
                float sa; if (rowidx) { const int rl = r - cume * BM; sa = (rl < cnte) ? rowmax[u.e * ECAP + rl] : 0.f; } else sa = rowmax[r];
                sa *= (1.f / (127.f * 127.f));
                float o[8];
#pragma unroll
                for (int n = 0; n < 2; ++n)
#pragma unroll
                    for (int j = 0; j < 4; ++j) { const float g = (float)__builtin_bit_cast(i32x4, acc[ai][0][m][n])[j] * (sa * cg[n * 4 + j]), up = (float)__builtin_bit_cast(i32x4, acc[ai][1][m][n])[j] * (sa * cu[n * 4 + j]);
                        o[n * 4 + j] = g * __builtin_amdgcn_rcpf(1.f + __builtin_amdgcn_exp2f(-1.4426950408889634f * g)) * up; }
                u32x2 w; w.x = pack_fp8x4(o[0], o[1], o[2], o[3]); w.y = pack_fp8x4(o[4], o[5], o[6], o[7]);
                *(u32x2*)rowp = w; }
    }
};

struct EpiSwiGLU8 {
    static constexpr bool PERM = true;
    unsigned char* O; int ldc; float sc;
    __device__ __forceinline__ void operator()(const f32x4 (&acc)[2][2][4][2], const Unit& u, int wr, int wc, int fr, int fq) const {
        const int row0 = u.pm * BM + wr * 64 + fr, col0 = u.pn * HALF + wc * 32 + 8 * fq;
#pragma unroll
        for (int ai = 0; ai < 2; ++ai)
#pragma unroll
            for (int m = 0; m < 4; ++m) { unsigned char* rowp = O + (size_t)(row0 + ai * HALF + m * 16) * ldc + col0;
                float r[8];
#pragma unroll
                for (int n = 0; n < 2; ++n)
#pragma unroll
                    for (int j = 0; j < 4; ++j) { const float g = acc[ai][0][m][n][j] * sc, up = acc[ai][1][m][n][j] * sc;
                        r[n * 4 + j] = g * __builtin_amdgcn_rcpf(1.f + __builtin_amdgcn_exp2f(-1.4426950408889634f * g)) * up; }
                u32x2 w; w.x = pack_fp8x4(r[0], r[1], r[2], r[3]); w.y = pack_fp8x4(r[4], r[5], r[6], r[7]);
                *(u32x2*)rowp = w; }
    }
};

template <class Epi, class Sched, bool ALIGN_EPI, int DT>
__device__ __forceinline__ void gemm_phase(LAS unsigned char* lds, const int KB, const Sched& S, const Epi& E) {
    const int tid = threadIdx.x, wid = __builtin_amdgcn_readfirstlane(tid >> 6), lane = tid & 63, wr = wid >> 2, wc = wid & 3, fr = lane & 15, fq = lane >> 4;
    const int nt = KB / 128;
    int Rr[2], Cc[2]; unsigned voffB[2];
#pragma unroll
    for (int i = 0; i < 2; ++i) { int R, C; stage_rc(tid * 16 + i * 8192, R, C); Rr[i] = R; Cc[i] = C; const int Rb = Epi::PERM ? ((R & ~31) + perm32(R & 31)) : R; voffB[i] = (unsigned)(Rb * KB + C * 2); }
    const size_t kstep = (size_t)(BK * 2);
    const size_t hstep = (size_t)HALF * KB;
    const unsigned ldsw = (unsigned)wid * 1024u;
    const int aoff = lds_byte(wr * 64 + fr, fq * 8), boff = lds_byte(wc * 32 + fr, fq * 8);
#define PG8_SA(b, h) (((b) * 2 + (h)) * HTB)
#define PG8_SB(b, h) ((4 + (b) * 2 + (h)) * HTB)
#define PG8_STAGE(bufoff, gbase, voff) do { _Pragma("unroll") for (int _i = 0; _i < 2; ++_i) \
        __builtin_amdgcn_global_load_lds((const unsigned*)((const char*)(gbase) + (voff)[_i]), (LAS unsigned*)(lds + (bufoff) + ldsw + _i * 8192), 16, 0, 0); } while (0)
#define PG8_LD32(p) __builtin_shufflevector(*(const LAS i32x4*)(p), *(const LAS i32x4*)((p) + 1024), 0, 1, 2, 3, 4, 5, 6, 7)
#define PG8_LDA(dst, b, h) do { _Pragma("unroll") for (int m = 0; m < 4; ++m) dst[m] = PG8_LD32(lds + PG8_SA(b, h) + aoff + m * 2048); } while (0)
#define PG8_LDB(dst, b, h) do { _Pragma("unroll") for (int n = 0; n < 2; ++n) dst[n] = PG8_LD32(lds + PG8_SB(b, h) + boff + n * 2048); } while (0)
#define PG8_LO(x) __builtin_bit_cast(bf16x8, __builtin_shufflevector((x), (x), 0, 1, 2, 3))
#define PG8_HI(x) __builtin_bit_cast(bf16x8, __builtin_shufflevector((x), (x), 4, 5, 6, 7))
#define PG8_MMA(ai, bj, At, Bt) do { __builtin_amdgcn_s_setprio(1); \
        if constexpr (DT == 2) { _Pragma("unroll") for (int m = 0; m < 4; ++m) _Pragma("unroll") for (int n = 0; n < 2; ++n) { \
            i32x4 _c = __builtin_bit_cast(i32x4, acc[ai][bj][m][n]); \
            _c = __builtin_amdgcn_mfma_i32_16x16x64_i8(__builtin_shufflevector(Bt[n], Bt[n], 0, 1, 2, 3), __builtin_shufflevector(At[m], At[m], 0, 1, 2, 3), _c, 0, 0, 0); \
            _c = __builtin_amdgcn_mfma_i32_16x16x64_i8(__builtin_shufflevector(Bt[n], Bt[n], 4, 5, 6, 7), __builtin_shufflevector(At[m], At[m], 4, 5, 6, 7), _c, 0, 0, 0); \
            acc[ai][bj][m][n] = __builtin_bit_cast(f32x4, _c); } } \
        else if constexpr (DT == 1) { _Pragma("unroll") for (int m = 0; m < 4; ++m) _Pragma("unroll") for (int n = 0; n < 2; ++n) \
            asm volatile("v_mfma_scale_f32_16x16x128_f8f6f4 %0, %1, %2, %0, %3, %3 op_sel_hi:[0,0,0]" : "+v"(acc[ai][bj][m][n]) : "v"(Bt[n]), "v"(At[m]), "v"(scv)); } \
        else { _Pragma("unroll") for (int m = 0; m < 4; ++m) _Pragma("unroll") for (int n = 0; n < 2; ++n) { \
            acc[ai][bj][m][n] = __builtin_amdgcn_mfma_f32_16x16x32_bf16(PG8_LO(Bt[n]), PG8_LO(At[m]), acc[ai][bj][m][n], 0, 0, 0); \
            acc[ai][bj][m][n] = __builtin_amdgcn_mfma_f32_16x16x32_bf16(PG8_HI(Bt[n]), PG8_HI(At[m]), acc[ai][bj][m][n], 0, 0, 0); } } \
        __builtin_amdgcn_s_setprio(0); } while (0)
#define PG8_WAIT_V(n) asm volatile("s_waitcnt vmcnt(" #n ")" ::: "memory")
#define PG8_WAIT_L(n) asm volatile("s_waitcnt lgkmcnt(" #n ")" ::: "memory")
#define PG8_BAR __builtin_amdgcn_s_barrier()
#define PG8_SCHED __builtin_amdgcn_sched_barrier(0)
    Unit cur, nxt; int ui = 0;
    if (!S.next(0, cur)) return;
    f32x4 acc[2][2][4][2];
#pragma unroll
    for (int a = 0; a < 2; ++a)
#pragma unroll
        for (int b = 0; b < 2; ++b)
#pragma unroll
            for (int m = 0; m < 4; ++m)
#pragma unroll
                for (int n = 0; n < 2; ++n) acc[a][b][m][n] = (f32x4){0.f, 0.f, 0.f, 0.f};
    i32x8 At[4], B0[2], B1[2];
    int scv = 0x7F7F7F7F; asm volatile("" : "+v"(scv));
    unsigned curA[2][2], nxtA[2][2], voffA[2];
    const char* const Ab = S.a_base(); const char* cA = Ab; const char* nA = Ab;
    if constexpr (Sched::GATHER) S.a_offsets(cur, Rr, Cc, curA);
    else {
#pragma unroll
        for (int i = 0; i < 2; ++i) voffA[i] = (unsigned)(Rr[i] * KB + Cc[i] * 2);
        cA = Ab + (size_t)cur.pm * 2 * hstep; }
    const char* cB = S.b_base(cur);
#define PG8_STA(bufoff, nextflag, h, koff) do { if constexpr (Sched::GATHER) { unsigned _o[2]; _o[0] = (nextflag) ? nxtA[h][0] : curA[h][0]; _o[1] = (nextflag) ? nxtA[h][1] : curA[h][1]; PG8_STAGE(bufoff, Ab + (koff), _o); } \
        else { PG8_STAGE(bufoff, ((nextflag) ? nA : cA) + (size_t)(h) * hstep + (koff), voffA); } } while (0)
    PG8_STAGE(PG8_SB(0, 0), cB, voffB); PG8_STAGE(PG8_SB(0, 1), cB + hstep, voffB); PG8_STA(PG8_SA(0, 0), false, 0, 0); PG8_STA(PG8_SA(0, 1), false, 1, 0);
    if (wr == 1) PG8_BAR;
    PG8_WAIT_V(2); PG8_BAR;
    PG8_STAGE(PG8_SB(1, 0), cB + kstep, voffB); PG8_STA(PG8_SA(1, 0), false, 0, kstep); PG8_STAGE(PG8_SB(1, 1), cB + hstep + kstep, voffB);
    PG8_WAIT_V(6); PG8_BAR;
    for (;;) {
        const bool has_next = S.next(ui + 1, nxt);
        if constexpr (Sched::GATHER) {
            if (has_next) S.a_offsets(nxt, Rr, Cc, nxtA);
            else {
#pragma unroll
                for (int h = 0; h < 2; ++h)
#pragma unroll
                    for (int i = 0; i < 2; ++i) nxtA[h][i] = curA[h][i]; }
        } else nA = has_next ? Ab + (size_t)nxt.pm * 2 * hstep : cA;
        const char* nB = has_next ? S.b_base(nxt) : cB;
        for (int t = 0; t < nt; t += 2) {
            const bool last = (t == nt - 2);
            const size_t k1 = (size_t)(t + 1) * kstep, k2 = last ? 0 : (size_t)(t + 2) * kstep, k3 = k2 + kstep;
            const char* b2 = last ? nB : cB + (size_t)(t + 2) * kstep; const char* b3 = b2 + kstep;
            PG8_LDB(B0, 0, 0); PG8_LDB(B1, 0, 1); PG8_SCHED; PG8_LDA(At, 0, 0); PG8_STA(PG8_SA(1, 1), false, 1, k1);
            PG8_WAIT_V(8); PG8_WAIT_L(0); PG8_BAR; PG8_MMA(0, 0, At, B0); PG8_MMA(0, 1, At, B1); PG8_BAR; PG8_SCHED;
            PG8_LDA(At, 0, 1); PG8_STAGE(PG8_SB(0, 0), b2, voffB); PG8_STAGE(PG8_SB(0, 1), b2 + hstep, voffB); PG8_STA(PG8_SA(0, 0), last, 0, k2);
            PG8_WAIT_V(8); PG8_WAIT_L(0); PG8_BAR; PG8_MMA(1, 0, At, B0); PG8_MMA(1, 1, At, B1); PG8_BAR; PG8_SCHED;
            PG8_LDB(B0, 1, 0); PG8_LDB(B1, 1, 1); PG8_SCHED; PG8_LDA(At, 1, 0); PG8_STA(PG8_SA(0, 1), last, 1, k2);
            PG8_WAIT_V(8); PG8_WAIT_L(0); PG8_BAR; PG8_MMA(0, 0, At, B0); PG8_MMA(0, 1, At, B1); PG8_BAR; PG8_SCHED;
            PG8_LDA(At, 1, 1); PG8_STAGE(PG8_SB(1, 0), b3, voffB); PG8_STAGE(PG8_SB(1, 1), b3 + hstep, voffB); PG8_STA(PG8_SA(1, 0), last, 0, k3);
            PG8_WAIT_V(8); PG8_WAIT_L(0); PG8_BAR; PG8_MMA(1, 0, At, B0); PG8_MMA(1, 1, At, B1); PG8_BAR; PG8_SCHED;
        }
        if constexpr (ALIGN_EPI) { if (wr == 0) PG8_BAR; }
        if constexpr (DT == 1) asm volatile("s_nop 15\n\ts_nop 15" ::: "memory");
        E(acc, cur, wr, wc, fr, fq);
        if (!has_next) break;
#pragma unroll
        for (int a = 0; a < 2; ++a)
#pragma unroll
            for (int b = 0; b < 2; ++b)
#pragma unroll
                for (int m = 0; m < 4; ++m)
#pragma unroll
                    for (int n = 0; n < 2; ++n) acc[a][b][m][n] = (f32x4){0.f, 0.f, 0.f, 0.f};
        cur = nxt; cB = nB; cA = nA; ++ui;
        if constexpr (Sched::GATHER) {
#pragma unroll
            for (int h = 0; h < 2; ++h)
#pragma unroll
                for (int i = 0; i < 2; ++i) curA[h][i] = nxtA[h][i]; }
        if constexpr (ALIGN_EPI) { if (wr == 1) PG8_BAR; }
    }
    PG8_WAIT_V(0);
    if constexpr (!ALIGN_EPI) { if (wr == 0) PG8_BAR; }
    PG8_BAR;
#undef PG8_SA
#undef PG8_SB
#undef PG8_STAGE
#undef PG8_STA
#undef PG8_LDA
#undef PG8_LDB
#undef PG8_MMA
#undef PG8_LD32
#undef PG8_LO
#undef PG8_HI
#undef PG8_WAIT_V
#undef PG8_WAIT_L
#undef PG8_BAR
#undef PG8_SCHED
}
}

#define XB_TMO      128
#define XB_XCNT(j)  (256  + 64 * (j))
#define XB_XSUB(j)  (1280 + 64 * (j))
#define XB_XGEN(j)  (2304 + 64 * (j))
#define XB_TOP      3328
#define XB_TOPGEN   3392
#define XCD_BAR_WORDS 3456
#define XB_SPIN_CAP (1u << 18)
__device__ __forceinline__ unsigned xb_ld(unsigned* p)              { return __hip_atomic_load(p, __ATOMIC_RELAXED, __HIP_MEMORY_SCOPE_AGENT); }
__device__ __forceinline__ unsigned xb_add(unsigned* p, unsigned v) { return __hip_atomic_fetch_add(p, v, __ATOMIC_RELAXED, __HIP_MEMORY_SCOPE_AGENT); }
__device__ __forceinline__ unsigned xb_xcc_id() { return (unsigned)__builtin_amdgcn_s_getreg((3 << 11) | 20) & 0xFu; }
#define XB_SPIN(cond, bar) do { unsigned _sp = 0; while (cond) { __builtin_amdgcn_s_sleep(1); \
    if ((++_sp & 255u) == 0u) { if (xb_ld(&(bar)[XB_TMO])) break; if (_sp > XB_SPIN_CAP) { atomicAdd(&(bar)[XB_TMO], 1u); break; } } } } while (0)
struct XcdBarrier { unsigned* bar; unsigned x; volatile LAS unsigned* st; };
__device__ __forceinline__ XcdBarrier xcd_barrier_post(unsigned* bar, volatile LAS unsigned* st) {
    XcdBarrier b; b.bar = bar; b.x = xb_xcc_id(); b.st = st;
    if (threadIdx.x == 0) (void)xb_add(&bar[XB_XCNT(b.x)], 1u);
    return b;
}
__device__ __forceinline__ void xcd_barrier_complete(unsigned* bar, unsigned x, unsigned& nloc, unsigned& nx) {
    const unsigned G = gridDim.x * gridDim.y * gridDim.z;
    unsigned sum, cnt, mine, sp = 0u;
    for (;;) {
        sum = 0u; cnt = 0u; mine = 0u;
#pragma unroll
        for (unsigned j = 0; j < 16; ++j) { const unsigned c = xb_ld(&bar[XB_XCNT(j)]); sum += c; cnt += (c > 0u) ? 1u : 0u; mine = (j == x) ? c : mine; }
        if (sum == G) break;
        __builtin_amdgcn_s_sleep(1);
        if ((++sp & 255u) == 0u) { if (xb_ld(&bar[XB_TMO])) break; if (sp > XB_SPIN_CAP) { atomicAdd(&bar[XB_TMO], 1u); break; } }
    }
    nloc = mine > 0u ? mine : 1u; nx = cnt > 0u ? cnt : 1u;
}
__device__ __forceinline__ void xcd_barrier(const XcdBarrier& b) {
    asm volatile("s_waitcnt vmcnt(0)" ::: "memory");
    __syncthreads();
    if (threadIdx.x == 0) {
        unsigned* bar = b.bar;
        __builtin_amdgcn_s_waitcnt(0);
        unsigned nloc = b.st[0], nx = b.st[1];
        if (nloc == 0u) { xcd_barrier_complete(bar, b.x, nloc, nx); b.st[0] = nloc; b.st[1] = nx; }
        const unsigned old = xb_add(&bar[XB_XSUB(b.x)], 1u);
        const unsigned gen = old / nloc;
        if (old + 1u == (gen + 1u) * nloc) {
            __builtin_amdgcn_fence(__ATOMIC_RELEASE, "agent");
            asm volatile("s_waitcnt vmcnt(0)" ::: "memory");
            const unsigned og = xb_add(&bar[XB_TOP], 1u);
            const unsigned tg = og / nx;
            if (og + 1u == (tg + 1u) * nx) xb_add(&bar[XB_TOPGEN], 1u);
            else XB_SPIN(xb_ld(&bar[XB_TOPGEN]) == tg, bar);
            __builtin_amdgcn_fence(__ATOMIC_ACQUIRE, "agent");
            xb_add(&bar[XB_XGEN(b.x)], 1u);
            asm volatile("s_waitcnt vmcnt(0)" ::: "memory");
        } else {
            XB_SPIN(xb_ld(&bar[XB_XGEN(b.x)]) == gen, bar);
            __builtin_amdgcn_fence(__ATOMIC_ACQUIRE, "agent");
            asm volatile("s_waitcnt vmcnt(0)" ::: "memory");
        }
    }
    __syncthreads();
}

constexpr int RING_BYTES = 131072, LDSCTL_OFF = RING_BYTES, MISC_OFF = LDSCTL_OFF + 320, LDS_BYTES = 147456;
enum { IN_X = 0, IN_C, IN_ADAW, IN_ADAB, IN_GPREM, IN_GPOSTM, IN_GPREF, IN_GPOSTF, IN_WIN, IN_WOUT, IN_CONVW, IN_CONVB, IN_IGB, IN_FGB, IN_MNW, IN_SINK,
       IN_FG, IN_FU, IN_FD, IN_ROUTER, IN_MG, IN_MU, IN_MD, N_INPUTS };
struct Args { const float* in[N_INPUTS]; float* out; unsigned char* ws; int ph_lo, ph_hi; };
struct Frame {
    LAS unsigned char* lds; unsigned char* glds; unsigned* ctl; unsigned char* ws;
    int tid, lane, wave, G, gw, NGW;
};

__device__ __forceinline__ void p0_ada(Frame& F, const float* c, const float* ada_w, const float* ada_b, float* mod) {
    float* cond = (float*)F.glds;
    float* part = (float*)(F.glds + 65536);
    for (int i = F.tid; i < NB * D; i += NTHR) { const int b = i / D, k = i % D; cond[k * 8 + b] = silu_f(c[i]); }
    __syncthreads();
    const int cq = F.lane & 15, ks = F.lane >> 4;
    for (int u = blockIdx.x; u < 384; u += F.G) {
        const int l = u / 192, cb = u % 192;
        const float* W = ada_w + (size_t)l * D * 6 * D + cb * 64 + cq * 4;
        f32x4 acc[8];
#pragma unroll
        for (int b = 0; b < 8; ++b) acc[b] = (f32x4){0.f, 0.f, 0.f, 0.f};
        const int kbase = F.wave * 256 + ks;
#pragma unroll 4
        for (int it = 0; it < 64; ++it) {
            const int k = kbase + 4 * it;
            const f32x4 w = __builtin_nontemporal_load((const f32x4*)(W + (size_t)k * 6 * D));
            const f32x4 c0 = *(const f32x4*)(cond + k * 8), c1 = *(const f32x4*)(cond + k * 8 + 4);
            acc[0] += w * c0[0]; acc[1] += w * c0[1]; acc[2] += w * c0[2]; acc[3] += w * c0[3];
            acc[4] += w * c1[0]; acc[5] += w * c1[1]; acc[6] += w * c1[2]; acc[7] += w * c1[3];
        }
#pragma unroll
        for (int b = 0; b < 8; ++b)
#pragma unroll
            for (int j = 0; j < 4; ++j) { float v = acc[b][j]; v += __shfl_xor(v, 16); v += __shfl_xor(v, 32); acc[b][j] = v; }
        if (F.lane < 16) {
#pragma unroll
            for (int b = 0; b < 8; ++b) *(f32x4*)(part + (F.wave * 8 + b) * 64 + cq * 4) = acc[b];
        }
        __syncthreads();
        { const int b = F.tid >> 6, col = F.tid & 63; float s = ada_b[(size_t)l * 6 * D + cb * 64 + col];
#pragma unroll
          for (int w = 0; w < 8; ++w) s += part[(w * 8 + b) * 64 + col];
          mod[((size_t)l * NB + b) * 6 * D + cb * 64 + col] = s; }
        __syncthreads();
    }
}
__device__ __forceinline__ void cvt_item(const float* src, int ld, int k0, int c0, bf16_t* dst, int Kd, int drow0, unsigned char* scr, int lane) {
    const int c = lane & 15, q = lane >> 4;
    f32x4 v[4][4];
#pragma unroll
    for (int g = 0; g < 4; ++g)
#pragma unroll
        for (int j = 0; j < 4; ++j) v[g][j] = __builtin_nontemporal_load((const f32x4*)(src + (size_t)(k0 + 16 * g + 4 * q + j) * ld + c0 + 4 * c));
#pragma unroll
    for (int g = 0; g < 4; ++g)
#pragma unroll
        for (int i = 0; i < 4; ++i) { u32x2 w; w.x = cvtpk(v[g][0][i], v[g][1][i]); w.y = cvtpk(v[g][2][i], v[g][3][i]);
            *(u32x2*)(scr + (4 * c + i) * 136 + (16 * g + 4 * q) * 2) = w; }
    asm volatile("s_waitcnt lgkmcnt(0)" ::: "memory");
#pragma unroll
    for (int r = 0; r < 8; ++r) { const int n = 8 * r + (lane >> 3), ch = lane & 7;
        const u32x2 a = *(const u32x2*)(scr + n * 136 + ch * 16), b = *(const u32x2*)(scr + n * 136 + ch * 16 + 8);
        u32x4 o; o.x = a.x; o.y = a.y; o.z = b.x; o.w = b.y;
        *(u32x4*)(dst + (size_t)(drow0 + n) * Kd + k0 + 8 * ch) = o; }
    asm volatile("s_waitcnt lgkmcnt(0)" ::: "memory");
}
constexpr float WSC = 64.f, WSC_INV = 1.f / 64.f;
__device__ __forceinline__ void cvt_item8(const float* src, int ld, int k0, int c0, unsigned char* dst, int Kd, int drow0, unsigned char* scr, int lane) {
    const int c = lane & 7, q = lane >> 3;
    f32x4 v[4][4];
#pragma unroll
    for (int g = 0; g < 4; ++g)
#pragma unroll
        for (int j = 0; j < 4; ++j) v[g][j] = __builtin_nontemporal_load((const f32x4*)(src + (size_t)(k0 + 32 * g + 4 * q + j) * ld + c0 + 4 * c));
#pragma unroll
    for (int g = 0; g < 4; ++g)
#pragma unroll
        for (int i = 0; i < 4; ++i) *(unsigned*)(scr + (4 * c + i) * 132 + 32 * g + 4 * q) = pg8::pack_fp8x4(v[g][0][i] * WSC, v[g][1][i] * WSC, v[g][2][i] * WSC, v[g][3][i] * WSC);
    asm volatile("s_waitcnt lgkmcnt(0)" ::: "memory");
#pragma unroll
    for (int r = 0; r < 4; ++r) { const int n = 8 * r + (lane >> 3), ch = lane & 7; const unsigned char* p = scr + n * 132 + ch * 16;
        u32x4 o; o.x = *(const unsigned*)(p); o.y = *(const unsigned*)(p + 4); o.z = *(const unsigned*)(p + 8); o.w = *(const unsigned*)(p + 12);
        *(u32x4*)(dst + (size_t)(drow0 + n) * Kd + k0 + 16 * ch) = o; }
    asm volatile("s_waitcnt lgkmcnt(0)" ::: "memory");
}
__device__ __forceinline__ const float* inptr(const Frame& F, int i);
constexpr int CMS_KB = 2;
constexpr float CMS_F = 1.4f;
constexpr size_t COLMAX_OFF = 524288;
__device__ __forceinline__ void colmax_item(const float* src, int ld, int k0, int c0, float* cmx  , int lane) {
    const int c = lane & 7, q = lane >> 3;
    f32x4 mx = (f32x4){0.f, 0.f, 0.f, 0.f};
#pragma unroll
    for (int g = 0; g < 4; ++g)
#pragma unroll
        for (int j = 0; j < 4; ++j) { const f32x4 v = *(const f32x4*)(src + (size_t)(k0 + 32 * g + 4 * q + j) * ld + c0 + 4 * c);
            mx[0] = fmaxf(mx[0], fabsf(v[0])); mx[1] = fmaxf(mx[1], fabsf(v[1])); mx[2] = fmaxf(mx[2], fabsf(v[2])); mx[3] = fmaxf(mx[3], fabsf(v[3])); }
#pragma unroll
    for (int i = 0; i < 4; ++i) { float v = mx[i]; v = fmaxf(v, __shfl_xor(v, 8)); v = fmaxf(v, __shfl_xor(v, 16)); v = fmaxf(v, __shfl_xor(v, 32)); mx[i] = v; }
    if (q == 0) {
#pragma unroll
        for (int i = 0; i < 4; ++i) atomicMax((unsigned*)(cmx + 4 * c + i), __float_as_uint(mx[i] * CMS_F)); }
}
__device__ __forceinline__ unsigned pack_i8x4(float a, float b, float c, float d) {
    const int ia = (int)rintf(fminf(fmaxf(a, -127.f), 127.f)), ib = (int)rintf(fminf(fmaxf(b, -127.f), 127.f)), ic = (int)rintf(fminf(fmaxf(c, -127.f), 127.f)), id = (int)rintf(fminf(fmaxf(d, -127.f), 127.f));
    return (unsigned)(ia & 0xff) | ((unsigned)(ib & 0xff) << 8) | ((unsigned)(ic & 0xff) << 16) | ((unsigned)(id & 0xff) << 24);
}
__device__ __forceinline__ void cvt_item_i8(const float* src, int ld, int k0, int c0, unsigned char* dst, int Kd, int drow0, const float* cmx  , unsigned char* scr, int lane) {
    const int c = lane & 7, q = lane >> 3;
    const f32x4 cm = *(const f32x4*)(cmx + 4 * c);
    f32x4 inv; inv[0] = cm[0] > 0.f ? 127.f / cm[0] : 0.f; inv[1] = cm[1] > 0.f ? 127.f / cm[1] : 0.f; inv[2] = cm[2] > 0.f ? 127.f / cm[2] : 0.f; inv[3] = cm[3] > 0.f ? 127.f / cm[3] : 0.f;
    f32x4 v[4][4];
#pragma unroll
    for (int g = 0; g < 4; ++g)
#pragma unroll
        for (int j = 0; j < 4; ++j) v[g][j] = __builtin_nontemporal_load((const f32x4*)(src + (size_t)(k0 + 32 * g + 4 * q + j) * ld + c0 + 4 * c));
#pragma unroll
    for (int g = 0; g < 4; ++g)
#pragma unroll
        for (int i = 0; i < 4; ++i) *(unsigned*)(scr + (4 * c + i) * 132 + 32 * g + 4 * q) = pack_i8x4(v[g][0][i] * inv[i], v[g][1][i] * inv[i], v[g][2][i] * inv[i], v[g][3][i] * inv[i]);
    asm volatile("s_waitcnt lgkmcnt(0)" ::: "memory");
#pragma unroll
    for (int r = 0; r < 4; ++r) { const int n = 8 * r + (lane >> 3), ch = lane & 7; const unsigned char* p = scr + n * 132 + ch * 16;
        u32x4 o; o.x = *(const unsigned*)(p); o.y = *(const unsigned*)(p + 4); o.z = *(const unsigned*)(p + 8); o.w = *(const unsigned*)(p + 12);
        *(u32x4*)(dst + (size_t)(drow0 + n) * Kd + k0 + 16 * ch) = o; }
    asm volatile("s_waitcnt lgkmcnt(0)" ::: "memory");
}
constexpr int CI_WI = 16 * 152  , CI_WO = 16 * 64, CI_FD = 44 * 64, CI_FGU = 2 * 16 * 176, CI_MD = 8 * 22 * 64, CI_MGU = 16 * 16 * 88;
constexpr int CS_WI = CMS_KB * 152, CS_FGU = 2 * CMS_KB * 176, CS_MGU = 16 * CMS_KB * 88;
constexpr int CONV_N0 = CS_WI + CI_WO + CI_FD + CS_FGU, CONV_N1 = CI_WI + CI_FGU, CONV_N2 = CS_WI + CI_WO + CI_MD + CS_MGU, CONV_N3 = CI_MGU, CONV_N4 = CI_WI;
constexpr int CMX_WIN = 2 * DFF + 16 * DFE;
template <int GRP>
__device__ __forceinline__ void conv_item(Frame& F, int r) {
    unsigned char* scr = F.glds + F.wave * 8704; unsigned char* ws = F.ws;
    float* cmx = (float*)(ws + WS_CTL + COLMAX_OFF);
    if (GRP == 0 || GRP == 1 || GRP == 2 || GRP == 4) {
        constexpr int l = (GRP == 2 || GRP == 4) ? 1 : 0;
        constexpr bool QUANT = (GRP == 1 || GRP == 4); constexpr int NI = QUANT ? CI_WI : CS_WI;
        if (r < NI) { const int kb = r / 152, nb = r % 152, c0 = (nb < 112) ? nb * 32 : SRC_GATE + 8 + (nb - 112) * 32, drow = nb * 32;
            if (QUANT) cvt_item_i8(inptr(F, IN_WIN) + (size_t)l * D * NIN_SRC, NIN_SRC, kb * 128, c0, ws + WS_WIN + (size_t)l * NIN * D, D, drow, cmx + CMX_WIN + l * NIN + drow, scr, F.lane);
            else colmax_item(inptr(F, IN_WIN) + (size_t)l * D * NIN_SRC, NIN_SRC, kb * 128, c0, cmx + CMX_WIN + l * NIN + drow, F.lane);
            return; }
        r -= NI;
    }
    if (GRP == 0 || GRP == 2) {
        constexpr int l = (GRP == 2) ? 1 : 0;
        if (r < CI_WO) { const int kb = r / 64, nb = r % 64;
            cvt_item8(inptr(F, IN_WOUT) + (size_t)l * D * D, D, kb * 128, nb * 32, ws + WS_WOUT + (size_t)l * D * D, D, nb * 32, scr, F.lane); return; }
        r -= CI_WO;
        if (GRP == 0) {
            if (r < CI_FD) { const int kb = r / 64, nb = r % 64; cvt_item8(inptr(F, IN_FD), D, kb * 128, nb * 32, ws + WS_WD, DFF, nb * 32, scr, F.lane); return; }
            r -= CI_FD;
        } else {
            if (r < CI_MD) { const int e = r / (22 * 64); r %= (22 * 64); const int kb = r / 64, nb = r % 64;
                cvt_item8(inptr(F, IN_MD) + (size_t)e * DFE * D, D, kb * 128, nb * 32, ws + WS_MD + (size_t)e * D * DFE, DFE, nb * 32, scr, F.lane); return; }
            r -= CI_MD;
        }
    }
    if (GRP == 0 || GRP == 1) { constexpr int KBN = (GRP == 1) ? 16 : CMS_KB, I_F = KBN * 176; const int up = r / I_F; r %= I_F; const int kb = r / 176, nb = r % 176, n0 = nb * 32, drow = (n0 >> 7) * 256 + up * 128 + (n0 & 127);
        if (GRP == 1) cvt_item_i8(inptr(F, up ? IN_FU : IN_FG), DFF, kb * 128, n0, ws + WS_WGU, D, drow, cmx + drow, scr, F.lane);
        else colmax_item(inptr(F, up ? IN_FU : IN_FG), DFF, kb * 128, n0, cmx + drow, F.lane); }
    else { constexpr int KBN = (GRP == 3) ? 16 : CMS_KB, I_E = KBN * 88; const int up = r / (8 * I_E); r %= (8 * I_E); const int e = r / I_E; r %= I_E; const int kb = r / 88, nb = r % 88, n0 = nb * 32, drow = (n0 >> 7) * 256 + up * 128 + (n0 & 127);
        if (GRP == 3) cvt_item_i8(inptr(F, up ? IN_MU : IN_MG) + (size_t)e * D * DFE, DFE, kb * 128, n0, ws + WS_MGU + (size_t)e * 2 * DFE * D, D, drow, cmx + 2 * DFF + e * 2 * DFE + drow, scr, F.lane);
        else colmax_item(inptr(F, up ? IN_MU : IN_MG) + (size_t)e * D * DFE, DFE, kb * 128, n0, cmx + 2 * DFF + e * 2 * DFE + drow, F.lane); }
}
template <int GRP>
__device__ __forceinline__ void conv_all(Frame& F, int first = 0) {
    constexpr int N = (GRP == 0) ? CONV_N0 : (GRP == 1) ? CONV_N1 : (GRP == 2) ? CONV_N2 : (GRP == 3) ? CONV_N3 : CONV_N4;
    for (int it = first + F.gw; it < N; it += F.NGW) conv_item<GRP>(F, it);
}
template <int YMODE, int EXTRA, bool NORM_OUT, bool XN8  , bool XIN_BF = false  , bool XOUT_BF = false  >
__device__ __forceinline__ void row_phase(Frame& F, const float* xin, float* xout, const bf16_t* ybuf, const float* gpost, const float* gt  ,
                                          const float* gpre, const float* sc, const float* sh, bf16_t* XN,
                                          const float* wex, int ldw, const float* bi, const float* bfg, float* gates_out,
                                          const uint4* tok_in, uint4* tok_out, int* idx_out, unsigned* cntw, float* rowmax = nullptr) {
    LAS float* we = (LAS float*)F.lds;
    LAS float* vA = (LAS float*)(F.lds + 65536);
    LAS float* vB = (LAS float*)(F.lds + 73728);
    LAS float* vC = (LAS float*)(F.lds + 81920);
    LAS float* route = (LAS float*)(F.lds + 90112);
    LAS int* routei = (LAS int*)route;
    LAS int* cumt = (LAS int*)(F.lds + 90112 + 2048);
    if (EXTRA) {
        for (int k = F.tid; k < D; k += NTHR) { const f32x4 a = *(const f32x4*)(wex + (size_t)k * ldw), b = *(const f32x4*)(wex + (size_t)k * ldw + 4);
            we[0 * D + k] = a[0]; we[1 * D + k] = a[1]; we[2 * D + k] = a[2]; we[3 * D + k] = a[3]; we[4 * D + k] = b[0]; we[5 * D + k] = b[1]; we[6 * D + k] = b[2]; we[7 * D + k] = b[3]; }
    }
    if (YMODE == 2) { if (F.tid == 0) { int cum = 0; for (int e = 0; e < NE; ++e) { cumt[e] = cum; cum += (int)((__hip_atomic_load(cntw + e, __ATOMIC_RELAXED, __HIP_MEMORY_SCOPE_AGENT) + 255u) >> 8); } } }
    for (int blk = blockIdx.x; blk < M / 64; blk += F.G) {
        const int b = (blk * 64) / SEQ;
        __syncthreads();
        { const int col = 4 * F.tid;
            if (YMODE) { const f32x4 g = *(const f32x4*)(gt + (size_t)b * 6 * D + col), p = *(const f32x4*)(gpost + col); *(LAS f32x4*)(vA + col) = g * p; }
            if (NORM_OUT) { const f32x4 g = *(const f32x4*)(gpre + col), s = *(const f32x4*)(sc + (size_t)b * 6 * D + col); *(LAS f32x4*)(vB + col) = g * (1.f + s); *(LAS f32x4*)(vC + col) = *(const f32x4*)(sh + (size_t)b * 6 * D + col); } }
        __syncthreads();
        f32x4 xr[8]; u32x2 xrb[8], yr[8], yr2[8]; float w1n = 0.f, w2n = 0.f;
#define RP_LOAD(rr_) do { const size_t row_ = (size_t)blk * 64 + F.wave * 8 + (((rr_) + blk) & 7);   \
            if (XIN_BF) { _Pragma("unroll") for (int j = 0; j < 8; ++j) xrb[j] = __builtin_nontemporal_load((const u32x2*)((const bf16_t*)xin + row_ * D + 256 * j + 4 * F.lane)); } \
            else { _Pragma("unroll") for (int j = 0; j < 8; ++j) xr[j] = __builtin_nontemporal_load((const f32x4*)(xin + row_ * D + 256 * j + 4 * F.lane)); } \
            if (YMODE == 1) { _Pragma("unroll") for (int j = 0; j < 8; ++j) yr[j] = __builtin_nontemporal_load((const u32x2*)(ybuf + row_ * D + 256 * j + 4 * F.lane)); } \
            if (YMODE == 2) { const uint4 ti = tok_in[row_]; \
                const int e1 = (int)(ti.x >> 16), k1 = (int)(ti.x & 0xffffu), e2 = (int)(ti.y >> 16), k2 = (int)(ti.y & 0xffffu); \
                const size_t r1 = (size_t)cumt[e1] * 256 + k1, r2 = (size_t)cumt[e2] * 256 + k2; w1n = __uint_as_float(ti.z); w2n = __uint_as_float(ti.w); \
                _Pragma("unroll") for (int j = 0; j < 8; ++j) { yr[j] = __builtin_nontemporal_load((const u32x2*)(ybuf + r1 * D + 256 * j + 4 * F.lane)); yr2[j] = __builtin_nontemporal_load((const u32x2*)(ybuf + r2 * D + 256 * j + 4 * F.lane)); } } } while (0)
        RP_LOAD(0);
#pragma unroll 1
        for (int rr = 0; rr < 8; ++rr) {
            const int rl = F.wave * 8 + ((rr + blk) & 7); const size_t row = (size_t)blk * 64 + rl;
            asm volatile("" ::: "memory");
            f32x4 x[8];
#pragma unroll
            for (int j = 0; j < 8; ++j) x[j] = XIN_BF ? (f32x4){bflo(xrb[j].x), bfhi(xrb[j].x), bflo(xrb[j].y), bfhi(xrb[j].y)} : xr[j];
            f32x4 y[8];
            if (YMODE == 1) {
#pragma unroll
                for (int j = 0; j < 8; ++j) y[j] = (f32x4){bflo(yr[j].x), bfhi(yr[j].x), bflo(yr[j].y), bfhi(yr[j].y)};
            }
            if (YMODE == 2) {
#pragma unroll
                for (int j = 0; j < 8; ++j) y[j] = (f32x4){bflo(yr[j].x), bfhi(yr[j].x), bflo(yr[j].y), bfhi(yr[j].y)} * w1n + (f32x4){bflo(yr2[j].x), bfhi(yr2[j].x), bflo(yr2[j].y), bfhi(yr2[j].y)} * w2n;
            }
            if (rr < 7) RP_LOAD(rr + 1);
            if (YMODE) {
                float ss = 0.f;
#pragma unroll
                for (int j = 0; j < 8; ++j) ss += (y[j][0] * y[j][0] + y[j][1] * y[j][1]) + (y[j][2] * y[j][2] + y[j][3] * y[j][3]);
                const float r = 1.f / sqrtf(wave_sum(ss) * (1.f / D) + RMS_EPS);
#pragma unroll
                for (int j = 0; j < 8; ++j) { x[j] += *(const LAS f32x4*)(vA + 256 * j + 4 * F.lane) * (y[j] * r);
                    if (XOUT_BF) { u32x2 w; w.x = cvtpk(x[j][0], x[j][1]); w.y = cvtpk(x[j][2], x[j][3]); *(u32x2*)((bf16_t*)xout + row * D + 256 * j + 4 * F.lane) = w; }
                    else __builtin_nontemporal_store(x[j], (f32x4*)(xout + row * D + 256 * j + 4 * F.lane)); }
            }
            if (NORM_OUT) {
                float ss = 0.f;
#pragma unroll
                for (int j = 0; j < 8; ++j) ss += (x[j][0] * x[j][0] + x[j][1] * x[j][1]) + (x[j][2] * x[j][2] + x[j][3] * x[j][3]);
                const float r = 1.f / sqrtf(wave_sum(ss) * (1.f / D) + RMS_EPS);
#pragma unroll
                for (int j = 0; j < 8; ++j) x[j] = (x[j] * r) * *(const LAS f32x4*)(vB + 256 * j + 4 * F.lane) + *(const LAS f32x4*)(vC + 256 * j + 4 * F.lane);
                if (XN8) {
                    float am = 0.f;
#pragma unroll
                    for (int j = 0; j < 8; ++j) am = fmaxf(fmaxf(am, fmaxf(fabsf(x[j][0]), fabsf(x[j][1]))), fmaxf(fabsf(x[j][2]), fabsf(x[j][3])));
                    am = wave_max(am);
                    const float inv = am > 0.f ? 127.f / am : 0.f;
                    if (F.lane == 0) { rowmax[row] = am; if (EXTRA == 2) route[384 + rl] = am; }
#pragma unroll
                    for (int j = 0; j < 8; ++j) *(unsigned*)((unsigned char*)XN + row * D + 256 * j + 4 * F.lane) = pack_i8x4(x[j][0] * inv, x[j][1] * inv, x[j][2] * inv, x[j][3] * inv);
                } else {
#pragma unroll
                    for (int j = 0; j < 8; ++j) { u32x2 w; w.x = cvtpk(x[j][0], x[j][1]); w.y = cvtpk(x[j][2], x[j][3]); *(u32x2*)(XN + row * D + 256 * j + 4 * F.lane) = w; }
                }
                if (EXTRA) {
                    float d8[8];
#pragma unroll
                    for (int e = 0; e < 8; ++e) { float s = 0.f;
#pragma unroll
                        for (int j = 0; j < 8; ++j) { const f32x4 w = *(const LAS f32x4*)(we + e * D + 256 * j + 4 * F.lane); s += (x[j][0] * w[0] + x[j][1] * w[1]) + (x[j][2] * w[2] + x[j][3] * w[3]); }
                        d8[e] = wave_sum(s); asm volatile("" ::: "memory"); }
                    if (EXTRA == 1) {
                        float v = 0.f;
#pragma unroll
                        for (int e = 0; e < 8; ++e) v = (F.lane == e) ? d8[e] : v;
                        if (F.lane < 8) { const float bb = (F.lane < 4) ? bi[F.lane] : bfg[F.lane - 4]; const float z = 15.f * tanhf((v + bb) * (1.f / 15.f));
                            const float o = (F.lane < 4) ? z : (fminf(z, 0.f) - log1pf(expf(-fabsf(z)))); gates_out[row * 8 + F.lane] = o; }
                    } else {
                        int e1 = 0; float v1 = d8[0];
#pragma unroll
                        for (int e = 1; e < 8; ++e) if (d8[e] > v1) { v1 = d8[e]; e1 = e; }
                        int e2 = -1; float v2 = -3.0e38f;
#pragma unroll
                        for (int e = 0; e < 8; ++e) if (e != e1 && d8[e] > v2) { v2 = d8[e]; e2 = e; }
                        const float w1 = 1.f / (1.f + expf(v2 - v1));
                        if (F.lane == 0) { routei[rl * 4 + 0] = e1; routei[rl * 4 + 1] = e2; route[rl * 4 + 2] = w1; route[rl * 4 + 3] = 1.f - w1; }
                    }
                }
            }
        }
#undef RP_LOAD
        if (EXTRA == 2) {
            __syncthreads();
            if (F.tid < NE) { const int e = F.tid; int c = 0;
                for (int r = 0; r < 64; ++r) c += (routei[r * 4] == e) + (routei[r * 4 + 1] == e);
                int base = (int)__hip_atomic_fetch_add(cntw + e, (unsigned)c, __ATOMIC_RELAXED, __HIP_MEMORY_SCOPE_AGENT);
                float* rms = rowmax + (WS_RMSLOT - WS_ROWMAX) / 4;
                for (int r = 0; r < 64; ++r) { if (routei[r * 4] == e) { idx_out[e * ECAP + base] = blk * 64 + r; rms[e * ECAP + base] = route[384 + r]; routei[256 + r * 2] = base; ++base; }
                                               if (routei[r * 4 + 1] == e) { idx_out[e * ECAP + base] = blk * 64 + r; rms[e * ECAP + base] = route[384 + r]; routei[256 + r * 2 + 1] = base; ++base; } } }
            __syncthreads();
            if (F.tid < 64) { const int r = F.tid; uint4 ti; ti.x = ((unsigned)routei[r * 4] << 16) | (unsigned)routei[256 + r * 2]; ti.y = ((unsigned)routei[r * 4 + 1] << 16) | (unsigned)routei[256 + r * 2 + 1];
                ti.z = __float_as_uint(route[r * 4 + 2]); ti.w = __float_as_uint(route[r * 4 + 3]); tok_out[(size_t)blk * 64 + r] = ti; }
        }
    }
    __syncthreads();
}

namespace att {
constexpr int KROW = 144, VROW = 520, K_OFF = 0, V_OFF = 256 * KROW, KM_OFF = V_OFF + 64 * VROW;
constexpr float C2 = 0.125f * 1.4426950408889634f, NEG = -3.0e38f;
__device__ __forceinline__ void stage_kv(LAS unsigned char* lds, const bf16_t* kcol, const bf16_t* vcol, size_t grow0, int nk, int kc0, int tid) {
    for (int c = tid; c < nk * 8; c += NTHR) { const int key = c >> 3, part = c & 7;
        const u32x4 v = *(const u32x4*)(kcol + (grow0 + key) * NIN + part * 8);
        *(LAS u32x4*)(lds + K_OFF + (kc0 + key) * KROW + part * 16) = v; }
    const int np = nk >> 1;
    for (int it = tid; it < np * 8; it += NTHR) { const int kp = it % np, dp = it / np;
        const u32x4 a = *(const u32x4*)(vcol + (grow0 + 2 * kp) * NIN + dp * 8), b = *(const u32x4*)(vcol + (grow0 + 2 * kp + 1) * NIN + dp * 8);
        LAS unsigned char* dst = lds + V_OFF + (dp * 8) * VROW + (kc0 + 2 * kp) * 2;
        *(LAS unsigned*)(dst + 0 * VROW) = (a.x & 0xffffu) | (b.x << 16); *(LAS unsigned*)(dst + 1 * VROW) = (a.x >> 16) | (b.x & 0xffff0000u);
        *(LAS unsigned*)(dst + 2 * VROW) = (a.y & 0xffffu) | (b.y << 16); *(LAS unsigned*)(dst + 3 * VROW) = (a.y >> 16) | (b.y & 0xffff0000u);
        *(LAS unsigned*)(dst + 4 * VROW) = (a.z & 0xffffu) | (b.z << 16); *(LAS unsigned*)(dst + 5 * VROW) = (a.z >> 16) | (b.z & 0xffff0000u);
        *(LAS unsigned*)(dst + 6 * VROW) = (a.w & 0xffffu) | (b.w << 16); *(LAS unsigned*)(dst + 7 * VROW) = (a.w >> 16) | (b.w & 0xffff0000u); }
}
struct KVRegs { u32x4 k[4], va[2], vb[2]; };
__device__ __forceinline__ void kv_load(KVRegs& R, const bf16_t* kcol, const bf16_t* vcol, size_t grow0, int tid) {
#pragma unroll
    for (int i = 0; i < 4; ++i) { const int c = tid + i * NTHR, key = c >> 3, part = c & 7; R.k[i] = *(const u32x4*)(kcol + (grow0 + key) * NIN + part * 8); }
#pragma unroll
    for (int i = 0; i < 2; ++i) { const int it = tid + i * NTHR, kp = it & 127, dp = it >> 7;
        R.va[i] = *(const u32x4*)(vcol + (grow0 + 2 * kp) * NIN + dp * 8); R.vb[i] = *(const u32x4*)(vcol + (grow0 + 2 * kp + 1) * NIN + dp * 8); }
}
__device__ __forceinline__ void kv_store(LAS unsigned char* lds, const KVRegs& R, int tid) {
#pragma unroll
    for (int i = 0; i < 4; ++i) { const int c = tid + i * NTHR, key = c >> 3, part = c & 7; *(LAS u32x4*)(lds + K_OFF + key * KROW + part * 16) = R.k[i]; }
#pragma unroll
    for (int i = 0; i < 2; ++i) { const int it = tid + i * NTHR, kp = it & 127, dp = it >> 7; const u32x4 a = R.va[i], b = R.vb[i];
        LAS unsigned char* dst = lds + V_OFF + (dp * 8) * VROW + (2 * kp) * 2;
        *(LAS unsigned*)(dst + 0 * VROW) = (a.x & 0xffffu) | (b.x << 16); *(LAS unsigned*)(dst + 1 * VROW) = (a.x >> 16) | (b.x & 0xffff0000u);
        *(LAS unsigned*)(dst + 2 * VROW) = (a.y & 0xffffu) | (b.y << 16); *(LAS unsigned*)(dst + 3 * VROW) = (a.y >> 16) | (b.y & 0xffff0000u);
        *(LAS unsigned*)(dst + 4 * VROW) = (a.z & 0xffffu) | (b.z << 16); *(LAS unsigned*)(dst + 5 * VROW) = (a.z >> 16) | (b.z & 0xffff0000u);
        *(LAS unsigned*)(dst + 6 * VROW) = (a.w & 0xffffu) | (b.w << 16); *(LAS unsigned*)(dst + 7 * VROW) = (a.w >> 16) | (b.w & 0xffff0000u); }
}
struct State { f32x16 o0, o1, negm; float m, l; };
constexpr float THR = 5.f, M0 = -1000.f;
__device__ __forceinline__ void init(State& st) {
#pragma unroll
    for (int r = 0; r < 16; ++r) { st.o0[r] = 0.f; st.o1[r] = 0.f; st.negm[r] = -M0; }
    st.m = M0; st.l = 0.f;
}
__device__ __forceinline__ float xhalf_max(float v) { auto rr = __builtin_amdgcn_permlane32_swap(__float_as_uint(v), __float_as_uint(v), false, false); return fmaxf(__uint_as_float(rr[0]), __uint_as_float(rr[1])); }
__device__ __forceinline__ float xhalf_sum(float v) { auto rr = __builtin_amdgcn_permlane32_swap(__float_as_uint(v), __float_as_uint(v), false, false); return __uint_as_float(rr[0]) + __uint_as_float(rr[1]); }
__device__ __forceinline__ void block_mask(State& st, bool lane_ok) {
#pragma unroll
    for (int r = 0; r < 16; ++r) st.negm[r] = lane_ok ? -st.m : NEG;
}
template <int MODE>
__device__ __forceinline__ void tile(LAS unsigned char* lds, int kt, const bf16x8 (&qf)[4], State& st, int lane) {
    const int r32 = lane & 31, h = lane >> 5;
    f32x16 S;
    if (MODE == 3) S = st.negm;
    else {
#pragma unroll
        for (int r = 0; r < 16; ++r) { const int ko = (r & 3) + 8 * (r >> 2) + 4 * h; const bool ok = (MODE == 1) ? (ko <= r32) : (ko > r32); S[r] = ok ? st.negm[r] : NEG; } }
    const LAS unsigned char* kp = lds + K_OFF + (kt * 32 + r32) * KROW + h * 16;
#pragma unroll
    for (int s = 0; s < 4; ++s) { const bf16x8 a = *(const LAS bf16x8*)(kp + s * 32); S = __builtin_amdgcn_mfma_f32_32x32x16_bf16(a, qf[s], S, 0, 0, 0); }
    float tmax;
    asm volatile("s_nop 15\n\ts_nop 7" : "+v"(S));
    { float m0, m1, m2, m3, m4;
      asm("v_max3_f32 %0, %1, %2, %3" : "=v"(m0) : "v"(S[0]), "v"(S[1]), "v"(S[2]));    asm("v_max3_f32 %0, %1, %2, %3" : "=v"(m1) : "v"(S[3]), "v"(S[4]), "v"(S[5]));
      asm("v_max3_f32 %0, %1, %2, %3" : "=v"(m2) : "v"(S[6]), "v"(S[7]), "v"(S[8]));    asm("v_max3_f32 %0, %1, %2, %3" : "=v"(m3) : "v"(S[9]), "v"(S[10]), "v"(S[11]));
      asm("v_max3_f32 %0, %1, %2, %3" : "=v"(m4) : "v"(S[12]), "v"(S[13]), "v"(S[14])); asm("v_max3_f32 %0, %1, %2, %3" : "=v"(m0) : "v"(m0), "v"(m1), "v"(S[15]));
      asm("v_max3_f32 %0, %1, %2, %3" : "=v"(m2) : "v"(m2), "v"(m3), "v"(m4));          asm("v_max_f32 %0, %1, %2" : "=v"(tmax) : "v"(m0), "v"(m2)); }
    tmax = xhalf_max(tmax);
    if (__any(tmax > THR)) {
        const float d = tmax > THR ? tmax : 0.f, alpha = __builtin_amdgcn_exp2f(-d);
        st.m += d; st.l *= alpha;
#pragma unroll
        for (int r = 0; r < 16; ++r) { S[r] -= d; st.negm[r] -= d; st.o0[r] *= alpha; st.o1[r] *= alpha; }
    }
    float ls0 = 0.f, ls1 = 0.f;
#pragma unroll
    for (int r = 0; r < 16; r += 2) { const float p0 = __builtin_amdgcn_exp2f(S[r]), p1 = __builtin_amdgcn_exp2f(S[r + 1]); S[r] = p0; S[r + 1] = p1; ls0 += p0; ls1 += p1; }
    st.l += ls0 + ls1;
    const LAS unsigned char* vp = lds + V_OFF + r32 * VROW + kt * 64 + h * 8;
#pragma unroll
    for (int s = 0; s < 2; ++s) {
        u32x4 pw; pw.x = cvtpk(S[8 * s + 0], S[8 * s + 1]); pw.y = cvtpk(S[8 * s + 2], S[8 * s + 3]); pw.z = cvtpk(S[8 * s + 4], S[8 * s + 5]); pw.w = cvtpk(S[8 * s + 6], S[8 * s + 7]);
        const bf16x8 pf = __builtin_bit_cast(bf16x8, pw);
        { const u32x2 lo = *(const LAS u32x2*)(vp + s * 32), hi = *(const LAS u32x2*)(vp + s * 32 + 16); u32x4 aw; aw.x = lo.x; aw.y = lo.y; aw.z = hi.x; aw.w = hi.y;
          st.o0 = __builtin_amdgcn_mfma_f32_32x32x16_bf16(__builtin_bit_cast(bf16x8, aw), pf, st.o0, 0, 0, 0); }
        { const u32x2 lo = *(const LAS u32x2*)(vp + 32 * VROW + s * 32), hi = *(const LAS u32x2*)(vp + 32 * VROW + s * 32 + 16); u32x4 aw; aw.x = lo.x; aw.y = lo.y; aw.z = hi.x; aw.w = hi.y;
          st.o1 = __builtin_amdgcn_mfma_f32_32x32x16_bf16(__builtin_bit_cast(bf16x8, aw), pf, st.o1, 0, 0, 0); }
    }
}
constexpr float YSC = 16.f;
__device__ __forceinline__ void store_out(const State& st, float inv, unsigned char* orow  , int lane) {
    const int h = lane >> 5;
#pragma unroll
    for (int g = 0; g < 4; ++g) {
        *(unsigned*)(orow + 8 * g + 4 * h) = pg8::pack_fp8x4(st.o0[4 * g] * inv, st.o0[4 * g + 1] * inv, st.o0[4 * g + 2] * inv, st.o0[4 * g + 3] * inv);
        *(unsigned*)(orow + 32 + 8 * g + 4 * h) = pg8::pack_fp8x4(st.o1[4 * g] * inv, st.o1[4 * g + 1] * inv, st.o1[4 * g + 2] * inv, st.o1[4 * g + 3] * inv); }
}
__device__ __forceinline__ void moba_unit(Frame& F, const bf16_t* proj, const float* kmean, unsigned char* Y, int b, int h, int j) {
    LAS unsigned char* lds = F.lds; const int lane = F.lane, r32 = lane & 31, hh = lane >> 5, w = F.wave;
    const size_t rb = (size_t)b * SEQ; const int t = j * 256 + w * 32 + r32;
    bf16x8 qf[4];
    { const bf16_t* qrow = proj + (rb + t) * NIN + C_MQ + h * 64 + hh * 8;
#pragma unroll
      for (int s = 0; s < 4; ++s) qf[s] = *(const bf16x8*)(qrow + s * 16); }
    LBAR();
    LAS float* km = (LAS float*)(lds + KM_OFF);
    if (F.tid < j * 64) km[F.tid] = kmean[(size_t)(b * 8 + (F.tid >> 6)) * 512 + h * 64 + (F.tid & 63)];
    LBAR();
    unsigned sel;
    if (j <= 3) sel = (1u << j) - 1u;
    else {
        float g[7];
#pragma unroll
        for (int n = 0; n < 7; ++n) { g[n] = NEG;
            if (n < j) { float a = 0.f;
#pragma unroll
                for (int s = 0; s < 4; ++s)
#pragma unroll
                    for (int jj = 0; jj < 8; ++jj) a += bf1((bf16_t)qf[s][jj]) * km[n * 64 + 16 * s + 8 * hh + jj];
                a += __shfl_xor(a, 32); g[n] = a; } }
        sel = 0u;
#pragma unroll
        for (int r = 0; r < 3; ++r) { float best = NEG; int bi = 0;
#pragma unroll
            for (int n = 0; n < 7; ++n) if (n < j && !((sel >> n) & 1u) && g[n] > best) { best = g[n]; bi = n; }
            sel |= 1u << bi; }
    }
    State st; init(st);
    const bf16_t* kcol = proj + C_MK + h * 64; const bf16_t* vcol = proj + C_MV + h * 64;
    KVRegs R; kv_load(R, kcol, vcol, rb, F.tid);
    for (int n = 0; n <= j; ++n) {
        LBAR();
        kv_store(lds, R, F.tid);
        if (n < j) kv_load(R, kcol, vcol, rb + (size_t)(n + 1) * 256, F.tid);
        LBAR();
        if (n < j) { const bool ok = (sel >> n) & 1u;
            if (__any(ok)) { block_mask(st, ok); for (int kt = 0; kt < 8; ++kt) tile<3>(lds, kt, qf, st, lane); } }
        else { block_mask(st, true); for (int kt = 0; kt < w; ++kt) tile<3>(lds, kt, qf, st, lane);
               tile<1>(lds, w, qf, st, lane); }
    }
    const float lt = xhalf_sum(st.l);
    store_out(st, YSC / lt, Y + (rb + t) * D + h * 64, lane);
}
__device__ __forceinline__ void swa_unit(Frame& F, const bf16_t* proj, const float* sinks, unsigned char* Y, int b, int kvh, int qb) {
    LAS unsigned char* lds = F.lds; int lane = F.lane; asm volatile("" : "+v"(lane));
    const int r32 = lane & 31, hh = lane >> 5, w = F.wave, hq = kvh * 8 + w;
    const size_t rb = (size_t)b * SEQ;
    const bf16_t* kcol = proj + C_SK + kvh * 64; const bf16_t* vcol = proj + C_SV + kvh * 64;
    LBAR();
    if (qb > 0) stage_kv(lds, kcol, vcol, rb + (size_t)qb * 128 - 128, 256, 0, F.tid);
    else        stage_kv(lds, kcol, vcol, rb, 128, 128, F.tid);
    LBAR();
    const float sk = sinks[hq] * 1.4426950408889634f;
    for (int sb = 0; sb < 4; ++sb) {
        const int t = qb * 128 + sb * 32 + r32;
        bf16x8 qf[4];
        { const bf16_t* qrow = proj + (rb + t) * NIN + C_SQ + hq * 64 + hh * 8;
#pragma unroll
          for (int s = 0; s < 4; ++s) qf[s] = *(const bf16x8*)(qrow + s * 16); }
        State st; init(st);
        int kt0 = sb; if (qb == 0 && kt0 < 4) kt0 = 4;
        if (kt0 == sb) tile<2>(lds, sb, qf, st, lane);
        for (int kt = (kt0 > sb + 1 ? kt0 : sb + 1); kt < sb + 4; ++kt) tile<3>(lds, kt, qf, st, lane);
        tile<1>(lds, sb + 4, qf, st, lane);
        const float lt = xhalf_sum(st.l) + __builtin_amdgcn_exp2f(sk - st.m);
        store_out(st, YSC / lt, Y + (rb + t) * D + 1024 + hq * 64, lane);
    }
}
}

#include <hip/hip_bf16.h>
#include <cmath>
namespace mob {
using bf16=__hip_bfloat16;
using bf16x8=__attribute__((ext_vector_type(8)))short;
using s16x4=__attribute__((ext_vector_type(4)))short;
using f32x16=__attribute__((ext_vector_type(16)))float;
using u32x4=__attribute__((ext_vector_type(4)))unsigned;
constexpr int SEQ=2048,D=64,DM=4864;
constexpr int NW=8,QBLK=32,QB=QBLK*NW,KVBLK=64,NQB=SEQ/QB;
__device__ __forceinline__ int crow(int r,int hi){return (r&3)+8*(r>>2)+4*hi;}
#define SBAR() __builtin_amdgcn_sched_barrier(0)
__device__ __forceinline__ void cmask(f32x16&p0,f32x16&p1,int jb,int qrel,int hi){
  const float NEG=-INFINITY; int kb=64*jb+4*hi;
  #pragma unroll
  for(int r=0;r<16;++r){int kv=kb+(r&3)+8*(r>>2); if(kv>qrel)p0[r]=NEG; if(kv+32>qrel)p1[r]=NEG;}
}

constexpr int NSLOT=3, SLOTB=8192;
constexpr int LDS_K=0, LDS_V=NSLOT*SLOTB, LDS_WS=2*NSLOT*SLOTB, LDS_OST=LDS_WS+NW*64*4, LDS_BYTES=LDS_OST+NW*4096, LDS_KM=LDS_BYTES  ;
constexpr float NEGB=-3.0e38f, YSC=16.f;
constexpr float C2=0.125f*1.4426950408889634f;
__device__ __forceinline__ void glds16(const void*sbase,unsigned voff,unsigned lds_dst){unsigned keep;
  asm volatile("s_mov_b32 %0, m0\n\ts_mov_b32 m0, %2\n\ts_nop 0\n\tglobal_load_lds_dwordx4 %1, %3\n\ts_mov_b32 m0, %0":"=&s"(keep):"v"(voff),"s"(lds_dst),"s"(sbase):"memory");}
__device__ __forceinline__ float max3f(float a,float b,float c){float r;asm("v_max3_f32 %0, %1, %2, %3":"=v"(r):"v"(a),"v"(b),"v"(c));return r;}
__device__ __forceinline__ float max2f(float a,float b){float r;asm("v_max_f32_e32 %0, %1, %2":"=v"(r):"v"(a),"v"(b));return r;}
__device__ __forceinline__ float fadd_s(float a,float b){float r;asm("v_add_f32_e32 %0, %1, %2":"=v"(r):"v"(a),"v"(b));return r;}
__device__ __forceinline__ float fsub_s(float a,float b){float r;asm("v_sub_f32_e32 %0, %1, %2":"=v"(r):"v"(a),"v"(b));return r;}
typedef float f32x2_t __attribute__((ext_vector_type(2))); typedef __bf16 bf16x2_t __attribute__((ext_vector_type(2)));
__device__ __forceinline__ unsigned cvtpk_s(float lo,float hi){f32x2_t v={lo,hi};bf16x2_t b=__builtin_convertvector(v,bf16x2_t);return __builtin_bit_cast(unsigned,b);}
#define WAIT_BAR(N) asm volatile("s_waitcnt vmcnt(" #N ") lgkmcnt(0)\n\ts_barrier":::"memory")

__device__ __forceinline__ void qkt(f32x16&p0,f32x16&p1,const char*Kslot,const bf16x8*qr,const f32x16&negm,int r32,int hi){
  const char*kb=Kslot+hi*1024+r32*16;
  #pragma unroll
  for(int d0=0;d0<4;++d0){
    const bf16x8 b0=*reinterpret_cast<const bf16x8*>(kb+d0*2048);
    const bf16x8 b1=*reinterpret_cast<const bf16x8*>(kb+d0*2048+512);
    if(d0==0){p0=__builtin_amdgcn_mfma_f32_32x32x16_bf16(b0,qr[0],negm,0,0,0);p1=__builtin_amdgcn_mfma_f32_32x32x16_bf16(b1,qr[0],negm,0,0,0);}
    else{p0=__builtin_amdgcn_mfma_f32_32x32x16_bf16(b0,qr[d0],p0,0,0,0);p1=__builtin_amdgcn_mfma_f32_32x32x16_bf16(b1,qr[d0],p1,0,0,0);}}
}
typedef __attribute__((address_space(3))) const char* lds_cptr;
typedef short v4i16_t __attribute__((ext_vector_type(4)));
__device__ __forceinline__ void kload8(bf16x8*kf,lds_cptr kp){
  kf[0]=*(const __attribute__((address_space(3))) bf16x8*)(kp);      kf[1]=*(const __attribute__((address_space(3))) bf16x8*)(kp+512);
  kf[2]=*(const __attribute__((address_space(3))) bf16x8*)(kp+2048); kf[3]=*(const __attribute__((address_space(3))) bf16x8*)(kp+2560);
  kf[4]=*(const __attribute__((address_space(3))) bf16x8*)(kp+4096); kf[5]=*(const __attribute__((address_space(3))) bf16x8*)(kp+4608);
  kf[6]=*(const __attribute__((address_space(3))) bf16x8*)(kp+6144); kf[7]=*(const __attribute__((address_space(3))) bf16x8*)(kp+6656);
}
__device__ __forceinline__ void kload2(bf16x8*kf,lds_cptr kp,int j){ kf[2*j]=*(const __attribute__((address_space(3))) bf16x8*)(kp+j*2048); kf[2*j+1]=*(const __attribute__((address_space(3))) bf16x8*)(kp+j*2048+512); }
__device__ __forceinline__ s16x4 vtr(lds_cptr p){ return __builtin_bit_cast(s16x4,__builtin_amdgcn_ds_read_tr16_b64_v4i16((__attribute__((address_space(3))) v4i16_t*)p)); }
__device__ __forceinline__ float rowmax(const f32x16&p0,const f32x16&p1){
  float a=max3f(p0[0],p0[1],p1[0]),b=max3f(p0[2],p0[3],p1[1]);a=max3f(a,p1[2],p1[3]);
  #pragma unroll
  for(int r=4;r<16;r+=4){a=max3f(a,p0[r],p0[r+1]);b=max3f(b,p0[r+2],p0[r+3]);a=max3f(a,p1[r],p1[r+1]);b=max3f(b,p1[r+2],p1[r+3]);}
  const float m=max2f(a,b);
  auto rr=__builtin_amdgcn_permlane32_swap(__float_as_uint(m),__float_as_uint(m),false,false);
  return max2f(__uint_as_float(rr[0]),__uint_as_float(rr[1]));
}
__device__ __forceinline__ void pv(f32x16*o,int vb,bf16x8 pa0,bf16x8 pa1,bf16x8 pa2,bf16x8 pa3){
  #pragma unroll
  for(int d0=0;d0<2;++d0){s16x4 lo[4],hi[4];
    #pragma unroll
    for(int ks=0;ks<4;++ks){
      asm volatile("ds_read_b64_tr_b16 %0,%1 offset:%c2":"=&v"(lo[ks]):"v"(vb),"i"(d0*4096+ks*1024):"memory");
      asm volatile("ds_read_b64_tr_b16 %0,%1 offset:%c2":"=&v"(hi[ks]):"v"(vb),"i"(d0*4096+ks*1024+512):"memory");}
    asm volatile("s_waitcnt lgkmcnt(0)":::"memory");SBAR();
    #define PK(k) (bf16x8){lo[k][0],lo[k][1],lo[k][2],lo[k][3],hi[k][0],hi[k][1],hi[k][2],hi[k][3]}
    o[d0]=__builtin_amdgcn_mfma_f32_32x32x16_bf16(pa0,PK(0),o[d0],0,0,0);
    o[d0]=__builtin_amdgcn_mfma_f32_32x32x16_bf16(pa1,PK(1),o[d0],0,0,0);
    o[d0]=__builtin_amdgcn_mfma_f32_32x32x16_bf16(pa2,PK(2),o[d0],0,0,0);
    o[d0]=__builtin_amdgcn_mfma_f32_32x32x16_bf16(pa3,PK(3),o[d0],0,0,0);
    #undef PK
  }
}

#ifndef ATTN_STORE16
#define ATTN_STORE16(p,v) (*(u32x4*)(p)=(v))
#endif
template<int THRL> __device__ __forceinline__ void attn_unit(int b,int h,int qb,const bf16*Q,const bf16*__restrict__ K,const bf16*__restrict__ V,unsigned char*Y,const float*kmean,char*shm){
  const int tid=threadIdx.x,lane=tid&63,r32=lane&31,hi=lane>>5; const int wid=__builtin_amdgcn_readfirstlane(tid>>6);
  const long rowbase=(long)b*SEQ; const int q0=qb*QB;
  const bf16*Qw=Q+(rowbase+q0+wid*QBLK)*DM+h*D;
  const bf16*Kh=K+rowbase*DM+h*D,*Vh=V+rowbase*DM+h*D;
  const unsigned lds0=(unsigned)(uintptr_t)shm;
  float*wsf=(float*)(shm+LDS_WS)+wid*64;
  const unsigned koff=(unsigned)((lane*DM+wid*8)*2);
  const unsigned voff=(unsigned)(((16*(wid&3)+(lane>>2))*DM+(wid>>2)*32+(lane&3)*8)*2);
  const unsigned kdst=lds0+LDS_K+wid*1024, vdst=lds0+LDS_V+wid*1024;
  #define DMA_K(t,slot) glds16(Kh+(long)(t)*KVBLK*DM,koff,(unsigned)__builtin_amdgcn_readfirstlane(kdst+(slot)))
  #define DMA_V(t,slot) glds16(Vh+(long)(t)*KVBLK*DM,voff,(unsigned)__builtin_amdgcn_readfirstlane(vdst+(slot)))
  const char*Kbase=shm+LDS_K; bf16x8 kf[8];
  const lds_cptr shm3=(lds_cptr)shm; const lds_cptr kp0=shm3+LDS_K+hi*1024+r32*16; const lds_cptr vp0=shm3+LDS_V+((lane>>4)&1)*32+(lane&3)*8+(4*hi+((lane&15)>>2))*64;
  const int NT=(q0+QB)/KVBLK;
  DMA_K(0,0);DMA_V(0,0);DMA_K(1,SLOTB);
  bf16x8 qr[4];
  #pragma unroll
  for(int d0=0;d0<4;++d0)qr[d0]=*reinterpret_cast<const bf16x8*>(&Qw[(long)r32*DM+d0*16+hi*8]);
  unsigned sel;
  if(qb<=3) sel=(1u<<qb)-1u;
  else{
    float*km=(float*)(shm+LDS_KM);
    if(tid<qb*64) km[tid]=kmean[(size_t)(b*8+(tid>>6))*512+h*64+(tid&63)];
    asm volatile("s_waitcnt vmcnt(0) lgkmcnt(0)\n\ts_barrier":::"memory");
    float g[7];
    #pragma unroll
    for(int n=0;n<7;++n){ g[n]=NEGB;
      if(n<qb){ float a=0.f;
        #pragma unroll
        for(int s=0;s<4;++s)
          #pragma unroll
          for(int jj=0;jj<8;++jj) a+=__uint_as_float((unsigned)(unsigned short)qr[s][jj]<<16)*km[n*64+16*s+8*hi+jj];
        a+=__shfl_xor(a,32); g[n]=a; } }
    sel=0u;
    #pragma unroll
    for(int r=0;r<3;++r){ float best=NEGB; int bi=0;
      #pragma unroll
      for(int n=0;n<7;++n) if(n<qb&&!((sel>>n)&1u)&&g[n]>best){best=g[n];bi=n;}
      sel|=1u<<bi; }
  }
  #define OKB(n) (((n)>=qb)||(((sel>>(n))&1u)!=0u))
  float mhat=0.f,l_reg=0.f;f32x16 o[2];o[0]=f32x16{};o[1]=f32x16{};f32x16 negm;
  { const bool ok0=OKB(0);
    #pragma unroll
    for(int r=0;r<16;++r)negm[r]=ok0?0.f:NEGB; }
  asm volatile("":"+v"(negm));
  const int qrel=wid*QBLK+r32;
  #define CMASK(P0,P1,t) do{int jb_=(t)-(NT-4); if(jb_>=0)cmask(P0,P1,jb_,qrel,hi);}while(0)
  bool resc=false;
  #define START(P0,P1) do{ const float rm=rowmax(P0,P1); resc=false; \
    { const bool ok0_=OKB(0); const float dl=ok0_?rm:0.f; mhat=fadd_s(mhat,dl); \
      _Pragma("unroll") for(int r=0;r<16;++r){P0[r]=fsub_s(P0[r],dl);P1[r]=fsub_s(P1[r],dl);} \
      _Pragma("unroll") for(int r=0;r<16;++r)negm[r]=ok0_?-mhat:NEGB; asm volatile("":"+v"(negm)); } \
    _Pragma("unroll") for(int r=0;r<16;++r)P0[r]=__builtin_amdgcn_exp2f(P0[r]); }while(0)
  #define RESC() do{ if(resc){ asm volatile("s_waitcnt lgkmcnt(0)":::"memory"); \
      _Pragma("unroll") for(int d_=0;d_<2;++d_) _Pragma("unroll") for(int r=0;r<16;++r)o[d_][r]*=wsf[crow(r,hi)]; } }while(0)
  f32x16 pA0,pA1,pB0,pB1;
  int sl_prev=0,sl_cur=0,sl_next=SLOTB;
  #define ROT() do{sl_prev=sl_cur;sl_cur=sl_next;sl_next=(sl_next==(NSLOT-1)*SLOTB)?0:sl_next+SLOTB;}while(0)
  DMA_K(2,2*SLOTB);
  WAIT_BAR(3);
  qkt(pA0,pA1,Kbase,qr,negm,r32,hi);asm volatile("s_nop 15\n\ts_nop 7":"+v"(pA0),"+v"(pA1));CMASK(pA0,pA1,0);
  START(pA0,pA1);
  _Pragma("unroll") for(int r=0;r<16;++r)pA1[r]=__builtin_amdgcn_exp2f(pA1[r]);
  WAIT_BAR(0);
  DMA_K(3,0);DMA_V(1,SLOTB);
  ROT();
  kload8(kf,kp0+sl_cur);
  WAIT_BAR(2);
  s16x4 vlo[8],vhi[8]; u32x4 pw0,pw1,pw2,pw3;
  #define PKW(P,B) cvtpk_s(P[B],P[B+1])
  #define PAF(k) __builtin_bit_cast(bf16x8,pw##k)
  #define VFR(i) (bf16x8){vlo[i][0],vlo[i][1],vlo[i][2],vlo[i][3],vhi[i][0],vhi[i][1],vhi[i][2],vhi[i][3]}
  #define PIN(x) asm volatile("":"+v"(x))
  #define MX3(a,b,c) __builtin_fmaxf(__builtin_fmaxf((a),(b)),(c))
  #define GAPA(MF,A0,A1,A2,A3,W0,W1,PW) do{ MF; sacc+=A0; sacc+=A1; sacc+=A2; sacc+=A3; PIN(sacc); W0; W1; PIN(PW); SBAR(); }while(0)
  #define EX(v) __builtin_amdgcn_exp2f(v)
  #define GAPB(MF,X,B) do{ MF; X[B]=EX(X[B]); X[B+1]=EX(X[B+1]); X[B+2]=EX(X[B+2]); X[B+3]=EX(X[B+3]); PIN(X); SBAR(); }while(0)
  #define VRD(i) do{ vlo[i]=vtr(vp_+(((i)>>2)*4096+((i)&3)*1024)); vhi[i]=vtr(vp_+(((i)>>2)*4096+((i)&3)*1024+512)); }while(0)
  #define KRD(G,j) do{ if(G){ kload2(kf,kp0+sl_next,j); SBAR(); } }while(0)
  #define STEP(C0,C1,P0,P1,t,GK,GV,GL) do{ SBAR(); \
    const lds_cptr vp_=vp0+sl_prev; \
    VRD(0); SBAR(); float sacc=(P0[0]+P0[1]); \
    GAPA(C0=__builtin_amdgcn_mfma_f32_32x32x16_bf16(kf[0],qr[0],negm,0,0,0), P0[2],P0[3],P0[4],P0[5],     pw0[0]=PKW(P0,0), pw0[1]=PKW(P0,2), pw0); \
    VRD(4); SBAR(); GAPA(C1=__builtin_amdgcn_mfma_f32_32x32x16_bf16(kf[1],qr[0],negm,0,0,0), P0[6],P0[7],P0[8],P0[9],     pw0[2]=PKW(P0,4), pw0[3]=PKW(P0,6), pw0); \
    VRD(1); SBAR(); GAPA(C0=__builtin_amdgcn_mfma_f32_32x32x16_bf16(kf[2],qr[1],C0,0,0,0),   P0[10],P0[11],P0[12],P0[13], pw1[0]=PKW(P0,8), pw1[1]=PKW(P0,10), pw1); \
    VRD(5); SBAR(); GAPA(C1=__builtin_amdgcn_mfma_f32_32x32x16_bf16(kf[3],qr[1],C1,0,0,0),   P0[14],P0[15],P1[0],P1[1],   pw1[2]=PKW(P0,12),pw1[3]=PKW(P0,14), pw1); \
    VRD(2); SBAR(); GAPA(C0=__builtin_amdgcn_mfma_f32_32x32x16_bf16(kf[4],qr[2],C0,0,0,0),   P1[2],P1[3],P1[4],P1[5],     pw2[0]=PKW(P1,0), pw2[1]=PKW(P1,2), pw2); \
    VRD(6); SBAR(); GAPA(C1=__builtin_amdgcn_mfma_f32_32x32x16_bf16(kf[5],qr[2],C1,0,0,0),   P1[6],P1[7],P1[8],P1[9],     pw2[2]=PKW(P1,4), pw2[3]=PKW(P1,6), pw2); \
    VRD(3); SBAR(); GAPA(C0=__builtin_amdgcn_mfma_f32_32x32x16_bf16(kf[6],qr[3],C0,0,0,0),   P1[10],P1[11],P1[12],P1[13], pw3[0]=PKW(P1,8), pw3[1]=PKW(P1,10), pw3); \
    VRD(7); SBAR(); GAPA(C1=__builtin_amdgcn_mfma_f32_32x32x16_bf16(kf[7],qr[3],C1,0,0,0),   P1[14],P1[15],0.f,0.f,       pw3[2]=PKW(P1,12),pw3[3]=PKW(P1,14), pw3); \
    l_reg+=sacc; \
    if(GK){DMA_K((t)+3,sl_cur);} if(GV){DMA_V((t)+1,sl_next);} \
    CMASK(C0,C1,t); \
    { float a=MX3(C0[0],C0[1],C1[0]),b=MX3(C0[2],C0[3],C1[1]); a=MX3(a,C1[2],C1[3]); \
      _Pragma("unroll") for(int r=4;r<16;r+=4){a=MX3(a,C0[r],C0[r+1]);b=MX3(b,C0[r+2],C0[r+3]);a=MX3(a,C1[r],C1[r+1]);b=MX3(b,C1[r+2],C1[r+3]);} \
      float rm=__builtin_fmaxf(a,b); { auto rr=__builtin_amdgcn_permlane32_swap(__float_as_uint(rm),__float_as_uint(rm),false,false); rm=__builtin_fmaxf(__uint_as_float(rr[0]),__uint_as_float(rr[1])); } \
      resc=false; \
      if(__builtin_expect(__any(rm>(float)THRL),0)){ const float dl=__builtin_fmaxf(rm,0.f); mhat+=dl; \
        _Pragma("unroll") for(int r=0;r<16;++r){C0[r]-=dl;C1[r]-=dl;} \
        const float f=__builtin_amdgcn_exp2f(-dl); l_reg*=f; if(hi==0)wsf[r32]=f; resc=true; } \
      if(resc||((((t)+1)&3)==0)){ const bool okn_=OKB(((t)+1)>>2);   \
        _Pragma("unroll") for(int r=0;r<16;++r)negm[r]=okn_?-mhat:NEGB; asm volatile("":"+v"(negm)); } } \
    SBAR(); \
    GAPB(o[0]=__builtin_amdgcn_mfma_f32_32x32x16_bf16(PAF(0),VFR(0),o[0],0,0,0), C0,0); \
    GAPB(o[1]=__builtin_amdgcn_mfma_f32_32x32x16_bf16(PAF(0),VFR(4),o[1],0,0,0), C0,4); \
    KRD(GL,0); GAPB(o[0]=__builtin_amdgcn_mfma_f32_32x32x16_bf16(PAF(1),VFR(1),o[0],0,0,0), C0,8); \
    KRD(GL,1); GAPB(o[1]=__builtin_amdgcn_mfma_f32_32x32x16_bf16(PAF(1),VFR(5),o[1],0,0,0), C0,12); \
    KRD(GL,2); GAPB(o[0]=__builtin_amdgcn_mfma_f32_32x32x16_bf16(PAF(2),VFR(2),o[0],0,0,0), C1,0); \
    KRD(GL,3); GAPB(o[1]=__builtin_amdgcn_mfma_f32_32x32x16_bf16(PAF(2),VFR(6),o[1],0,0,0), C1,4); \
    GAPB(o[0]=__builtin_amdgcn_mfma_f32_32x32x16_bf16(PAF(3),VFR(3),o[0],0,0,0), C1,8); \
    GAPB(o[1]=__builtin_amdgcn_mfma_f32_32x32x16_bf16(PAF(3),VFR(7),o[1],0,0,0), C1,12); \
    }while(0)
  int t=1;
  #undef CMASK
  #define CMASK(P0,P1,t) do{}while(0)
  for(;t+5<NT;t+=2){
    STEP(pB0,pB1,pA0,pA1,t,true,true,true);     WAIT_BAR(2); RESC(); ROT();
    STEP(pA0,pA1,pB0,pB1,t+1,true,true,true);   WAIT_BAR(2); RESC(); ROT();
  }
  #undef CMASK
  const int lane_b=(int)__builtin_amdgcn_mbcnt_hi(~0u,__builtin_amdgcn_mbcnt_lo(~0u,0u)), hi_b=lane_b>>5, qrel_b=wid*QBLK+(lane_b&31);
  #define CMASK(P0,P1,t) do{int jb_=(t)-(NT-4); if(jb_>=0)cmask(P0,P1,jb_,qrel_b,hi_b);}while(0)
  #define ENDW(tt) do{ if((tt)+3<NT){WAIT_BAR(2);} else if((tt)+2<NT){WAIT_BAR(1);} else {WAIT_BAR(0);} }while(0)
  for(;t+1<NT;t+=2){
    STEP(pB0,pB1,pA0,pA1,t,(t+3<NT),(t+1<NT),(t+1<NT));       ENDW(t);   RESC(); ROT();
    STEP(pA0,pA1,pB0,pB1,t+1,(t+4<NT),(t+2<NT),(t+2<NT));     ENDW(t+1); RESC(); ROT();
  }
  STEP(pB0,pB1,pA0,pA1,NT-1,false,false,false); RESC();
  { float sacc=pB0[0]+pB0[1]; _Pragma("unroll") for(int r=2;r<16;++r)sacc+=pB0[r]; _Pragma("unroll") for(int r=0;r<16;++r)sacc+=pB1[r]; l_reg+=sacc;
    pw0=(u32x4){PKW(pB0,0),PKW(pB0,2),PKW(pB0,4),PKW(pB0,6)};pw1=(u32x4){PKW(pB0,8),PKW(pB0,10),PKW(pB0,12),PKW(pB0,14)};pw2=(u32x4){PKW(pB1,0),PKW(pB1,2),PKW(pB1,4),PKW(pB1,6)};pw3=(u32x4){PKW(pB1,8),PKW(pB1,10),PKW(pB1,12),PKW(pB1,14)};
    const int vb0=(int)(lds0+LDS_V)+((lane>>4)&1)*32+(lane&3)*8+(4*hi+((lane&15)>>2))*64;
    SBAR(); pv(o,vb0+sl_cur,PAF(0),PAF(1),PAF(2),PAF(3)); }
  #undef PKW
  #undef PAF
  #undef VFR
  #undef PIN
  #undef MX3
  #undef GAPA
  #undef GAPB
  #undef EX
  #undef VRD
  #undef KRD
  #undef STEP
  #undef ENDW
  {auto rr=__builtin_amdgcn_permlane32_swap(__float_as_uint(l_reg),__float_as_uint(l_reg),false,false);l_reg=__uint_as_float(rr[0])+__uint_as_float(rr[1]);}
  if(hi==0)wsf[32+r32]=l_reg;asm volatile("s_waitcnt lgkmcnt(0)":::"memory");
  float rli[16];
  #pragma unroll
  for(int r=0;r<16;++r)rli[r]=__builtin_amdgcn_rcpf(wsf[32+crow(r,hi)])*YSC;
  unsigned char*Yw=Y+(size_t)(rowbase+q0+wid*QBLK)*2048+h*D;
  { unsigned char*stg=(unsigned char*)(shm+LDS_OST)+wid*4096;
    #pragma unroll
    for(int r=0;r<16;++r){const int orow=crow(r,hi);
      const float a0=__builtin_fminf(__builtin_fmaxf(o[0][r]*rli[r],-448.f),448.f),a1=__builtin_fminf(__builtin_fmaxf(o[1][r]*rli[r],-448.f),448.f);
      const unsigned pk=(unsigned)__builtin_amdgcn_cvt_pk_fp8_f32(a0,a1,0,false);
      stg[orow*64+r32]=(unsigned char)(pk&0xffu); stg[orow*64+32+r32]=(unsigned char)((pk>>8)&0xffu);}
    asm volatile("s_waitcnt lgkmcnt(0)":::"memory");
    #pragma unroll
    for(int i=0;i<2;++i){const int row=i*16+(lane>>2),ch=lane&3; const u32x4 v=*(const u32x4*)(stg+row*64+ch*16); *(u32x4*)(Yw+(size_t)row*2048+ch*16)=v;} }
  asm volatile("s_waitcnt lgkmcnt(0)\n\ts_barrier":::"memory");
  #undef DMA_K
  #undef DMA_V
  #undef CMASK
  #undef START
  #undef RESC
  #undef ROT
  #undef OKB
}
#undef SBAR
#undef WAIT_BAR
#ifdef ATTN_STORE16
#undef ATTN_STORE16
#endif
}

namespace mls {
constexpr int RS = 272, TS = 144;
constexpr float CSC = 8.f, CSC_INV = 0.125f;
struct MW { unsigned char* CC; unsigned char* CP; float* NC; float* NP; float* SC; float* MP; };
__device__ __forceinline__ int cslot(int bh, int c) { return (c + bh) & 31; }
__device__ __forceinline__ float fsilu(float x) { return x * __builtin_amdgcn_rcpf(1.f + __builtin_amdgcn_exp2f(-1.4426950408889634f * x)); }
__device__ __forceinline__ void vt_write(LAS unsigned char* dst, const u32x4 a, const u32x4 bq) {
    *(LAS unsigned*)(dst + 0 * TS) = (a.x & 0xffffu) | (bq.x << 16); *(LAS unsigned*)(dst + 1 * TS) = (a.x >> 16) | (bq.x & 0xffff0000u);
    *(LAS unsigned*)(dst + 2 * TS) = (a.y & 0xffffu) | (bq.y << 16); *(LAS unsigned*)(dst + 3 * TS) = (a.y >> 16) | (bq.y & 0xffff0000u);
    *(LAS unsigned*)(dst + 4 * TS) = (a.z & 0xffffu) | (bq.z << 16); *(LAS unsigned*)(dst + 5 * TS) = (a.z >> 16) | (bq.z & 0xffff0000u);
    *(LAS unsigned*)(dst + 6 * TS) = (a.w & 0xffffu) | (bq.w << 16); *(LAS unsigned*)(dst + 7 * TS) = (a.w >> 16) | (bq.w & 0xffff0000u);
}
constexpr int XKWT = 0, XVT = 18432, XCW = 36864;
__device__ __forceinline__ void x_setup(Frame& F, const float* conv_w, const float* conv_b) {
    __syncthreads();
    for (int i = F.tid; i < 5 * 512; i += NTHR) { const int j = i >> 9, ch = i & 511; ((LAS float*)(F.lds + XCW))[i] = (j < 4) ? conv_w[j * 1024 + 512 + ch] : conv_b[512 + ch]; }
    __syncthreads();
}
struct XL { u32x4 raw[5], vr0, vr1; float li, lf; };
__device__ __forceinline__ void x_load(XL& L, const Frame& F, const bf16_t* proj, const float* gates, int u) {
    const int tid = F.tid, c = u & 31, bh = u >> 5, b = bh >> 2, h = bh & 3; const size_t rb = (size_t)b * SEQ;
    const int cc = tid & 15, rp = tid >> 4, tp = tid & 31, ec = tid >> 5;
#pragma unroll
    for (int i = 0; i < 5; ++i) { const int pos = c * 64 + 2 * rp - 3 + i;
        if (pos >= 0) L.raw[i] = *(const u32x4*)(proj + (rb + pos) * NIN + C_LK + h * 128 + 8 * cc); else L.raw[i] = (u32x4){0u, 0u, 0u, 0u}; }
    L.vr0 = *(const u32x4*)(proj + (rb + c * 64 + 2 * tp) * NIN + C_LV + h * 128 + 8 * ec); L.vr1 = *(const u32x4*)(proj + (rb + c * 64 + 2 * tp + 1) * NIN + C_LV + h * 128 + 8 * ec);
    L.li = gates[(rb + c * 64 + F.lane) * 8 + h]; L.lf = gates[(rb + c * 64 + F.lane) * 8 + 4 + h];
}
__device__ __forceinline__ void x_unit(Frame& F, const bf16_t* proj, const float* gates, const MW& W, int u, XL& cur, XL& nxt, bool has_next, int un) {
    LAS unsigned char* lds = F.lds; const int tid = F.tid, lane = F.lane, r32 = lane & 31, hh = lane >> 5, w = F.wave;
    const int bh = u >> 5, h = bh & 3;
    const int cc = tid & 15, rp = tid >> 4, tp = tid & 31, ec = tid >> 5;
    u32x4 raw[5];
#pragma unroll
    for (int i = 0; i < 5; ++i) raw[i] = cur.raw[i];
    const u32x4 vr0 = cur.vr0, vr1 = cur.vr1; const float li = cur.li, lf = cur.lf;
    const float bcs = scan64<false>(lf), cs = li - bcs, pm = scan64<true>(cs);
    const float blast = lane63(bcs), amax = blast + lane63(pm);
    const float wa = __expf(blast + cs - amax);
    LBAR();
    {   const LAS float* cw = (const LAS float*)(lds + XCW) + h * 128 + 8 * cc;
        u32x4 pk[2];
#pragma unroll
        for (int r = 0; r < 2; ++r) {
            f32x4 oa = *(const LAS f32x4*)(cw + 4 * 512), ob = *(const LAS f32x4*)(cw + 4 * 512 + 4);
#pragma unroll
            for (int j = 0; j < 4; ++j) { const u32x4 uu = raw[r + j]; const f32x4 wa4 = *(const LAS f32x4*)(cw + j * 512), wb4 = *(const LAS f32x4*)(cw + j * 512 + 4);
                oa += wa4 * (f32x4){bflo(uu.x), bfhi(uu.x), bflo(uu.y), bfhi(uu.y)}; ob += wb4 * (f32x4){bflo(uu.z), bfhi(uu.z), bflo(uu.w), bfhi(uu.w)}; }
            const float ws = __shfl(wa, 2 * rp + r) * 0.08838834764831845f;
#pragma unroll
            for (int i = 0; i < 4; ++i) { oa[i] = fsilu(oa[i]) * ws; ob[i] = fsilu(ob[i]) * ws; }
            pk[r].x = cvtpk(oa[0], oa[1]); pk[r].y = cvtpk(oa[2], oa[3]); pk[r].z = cvtpk(ob[0], ob[1]); pk[r].w = cvtpk(ob[2], ob[3]);
        }
#pragma unroll
        for (int i = 0; i < 8; ++i) { const int sh = 16 * (i & 1); const unsigned e0 = (pk[0][i >> 1] >> sh) & 0xffffu, e1 = (pk[1][i >> 1] >> sh) & 0xffffu;
            *(LAS unsigned*)(lds + XKWT + (8 * cc + i) * TS + (2 * rp) * 2) = e0 | (e1 << 16); }
        vt_write(lds + XVT + (8 * ec) * TS + (2 * tp) * 2, vr0, vr1);
    }
    if (has_next) x_load(nxt, F, proj, gates, un);
    LBAR();
#pragma unroll
    for (int i = 0; i < 2; ++i) { const int T = 2 * w + i, dt = T >> 2, e2 = T & 3;
        f32x16 acc;
#pragma unroll
        for (int r = 0; r < 16; ++r) acc[r] = 0.f;
#pragma unroll
        for (int k = 0; k < 4; ++k) { const bf16x8 a = *(const LAS bf16x8*)(lds + XKWT + (32 * dt + r32) * TS + (16 * k + 8 * hh) * 2);
            const bf16x8 bv = *(const LAS bf16x8*)(lds + XVT + (32 * e2 + r32) * TS + (16 * k + 8 * hh) * 2);
            acc = __builtin_amdgcn_mfma_f32_32x32x16_bf16(a, bv, acc, 0, 0, 0); }
        unsigned char* dst = W.CC + (size_t)((u & ~31) + cslot(u >> 5, u & 31)) * 16384 + (size_t)(32 * e2 + r32) * 128 + 32 * dt + 4 * hh;
#pragma unroll
        for (int g = 0; g < 4; ++g) *(unsigned*)(dst + 8 * g) = pg8::pack_fp8x4(acc[4 * g] * CSC, acc[4 * g + 1] * CSC, acc[4 * g + 2] * CSC, acc[4 * g + 3] * CSC); }
    if (tid < 128) { float sN = 0.f;
#pragma unroll
        for (int k = 0; k < 8; ++k) { const u32x4 uu = *(const LAS u32x4*)(lds + XKWT + tid * TS + k * 16);
            sN += (bflo(uu.x) + bfhi(uu.x)) + (bflo(uu.y) + bfhi(uu.y)) + (bflo(uu.z) + bfhi(uu.z)) + (bflo(uu.w) + bfhi(uu.w)); }
        W.NC[(size_t)u * 128 + tid] = sN; }
    if (tid == 0) { W.SC[u * 2] = blast; W.SC[u * 2 + 1] = amax; }
}
constexpr int YK = 4;
template <int GRP> struct ConvY { static constexpr int N = (GRP == 2) ? 3120 : 4096; };
template <int GRP>
__device__ __forceinline__ void y_phase(Frame& F, const MW& W) {
    for (int base = blockIdx.x * 256; base < 32 * 2048; base += F.G * 256) {
        if (F.tid >= 256) {
            if (base == (int)blockIdx.x * 256 && F.G == 256) {
#pragma unroll 1
                for (int k = 0; k < YK; ++k) { const int it = (int)blockIdx.x * 4 + (F.wave - 4) + k * 1024; if (it < ConvY<GRP>::N) conv_item<GRP>(F, it); }
            }
            continue; }
        const int bh = base >> 11, g = (base & 2047) + F.tid, e = g >> 4, d8 = (g & 15) * 8;
        const float* sc = W.SC + (size_t)bh * 64;
        const size_t off = (size_t)bh * 32 * 16384 + (size_t)e * 128 + d8;
        u32x2 v[32];
#pragma unroll
        for (int c = 0; c < 32; ++c) v[c] = __builtin_nontemporal_load((const u32x2*)(W.CC + off + (size_t)cslot(bh, c) * 16384));
        const bool nsc = (g < 32);
        f32x4 nv[32];
        if (nsc) {
#pragma unroll
            for (int c = 0; c < 32; ++c) nv[c] = *(const f32x4*)(W.NC + ((size_t)bh * 32 + c) * 128 + g * 4); }
        float C[8];
#pragma unroll
        for (int i = 0; i < 8; ++i) C[i] = 0.f;
        float m = 0.f;
#pragma unroll
        for (int c = 0; c < 32; ++c) {
            u32x2 o; o.x = pg8::pack_fp8x4(C[0], C[1], C[2], C[3]); o.y = pg8::pack_fp8x4(C[4], C[5], C[6], C[7]); *(u32x2*)(W.CP + off + (size_t)cslot(bh, c) * 16384) = o;
            const float bl = sc[2 * c], am = sc[2 * c + 1], mn = fmaxf(bl + m, am), dec = __expf(bl + m - mn), inj = __expf(am - mn);
            const auto x0 = __builtin_amdgcn_cvt_pk_f32_fp8((int)v[c].x, false), x1 = __builtin_amdgcn_cvt_pk_f32_fp8((int)v[c].x, true), x2 = __builtin_amdgcn_cvt_pk_f32_fp8((int)v[c].y, false), x3 = __builtin_amdgcn_cvt_pk_f32_fp8((int)v[c].y, true);
            C[0] = C[0] * dec + x0[0] * inj; C[1] = C[1] * dec + x0[1] * inj; C[2] = C[2] * dec + x1[0] * inj; C[3] = C[3] * dec + x1[1] * inj;
            C[4] = C[4] * dec + x2[0] * inj; C[5] = C[5] * dec + x2[1] * inj; C[6] = C[6] * dec + x3[0] * inj; C[7] = C[7] * dec + x3[1] * inj; m = mn; }
        if (nsc) {
            f32x4 N = (f32x4){0.f, 0.f, 0.f, 0.f}; float mm = 0.f;
#pragma unroll
            for (int c = 0; c < 32; ++c) {
                *(f32x4*)(W.NP + ((size_t)bh * 32 + c) * 128 + g * 4) = N; if (g == 0) W.MP[bh * 32 + c] = mm;
                const float bl = sc[2 * c], am = sc[2 * c + 1], mn = fmaxf(bl + mm, am), dec = __expf(bl + mm - mn), inj = __expf(am - mn);
                N = N * dec + nv[c] * inj; mm = mn; }
        }
    }
}
constexpr int QS = 0, QW = 17408, KS = 34816, ZCW = 52224  , VT = 72704, CB = 91136, NS = 125952, CSO = 126464, SSQ = 126720, ZNW = 127744  ;
struct Pre { u32x4 raw[7]; u32x4 vr[2]; float li, lf; };
__device__ __forceinline__ void prefetch(Pre& P, const bf16_t* proj, const float* gates, size_t rb, int c, int h, int tid, int lane) {
    const int cc = tid & 31, rg = tid >> 5;
    const int col = (cc < 16) ? (C_LQ + h * 128 + 8 * cc) : (C_LK + h * 128 + 8 * (cc - 16));
#pragma unroll
    for (int i = 0; i < 7; ++i) { const int pos = c * 64 + 4 * rg - 3 + i;
        if (pos >= 0) P.raw[i] = *(const u32x4*)(proj + (rb + pos) * NIN + col); else P.raw[i] = (u32x4){0u, 0u, 0u, 0u}; }
    const int tp = tid & 31, ec = tid >> 5;
    P.vr[0] = *(const u32x4*)(proj + (rb + c * 64 + 2 * tp) * NIN + C_LV + h * 128 + 8 * ec);
    P.vr[1] = *(const u32x4*)(proj + (rb + c * 64 + 2 * tp + 1) * NIN + C_LV + h * 128 + 8 * ec);
    P.li = gates[(rb + c * 64 + lane) * 8 + h]; P.lf = gates[(rb + c * 64 + lane) * 8 + 4 + h];
}
__device__ __forceinline__ void z_setup(Frame& F, const float* conv_w, const float* conv_b, const float* normw) {
    __syncthreads();
    for (int i = F.tid; i < 5 * 1024; i += NTHR) { const int j = i >> 10, ch = i & 1023; ((LAS float*)(F.lds + ZCW))[i] = (j < 4) ? conv_w[j * 1024 + ch] : conv_b[ch]; }
    ((LAS float*)(F.lds + ZNW))[F.tid] = normw[F.tid];
    __syncthreads();
}
struct ZL { Pre P; u32x4 cpv[2]; float npv, mprev; u32x2 og[4]; };
__device__ __forceinline__ void z_load(ZL& L, const Frame& F, const bf16_t* proj, const float* gates, const MW& W, int u) {
    const int tid = F.tid, lane = F.lane, r32 = lane & 31, hh = lane >> 5, w = F.wave, et = w & 3, tt = w >> 2;
    const int c = u & 31, bh = u >> 5, b = bh >> 2, h = bh & 3; const size_t rb = (size_t)b * SEQ, r0 = rb + (size_t)c * 64; const int trow = 32 * tt + r32;
    prefetch(L.P, proj, gates, rb, c, h, tid, lane);
#pragma unroll
    for (int i = 0; i < 2; ++i) L.cpv[i] = __builtin_nontemporal_load((const u32x4*)(W.CP + (size_t)((u & ~31) + cslot(u >> 5, u & 31)) * 16384 + (size_t)(tid + i * NTHR) * 16));
    L.npv = (tid < 128) ? W.NP[(size_t)u * 128 + tid] : 0.f; L.mprev = W.MP[u];
#pragma unroll
    for (int g = 0; g < 4; ++g) L.og[g] = *(const u32x2*)(proj + (r0 + trow) * NIN + C_LO + h * 128 + 32 * et + 8 * g + 4 * hh);
}
__device__ __forceinline__ void z_unit(Frame& F, const bf16_t* proj, const float* gates, const MW& W, unsigned char* Y, int u, ZL& cur, ZL& nxt, bool has_next, int un) {
    LAS unsigned char* lds = F.lds; const int tid = F.tid, lane = F.lane, r32 = lane & 31, hh = lane >> 5, w = F.wave, et = w & 3, tt = w >> 2;
    const int c = u & 31, bh = u >> 5, b = bh >> 2, h = bh & 3; const size_t rb = (size_t)b * SEQ, r0 = rb + (size_t)c * 64;
    const int trow = 32 * tt + r32;
    const Pre P = cur.P;
    u32x4 cpv[2];
#pragma unroll
    for (int i = 0; i < 2; ++i) cpv[i] = cur.cpv[i];
    const float npv = cur.npv, mprev = cur.mprev;
    u32x2 og[4];
#pragma unroll
    for (int g = 0; g < 4; ++g) og[g] = cur.og[g];
    const float bcs = scan64<false>(P.lf), cs = P.li - bcs, pm = scan64<true>(cs);
    const float il = bcs + mprev, mo = fmaxf(il, bcs + pm), wi = __expf(il - mo);
    const float rt = __shfl(bcs - mo, trow), eo = __shfl(__expf(-mo), trow);
    LBAR();
    if (w == 0) ((LAS float*)(lds + CSO))[lane] = cs;
#pragma unroll
    for (int i = 0; i < 2; ++i) { const int ci = tid + i * NTHR, e = ci >> 3, part = ci & 7;
        unsigned wv[8];
#pragma unroll
        for (int q = 0; q < 4; ++q) { const int uq = (int)cpv[i][q]; const auto lo = __builtin_amdgcn_cvt_pk_f32_fp8(uq, false), hi = __builtin_amdgcn_cvt_pk_f32_fp8(uq, true);
            wv[2 * q] = cvtpk(lo[0] * CSC_INV, lo[1] * CSC_INV); wv[2 * q + 1] = cvtpk(hi[0] * CSC_INV, hi[1] * CSC_INV); }
        u32x4 w0, w1; w0.x = wv[0]; w0.y = wv[1]; w0.z = wv[2]; w0.w = wv[3]; w1.x = wv[4]; w1.y = wv[5]; w1.z = wv[6]; w1.w = wv[7];
        *(LAS u32x4*)(lds + CB + e * RS + part * 32) = w0; *(LAS u32x4*)(lds + CB + e * RS + part * 32 + 16) = w1; }
    if (tid < 128) ((LAS float*)(lds + NS))[tid] = npv;
    {
        const int cc = tid & 31, rg = tid >> 5; const bool isk = cc >= 16; const int dcol = 8 * (cc & 15);
        const LAS float* cw = (const LAS float*)(lds + ZCW) + (isk ? 512 : 0) + h * 128 + dcol;
        const float ksc = isk ? 0.08838834764831845f : 1.f;
#pragma unroll
        for (int r = 0; r < 4; ++r) {
            f32x4 oa = *(const LAS f32x4*)(cw + 4 * 1024), ob = *(const LAS f32x4*)(cw + 4 * 1024 + 4);
#pragma unroll
            for (int j = 0; j < 4; ++j) { const u32x4 uu = P.raw[r + j]; const f32x4 wa4 = *(const LAS f32x4*)(cw + j * 1024), wb4 = *(const LAS f32x4*)(cw + j * 1024 + 4);
                oa += wa4 * (f32x4){bflo(uu.x), bfhi(uu.x), bflo(uu.y), bfhi(uu.y)}; ob += wb4 * (f32x4){bflo(uu.z), bfhi(uu.z), bflo(uu.w), bfhi(uu.w)}; }
#pragma unroll
            for (int i = 0; i < 4; ++i) { oa[i] = fsilu(oa[i]) * ksc; ob[i] = fsilu(ob[i]) * ksc; }
            const int t = 4 * rg + r; const float ws = __shfl(wi, t);
            u32x4 wv; wv.x = cvtpk(oa[0], oa[1]); wv.y = cvtpk(oa[2], oa[3]); wv.z = cvtpk(ob[0], ob[1]); wv.w = cvtpk(ob[2], ob[3]);
            *(LAS u32x4*)(lds + (isk ? KS : QS) + t * RS + dcol * 2) = wv;
            if (!isk) { u32x4 v; v.x = cvtpk(oa[0] * ws, oa[1] * ws); v.y = cvtpk(oa[2] * ws, oa[3] * ws); v.z = cvtpk(ob[0] * ws, ob[1] * ws); v.w = cvtpk(ob[2] * ws, ob[3] * ws);
                *(LAS u32x4*)(lds + QW + t * RS + dcol * 2) = v; }
            asm volatile("" ::: "memory");
        }
        vt_write(lds + VT + (8 * (tid >> 5)) * TS + (2 * (tid & 31)) * 2, P.vr[0], P.vr[1]);
    }
    if (has_next) z_load(nxt, F, proj, gates, W, un);
    LBAR();
    f32x16 acc;
#pragma unroll
    for (int r = 0; r < 16; ++r) acc[r] = 0.f;
    float den = 0.f;
    for (int st = 0; st <= tt; ++st) {
        f32x16 S;
#pragma unroll
        for (int r = 0; r < 16; ++r) S[r] = 0.f;
#pragma unroll
        for (int k = 0; k < 8; ++k) { const bf16x8 a = *(const LAS bf16x8*)(lds + KS + (32 * st + r32) * RS + (16 * k + 8 * hh) * 2); const bf16x8 qk = *(const LAS bf16x8*)(lds + QS + trow * RS + (16 * k + 8 * hh) * 2); S = __builtin_amdgcn_mfma_f32_32x32x16_bf16(a, qk, S, 0, 0, 0); }
        const LAS float* csp = (const LAS float*)(lds + CSO) + 32 * st + 4 * hh;
#pragma unroll
        for (int r = 0; r < 16; ++r) { const int so = (r & 3) + 8 * (r >> 2); const float cv = csp[so];
            const bool ok = (st < tt) || (so + 4 * hh <= r32);
            const float p = ok ? S[r] * __expf(rt + cv) : 0.f; S[r] = p; den += p; }
#pragma unroll
        for (int k2 = 0; k2 < 2; ++k2) {
            u32x4 pw; pw.x = cvtpk(S[8 * k2 + 0], S[8 * k2 + 1]); pw.y = cvtpk(S[8 * k2 + 2], S[8 * k2 + 3]); pw.z = cvtpk(S[8 * k2 + 4], S[8 * k2 + 5]); pw.w = cvtpk(S[8 * k2 + 6], S[8 * k2 + 7]);
            const LAS unsigned char* vp = lds + VT + (32 * et + r32) * TS + (32 * st + 16 * k2 + 4 * hh) * 2;
            const u32x2 lo = *(const LAS u32x2*)vp, hi = *(const LAS u32x2*)(vp + 16); u32x4 aw; aw.x = lo.x; aw.y = lo.y; aw.z = hi.x; aw.w = hi.y;
            acc = __builtin_amdgcn_mfma_f32_32x32x16_bf16(__builtin_bit_cast(bf16x8, aw), __builtin_bit_cast(bf16x8, pw), acc, 0, 0, 0); }
    }
    {
        const LAS float* nsp = (const LAS float*)(lds + NS);
#pragma unroll
        for (int k = 0; k < 8; ++k) {
            const bf16x8 a = *(const LAS bf16x8*)(lds + CB + (32 * et + r32) * RS + (16 * k + 8 * hh) * 2);
            const bf16x8 bq = *(const LAS bf16x8*)(lds + QW + trow * RS + (16 * k + 8 * hh) * 2);
            acc = __builtin_amdgcn_mfma_f32_32x32x16_bf16(a, bq, acc, 0, 0, 0);
            const f32x4 n0 = *(const LAS f32x4*)(nsp + 16 * k + 8 * hh), n1 = *(const LAS f32x4*)(nsp + 16 * k + 8 * hh + 4);
            den += bf1((bf16_t)bq[0]) * n0[0] + bf1((bf16_t)bq[1]) * n0[1] + bf1((bf16_t)bq[2]) * n0[2] + bf1((bf16_t)bq[3]) * n0[3]
                 + bf1((bf16_t)bq[4]) * n1[0] + bf1((bf16_t)bq[5]) * n1[1] + bf1((bf16_t)bq[6]) * n1[2] + bf1((bf16_t)bq[7]) * n1[3]; }
    }
    den += __shfl_xor(den, 32);
    const float hinv = 1.f / fmaxf(fabsf(den), eo);
    float ssq = 0.f;
#pragma unroll
    for (int r = 0; r < 16; ++r) { acc[r] *= hinv; ssq += acc[r] * acc[r]; }
    ssq += __shfl_xor(ssq, 32);
    if (hh == 0) ((LAS float*)(lds + SSQ))[et * 64 + trow] = ssq;
    LBAR();
    {
        const LAS float* sq = (const LAS float*)(lds + SSQ) + trow;
        const float tot = (sq[0] + sq[64]) + (sq[128] + sq[192]);
        const float rn = att::YSC / sqrtf(tot * (1.f / 128.f) + RMS_EPS);
        unsigned char* yrow = Y + (r0 + trow) * D + 512 + h * 128 + 32 * et + 4 * hh;
#pragma unroll
        for (int g = 0; g < 4; ++g) { const f32x4 nwg = *(const LAS f32x4*)(lds + ZNW + (h * 128 + 32 * et + 8 * g + 4 * hh) * 4); const float o0 = bflo(og[g].x), o1 = bfhi(og[g].x), o2 = bflo(og[g].y), o3 = bfhi(og[g].y);
            *(unsigned*)(yrow + 8 * g) = pg8::pack_fp8x4(acc[4 * g] * rn * nwg[0] * sigmoid_f(o0), acc[4 * g + 1] * rn * nwg[1] * sigmoid_f(o1), acc[4 * g + 2] * rn * nwg[2] * sigmoid_f(o2), acc[4 * g + 3] * rn * nwg[3] * sigmoid_f(o3)); }
    }
}
}

__device__ __forceinline__ int wq_pull(Frame& F, unsigned* qctr) {
    volatile LAS int* slot = (volatile LAS int*)(F.lds + LDSCTL_OFF + 256);
    __syncthreads();
    if (F.tid == 0) *slot = (int)__hip_atomic_fetch_add(qctr, 1u, __ATOMIC_RELAXED, __HIP_MEMORY_SCOPE_AGENT);
    __syncthreads();
    return __builtin_amdgcn_readfirstlane(*slot);
}
constexpr int N_PHASES = 18;
constexpr int N_LAUNCHES = MK_N_LAUNCHES;
constexpr int PTAB_OFF = LDSCTL_OFF + 512, MOETAB_OFF = LDSCTL_OFF + 64;
__device__ __forceinline__ const float* inptr(const Frame& F, int i) {
    const LAS unsigned* t = (const LAS unsigned*)(F.lds + PTAB_OFF) + 2 * i;
    const unsigned lo = __builtin_amdgcn_readfirstlane(t[0]), hi = __builtin_amdgcn_readfirstlane(t[1]);
    return (const float*)(((unsigned long long)hi << 32) | lo);
}
#define GRID_BAR() do { if (N_LAUNCHES == 1) xcd_barrier(bar); } while (0)
#define IN(k) (lo <= (k) && (k) < hi)
#define SEAM(k) do { if (IN(k) && IN((k) + 1)) GRID_BAR(); } while (0)
__device__ __forceinline__ void moe_table(Frame& F) {
    LAS int* tab = (LAS int*)(F.lds + MOETAB_OFF);
    __syncthreads();
    if (F.tid == 0) { int cum = 0; for (int e = 0; e < NE; ++e) { const int cn = (int)__hip_atomic_load(F.ctl + CW_CNT + e, __ATOMIC_RELAXED, __HIP_MEMORY_SCOPE_AGENT); tab[e] = cn; tab[8 + e] = cum; cum += (cn + 255) >> 8; } tab[16] = cum; }
    __syncthreads();
}
template <int GRP>
__device__ __forceinline__ void conv_part(Frame& F, int part) {
    constexpr int N = (GRP == 0) ? CONV_N0 : (GRP == 1) ? CONV_N1 : (GRP == 2) ? CONV_N2 : (GRP == 3) ? CONV_N3 : CONV_N4;
    const int niter = (N + F.NGW - 1) / F.NGW, i0 = part * niter / 3, i1 = (part + 1) * niter / 3;
#pragma unroll 1
    for (int i = i0; i < i1; ++i) { const int it = F.gw + i * F.NGW; if (it < N) conv_item<GRP>(F, it); }
}
template <int GRP>
__device__ __forceinline__ void conv_queue(Frame& F, unsigned* qctr) {
    constexpr int N = (GRP == 0) ? CONV_N0 : (GRP == 1) ? CONV_N1 : (GRP == 2) ? CONV_N2 : (GRP == 3) ? CONV_N3 : CONV_N4, BATCH = 32, NBATCH = (N + BATCH - 1) / BATCH;
    volatile LAS int* slot2 = (volatile LAS int*)(F.lds + LDSCTL_OFF + 264);
    int cur = wq_pull(F, qctr), par = 0;
    while (cur < NBATCH) {
        if (F.tid == 0) slot2[par] = (int)__hip_atomic_fetch_add(qctr, 1u, __ATOMIC_RELAXED, __HIP_MEMORY_SCOPE_AGENT);
#pragma unroll 1
        for (int i = F.wave; i < BATCH; i += NWAVES) { const int it = cur * BATCH + i; if (it < N) conv_item<GRP>(F, it); }
        __syncthreads();
        cur = __builtin_amdgcn_readfirstlane(slot2[par]); par ^= 1;
    }
}
template <int L>
__device__ __forceinline__ void layer(Frame& F, const XcdBarrier& bar, float* out, const int lo, const int hi) {
    constexpr int pb = 2 + 8 * L;
    unsigned char* ws = F.ws;
    float* mod = (float*)(ws + WS_MOD); float* gates = (float*)(ws + WS_GATES);
    uint4* tok = (uint4*)(ws + WS_TOK); int* idx = (int*)(ws + WS_TOK + 512 * 1024);
    bf16_t* XN = (bf16_t*)(ws + WS_XN); bf16_t* proj = (bf16_t*)(ws + WS_PROJ); unsigned char* ymix = ws + WS_YMIX; bf16_t* act = (bf16_t*)(ws + WS_ACT);
    bf16_t* yb = (bf16_t*)(ws + WS_YB);
    const float* modl = mod + (size_t)L * NB * 6 * D;
    if (IN(pb + 0)) {
        pg8::DenseSched S{(const char*)XN, (const char*)(ws + WS_WIN + (size_t)L * NIN * D), D, M / 256, NIN / 256, F.G, (int)blockIdx.x};
        pg8::EpiInProjI8 E{proj, NIN, (float*)(ws + WS_CTL + KMEAN_OFF + (size_t)L * 131072), (const float*)(ws + WS_ROWMAX), (const float*)(ws + WS_CTL + COLMAX_OFF) + CMX_WIN + L * NIN};
        pg8::gemm_phase<pg8::EpiInProjI8, pg8::DenseSched, true, 2>(F.lds, D, S, E);
    }
    SEAM(pb + 0);
    const mls::MW mw{ws + WS_CC, ws + WS_CP, (float*)(ws + WS_NC), (float*)(ws + WS_NP), (float*)(ws + WS_SC), (float*)(ws + WS_SC + 65536)};
    const float* km = (const float*)(ws + WS_CTL + KMEAN_OFF + (size_t)L * 131072);
    const int cls = (blockIdx.x >> 3) & 3; const bool odd = (cls & 1) != 0;
    if (IN(pb + 1)) {
        mls::x_setup(F, inptr(F, IN_CONVW) + (size_t)L * 4 * 1024, inptr(F, IN_CONVB) + (size_t)L * 1024);
        { int u = blockIdx.x; mls::XL xa; if (u < 1024) mls::x_load(xa, F, proj, gates, u);
          for (; u < 1024; u += F.G) { mls::XL xb; const bool hn = u + F.G < 1024; mls::x_unit(F, proj, gates, mw, u, xa, xb, hn, u + F.G); xa = xb; } }
        __syncthreads();
    }
    SEAM(pb + 1);
    if (IN(pb + 2)) {
        constexpr int GRP = (L == 0) ? 2 : 3;
        mls::y_phase<GRP>(F, mw);
        GRID_BAR();
        if (cls == 0) { conv_all<GRP>(F, (F.G == 256) ? mls::ConvY<GRP>::N : 0); __syncthreads(); }
        if (odd) { for (int p = blockIdx.x; p < 256; p += F.G) { const int bh = p >> 2, jj = p & 3; mob::attn_unit<8>(bh >> 3, bh & 7, 7 - jj, (const mob::bf16*)(proj + C_MQ), (const mob::bf16*)(proj + C_MK), (const mob::bf16*)(proj + C_MV), ymix, km, (char*)F.glds); } }
        __syncthreads();
        if (cls == 1) { conv_all<GRP>(F, (F.G == 256) ? mls::ConvY<GRP>::N : 0); __syncthreads(); }
        mls::z_setup(F, inptr(F, IN_CONVW) + (size_t)L * 4 * 1024, inptr(F, IN_CONVB) + (size_t)L * 1024, inptr(F, IN_MNW) + (size_t)L * 512);
        { int u = blockIdx.x; mls::ZL za; if (u < 1024) mls::z_load(za, F, proj, gates, mw, u);
          for (; u < 1024; u += F.G) { mls::ZL zb; const bool hn = u + F.G < 1024; mls::z_unit(F, proj, gates, mw, ymix, u, za, zb, hn, u + F.G); za = zb; } }
        __syncthreads();
        if (!odd) { for (int p = blockIdx.x; p < 256; p += F.G) { const int bh = p >> 2, jj = p & 3; mob::attn_unit<8>(bh >> 3, bh & 7, 7 - jj, (const mob::bf16*)(proj + C_MQ), (const mob::bf16*)(proj + C_MK), (const mob::bf16*)(proj + C_MV), ymix, km, (char*)F.glds); } }
        __syncthreads();
        if (cls == 2) { conv_all<GRP>(F, (F.G == 256) ? mls::ConvY<GRP>::N : 0); __syncthreads(); }
        for (int p = blockIdx.x; p < 256; p += F.G) { const int bh = p >> 2, jj = p & 3; mob::attn_unit<8>(bh >> 3, bh & 7, jj, (const mob::bf16*)(proj + C_MQ), (const mob::bf16*)(proj + C_MK), (const mob::bf16*)(proj + C_MV), ymix, km, (char*)F.glds); }
        for (int u = blockIdx.x; u < 256; u += F.G) att::swa_unit(F, proj, inptr(F, IN_SINK) + L * 16, ymix, u >> 5, (u >> 4) & 1, u & 15);
        __syncthreads();
        if (cls == 3) { conv_all<GRP>(F, (F.G == 256) ? mls::ConvY<GRP>::N : 0); __syncthreads(); }
    }
    SEAM(pb + 2);
    if (IN(pb + 3)) {
        pg8::DenseSched S{(const char*)ymix, (const char*)(ws + WS_WOUT + (size_t)L * D * D), D, M / 256, D / 256, F.G, (int)blockIdx.x};
        pg8::EpiBf16 E{yb, D, WSC_INV / att::YSC};
        pg8::gemm_phase<pg8::EpiBf16, pg8::DenseSched, true, 1>(F.lds, D, S, E);
    }
    SEAM(pb + 3);
    if (IN(pb + 4)) {
        float* xb = (float*)(ws + WS_XB);
        if constexpr (L == 0) row_phase<1, 0, true, true, false, true>(F, inptr(F, IN_X), xb, yb, inptr(F, IN_GPOSTM) + (size_t)L * D, modl + 2 * D, inptr(F, IN_GPREF) + (size_t)L * D, modl + 4 * D, modl + 3 * D, XN,
                                          nullptr, 0, nullptr, nullptr, nullptr, nullptr, nullptr, nullptr, nullptr, (float*)(ws + WS_ROWMAX));
        else        row_phase<1, 2, true, true, true, true>(F, xb, xb, yb, inptr(F, IN_GPOSTM) + (size_t)L * D, modl + 2 * D, inptr(F, IN_GPREF) + (size_t)L * D, modl + 4 * D, modl + 3 * D, XN,
                                          inptr(F, IN_ROUTER), 8, nullptr, nullptr, nullptr, nullptr, tok, idx, F.ctl + CW_CNT, (float*)(ws + WS_ROWMAX));
    }
    SEAM(pb + 4);
    if constexpr (L == 0) {
        if (IN(pb + 5)) {
            pg8::DenseSched S{(const char*)XN, (const char*)(ws + WS_WGU), D, M / 256, 2 * DFF / 256, F.G, (int)blockIdx.x};
            pg8::EpiSwiGLUI8 E{(unsigned char*)act, DFF, (const float*)(ws + WS_ROWMAX), (const float*)(ws + WS_CTL + COLMAX_OFF), nullptr, nullptr};
            pg8::gemm_phase<pg8::EpiSwiGLUI8, pg8::DenseSched, true, 2>(F.lds, D, S, E);
        }
        SEAM(pb + 5);
        if (IN(pb + 6)) {
            pg8::DenseSched S{(const char*)act, (const char*)(ws + WS_WD), DFF, M / 256, D / 256, F.G, (int)blockIdx.x};
            pg8::EpiBf16 E{yb, D, WSC_INV};
            pg8::gemm_phase<pg8::EpiBf16, pg8::DenseSched, true, 1>(F.lds, DFF, S, E);
        }
        SEAM(pb + 6);
        if (IN(pb + 7)) { float* xb = (float*)(ws + WS_XB); row_phase<1, 1, true, true, true, true>(F, xb, xb, yb, inptr(F, IN_GPOSTF), modl + 5 * D, inptr(F, IN_GPREM) + D, mod + (size_t)NB * 6 * D + 1 * D, mod + (size_t)NB * 6 * D + 0 * D, XN,
                                              inptr(F, IN_WIN) + (size_t)D * NIN_SRC + SRC_GATE, NIN_SRC, inptr(F, IN_IGB) + 4, inptr(F, IN_FGB) + 4, gates, nullptr, nullptr, nullptr, nullptr, (float*)(ws + WS_ROWMAX));
            conv_all<4>(F); }
        SEAM(pb + 7);
    } else {
        if (IN(pb + 5)) {
            moe_table(F);
            const LAS int* tab = (const LAS int*)(F.lds + MOETAB_OFF);
            pg8::MoeSched<true> S; S.A = (const char*)XN; S.W = (const char*)(ws + WS_MGU); S.idx = idx; S.tab = tab; S.KB = D; S.nN = 2 * DFE / 256; S.G = F.G; S.c = (int)blockIdx.x; S.wrows = 2 * DFE; S.ntile = tab[16];
            pg8::EpiSwiGLUI8 E{(unsigned char*)act, DFE, (const float*)(ws + WS_RMSLOT), (const float*)(ws + WS_CTL + COLMAX_OFF) + 2 * DFF, idx, tab};
            pg8::gemm_phase<pg8::EpiSwiGLUI8, pg8::MoeSched<true>, true, 2>(F.lds, D, S, E);
        }
        SEAM(pb + 5);
        if (IN(pb + 6)) {
            moe_table(F);
            const LAS int* tab = (const LAS int*)(F.lds + MOETAB_OFF);
            pg8::MoeSched<false> S; S.A = (const char*)act; S.W = (const char*)(ws + WS_MD); S.idx = idx; S.tab = tab; S.KB = DFE; S.nN = D / 256; S.G = F.G; S.c = (int)blockIdx.x; S.wrows = D; S.ntile = tab[16];
            pg8::EpiBf16 E{yb, D, WSC_INV};
            pg8::gemm_phase<pg8::EpiBf16, pg8::MoeSched<false>, true, 1>(F.lds, DFE, S, E);
        }
        SEAM(pb + 6);
        if (IN(pb + 7)) row_phase<2, 0, false, false, true, false>(F, (const float*)(ws + WS_XB), out, yb, inptr(F, IN_GPOSTF) + D, modl + 5 * D, nullptr, nullptr, nullptr, nullptr,
                                               nullptr, 0, nullptr, nullptr, nullptr, tok, nullptr, nullptr, F.ctl + CW_CNT);
    }
}
__global__ void __launch_bounds__(NTHR, 2) fwd(Args args) {
    extern __shared__ __attribute__((aligned(16))) unsigned char lds[];
    Frame F;
    F.lds = (LAS unsigned char*)lds; F.glds = lds; F.ws = args.ws; F.ctl = (unsigned*)(args.ws + WS_CTL);
    F.tid = threadIdx.x; F.lane = F.tid & 63; F.wave = __builtin_amdgcn_readfirstlane(F.tid >> 6);
    F.G = gridDim.x; F.gw = blockIdx.x * NWAVES + F.wave; F.NGW = F.G * NWAVES;
    volatile LAS unsigned* MISC = (volatile LAS unsigned*)(F.lds + MISC_OFF);
    for (int u = F.tid; u < (LDS_BYTES - LDSCTL_OFF) / 4; u += NTHR) ((LAS unsigned*)(F.lds + LDSCTL_OFF))[u] = 0u;
    __syncthreads();
    if (F.tid < N_INPUTS) { const unsigned long long p = (unsigned long long)args.in[F.tid]; LAS unsigned* t = (LAS unsigned*)(F.lds + PTAB_OFF) + 2 * F.tid; t[0] = (unsigned)p; t[1] = (unsigned)(p >> 32); }
    __syncthreads();
    XcdBarrier bar; bar.bar = F.ctl + CW_BAR; bar.x = 0; bar.st = nullptr;
    if (N_LAUNCHES == 1) bar = xcd_barrier_post(F.ctl + CW_BAR, MISC + 8);
    const int lo = args.ph_lo, hi = args.ph_hi;
    float* out = args.out;
    if (IN(0)) { p0_ada(F, inptr(F, IN_C), inptr(F, IN_ADAW), inptr(F, IN_ADAB), (float*)(F.ws + WS_MOD)); __syncthreads(); conv_all<0>(F); }
    SEAM(0);
    if (IN(1)) { float* mod = (float*)(F.ws + WS_MOD); const float* x = inptr(F, IN_X);
        row_phase<0, 1, true, true>(F, x, (float*)x  , nullptr, nullptr, nullptr, inptr(F, IN_GPREM), mod + 1 * D, mod + 0 * D, (bf16_t*)(F.ws + WS_XN),
                              inptr(F, IN_WIN) + SRC_GATE, NIN_SRC, inptr(F, IN_IGB), inptr(F, IN_FGB), (float*)(F.ws + WS_GATES), nullptr, nullptr, nullptr, nullptr, (float*)(F.ws + WS_ROWMAX));
        conv_all<1>(F); }
    SEAM(1);
    layer<0>(F, bar, out, lo, hi);
    layer<1>(F, bar, out, lo, hi);
}
#undef IN
#undef SEAM
#undef GRID_BAR

extern "C" void kernel_launch(void* const* d_in, const int* in_sizes, int n_in, void* d_out, int out_size, void* d_ws, size_t ws_size, hipStream_t stream) {
    static int grid = 0;
    if (grid == 0) {
        if (n_in != N_INPUTS || in_sizes[0] != M * D || out_size != M * D || ws_size < WS_END) { fprintf(stderr, "kernel_launch: unexpected problem (n_in %d, in0 %d, out %d, ws %zu); nothing launched\n", n_in, n_in > 0 ? in_sizes[0] : -1, out_size, ws_size); grid = -1; return; }
        int dev = 0, cus = 0, per_cu = 0;
        if (hipGetDevice(&dev) != hipSuccess || hipDeviceGetAttribute(&cus, hipDeviceAttributeMultiprocessorCount, dev) != hipSuccess) { grid = -1; return; }
        if (hipFuncSetAttribute((const void*)fwd, hipFuncAttributeMaxDynamicSharedMemorySize, LDS_BYTES) != hipSuccess) { fprintf(stderr, "kernel_launch: hipFuncSetAttribute failed\n"); grid = -1; return; }
        if (hipOccupancyMaxActiveBlocksPerMultiprocessor(&per_cu, (const void*)fwd, NTHR, LDS_BYTES) != hipSuccess || per_cu < 1) fprintf(stderr, "kernel_launch: occupancy query reports %d\n", per_cu);
        (void)hipGetLastError();
        grid = cus;
    }
    if (grid < 0) return;
    if (hipMemsetAsync((char*)d_ws + WS_CTL, 0, CTL_ZERO_BYTES, stream) != hipSuccess) return;
    Args a{};
    for (int i = 0; i < N_INPUTS; ++i) a.in[i] = (const float*)d_in[i];
    a.out = (float*)d_out; a.ws = (unsigned char*)d_ws;
    if (N_LAUNCHES == 1) { a.ph_lo = 0; a.ph_hi = N_PHASES; hipLaunchKernelGGL(fwd, dim3(grid), dim3(NTHR), LDS_BYTES, stream, a); }
    else for (int p = 0; p < N_PHASES; ++p) { a.ph_lo = p; a.ph_hi = p + 1; hipLaunchKernelGGL(fwd, dim3(grid), dim3(NTHR), LDS_BYTES, stream, a); }
}
```

```cpp
#include <hip/hip_runtime.h>
#include <cstdio>
#include <cstdint>

#ifndef MK_N_LAUNCHES
#define MK_N_LAUNCHES 1
#endif

#define LAS __attribute__((address_space(3)))
#define GAS __attribute__((address_space(1)))
typedef unsigned short bf16_t;
typedef short bf16x8 __attribute__((ext_vector_type(8)));
typedef float f32x4 __attribute__((ext_vector_type(4)));
typedef float f32x2 __attribute__((ext_vector_type(2)));
typedef float f32x16 __attribute__((ext_vector_type(16)));
typedef unsigned u32x4 __attribute__((ext_vector_type(4)));
typedef unsigned u32x2 __attribute__((ext_vector_type(2)));
typedef __bf16 bf16x2_t __attribute__((ext_vector_type(2)));

constexpr int NB = 8, SEQ = 2048, D = 2048, M = NB * SEQ;
constexpr int NIN_SRC = 4872, NIN = 4864;
constexpr int C_MQ = 0, C_MK = 512, C_MV = 1024, C_LQ = 1536, C_LK = 2048, C_LV = 2560, C_LO = 3072, C_SQ = 3584, C_SK = 4608, C_SV = 4736;
constexpr int SRC_GATE = 3584;
constexpr int DFF = 5632, DFE = 2816, NE = 8, ECAP = M;
constexpr float RMS_EPS = 1e-6f;
constexpr int NWAVES = 8, NTHR = 512;

constexpr size_t MiB = 1u << 20;
constexpr size_t WS_CTL = 0, CTL_ZERO_BYTES = 1 * MiB;
constexpr size_t WS_MOD = 1 * MiB;
constexpr size_t WS_GATES = 2 * MiB;
constexpr size_t WS_ROWMAX = 4 * MiB;
constexpr size_t WS_RMSLOT = 4 * MiB + 131072;
constexpr size_t WS_TOK = 3 * MiB;
constexpr size_t WS_WIN = 8 * MiB;
constexpr size_t WS_WOUT = 48 * MiB;
constexpr size_t WS_WGU = 64 * MiB;
constexpr size_t WS_WD = 108 * MiB;
constexpr size_t WS_MGU = 130 * MiB;
constexpr size_t WS_MD = 306 * MiB;
constexpr size_t WS_XN = 394 * MiB;
constexpr size_t WS_PROJ = 458 * MiB;
constexpr size_t WS_YMIX = 610 * MiB;
constexpr size_t WS_ACT = 458 * MiB;
constexpr size_t WS_YB = 674 * MiB;
constexpr size_t WS_XB = 810 * MiB;
constexpr size_t WS_CC = 874 * MiB;
constexpr size_t WS_CP = 906 * MiB;
constexpr size_t WS_NC = 938 * MiB, WS_NP = 939 * MiB, WS_SC = 940 * MiB;
constexpr size_t WS_END = 941 * MiB;
constexpr int CW_TMO = 0, CW_CODE = 1;
constexpr int CW_CNT = 64;
constexpr int CW_WQ = 128;
constexpr int CW_BAR = 4096;
constexpr size_t KMEAN_OFF = 262144;


__device__ __forceinline__ unsigned cvtpk(float lo, float hi) { f32x2 v = {lo, hi}; bf16x2_t b = __builtin_convertvector(v, bf16x2_t); return __builtin_bit_cast(unsigned, b); }
__device__ __forceinline__ float bflo(unsigned u) { return __uint_as_float(u << 16); }
__device__ __forceinline__ float bfhi(unsigned u) { return __uint_as_float(u & 0xffff0000u); }
__device__ __forceinline__ float bf1(bf16_t u) { return __uint_as_float(((unsigned)u) << 16); }
template <bool MAX>
__device__ __forceinline__ float scan64(float v) {
    constexpr int ident = MAX ? (int)0xff800000 : 0;
#define SCAN_STEP(ctrl, rm) { const float tf = __int_as_float(__builtin_amdgcn_update_dpp(ident, __float_as_int(v), ctrl, rm, 0xf, false)); v = MAX ? fmaxf(v, tf) : v + tf; }
    SCAN_STEP(0x111, 0xf) SCAN_STEP(0x112, 0xf) SCAN_STEP(0x114, 0xf) SCAN_STEP(0x118, 0xf) SCAN_STEP(0x142, 0xa) SCAN_STEP(0x143, 0xc)
#undef SCAN_STEP
    return v;
}
__device__ __forceinline__ float lane63(float v) { return __int_as_float(__builtin_amdgcn_readlane(__float_as_int(v), 63)); }
__device__ __forceinline__ float wave_sum(float v) { return lane63(scan64<false>(v)); }
__device__ __forceinline__ float wave_max(float v) { return lane63(scan64<true>(v)); }
#define LBAR() do { asm volatile("s_waitcnt lgkmcnt(0)" ::: "memory"); __builtin_amdgcn_s_barrier(); asm volatile("" ::: "memory"); } while (0)
__device__ __forceinline__ float silu_f(float x) { return x / (1.f + __expf(-x)); }
__device__ __forceinline__ float sigmoid_f(float x) { return 1.f / (1.f + __expf(-x)); }

namespace pg8 {
constexpr int BM = 256, BK = 64, HALF = 128, HTB = HALF * BK * 2, STAGE_BYTES = 8 * HTB, NXCD = 8, WGM = 8;
__host__ __device__ __forceinline__ int lds_byte(int r, int c) { const int st = (r >> 4) * 2 + (c >> 5), rr = r & 15, cc = c & 31, ob = rr * 64 + cc * 2; return st * 1024 + (ob ^ (((ob >> 9) & 1) << 5)); }
__host__ __device__ __forceinline__ void stage_rc(int b, int& R, int& C) { const int st = b / 1024, sb = b % 1024, swz = sb ^ (((sb >> 9) & 1) << 5); R = (st >> 1) * 16 + swz / 64; C = (st & 1) * 32 + (swz % 64) / 2; }
__host__ __device__ __forceinline__ int perm32(int rho) { const int n = rho >> 4, i = rho & 15; return 8 * (i >> 2) + 4 * n + (i & 3); }

struct Unit { int pm, pn, e; };
__device__ __forceinline__ unsigned pack_fp8x4(float a, float b, float c, float d) {
    a = fminf(fmaxf(a, -448.f), 448.f); b = fminf(fmaxf(b, -448.f), 448.f); c = fminf(fmaxf(c, -448.f), 448.f); d = fminf(fmaxf(d, -448.f), 448.f);
    int p = __builtin_amdgcn_cvt_pk_fp8_f32(a, b, 0, false); p = __builtin_amdgcn_cvt_pk_fp8_f32(c, d, p, true); return (unsigned)p;
}


__device__ __forceinline__ bool static_next(int i, int G, int c, int nM, int nN, int& pm, int& pn) {
    const int nwg = nM * nN; const long L = (long)i * G + c; if (L >= nwg) return false;
    int wgid = (int)L; { const int q = nwg / NXCD, r = nwg % NXCD, xcd = wgid % NXCD, off = wgid / NXCD; wgid = (xcd < r ? xcd * (q + 1) : r * (q + 1) + (xcd - r) * q) + off; }
    const int nig = WGM * nN, gid = wgid / nig, fm = gid * WGM, gsz = (nM - fm) < WGM ? (nM - fm) : WGM;
    pm = fm + ((wgid % nig) % gsz); pn = (wgid % nig) / gsz; return true;
}

struct DenseSched {
    static constexpr bool GATHER = false;
    const char* A; const char* Bt; int KB  , nM, nN, G, c;
    __device__ __forceinline__ bool next(int i, Unit& u) const { u.e = 0; return static_next(i, G, c, nM, nN, u.pm, u.pn); }
    __device__ __forceinline__ const char* a_base() const { return A; }
    __device__ __forceinline__ void a_offsets(const Unit& u, const int (&Rr)[2], const int (&Cc)[2], unsigned (&off)[2][2]) const {
#pragma unroll
        for (int h = 0; h < 2; ++h)
#pragma unroll
            for (int i = 0; i < 2; ++i) off[h][i] = (unsigned)((u.pm * BM + h * HALF + Rr[i]) * KB + Cc[i] * 2);
    }
    __device__ __forceinline__ const char* b_base(const Unit& u) const { return Bt + (size_t)u.pn * BM * KB; }
};
template <bool GATHER_>
struct MoeSched {
    static constexpr bool GATHER = GATHER_;
    const char* A; const char* W; const int* idx; const LAS int* tab  ; int KB, nN, G, c, wrows  , ntile;
    __device__ __forceinline__ bool next(int i, Unit& u) const { if (!static_next(i, G, c, ntile, nN, u.pm, u.pn)) return false; int e = 0;
#pragma unroll
        for (int j = 1; j < NE; ++j) e += (u.pm >= tab[8 + j]) ? 1 : 0;
        u.e = e; return true; }
    __device__ __forceinline__ const char* a_base() const { return A; }
    __device__ __forceinline__ void a_offsets(const Unit& u, const int (&Rr)[2], const int (&Cc)[2], unsigned (&off)[2][2]) const {
        const int cume = tab[8 + u.e], cnte = tab[u.e];
#pragma unroll
        for (int h = 0; h < 2; ++h)
#pragma unroll
            for (int i = 0; i < 2; ++i) {
                if (GATHER_) { const int rl = (u.pm - cume) * BM + h * HALF + Rr[i]; const int tok = (rl < cnte) ? idx[u.e * ECAP + rl] : 0; off[h][i] = (unsigned)(tok * KB + Cc[i] * 2); }
                else off[h][i] = (unsigned)((u.pm * BM + h * HALF + Rr[i]) * KB + Cc[i] * 2);
            }
    }
    __device__ __forceinline__ const char* b_base(const Unit& u) const { return W + ((size_t)u.e * wrows + (size_t)u.pn * BM) * KB; }
};

struct EpiBf16 {
    static constexpr bool PERM = true;
    bf16_t* O; int ldc; float sc;
    __device__ __forceinline__ void operator()(const f32x4 (&acc)[2][2][4][2], const Unit& u, int wr, int wc, int fr, int fq) const {
        const int row0 = u.pm * BM + wr * 64 + fr, col0 = u.pn * BM + wc * 32 + 8 * fq;
#pragma unroll
        for (int ai = 0; ai < 2; ++ai)
#pragma unroll
            for (int m = 0; m < 4; ++m) { bf16_t* rowp = O + (size_t)(row0 + ai * HALF + m * 16) * ldc + col0;
#pragma unroll
                for (int bj = 0; bj < 2; ++bj) { const f32x4 v0 = acc[ai][bj][m][0] * sc, v1 = acc[ai][bj][m][1] * sc;
                    u32x4 w; w.x = cvtpk(v0[0], v0[1]); w.y = cvtpk(v0[2], v0[3]); w.z = cvtpk(v1[0], v1[1]); w.w = cvtpk(v1[2], v1[3]);
                    *(u32x4*)(rowp + bj * HALF) = w; } }
    }
};
struct EpiInProjI8 {
    static constexpr bool PERM = true;
    bf16_t* O; int ldc; float* kmean; const float* rowmax; const float* colmax;
    __device__ __forceinline__ void operator()(const f32x4 (&acc)[2][2][4][2], const Unit& u, int wr, int wc, int fr, int fq) const {
        typedef int i32x4_ __attribute__((ext_vector_type(4)));
        const int row0 = u.pm * BM + wr * 64 + fr, col0 = u.pn * BM + wc * 32 + 8 * fq;
        const float qsc = (u.pn < 2 || (u.pn >= 14 && u.pn < 18)) ? 0.125f * 1.4426950408889634f : 1.f;
        f32x4 cmv[2][2], cs[2][2];
#pragma unroll
        for (int bj = 0; bj < 2; ++bj)
#pragma unroll
            for (int n = 0; n < 2; ++n) { cmv[bj][n] = *(const f32x4*)(colmax + col0 + bj * HALF + 4 * n) * (qsc / (127.f * 127.f)); cs[bj][n] = (f32x4){0.f, 0.f, 0.f, 0.f}; }
#pragma unroll
        for (int ai = 0; ai < 2; ++ai)
#pragma unroll
            for (int m = 0; m < 4; ++m) { const int r = row0 + ai * HALF + m * 16; bf16_t* rowp = O + (size_t)r * ldc + col0; const float sa = rowmax[r];
#pragma unroll
                for (int bj = 0; bj < 2; ++bj) { f32x4 v[2];
#pragma unroll
                    for (int n = 0; n < 2; ++n) { const i32x4_ iv = __builtin_bit_cast(i32x4_, acc[ai][bj][m][n]);
                        v[n] = (f32x4){(float)iv[0], (float)iv[1], (float)iv[2], (float)iv[3]} * (cmv[bj][n] * sa); cs[bj][n] += v[n]; }
                    u32x4 w; w.x = cvtpk(v[0][0], v[0][1]); w.y = cvtpk(v[0][2], v[0][3]); w.z = cvtpk(v[1][0], v[1][1]); w.w = cvtpk(v[1][2], v[1][3]);
                    *(u32x4*)(rowp + bj * HALF) = w; } }
        if (u.pn == 2 || u.pn == 3) {
#pragma unroll
            for (int bj = 0; bj < 2; ++bj)
#pragma unroll
                for (int n = 0; n < 2; ++n) {
#pragma unroll
                    for (int j = 0; j < 4; ++j) { float v = cs[bj][n][j]; v += __shfl_xor(v, 1); v += __shfl_xor(v, 2); v += __shfl_xor(v, 4); v += __shfl_xor(v, 8); cs[bj][n][j] = v; }
                    if (fr == 0) { float* kp = kmean + (size_t)u.pm * 512 + (u.pn - 2) * BM + bj * HALF + wc * 32 + 8 * fq + 4 * n;
#pragma unroll
                        for (int j = 0; j < 4; ++j) atomicAdd(kp + j, cs[bj][n][j] * (1.f / 256.f)); } }
        }
    }
};
typedef int i32x8 __attribute__((ext_vector_type(8)));
typedef int i32x4 __attribute__((ext_vector_type(4)));
struct EpiSwiGLUI8 {
    static constexpr bool PERM = true;
    unsigned char* O; int ldc; const float* rowmax; const float* colmax  ; const int* rowidx  ; const LAS int* tab;
    __device__ __forceinline__ void operator()(const f32x4 (&acc)[2][2][4][2], const Unit& u, int wr, int wc, int fr, int fq) const {
        const int row0 = u.pm * BM + wr * 64 + fr, col0 = u.pn * HALF + wc * 32 + 8 * fq;
        const float* cm = colmax + (size_t)u.e * 2 * ldc + u.pn * BM + wc * 32 + 8 * fq;
        const f32x4 cg0 = *(const f32x4*)(cm), cg1 = *(const f32x4*)(cm + 4), cu0 = *(const f32x4*)(cm + HALF), cu1 = *(const f32x4*)(cm + HALF + 4);
        const float cg[8] = {cg0[0], cg0[1], cg0[2], cg0[3], cg1[0], cg1[1], cg1[2], cg1[3]}, cu[8] = {cu0[0], cu0[1], cu0[2], cu0[3], cu1[0], cu1[1], cu1[2], cu1[3]};
        int cume = 0, cnte = 0x7fffffff; if (rowidx) { cume = tab[8 + u.e]; cnte = tab[u.e]; }
#pragma unroll
        for (int ai = 0; ai < 2; ++ai)
#pragma unroll
            for (int m = 0; m < 4; ++m) { const int r = row0 + ai * HALF + m * 16; unsigned char* rowp = O + (size_t)r * ldc + col0;
                float sa; if (rowidx) { const int rl = r - cume * BM; sa = (rl < cnte) ? rowmax[u.e * ECAP + rl] : 0.f; } else sa = rowmax[r];
                sa *= (1.f / (127.f * 127.f));
                float o[8];
#pragma unroll
                for (int n = 0; n < 2; ++n)
#pragma unroll
                    for (int j = 0; j < 4; ++j) { const float g = (float)__builtin_bit_cast(i32x4, acc[ai][0][m][n])[j] * (sa * cg[n * 4 + j]), up = (float)__builtin_bit_cast(i32x4, acc[ai][1][m][n])[j] * (sa * cu[n * 4 + j]);
                        o[n * 4 + j] = g * __builtin_amdgcn_rcpf(1.f + __builtin_amdgcn_exp2f(-1.4426950408889634f * g)) * up; }
                u32x2 w; w.x = pack_fp8x4(o[0], o[1], o[2], o[3]); w.y = pack_fp8x4(o[4], o[5], o[6], o[7]);
                *(u32x2*)rowp = w; }
    }
};

struct EpiSwiGLU8 {
    static constexpr bool PERM = true;
    unsigned char* O; int ldc; float sc;
    __device__ __forceinline__ void operator()(const f32x4 (&acc)[2][2][4][2], const Unit& u, int wr, int wc, int fr, int fq) const {
        const int row0 = u.pm * BM + wr * 64 + fr, col0 = u.pn * HALF + wc * 32 + 8 * fq;
#pragma unroll
        for (int ai = 0; ai < 2; ++ai)
#pragma unroll
            for (int m = 0; m < 4; ++m) { unsigned char* rowp = O + (size_t)(row0 + ai * HALF + m * 16) * ldc + col0;
                float r[8];
#pragma unroll
                for (int n = 0; n < 2; ++n)
#pragma unroll
                    for (int j = 0; j < 4; ++j) { const float g = acc[ai][0][m][n][j] * sc, up = acc[ai][1][m][n][j] * sc;
                        r[n * 4 + j] = g * __builtin_amdgcn_rcpf(1.f + __builtin_amdgcn_exp2f(-1.4426950408889634f * g)) * up; }
                u32x2 w; w.x = pack_fp8x4(r[0], r[1], r[2], r[3]); w.y = pack_fp8x4(r[4], r[5], r[6], r[7]);
                *(u32x2*)rowp = w; }
    }
};

template <class Epi, class Sched, bool ALIGN_EPI, int DT>
__device__ __forceinline__ void gemm_phase(LAS unsigned char* lds, const int KB, const Sched& S, const Epi& E) {
    const int tid = threadIdx.x, wid = __builtin_amdgcn_readfirstlane(tid >> 6), lane = tid & 63, wr = wid >> 2, wc = wid & 3, fr = lane & 15, fq = lane >> 4;
    const int nt = KB / 128;
    int Rr[2], Cc[2]; unsigned voffB[2];
#pragma unroll
    for (int i = 0; i < 2; ++i) { int R, C; stage_rc(tid * 16 + i * 8192, R, C); Rr[i] = R; Cc[i] = C; const int Rb = Epi::PERM ? ((R & ~31) + perm32(R & 31)) : R; voffB[i] = (unsigned)(Rb * KB + C * 2); }
    const size_t kstep = (size_t)(BK * 2);
    const size_t hstep = (size_t)HALF * KB;
    const unsigned ldsw = (unsigned)wid * 1024u;
    const int aoff = lds_byte(wr * 64 + fr, fq * 8), boff = lds_byte(wc * 32 + fr, fq * 8);
#define PG8_SA(b, h) (((b) * 2 + (h)) * HTB)
#define PG8_SB(b, h) ((4 + (b) * 2 + (h)) * HTB)
#define PG8_STAGE(bufoff, gbase, voff) do { _Pragma("unroll") for (int _i = 0; _i < 2; ++_i) \
        __builtin_amdgcn_global_load_lds((const unsigned*)((const char*)(gbase) + (voff)[_i]), (LAS unsigned*)(lds + (bufoff) + ldsw + _i * 8192), 16, 0, 0); } while (0)
#define PG8_LD32(p) __builtin_shufflevector(*(const LAS i32x4*)(p), *(const LAS i32x4*)((p) + 1024), 0, 1, 2, 3, 4, 5, 6, 7)
#define PG8_LDA(dst, b, h) do { _Pragma("unroll") for (int m = 0; m < 4; ++m) dst[m] = PG8_LD32(lds + PG8_SA(b, h) + aoff + m * 2048); } while (0)
#define PG8_LDB(dst, b, h) do { _Pragma("unroll") for (int n = 0; n < 2; ++n) dst[n] = PG8_LD32(lds + PG8_SB(b, h) + boff + n * 2048); } while (0)
#define PG8_LO(x) __builtin_bit_cast(bf16x8, __builtin_shufflevector((x), (x), 0, 1, 2, 3))
#define PG8_HI(x) __builtin_bit_cast(bf16x8, __builtin_shufflevector((x), (x), 4, 5, 6, 7))
#define PG8_MMA(ai, bj, At, Bt) do { __builtin_amdgcn_s_setprio(1); \
        if constexpr (DT == 2) { _Pragma("unroll") for (int m = 0; m < 4; ++m) _Pragma("unroll") for (int n = 0; n < 2; ++n) { \
            i32x4 _c = __builtin_bit_cast(i32x4, acc[ai][bj][m][n]); \
            _c = __builtin_amdgcn_mfma_i32_16x16x64_i8(__builtin_shufflevector(Bt[n], Bt[n], 0, 1, 2, 3), __builtin_shufflevector(At[m], At[m], 0, 1, 2, 3), _c, 0, 0, 0); \
            _c = __builtin_amdgcn_mfma_i32_16x16x64_i8(__builtin_shufflevector(Bt[n], Bt[n], 4, 5, 6, 7), __builtin_shufflevector(At[m], At[m], 4, 5, 6, 7), _c, 0, 0, 0); \
            acc[ai][bj][m][n] = __builtin_bit_cast(f32x4, _c); } } \
        else if constexpr (DT == 1) { _Pragma("unroll") for (int m = 0; m < 4; ++m) _Pragma("unroll") for (int n = 0; n < 2; ++n) \
            asm volatile("v_mfma_scale_f32_16x16x128_f8f6f4 %0, %1, %2, %0, %3, %3 op_sel_hi:[0,0,0]" : "+v"(acc[ai][bj][m][n]) : "v"(Bt[n]), "v"(At[m]), "v"(scv)); } \
        else { _Pragma("unroll") for (int m = 0; m < 4; ++m) _Pragma("unroll") for (int n = 0; n < 2; ++n) { \
            acc[ai][bj][m][n] = __builtin_amdgcn_mfma_f32_16x16x32_bf16(PG8_LO(Bt[n]), PG8_LO(At[m]), acc[ai][bj][m][n], 0, 0, 0); \
            acc[ai][bj][m][n] = __builtin_amdgcn_mfma_f32_16x16x32_bf16(PG8_HI(Bt[n]), PG8_HI(At[m]), acc[ai][bj][m][n], 0, 0, 0); } } \
        __builtin_amdgcn_s_setprio(0); } while (0)
#define PG8_WAIT_V(n) asm volatile("s_waitcnt vmcnt(" #n ")" ::: "memory")
#define PG8_WAIT_L(n) asm volatile("s_waitcnt lgkmcnt(" #n ")" ::: "memory")
#define PG8_BAR __builtin_amdgcn_s_barrier()
#define PG8_SCHED __builtin_amdgcn_sched_barrier(0)
    Unit cur, nxt; int ui = 0;
    if (!S.next(0, cur)) return;
    f32x4 acc[2][2][4][2];
#pragma unroll
    for (int a = 0; a < 2; ++a)
#pragma unroll
        for (int b = 0; b < 2; ++b)
#pragma unroll
            for (int m = 0; m < 4; ++m)
#pragma unroll
                for (int n = 0; n < 2; ++n) acc[a][b][m][n] = (f32x4){0.f, 0.f, 0.f, 0.f};
    i32x8 At[4], B0[2], B1[2];
    int scv = 0x7F7F7F7F; asm volatile("" : "+v"(scv));
    unsigned curA[2][2], nxtA[2][2], voffA[2];
    const char* const Ab = S.a_base(); const char* cA = Ab; const char* nA = Ab;
    if constexpr (Sched::GATHER) S.a_offsets(cur, Rr, Cc, curA);
    else {
#pragma unroll
        for (int i = 0; i < 2; ++i) voffA[i] = (unsigned)(Rr[i] * KB + Cc[i] * 2);
        cA = Ab + (size_t)cur.pm * 2 * hstep; }
    const char* cB = S.b_base(cur);
#define PG8_STA(bufoff, nextflag, h, koff) do { if constexpr (Sched::GATHER) { unsigned _o[2]; _o[0] = (nextflag) ? nxtA[h][0] : curA[h][0]; _o[1] = (nextflag) ? nxtA[h][1] : curA[h][1]; PG8_STAGE(bufoff, Ab + (koff), _o); } \
        else { PG8_STAGE(bufoff, ((nextflag) ? nA : cA) + (size_t)(h) * hstep + (koff), voffA); } } while (0)
    PG8_STAGE(PG8_SB(0, 0), cB, voffB); PG8_STAGE(PG8_SB(0, 1), cB + hstep, voffB); PG8_STA(PG8_SA(0, 0), false, 0, 0); PG8_STA(PG8_SA(0, 1), false, 1, 0);
    if (wr == 1) PG8_BAR;
    PG8_WAIT_V(2); PG8_BAR;
    PG8_STAGE(PG8_SB(1, 0), cB + kstep, voffB); PG8_STA(PG8_SA(1, 0), false, 0, kstep); PG8_STAGE(PG8_SB(1, 1), cB + hstep + kstep, voffB);
    PG8_WAIT_V(6); PG8_BAR;
    for (;;) {
        const bool has_next = S.next(ui + 1, nxt);
        if constexpr (Sched::GATHER) {
            if (has_next) S.a_offsets(nxt, Rr, Cc, nxtA);
            else {
#pragma unroll
                for (int h = 0; h < 2; ++h)
#pragma unroll
                    for (int i = 0; i < 2; ++i) nxtA[h][i] = curA[h][i]; }
        } else nA = has_next ? Ab + (size_t)nxt.pm * 2 * hstep : cA;
        const char* nB = has_next ? S.b_base(nxt) : cB;
        for (int t = 0; t < nt; t += 2) {
            const bool last = (t == nt - 2);
            const size_t k1 = (size_t)(t + 1) * kstep, k2 = last ? 0 : (size_t)(t + 2) * kstep, k3 = k2 + kstep;
            const char* b2 = last ? nB : cB + (size_t)(t + 2) * kstep; const char* b3 = b2 + kstep;
            PG8_LDB(B0, 0, 0); PG8_LDB(B1, 0, 1); PG8_SCHED; PG8_LDA(At, 0, 0); PG8_STA(PG8_SA(1, 1), false, 1, k1);
            PG8_WAIT_V(8); PG8_WAIT_L(0); PG8_BAR; PG8_MMA(0, 0, At, B0); PG8_MMA(0, 1, At, B1); PG8_BAR; PG8_SCHED;
            PG8_LDA(At, 0, 1); PG8_STAGE(PG8_SB(0, 0), b2, voffB); PG8_STAGE(PG8_SB(0, 1), b2 + hstep, voffB); PG8_STA(PG8_SA(0, 0), last, 0, k2);
            PG8_WAIT_V(8); PG8_WAIT_L(0); PG8_BAR; PG8_MMA(1, 0, At, B0); PG8_MMA(1, 1, At, B1); PG8_BAR; PG8_SCHED;
            PG8_LDB(B0, 1, 0); PG8_LDB(B1, 1, 1); PG8_SCHED; PG8_LDA(At, 1, 0); PG8_STA(PG8_SA(0, 1), last, 1, k2);
            PG8_WAIT_V(8); PG8_WAIT_L(0); PG8_BAR; PG8_MMA(0, 0, At, B0); PG8_MMA(0, 1, At, B1); PG8_BAR; PG8_SCHED;
            PG8_LDA(At, 1, 1); PG8_STAGE(PG8_SB(1, 0), b3, voffB); PG8_STAGE(PG8_SB(1, 1), b3 + hstep, voffB); PG8_STA(PG8_SA(1, 0), last, 0, k3);
            PG8_WAIT_V(8); PG8_WAIT_L(0); PG8_BAR; PG8_MMA(1, 0, At, B0); PG8_MMA(1, 1, At, B1); PG8_BAR; PG8_SCHED;
        }
        if constexpr (ALIGN_EPI) { if (wr == 0) PG8_BAR; }
        if constexpr (DT == 1) asm volatile("s_nop 15\n\ts_nop 15" ::: "memory");
        E(acc, cur, wr, wc, fr, fq);
        if (!has_next) break;
#pragma unroll
        for (int a = 0; a < 2; ++a)
#pragma unroll
            for (int b = 0; b < 2; ++b)
#pragma unroll
                for (int m = 0; m < 4; ++m)
#pragma unroll
                    for (int n = 0; n < 2; ++n) acc[a][b][m][n] = (f32x4){0.f, 0.f, 0.f, 0.f};
        cur = nxt; cB = nB; cA = nA; ++ui;
        if constexpr (Sched::GATHER) {
#pragma unroll
            for (int h = 0; h < 2; ++h)
#pragma unroll
                for (int i = 0; i < 2; ++i) curA[h][i] = nxtA[h][i]; }
        if constexpr (ALIGN_EPI) { if (wr == 1) PG8_BAR; }
    }
    PG8_WAIT_V(0);
    if constexpr (!ALIGN_EPI) { if (wr == 0) PG8_BAR; }
    PG8_BAR;
#undef PG8_SA
#undef PG8_SB
#undef PG8_STAGE
#undef PG8_STA
#undef PG8_LDA
#undef PG8_LDB
#undef PG8_MMA
#undef PG8_LD32
#undef PG8_LO
#undef PG8_HI
#undef PG8_WAIT_V
#undef PG8_WAIT_L
#undef PG8_BAR
#undef PG8_SCHED
}
}

#define XB_TMO      128
#define XB_XCNT(j)  (256  + 64 * (j))
#define XB_XSUB(j)  (1280 + 64 * (j))
#define XB_XGEN(j)  (2304 + 64 * (j))
#define XB_TOP      3328
#define XB_TOPGEN   3392
#define XCD_BAR_WORDS 3456
#define XB_SPIN_CAP (1u << 18)
__device__ __forceinline__ unsigned xb_ld(unsigned* p)              { return __hip_atomic_load(p, __ATOMIC_RELAXED, __HIP_MEMORY_SCOPE_AGENT); }
__device__ __forceinline__ unsigned xb_add(unsigned* p, unsigned v) { return __hip_atomic_fetch_add(p, v, __ATOMIC_RELAXED, __HIP_MEMORY_SCOPE_AGENT); }
__device__ __forceinline__ unsigned xb_xcc_id() { return (unsigned)__builtin_amdgcn_s_getreg((3 << 11) | 20) & 0xFu; }
#define XB_SPIN(cond, bar) do { unsigned _sp = 0; while (cond) { __builtin_amdgcn_s_sleep(1); \
    if ((++_sp & 255u) == 0u) { if (xb_ld(&(bar)[XB_TMO])) break; if (_sp > XB_SPIN_CAP) { atomicAdd(&(bar)[XB_TMO], 1u); break; } } } } while (0)
struct XcdBarrier { unsigned* bar; unsigned x; volatile LAS unsigned* st; };
__device__ __forceinline__ XcdBarrier xcd_barrier_post(unsigned* bar, volatile LAS unsigned* st) {
    XcdBarrier b; b.bar = bar; b.x = xb_xcc_id(); b.st = st;
    if (threadIdx.x == 0) (void)xb_add(&bar[XB_XCNT(b.x)], 1u);
    return b;
}
__device__ __forceinline__ void xcd_barrier_complete(unsigned* bar, unsigned x, unsigned& nloc, unsigned& nx) {
    const unsigned G = gridDim.x * gridDim.y * gridDim.z;
    unsigned sum, cnt, mine, sp = 0u;
    for (;;) {
        sum = 0u; cnt = 0u; mine = 0u;
#pragma unroll
        for (unsigned j = 0; j < 16; ++j) { const unsigned c = xb_ld(&bar[XB_XCNT(j)]); sum += c; cnt += (c > 0u) ? 1u : 0u; mine = (j == x) ? c : mine; }
        if (sum == G) break;
        __builtin_amdgcn_s_sleep(1);
        if ((++sp & 255u) == 0u) { if (xb_ld(&bar[XB_TMO])) break; if (sp > XB_SPIN_CAP) { atomicAdd(&bar[XB_TMO], 1u); break; } }
    }
    nloc = mine > 0u ? mine : 1u; nx = cnt > 0u ? cnt : 1u;
}
__device__ __forceinline__ void xcd_barrier(const XcdBarrier& b) {
    asm volatile("s_waitcnt vmcnt(0)" ::: "memory");
    __syncthreads();
    if (threadIdx.x == 0) {
        unsigned* bar = b.bar;
        __builtin_amdgcn_s_waitcnt(0);
        unsigned nloc = b.st[0], nx = b.st[1];
        if (nloc == 0u) { xcd_barrier_complete(bar, b.x, nloc, nx); b.st[0] = nloc; b.st[1] = nx; }
        const unsigned old = xb_add(&bar[XB_XSUB(b.x)], 1u);
        const unsigned gen = old / nloc;
        if (old + 1u == (gen + 1u) * nloc) {
            __builtin_amdgcn_fence(__ATOMIC_RELEASE, "agent");
            asm volatile("s_waitcnt vmcnt(0)" ::: "memory");
            const unsigned og = xb_add(&bar[XB_TOP], 1u);
            const unsigned tg = og / nx;
            if (og + 1u == (tg + 1u) * nx) xb_add(&bar[XB_TOPGEN], 1u);
            else XB_SPIN(xb_ld(&bar[XB_TOPGEN]) == tg, bar);
            __builtin_amdgcn_fence(__ATOMIC_ACQUIRE, "agent");
            xb_add(&bar[XB_XGEN(b.x)], 1u);
            asm volatile("s_waitcnt vmcnt(0)" ::: "memory");
        } else {
            XB_SPIN(xb_ld(&bar[XB_XGEN(b.x)]) == gen, bar);
            __builtin_amdgcn_fence(__ATOMIC_ACQUIRE, "agent");
            asm volatile("s_waitcnt vmcnt(0)" ::: "memory");
        }
    }
    __syncthreads();
}

constexpr int RING_BYTES = 131072, LDSCTL_OFF = RING_BYTES, MISC_OFF = LDSCTL_OFF + 320, LDS_BYTES = 147456;
enum { IN_X = 0, IN_C, IN_ADAW, IN_ADAB, IN_GPREM, IN_GPOSTM, IN_GPREF, IN_GPOSTF, IN_WIN, IN_WOUT, IN_CONVW, IN_CONVB, IN_IGB, IN_FGB, IN_MNW, IN_SINK,
       IN_FG, IN_FU, IN_FD, IN_ROUTER, IN_MG, IN_MU, IN_MD, N_INPUTS };
struct Args { const float* in[N_INPUTS]; float* out; unsigned char* ws; int ph_lo, ph_hi; };
struct Frame {
    LAS unsigned char* lds; unsigned char* glds; unsigned* ctl; unsigned char* ws;
    int tid, lane, wave, G, gw, NGW;
};

__device__ __forceinline__ void p0_ada(Frame& F, const float* c, const float* ada_w, const float* ada_b, float* mod) {
    float* cond = (float*)F.glds;
    float* part = (float*)(F.glds + 65536);
    for (int i = F.tid; i < NB * D; i += NTHR) { const int b = i / D, k = i % D; cond[k * 8 + b] = silu_f(c[i]); }
    __syncthreads();
    const int cq = F.lane & 7, ks = F.lane >> 3;
    for (int u = blockIdx.x; u < 768; u += F.G) {
        const int l = u / 384, cb = u % 384;
        const float* W = ada_w + (size_t)l * D * 6 * D + cb * 32 + cq * 4;
        f32x4 acc[8];
#pragma unroll
        for (int b = 0; b < 8; ++b) acc[b] = (f32x4){0.f, 0.f, 0.f, 0.f};
        const int kbase = F.wave * 256 + ks;
#pragma unroll 4
        for (int it = 0; it < 32; ++it) {
            const int k = kbase + 8 * it;
            const f32x4 w = __builtin_nontemporal_load((const f32x4*)(W + (size_t)k * 6 * D));
            const f32x4 c0 = *(const f32x4*)(cond + k * 8), c1 = *(const f32x4*)(cond + k * 8 + 4);
            acc[0] += w * c0[0]; acc[1] += w * c0[1]; acc[2] += w * c0[2]; acc[3] += w * c0[3];
            acc[4] += w * c1[0]; acc[5] += w * c1[1]; acc[6] += w * c1[2]; acc[7] += w * c1[3];
        }
#pragma unroll
        for (int b = 0; b < 8; ++b)
#pragma unroll
            for (int j = 0; j < 4; ++j) { float v = acc[b][j]; v += __shfl_xor(v, 8); v += __shfl_xor(v, 16); v += __shfl_xor(v, 32); acc[b][j] = v; }
        if (F.lane < 8) {
#pragma unroll
            for (int b = 0; b < 8; ++b) *(f32x4*)(part + (F.wave * 8 + b) * 32 + cq * 4) = acc[b];
        }
        __syncthreads();
        if (F.tid < 256) { const int b = F.tid >> 5, col = F.tid & 31; float s = ada_b[(size_t)l * 6 * D + cb * 32 + col];
#pragma unroll
          for (int w = 0; w < 8; ++w) s += part[(w * 8 + b) * 32 + col];
          mod[((size_t)l * NB + b) * 6 * D + cb * 32 + col] = s; }
        __syncthreads();
    }
}
__device__ __forceinline__ void cvt_item(const float* src, int ld, int k0, int c0, bf16_t* dst, int Kd, int drow0, unsigned char* scr, int lane) {
    const int c = lane & 15, q = lane >> 4;
    f32x4 v[4][4];
#pragma unroll
    for (int g = 0; g < 4; ++g)
#pragma unroll
        for (int j = 0; j < 4; ++j) v[g][j] = __builtin_nontemporal_load((const f32x4*)(src + (size_t)(k0 + 16 * g + 4 * q + j) * ld + c0 + 4 * c));
#pragma unroll
    for (int g = 0; g < 4; ++g)
#pragma unroll
        for (int i = 0; i < 4; ++i) { u32x2 w; w.x = cvtpk(v[g][0][i], v[g][1][i]); w.y = cvtpk(v[g][2][i], v[g][3][i]);
            *(u32x2*)(scr + (4 * c + i) * 136 + (16 * g + 4 * q) * 2) = w; }
    asm volatile("s_waitcnt lgkmcnt(0)" ::: "memory");
#pragma unroll
    for (int r = 0; r < 8; ++r) { const int n = 8 * r + (lane >> 3), ch = lane & 7;
        const u32x2 a = *(const u32x2*)(scr + n * 136 + ch * 16), b = *(const u32x2*)(scr + n * 136 + ch * 16 + 8);
        u32x4 o; o.x = a.x; o.y = a.y; o.z = b.x; o.w = b.y;
        *(u32x4*)(dst + (size_t)(drow0 + n) * Kd + k0 + 8 * ch) = o; }
    asm volatile("s_waitcnt lgkmcnt(0)" ::: "memory");
}
constexpr float WSC = 64.f, WSC_INV = 1.f / 64.f;
__device__ __forceinline__ void cvt_item8(const float* src, int ld, int k0, int c0, unsigned char* dst, int Kd, int drow0, unsigned char* scr, int lane) {
    const int c = lane & 7, q = lane >> 3;
    f32x4 v[4][4];
#pragma unroll
    for (int g = 0; g < 4; ++g)
#pragma unroll
        for (int j = 0; j < 4; ++j) v[g][j] = __builtin_nontemporal_load((const f32x4*)(src + (size_t)(k0 + 32 * g + 4 * q + j) * ld + c0 + 4 * c));
#pragma unroll
    for (int g = 0; g < 4; ++g)
#pragma unroll
        for (int i = 0; i < 4; ++i) *(unsigned*)(scr + (4 * c + i) * 132 + 32 * g + 4 * q) = pg8::pack_fp8x4(v[g][0][i] * WSC, v[g][1][i] * WSC, v[g][2][i] * WSC, v[g][3][i] * WSC);
    asm volatile("s_waitcnt lgkmcnt(0)" ::: "memory");
#pragma unroll
    for (int r = 0; r < 4; ++r) { const int n = 8 * r + (lane >> 3), ch = lane & 7; const unsigned char* p = scr + n * 132 + ch * 16;
        u32x4 o; o.x = *(const unsigned*)(p); o.y = *(const unsigned*)(p + 4); o.z = *(const unsigned*)(p + 8); o.w = *(const unsigned*)(p + 12);
        *(u32x4*)(dst + (size_t)(drow0 + n) * Kd + k0 + 16 * ch) = o; }
    asm volatile("s_waitcnt lgkmcnt(0)" ::: "memory");
}
__device__ __forceinline__ const float* inptr(const Frame& F, int i);
constexpr int CMS_KB = 2;
constexpr float CMS_F = 1.4f;
constexpr size_t COLMAX_OFF = 524288;
__device__ __forceinline__ void colmax_item(const float* src, int ld, int k0, int c0, float* cmx  , int lane) {
    const int c = lane & 7, q = lane >> 3;
    f32x4 mx = (f32x4){0.f, 0.f, 0.f, 0.f};
#pragma unroll
    for (int g = 0; g < 4; ++g)
#pragma unroll
        for (int j = 0; j < 4; ++j) { const f32x4 v = *(const f32x4*)(src + (size_t)(k0 + 32 * g + 4 * q + j) * ld + c0 + 4 * c);
            mx[0] = fmaxf(mx[0], fabsf(v[0])); mx[1] = fmaxf(mx[1], fabsf(v[1])); mx[2] = fmaxf(mx[2], fabsf(v[2])); mx[3] = fmaxf(mx[3], fabsf(v[3])); }
#pragma unroll
    for (int i = 0; i < 4; ++i) { float v = mx[i]; v = fmaxf(v, __shfl_xor(v, 8)); v = fmaxf(v, __shfl_xor(v, 16)); v = fmaxf(v, __shfl_xor(v, 32)); mx[i] = v; }
    if (q == 0) {
#pragma unroll
        for (int i = 0; i < 4; ++i) atomicMax((unsigned*)(cmx + 4 * c + i), __float_as_uint(mx[i] * CMS_F)); }
}
__device__ __forceinline__ unsigned pack_i8x4(float a, float b, float c, float d) {
    const int ia = (int)rintf(fminf(fmaxf(a, -127.f), 127.f)), ib = (int)rintf(fminf(fmaxf(b, -127.f), 127.f)), ic = (int)rintf(fminf(fmaxf(c, -127.f), 127.f)), id = (int)rintf(fminf(fmaxf(d, -127.f), 127.f));
    return (unsigned)(ia & 0xff) | ((unsigned)(ib & 0xff) << 8) | ((unsigned)(ic & 0xff) << 16) | ((unsigned)(id & 0xff) << 24);
}
__device__ __forceinline__ void cvt_item_i8(const float* src, int ld, int k0, int c0, unsigned char* dst, int Kd, int drow0, const float* cmx  , unsigned char* scr, int lane) {
    const int c = lane & 7, q = lane >> 3;
    const f32x4 cm = *(const f32x4*)(cmx + 4 * c);
    f32x4 inv; inv[0] = cm[0] > 0.f ? 127.f / cm[0] : 0.f; inv[1] = cm[1] > 0.f ? 127.f / cm[1] : 0.f; inv[2] = cm[2] > 0.f ? 127.f / cm[2] : 0.f; inv[3] = cm[3] > 0.f ? 127.f / cm[3] : 0.f;
    f32x4 v[4][4];
#pragma unroll
    for (int g = 0; g < 4; ++g)
#pragma unroll
        for (int j = 0; j < 4; ++j) v[g][j] = __builtin_nontemporal_load((const f32x4*)(src + (size_t)(k0 + 32 * g + 4 * q + j) * ld + c0 + 4 * c));
#pragma unroll
    for (int g = 0; g < 4; ++g)
#pragma unroll
        for (int i = 0; i < 4; ++i) *(unsigned*)(scr + (4 * c + i) * 132 + 32 * g + 4 * q) = pack_i8x4(v[g][0][i] * inv[i], v[g][1][i] * inv[i], v[g][2][i] * inv[i], v[g][3][i] * inv[i]);
    asm volatile("s_waitcnt lgkmcnt(0)" ::: "memory");
#pragma unroll
    for (int r = 0; r < 4; ++r) { const int n = 8 * r + (lane >> 3), ch = lane & 7; const unsigned char* p = scr + n * 132 + ch * 16;
        u32x4 o; o.x = *(const unsigned*)(p); o.y = *(const unsigned*)(p + 4); o.z = *(const unsigned*)(p + 8); o.w = *(const unsigned*)(p + 12);
        *(u32x4*)(dst + (size_t)(drow0 + n) * Kd + k0 + 16 * ch) = o; }
    asm volatile("s_waitcnt lgkmcnt(0)" ::: "memory");
}
constexpr int CI_WI = 16 * 152  , CI_WO = 16 * 64, CI_FD = 44 * 64, CI_FGU = 2 * 16 * 176, CI_MD = 8 * 22 * 64, CI_MGU = 16 * 16 * 88;
constexpr int CS_WI = CMS_KB * 152, CS_FGU = 2 * CMS_KB * 176, CS_MGU = 16 * CMS_KB * 88;
constexpr int CONV_N0 = CS_WI + CI_WO + CI_FD + CS_FGU, CONV_N1 = CI_WI + CI_FGU, CONV_N2 = CS_WI + CI_WO + CI_MD + CS_MGU, CONV_N3 = CI_MGU, CONV_N4 = CI_WI;
constexpr int CMX_WIN = 2 * DFF + 16 * DFE;
template <int GRP>
__device__ __forceinline__ void conv_item(Frame& F, int r) {
    unsigned char* scr = F.glds + F.wave * 8704; unsigned char* ws = F.ws;
    float* cmx = (float*)(ws + WS_CTL + COLMAX_OFF);
    if (GRP == 0 || GRP == 1 || GRP == 2 || GRP == 4) {
        constexpr int l = (GRP == 2 || GRP == 4) ? 1 : 0;
        constexpr bool QUANT = (GRP == 1 || GRP == 4); constexpr int NI = QUANT ? CI_WI : CS_WI;
        if (r < NI) { const int kb = r / 152, nb = r % 152, c0 = (nb < 112) ? nb * 32 : SRC_GATE + 8 + (nb - 112) * 32, drow = nb * 32;
            if (QUANT) cvt_item_i8(inptr(F, IN_WIN) + (size_t)l * D * NIN_SRC, NIN_SRC, kb * 128, c0, ws + WS_WIN + (size_t)l * NIN * D, D, drow, cmx + CMX_WIN + l * NIN + drow, scr, F.lane);
            else colmax_item(inptr(F, IN_WIN) + (size_t)l * D * NIN_SRC, NIN_SRC, kb * 128, c0, cmx + CMX_WIN + l * NIN + drow, F.lane);
            return; }
        r -= NI;
    }
    if (GRP == 0 || GRP == 2) {
        constexpr int l = (GRP == 2) ? 1 : 0;
        if (r < CI_WO) { const int kb = r / 64, nb = r % 64;
            cvt_item8(inptr(F, IN_WOUT) + (size_t)l * D * D, D, kb * 128, nb * 32, ws + WS_WOUT + (size_t)l * D * D, D, nb * 32, scr, F.lane); return; }
        r -= CI_WO;
        if (GRP == 0) {
            if (r < CI_FD) { const int kb = r / 64, nb = r % 64; cvt_item8(inptr(F, IN_FD), D, kb * 128, nb * 32, ws + WS_WD, DFF, nb * 32, scr, F.lane); return; }
            r -= CI_FD;
        } else {
            if (r < CI_MD) { const int e = r / (22 * 64); r %= (22 * 64); const int kb = r / 64, nb = r % 64;
                cvt_item8(inptr(F, IN_MD) + (size_t)e * DFE * D, D, kb * 128, nb * 32, ws + WS_MD + (size_t)e * D * DFE, DFE, nb * 32, scr, F.lane); return; }
            r -= CI_MD;
        }
    }
    if (GRP == 0 || GRP == 1) { constexpr int KBN = (GRP == 1) ? 16 : CMS_KB, I_F = KBN * 176; const int up = r / I_F; r %= I_F; const int kb = r / 176, nb = r % 176, n0 = nb * 32, drow = (n0 >> 7) * 256 + up * 128 + (n0 & 127);
        if (GRP == 1) cvt_item_i8(inptr(F, up ? IN_FU : IN_FG), DFF, kb * 128, n0, ws + WS_WGU, D, drow, cmx + drow, scr, F.lane);
        else colmax_item(inptr(F, up ? IN_FU : IN_FG), DFF, kb * 128, n0, cmx + drow, F.lane); }
    else { constexpr int KBN = (GRP == 3) ? 16 : CMS_KB, I_E = KBN * 88; const int up = r / (8 * I_E); r %= (8 * I_E); const int e = r / I_E; r %= I_E; const int kb = r / 88, nb = r % 88, n0 = nb * 32, drow = (n0 >> 7) * 256 + up * 128 + (n0 & 127);
        if (GRP == 3) cvt_item_i8(inptr(F, up ? IN_MU : IN_MG) + (size_t)e * D * DFE, DFE, kb * 128, n0, ws + WS_MGU + (size_t)e * 2 * DFE * D, D, drow, cmx + 2 * DFF + e * 2 * DFE + drow, scr, F.lane);
        else colmax_item(inptr(F, up ? IN_MU : IN_MG) + (size_t)e * D * DFE, DFE, kb * 128, n0, cmx + 2 * DFF + e * 2 * DFE + drow, F.lane); }
}
template <int GRP>
__device__ __forceinline__ void conv_all(Frame& F, int first = 0) {
    constexpr int N = (GRP == 0) ? CONV_N0 : (GRP == 1) ? CONV_N1 : (GRP == 2) ? CONV_N2 : (GRP == 3) ? CONV_N3 : CONV_N4;
    for (int it = first + F.gw; it < N; it += F.NGW) conv_item<GRP>(F, it);
}
template <int YMODE, int EXTRA, bool NORM_OUT, bool XN8  , bool XIN_BF = false  , bool XOUT_BF = false  >
__device__ __forceinline__ void row_phase(Frame& F, const float* xin, float* xout, const bf16_t* ybuf, const float* gpost, const float* gt  ,
                                          const float* gpre, const float* sc, const float* sh, bf16_t* XN,
                                          const float* wex, int ldw, const float* bi, const float* bfg, float* gates_out,
                                          const uint4* tok_in, uint4* tok_out, int* idx_out, unsigned* cntw, float* rowmax = nullptr) {
    LAS float* we = (LAS float*)F.lds;
    LAS float* vA = (LAS float*)(F.lds + 65536);
    LAS float* vB = (LAS float*)(F.lds + 73728);
    LAS float* vC = (LAS float*)(F.lds + 81920);
    LAS float* route = (LAS float*)(F.lds + 90112);
    LAS int* routei = (LAS int*)route;
    LAS int* cumt = (LAS int*)(F.lds + 90112 + 2048);
    if (EXTRA) {
        for (int k = F.tid; k < D; k += NTHR) { const f32x4 a = *(const f32x4*)(wex + (size_t)k * ldw), b = *(const f32x4*)(wex + (size_t)k * ldw + 4);
            we[0 * D + k] = a[0]; we[1 * D + k] = a[1]; we[2 * D + k] = a[2]; we[3 * D + k] = a[3]; we[4 * D + k] = b[0]; we[5 * D + k] = b[1]; we[6 * D + k] = b[2]; we[7 * D + k] = b[3]; }
    }
    if (YMODE == 2) { if (F.tid == 0) { int cum = 0; for (int e = 0; e < NE; ++e) { cumt[e] = cum; cum += (int)((__hip_atomic_load(cntw + e, __ATOMIC_RELAXED, __HIP_MEMORY_SCOPE_AGENT) + 255u) >> 8); } } }
    for (int blk = blockIdx.x; blk < M / 64; blk += F.G) {
        const int b = (blk * 64) / SEQ;
        __syncthreads();
        { const int col = 4 * F.tid;
            if (YMODE) { const f32x4 g = *(const f32x4*)(gt + (size_t)b * 6 * D + col), p = *(const f32x4*)(gpost + col); *(LAS f32x4*)(vA + col) = g * p; }
            if (NORM_OUT) { const f32x4 g = *(const f32x4*)(gpre + col), s = *(const f32x4*)(sc + (size_t)b * 6 * D + col); *(LAS f32x4*)(vB + col) = g * (1.f + s); *(LAS f32x4*)(vC + col) = *(const f32x4*)(sh + (size_t)b * 6 * D + col); } }
        __syncthreads();
        f32x4 xr[8]; u32x2 xrb[8], yr[8], yr2[8]; float w1n = 0.f, w2n = 0.f;
#define RP_LOAD(rr_) do { const size_t row_ = (size_t)blk * 64 + F.wave * 8 + (((rr_) + blk) & 7);   \
            if (XIN_BF) { _Pragma("unroll") for (int j = 0; j < 8; ++j) xrb[j] = __builtin_nontemporal_load((const u32x2*)((const bf16_t*)xin + row_ * D + 256 * j + 4 * F.lane)); } \
            else { _Pragma("unroll") for (int j = 0; j < 8; ++j) xr[j] = __builtin_nontemporal_load((const f32x4*)(xin + row_ * D + 256 * j + 4 * F.lane)); } \
            if (YMODE == 1) { _Pragma("unroll") for (int j = 0; j < 8; ++j) yr[j] = __builtin_nontemporal_load((const u32x2*)(ybuf + row_ * D + 256 * j + 4 * F.lane)); } \
            if (YMODE == 2) { const uint4 ti = tok_in[row_]; \
                const int e1 = (int)(ti.x >> 16), k1 = (int)(ti.x & 0xffffu), e2 = (int)(ti.y >> 16), k2 = (int)(ti.y & 0xffffu); \
                const size_t r1 = (size_t)cumt[e1] * 256 + k1, r2 = (size_t)cumt[e2] * 256 + k2; w1n = __uint_as_float(ti.z); w2n = __uint_as_float(ti.w); \
                _Pragma("unroll") for (int j = 0; j < 8; ++j) { yr[j] = __builtin_nontemporal_load((const u32x2*)(ybuf + r1 * D + 256 * j + 4 * F.lane)); yr2[j] = __builtin_nontemporal_load((const u32x2*)(ybuf + r2 * D + 256 * j + 4 * F.lane)); } } } while (0)
        RP_LOAD(0);
#pragma unroll 1
        for (int rr = 0; rr < 8; ++rr) {
            const int rl = F.wave * 8 + ((rr + blk) & 7); const size_t row = (size_t)blk * 64 + rl;
            asm volatile("" ::: "memory");
            f32x4 x[8];
#pragma unroll
            for (int j = 0; j < 8; ++j) x[j] = XIN_BF ? (f32x4){bflo(xrb[j].x), bfhi(xrb[j].x), bflo(xrb[j].y), bfhi(xrb[j].y)} : xr[j];
            f32x4 y[8];
            if (YMODE == 1) {
#pragma unroll
                for (int j = 0; j < 8; ++j) y[j] = (f32x4){bflo(yr[j].x), bfhi(yr[j].x), bflo(yr[j].y), bfhi(yr[j].y)};
            }
            if (YMODE == 2) {
#pragma unroll
                for (int j = 0; j < 8; ++j) y[j] = (f32x4){bflo(yr[j].x), bfhi(yr[j].x), bflo(yr[j].y), bfhi(yr[j].y)} * w1n + (f32x4){bflo(yr2[j].x), bfhi(yr2[j].x), bflo(yr2[j].y), bfhi(yr2[j].y)} * w2n;
            }
            if (rr < 7) RP_LOAD(rr + 1);
            if (YMODE) {
                float ss = 0.f;
#pragma unroll
                for (int j = 0; j < 8; ++j) ss += (y[j][0] * y[j][0] + y[j][1] * y[j][1]) + (y[j][2] * y[j][2] + y[j][3] * y[j][3]);
                const float r = 1.f / sqrtf(wave_sum(ss) * (1.f / D) + RMS_EPS);
#pragma unroll
                for (int j = 0; j < 8; ++j) { x[j] += *(const LAS f32x4*)(vA + 256 * j + 4 * F.lane) * (y[j] * r);
                    if (XOUT_BF) { u32x2 w; w.x = cvtpk(x[j][0], x[j][1]); w.y = cvtpk(x[j][2], x[j][3]); *(u32x2*)((bf16_t*)xout + row * D + 256 * j + 4 * F.lane) = w; }
                    else __builtin_nontemporal_store(x[j], (f32x4*)(xout + row * D + 256 * j + 4 * F.lane)); }
            }
            if (NORM_OUT) {
                float ss = 0.f;
#pragma unroll
                for (int j = 0; j < 8; ++j) ss += (x[j][0] * x[j][0] + x[j][1] * x[j][1]) + (x[j][2] * x[j][2] + x[j][3] * x[j][3]);
                const float r = 1.f / sqrtf(wave_sum(ss) * (1.f / D) + RMS_EPS);
#pragma unroll
                for (int j = 0; j < 8; ++j) x[j] = (x[j] * r) * *(const LAS f32x4*)(vB + 256 * j + 4 * F.lane) + *(const LAS f32x4*)(vC + 256 * j + 4 * F.lane);
                if (XN8) {
                    float am = 0.f;
#pragma unroll
                    for (int j = 0; j < 8; ++j) am = fmaxf(fmaxf(am, fmaxf(fabsf(x[j][0]), fabsf(x[j][1]))), fmaxf(fabsf(x[j][2]), fabsf(x[j][3])));
                    am = wave_max(am);
                    const float inv = am > 0.f ? 127.f / am : 0.f;
                    if (F.lane == 0) { rowmax[row] = am; if (EXTRA == 2) route[384 + rl] = am; }
#pragma unroll
                    for (int j = 0; j < 8; ++j) *(unsigned*)((unsigned char*)XN + row * D + 256 * j + 4 * F.lane) = pack_i8x4(x[j][0] * inv, x[j][1] * inv, x[j][2] * inv, x[j][3] * inv);
                } else {
#pragma unroll
                    for (int j = 0; j < 8; ++j) { u32x2 w; w.x = cvtpk(x[j][0], x[j][1]); w.y = cvtpk(x[j][2], x[j][3]); *(u32x2*)(XN + row * D + 256 * j + 4 * F.lane) = w; }
                }
                if (EXTRA) {
                    float d8[8];
#pragma unroll
                    for (int e = 0; e < 8; ++e) { float s = 0.f;
#pragma unroll
                        for (int j = 0; j < 8; ++j) { const f32x4 w = *(const LAS f32x4*)(we + e * D + 256 * j + 4 * F.lane); s += (x[j][0] * w[0] + x[j][1] * w[1]) + (x[j][2] * w[2] + x[j][3] * w[3]); }
                        d8[e] = wave_sum(s); asm volatile("" ::: "memory"); }
                    if (EXTRA == 1) {
                        float v = 0.f;
#pragma unroll
                        for (int e = 0; e < 8; ++e) v = (F.lane == e) ? d8[e] : v;
                        if (F.lane < 8) { const float bb = (F.lane < 4) ? bi[F.lane] : bfg[F.lane - 4]; const float z = 15.f * tanhf((v + bb) * (1.f / 15.f));
                            const float o = (F.lane < 4) ? z : (fminf(z, 0.f) - log1pf(expf(-fabsf(z)))); gates_out[row * 8 + F.lane] = o; }
                    } else {
                        int e1 = 0; float v1 = d8[0];
#pragma unroll
                        for (int e = 1; e < 8; ++e) if (d8[e] > v1) { v1 = d8[e]; e1 = e; }
                        int e2 = -1; float v2 = -3.0e38f;
#pragma unroll
                        for (int e = 0; e < 8; ++e) if (e != e1 && d8[e] > v2) { v2 = d8[e]; e2 = e; }
                        const float w1 = 1.f / (1.f + expf(v2 - v1));
                        if (F.lane == 0) { routei[rl * 4 + 0] = e1; routei[rl * 4 + 1] = e2; route[rl * 4 + 2] = w1; route[rl * 4 + 3] = 1.f - w1; }
                    }
                }
            }
        }
#undef RP_LOAD
        if (EXTRA == 2) {
            __syncthreads();
            if (F.tid < NE) { const int e = F.tid; int c = 0;
                for (int r = 0; r < 64; ++r) c += (routei[r * 4] == e) + (routei[r * 4 + 1] == e);
                int base = (int)__hip_atomic_fetch_add(cntw + e, (unsigned)c, __ATOMIC_RELAXED, __HIP_MEMORY_SCOPE_AGENT);
                float* rms = rowmax + (WS_RMSLOT - WS_ROWMAX) / 4;
                for (int r = 0; r < 64; ++r) { if (routei[r * 4] == e) { idx_out[e * ECAP + base] = blk * 64 + r; rms[e * ECAP + base] = route[384 + r]; routei[256 + r * 2] = base; ++base; }
                                               if (routei[r * 4 + 1] == e) { idx_out[e * ECAP + base] = blk * 64 + r; rms[e * ECAP + base] = route[384 + r]; routei[256 + r * 2 + 1] = base; ++base; } } }
            __syncthreads();
            if (F.tid < 64) { const int r = F.tid; uint4 ti; ti.x = ((unsigned)routei[r * 4] << 16) | (unsigned)routei[256 + r * 2]; ti.y = ((unsigned)routei[r * 4 + 1] << 16) | (unsigned)routei[256 + r * 2 + 1];
                ti.z = __float_as_uint(route[r * 4 + 2]); ti.w = __float_as_uint(route[r * 4 + 3]); tok_out[(size_t)blk * 64 + r] = ti; }
        }
    }
    __syncthreads();
}

namespace att {
constexpr int KROW = 144, VROW = 520, K_OFF = 0, V_OFF = 256 * KROW, KM_OFF = V_OFF + 64 * VROW;
constexpr float C2 = 0.125f * 1.4426950408889634f, NEG = -3.0e38f;
__device__ __forceinline__ void stage_kv(LAS unsigned char* lds, const bf16_t* kcol, const bf16_t* vcol, size_t grow0, int nk, int kc0, int tid) {
    for (int c = tid; c < nk * 8; c += NTHR) { const int key = c >> 3, part = c & 7;
        const u32x4 v = *(const u32x4*)(kcol + (grow0 + key) * NIN + part * 8);
        *(LAS u32x4*)(lds + K_OFF + (kc0 + key) * KROW + part * 16) = v; }
    const int np = nk >> 1;
    for (int it = tid; it < np * 8; it += NTHR) { const int kp = it % np, dp = it / np;
        const u32x4 a = *(const u32x4*)(vcol + (grow0 + 2 * kp) * NIN + dp * 8), b = *(const u32x4*)(vcol + (grow0 + 2 * kp + 1) * NIN + dp * 8);
        LAS unsigned char* dst = lds + V_OFF + (dp * 8) * VROW + (kc0 + 2 * kp) * 2;
        *(LAS unsigned*)(dst + 0 * VROW) = (a.x & 0xffffu) | (b.x << 16); *(LAS unsigned*)(dst + 1 * VROW) = (a.x >> 16) | (b.x & 0xffff0000u);
        *(LAS unsigned*)(dst + 2 * VROW) = (a.y & 0xffffu) | (b.y << 16); *(LAS unsigned*)(dst + 3 * VROW) = (a.y >> 16) | (b.y & 0xffff0000u);
        *(LAS unsigned*)(dst + 4 * VROW) = (a.z & 0xffffu) | (b.z << 16); *(LAS unsigned*)(dst + 5 * VROW) = (a.z >> 16) | (b.z & 0xffff0000u);
        *(LAS unsigned*)(dst + 6 * VROW) = (a.w & 0xffffu) | (b.w << 16); *(LAS unsigned*)(dst + 7 * VROW) = (a.w >> 16) | (b.w & 0xffff0000u); }
}
struct KVRegs { u32x4 k[4], va[2], vb[2]; };
__device__ __forceinline__ void kv_load(KVRegs& R, const bf16_t* kcol, const bf16_t* vcol, size_t grow0, int tid) {
#pragma unroll
    for (int i = 0; i < 4; ++i) { const int c = tid + i * NTHR, key = c >> 3, part = c & 7; R.k[i] = *(const u32x4*)(kcol + (grow0 + key) * NIN + part * 8); }
#pragma unroll
    for (int i = 0; i < 2; ++i) { const int it = tid + i * NTHR, kp = it & 127, dp = it >> 7;
        R.va[i] = *(const u32x4*)(vcol + (grow0 + 2 * kp) * NIN + dp * 8); R.vb[i] = *(const u32x4*)(vcol + (grow0 + 2 * kp + 1) * NIN + dp * 8); }
}
__device__ __forceinline__ void kv_store(LAS unsigned char* lds, const KVRegs& R, int tid) {
#pragma unroll
    for (int i = 0; i < 4; ++i) { const int c = tid + i * NTHR, key = c >> 3, part = c & 7; *(LAS u32x4*)(lds + K_OFF + key * KROW + part * 16) = R.k[i]; }
#pragma unroll
    for (int i = 0; i < 2; ++i) { const int it = tid + i * NTHR, kp = it & 127, dp = it >> 7; const u32x4 a = R.va[i], b = R.vb[i];
        LAS unsigned char* dst = lds + V_OFF + (dp * 8) * VROW + (2 * kp) * 2;
        *(LAS unsigned*)(dst + 0 * VROW) = (a.x & 0xffffu) | (b.x << 16); *(LAS unsigned*)(dst + 1 * VROW) = (a.x >> 16) | (b.x & 0xffff0000u);
        *(LAS unsigned*)(dst + 2 * VROW) = (a.y & 0xffffu) | (b.y << 16); *(LAS unsigned*)(dst + 3 * VROW) = (a.y >> 16) | (b.y & 0xffff0000u);
        *(LAS unsigned*)(dst + 4 * VROW) = (a.z & 0xffffu) | (b.z << 16); *(LAS unsigned*)(dst + 5 * VROW) = (a.z >> 16) | (b.z & 0xffff0000u);
        *(LAS unsigned*)(dst + 6 * VROW) = (a.w & 0xffffu) | (b.w << 16); *(LAS unsigned*)(dst + 7 * VROW) = (a.w >> 16) | (b.w & 0xffff0000u); }
}
struct State { f32x16 o0, o1, negm; float m, l; };
constexpr float THR = 5.f, M0 = -1000.f;
__device__ __forceinline__ void init(State& st) {
#pragma unroll
    for (int r = 0; r < 16; ++r) { st.o0[r] = 0.f; st.o1[r] = 0.f; st.negm[r] = -M0; }
    st.m = M0; st.l = 0.f;
}
__device__ __forceinline__ float xhalf_max(float v) { auto rr = __builtin_amdgcn_permlane32_swap(__float_as_uint(v), __float_as_uint(v), false, false); return fmaxf(__uint_as_float(rr[0]), __uint_as_float(rr[1])); }
__device__ __forceinline__ float xhalf_sum(float v) { auto rr = __builtin_amdgcn_permlane32_swap(__float_as_uint(v), __float_as_uint(v), false, false); return __uint_as_float(rr[0]) + __uint_as_float(rr[1]); }
__device__ __forceinline__ void block_mask(State& st, bool lane_ok) {
#pragma unroll
    for (int r = 0; r < 16; ++r) st.negm[r] = lane_ok ? -st.m : NEG;
}
template <int MODE>
__device__ __forceinline__ void tile(LAS unsigned char* lds, int kt, const bf16x8 (&qf)[4], State& st, int lane) {
    const int r32 = lane & 31, h = lane >> 5;
    f32x16 S;
    if (MODE == 3) S = st.negm;
    else {
#pragma unroll
        for (int r = 0; r < 16; ++r) { const int ko = (r & 3) + 8 * (r >> 2) + 4 * h; const bool ok = (MODE == 1) ? (ko <= r32) : (ko > r32); S[r] = ok ? st.negm[r] : NEG; } }
    const LAS unsigned char* kp = lds + K_OFF + (kt * 32 + r32) * KROW + h * 16;
#pragma unroll
    for (int s = 0; s < 4; ++s) { const bf16x8 a = *(const LAS bf16x8*)(kp + s * 32); S = __builtin_amdgcn_mfma_f32_32x32x16_bf16(a, qf[s], S, 0, 0, 0); }
    float tmax;
    asm volatile("s_nop 15\n\ts_nop 7" : "+v"(S));
    { float m0, m1, m2, m3, m4;
      asm("v_max3_f32 %0, %1, %2, %3" : "=v"(m0) : "v"(S[0]), "v"(S[1]), "v"(S[2]));    asm("v_max3_f32 %0, %1, %2, %3" : "=v"(m1) : "v"(S[3]), "v"(S[4]), "v"(S[5]));
      asm("v_max3_f32 %0, %1, %2, %3" : "=v"(m2) : "v"(S[6]), "v"(S[7]), "v"(S[8]));    asm("v_max3_f32 %0, %1, %2, %3" : "=v"(m3) : "v"(S[9]), "v"(S[10]), "v"(S[11]));
      asm("v_max3_f32 %0, %1, %2, %3" : "=v"(m4) : "v"(S[12]), "v"(S[13]), "v"(S[14])); asm("v_max3_f32 %0, %1, %2, %3" : "=v"(m0) : "v"(m0), "v"(m1), "v"(S[15]));
      asm("v_max3_f32 %0, %1, %2, %3" : "=v"(m2) : "v"(m2), "v"(m3), "v"(m4));          asm("v_max_f32 %0, %1, %2" : "=v"(tmax) : "v"(m0), "v"(m2)); }
    tmax = xhalf_max(tmax);
    if (__any(tmax > THR)) {
        const float d = tmax > THR ? tmax : 0.f, alpha = __builtin_amdgcn_exp2f(-d);
        st.m += d; st.l *= alpha;
#pragma unroll
        for (int r = 0; r < 16; ++r) { S[r] -= d; st.negm[r] -= d; st.o0[r] *= alpha; st.o1[r] *= alpha; }
    }
    float ls0 = 0.f, ls1 = 0.f;
#pragma unroll
    for (int r = 0; r < 16; r += 2) { const float p0 = __builtin_amdgcn_exp2f(S[r]), p1 = __builtin_amdgcn_exp2f(S[r + 1]); S[r] = p0; S[r + 1] = p1; ls0 += p0; ls1 += p1; }
    st.l += ls0 + ls1;
    const LAS unsigned char* vp = lds + V_OFF + r32 * VROW + kt * 64 + h * 8;
#pragma unroll
    for (int s = 0; s < 2; ++s) {
        u32x4 pw; pw.x = cvtpk(S[8 * s + 0], S[8 * s + 1]); pw.y = cvtpk(S[8 * s + 2], S[8 * s + 3]); pw.z = cvtpk(S[8 * s + 4], S[8 * s + 5]); pw.w = cvtpk(S[8 * s + 6], S[8 * s + 7]);
        const bf16x8 pf = __builtin_bit_cast(bf16x8, pw);
        { const u32x2 lo = *(const LAS u32x2*)(vp + s * 32), hi = *(const LAS u32x2*)(vp + s * 32 + 16); u32x4 aw; aw.x = lo.x; aw.y = lo.y; aw.z = hi.x; aw.w = hi.y;
          st.o0 = __builtin_amdgcn_mfma_f32_32x32x16_bf16(__builtin_bit_cast(bf16x8, aw), pf, st.o0, 0, 0, 0); }
        { const u32x2 lo = *(const LAS u32x2*)(vp + 32 * VROW + s * 32), hi = *(const LAS u32x2*)(vp + 32 * VROW + s * 32 + 16); u32x4 aw; aw.x = lo.x; aw.y = lo.y; aw.z = hi.x; aw.w = hi.y;
          st.o1 = __builtin_amdgcn_mfma_f32_32x32x16_bf16(__builtin_bit_cast(bf16x8, aw), pf, st.o1, 0, 0, 0); }
    }
}
constexpr float YSC = 16.f;
__device__ __forceinline__ void store_out(const State& st, float inv, unsigned char* orow  , int lane) {
    const int h = lane >> 5;
#pragma unroll
    for (int g = 0; g < 4; ++g) {
        *(unsigned*)(orow + 8 * g + 4 * h) = pg8::pack_fp8x4(st.o0[4 * g] * inv, st.o0[4 * g + 1] * inv, st.o0[4 * g + 2] * inv, st.o0[4 * g + 3] * inv);
        *(unsigned*)(orow + 32 + 8 * g + 4 * h) = pg8::pack_fp8x4(st.o1[4 * g] * inv, st.o1[4 * g + 1] * inv, st.o1[4 * g + 2] * inv, st.o1[4 * g + 3] * inv); }
}
__device__ __forceinline__ void moba_unit(Frame& F, const bf16_t* proj, const float* kmean, unsigned char* Y, int b, int h, int j) {
    LAS unsigned char* lds = F.lds; const int lane = F.lane, r32 = lane & 31, hh = lane >> 5, w = F.wave;
    const size_t rb = (size_t)b * SEQ; const int t = j * 256 + w * 32 + r32;
    bf16x8 qf[4];
    { const bf16_t* qrow = proj + (rb + t) * NIN + C_MQ + h * 64 + hh * 8;
#pragma unroll
      for (int s = 0; s < 4; ++s) qf[s] = *(const bf16x8*)(qrow + s * 16); }
    LBAR();
    LAS float* km = (LAS float*)(lds + KM_OFF);
    if (F.tid < j * 64) km[F.tid] = kmean[(size_t)(b * 8 + (F.tid >> 6)) * 512 + h * 64 + (F.tid & 63)];
    LBAR();
    unsigned sel;
    if (j <= 3) sel = (1u << j) - 1u;
    else {
        float g[7];
#pragma unroll
        for (int n = 0; n < 7; ++n) { g[n] = NEG;
            if (n < j) { float a = 0.f;
#pragma unroll
                for (int s = 0; s < 4; ++s)
#pragma unroll
                    for (int jj = 0; jj < 8; ++jj) a += bf1((bf16_t)qf[s][jj]) * km[n * 64 + 16 * s + 8 * hh + jj];
                a += __shfl_xor(a, 32); g[n] = a; } }
        sel = 0u;
#pragma unroll
        for (int r = 0; r < 3; ++r) { float best = NEG; int bi = 0;
#pragma unroll
            for (int n = 0; n < 7; ++n) if (n < j && !((sel >> n) & 1u) && g[n] > best) { best = g[n]; bi = n; }
            sel |= 1u << bi; }
    }
    State st; init(st);
    const bf16_t* kcol = proj + C_MK + h * 64; const bf16_t* vcol = proj + C_MV + h * 64;
    KVRegs R; kv_load(R, kcol, vcol, rb, F.tid);
    for (int n = 0; n <= j; ++n) {
        LBAR();
        kv_store(lds, R, F.tid);
        if (n < j) kv_load(R, kcol, vcol, rb + (size_t)(n + 1) * 256, F.tid);
        LBAR();
        if (n < j) { const bool ok = (sel >> n) & 1u;
            if (__any(ok)) { block_mask(st, ok); for (int kt = 0; kt < 8; ++kt) tile<3>(lds, kt, qf, st, lane); } }
        else { block_mask(st, true); for (int kt = 0; kt < w; ++kt) tile<3>(lds, kt, qf, st, lane);
               tile<1>(lds, w, qf, st, lane); }
    }
    const float lt = xhalf_sum(st.l);
    store_out(st, YSC / lt, Y + (rb + t) * D + h * 64, lane);
}
__device__ __forceinline__ void swa_unit(Frame& F, const bf16_t* proj, const float* sinks, unsigned char* Y, int b, int kvh, int qb) {
    LAS unsigned char* lds = F.lds; int lane = F.lane; asm volatile("" : "+v"(lane));
    const int r32 = lane & 31, hh = lane >> 5, w = F.wave, hq = kvh * 8 + w;
    const size_t rb = (size_t)b * SEQ;
    const bf16_t* kcol = proj + C_SK + kvh * 64; const bf16_t* vcol = proj + C_SV + kvh * 64;
    LBAR();
    if (qb > 0) stage_kv(lds, kcol, vcol, rb + (size_t)qb * 128 - 128, 256, 0, F.tid);
    else        stage_kv(lds, kcol, vcol, rb, 128, 128, F.tid);
    LBAR();
    const float sk = sinks[hq] * 1.4426950408889634f;
    for (int sb = 0; sb < 4; ++sb) {
        const int t = qb * 128 + sb * 32 + r32;
        bf16x8 qf[4];
        { const bf16_t* qrow = proj + (rb + t) * NIN + C_SQ + hq * 64 + hh * 8;
#pragma unroll
          for (int s = 0; s < 4; ++s) qf[s] = *(const bf16x8*)(qrow + s * 16); }
        State st; init(st);
        int kt0 = sb; if (qb == 0 && kt0 < 4) kt0 = 4;
        if (kt0 == sb) tile<2>(lds, sb, qf, st, lane);
        for (int kt = (kt0 > sb + 1 ? kt0 : sb + 1); kt < sb + 4; ++kt) tile<3>(lds, kt, qf, st, lane);
        tile<1>(lds, sb + 4, qf, st, lane);
        const float lt = xhalf_sum(st.l) + __builtin_amdgcn_exp2f(sk - st.m);
        store_out(st, YSC / lt, Y + (rb + t) * D + 1024 + hq * 64, lane);
    }
}
}

#include <hip/hip_bf16.h>
#include <cmath>
namespace mob {
using bf16=__hip_bfloat16;
using bf16x8=__attribute__((ext_vector_type(8)))short;
using s16x4=__attribute__((ext_vector_type(4)))short;
using f32x16=__attribute__((ext_vector_type(16)))float;
using u32x4=__attribute__((ext_vector_type(4)))unsigned;
constexpr int SEQ=2048,D=64,DM=4864;
constexpr int NW=8,QBLK=32,QB=QBLK*NW,KVBLK=64,NQB=SEQ/QB;
__device__ __forceinline__ int crow(int r,int hi){return (r&3)+8*(r>>2)+4*hi;}
#define SBAR() __builtin_amdgcn_sched_barrier(0)
__device__ __forceinline__ void cmask(f32x16&p0,f32x16&p1,int jb,int qrel,int hi){
  const float NEG=-INFINITY; int kb=64*jb+4*hi;
  #pragma unroll
  for(int r=0;r<16;++r){int kv=kb+(r&3)+8*(r>>2); if(kv>qrel)p0[r]=NEG; if(kv+32>qrel)p1[r]=NEG;}
}

constexpr int NSLOT=3, SLOTB=8192;
constexpr int LDS_K=0, LDS_V=NSLOT*SLOTB, LDS_WS=2*NSLOT*SLOTB, LDS_OST=LDS_WS+NW*64*4, LDS_BYTES=LDS_OST+NW*4096, LDS_KM=LDS_BYTES  ;
constexpr float NEGB=-3.0e38f, YSC=16.f;
constexpr float C2=0.125f*1.4426950408889634f;
__device__ __forceinline__ void glds16(const void*sbase,unsigned voff,unsigned lds_dst){unsigned keep;
  asm volatile("s_mov_b32 %0, m0\n\ts_mov_b32 m0, %2\n\ts_nop 0\n\tglobal_load_lds_dwordx4 %1, %3\n\ts_mov_b32 m0, %0":"=&s"(keep):"v"(voff),"s"(lds_dst),"s"(sbase):"memory");}
__device__ __forceinline__ float max3f(float a,float b,float c){float r;asm("v_max3_f32 %0, %1, %2, %3":"=v"(r):"v"(a),"v"(b),"v"(c));return r;}
__device__ __forceinline__ float max2f(float a,float b){float r;asm("v_max_f32_e32 %0, %1, %2":"=v"(r):"v"(a),"v"(b));return r;}
__device__ __forceinline__ float fadd_s(float a,float b){float r;asm("v_add_f32_e32 %0, %1, %2":"=v"(r):"v"(a),"v"(b));return r;}
__device__ __forceinline__ float fsub_s(float a,float b){float r;asm("v_sub_f32_e32 %0, %1, %2":"=v"(r):"v"(a),"v"(b));return r;}
typedef float f32x2_t __attribute__((ext_vector_type(2))); typedef __bf16 bf16x2_t __attribute__((ext_vector_type(2)));
__device__ __forceinline__ unsigned cvtpk_s(float lo,float hi){f32x2_t v={lo,hi};bf16x2_t b=__builtin_convertvector(v,bf16x2_t);return __builtin_bit_cast(unsigned,b);}
#define WAIT_BAR(N) asm volatile("s_waitcnt vmcnt(" #N ") lgkmcnt(0)\n\ts_barrier":::"memory")

__device__ __forceinline__ void qkt(f32x16&p0,f32x16&p1,const char*Kslot,const bf16x8*qr,const f32x16&negm,int r32,int hi){
  const char*kb=Kslot+hi*1024+r32*16;
  #pragma unroll
  for(int d0=0;d0<4;++d0){
    const bf16x8 b0=*reinterpret_cast<const bf16x8*>(kb+d0*2048);
    const bf16x8 b1=*reinterpret_cast<const bf16x8*>(kb+d0*2048+512);
    if(d0==0){p0=__builtin_amdgcn_mfma_f32_32x32x16_bf16(b0,qr[0],negm,0,0,0);p1=__builtin_amdgcn_mfma_f32_32x32x16_bf16(b1,qr[0],negm,0,0,0);}
    else{p0=__builtin_amdgcn_mfma_f32_32x32x16_bf16(b0,qr[d0],p0,0,0,0);p1=__builtin_amdgcn_mfma_f32_32x32x16_bf16(b1,qr[d0],p1,0,0,0);}}
}
typedef __attribute__((address_space(3))) const char* lds_cptr;
typedef short v4i16_t __attribute__((ext_vector_type(4)));
__device__ __forceinline__ void kload8(bf16x8*kf,lds_cptr kp){
  kf[0]=*(const __attribute__((address_space(3))) bf16x8*)(kp);      kf[1]=*(const __attribute__((address_space(3))) bf16x8*)(kp+512);
  kf[2]=*(const __attribute__((address_space(3))) bf16x8*)(kp+2048); kf[3]=*(const __attribute__((address_space(3))) bf16x8*)(kp+2560);
  kf[4]=*(const __attribute__((address_space(3))) bf16x8*)(kp+4096); kf[5]=*(const __attribute__((address_space(3))) bf16x8*)(kp+4608);
  kf[6]=*(const __attribute__((address_space(3))) bf16x8*)(kp+6144); kf[7]=*(const __attribute__((address_space(3))) bf16x8*)(kp+6656);
}
__device__ __forceinline__ void kload2(bf16x8*kf,lds_cptr kp,int j){ kf[2*j]=*(const __attribute__((address_space(3))) bf16x8*)(kp+j*2048); kf[2*j+1]=*(const __attribute__((address_space(3))) bf16x8*)(kp+j*2048+512); }
__device__ __forceinline__ s16x4 vtr(lds_cptr p){ return __builtin_bit_cast(s16x4,__builtin_amdgcn_ds_read_tr16_b64_v4i16((__attribute__((address_space(3))) v4i16_t*)p)); }
__device__ __forceinline__ float rowmax(const f32x16&p0,const f32x16&p1){
  float a=max3f(p0[0],p0[1],p1[0]),b=max3f(p0[2],p0[3],p1[1]);a=max3f(a,p1[2],p1[3]);
  #pragma unroll
  for(int r=4;r<16;r+=4){a=max3f(a,p0[r],p0[r+1]);b=max3f(b,p0[r+2],p0[r+3]);a=max3f(a,p1[r],p1[r+1]);b=max3f(b,p1[r+2],p1[r+3]);}
  const float m=max2f(a,b);
  auto rr=__builtin_amdgcn_permlane32_swap(__float_as_uint(m),__float_as_uint(m),false,false);
  return max2f(__uint_as_float(rr[0]),__uint_as_float(rr[1]));
}
__device__ __forceinline__ void pv(f32x16*o,int vb,bf16x8 pa0,bf16x8 pa1,bf16x8 pa2,bf16x8 pa3){
  #pragma unroll
  for(int d0=0;d0<2;++d0){s16x4 lo[4],hi[4];
    #pragma unroll
    for(int ks=0;ks<4;++ks){
      asm volatile("ds_read_b64_tr_b16 %0,%1 offset:%c2":"=&v"(lo[ks]):"v"(vb),"i"(d0*4096+ks*1024):"memory");
      asm volatile("ds_read_b64_tr_b16 %0,%1 offset:%c2":"=&v"(hi[ks]):"v"(vb),"i"(d0*4096+ks*1024+512):"memory");}
    asm volatile("s_waitcnt lgkmcnt(0)":::"memory");SBAR();
    #define PK(k) (bf16x8){lo[k][0],lo[k][1],lo[k][2],lo[k][3],hi[k][0],hi[k][1],hi[k][2],hi[k][3]}
    o[d0]=__builtin_amdgcn_mfma_f32_32x32x16_bf16(pa0,PK(0),o[d0],0,0,0);
    o[d0]=__builtin_amdgcn_mfma_f32_32x32x16_bf16(pa1,PK(1),o[d0],0,0,0);
    o[d0]=__builtin_amdgcn_mfma_f32_32x32x16_bf16(pa2,PK(2),o[d0],0,0,0);
    o[d0]=__builtin_amdgcn_mfma_f32_32x32x16_bf16(pa3,PK(3),o[d0],0,0,0);
    #undef PK
  }
}

#ifndef ATTN_STORE16
#define ATTN_STORE16(p,v) (*(u32x4*)(p)=(v))
#endif
template<int THRL> __device__ __forceinline__ void attn_unit(int b,int h,int qb,const bf16*Q,const bf16*__restrict__ K,const bf16*__restrict__ V,unsigned char*Y,const float*kmean,char*shm){
  const int tid=threadIdx.x,lane=tid&63,r32=lane&31,hi=lane>>5; const int wid=__builtin_amdgcn_readfirstlane(tid>>6);
  const long rowbase=(long)b*SEQ; const int q0=qb*QB;
  const bf16*Qw=Q+(rowbase+q0+wid*QBLK)*DM+h*D;
  const bf16*Kh=K+rowbase*DM+h*D,*Vh=V+rowbase*DM+h*D;
  const unsigned lds0=(unsigned)(uintptr_t)shm;
  float*wsf=(float*)(shm+LDS_WS)+wid*64;
  const unsigned koff=(unsigned)((lane*DM+wid*8)*2);
  const unsigned voff=(unsigned)(((16*(wid&3)+(lane>>2))*DM+(wid>>2)*32+(lane&3)*8)*2);
  const unsigned kdst=lds0+LDS_K+wid*1024, vdst=lds0+LDS_V+wid*1024;
  #define DMA_K(t,slot) glds16(Kh+(long)(t)*KVBLK*DM,koff,(unsigned)__builtin_amdgcn_readfirstlane(kdst+(slot)))
  #define DMA_V(t,slot) glds16(Vh+(long)(t)*KVBLK*DM,voff,(unsigned)__builtin_amdgcn_readfirstlane(vdst+(slot)))
  const char*Kbase=shm+LDS_K; bf16x8 kf[8];
  const lds_cptr shm3=(lds_cptr)shm; const lds_cptr kp0=shm3+LDS_K+hi*1024+r32*16; const lds_cptr vp0=shm3+LDS_V+((lane>>4)&1)*32+(lane&3)*8+(4*hi+((lane&15)>>2))*64;
  const int NT=(q0+QB)/KVBLK;
  DMA_K(0,0);DMA_V(0,0);DMA_K(1,SLOTB);
  bf16x8 qr[4];
  #pragma unroll
  for(int d0=0;d0<4;++d0)qr[d0]=*reinterpret_cast<const bf16x8*>(&Qw[(long)r32*DM+d0*16+hi*8]);
  unsigned sel;
  if(qb<=3) sel=(1u<<qb)-1u;
  else{
    float*km=(float*)(shm+LDS_KM);
    if(tid<qb*64) km[tid]=kmean[(size_t)(b*8+(tid>>6))*512+h*64+(tid&63)];
    asm volatile("s_waitcnt vmcnt(0) lgkmcnt(0)\n\ts_barrier":::"memory");
    float g[7];
    #pragma unroll
    for(int n=0;n<7;++n){ g[n]=NEGB;
      if(n<qb){ float a=0.f;
        #pragma unroll
        for(int s=0;s<4;++s)
          #pragma unroll
          for(int jj=0;jj<8;++jj) a+=__uint_as_float((unsigned)(unsigned short)qr[s][jj]<<16)*km[n*64+16*s+8*hi+jj];
        a+=__shfl_xor(a,32); g[n]=a; } }
    sel=0u;
    #pragma unroll
    for(int r=0;r<3;++r){ float best=NEGB; int bi=0;
      #pragma unroll
      for(int n=0;n<7;++n) if(n<qb&&!((sel>>n)&1u)&&g[n]>best){best=g[n];bi=n;}
      sel|=1u<<bi; }
  }
  #define OKB(n) (((n)>=qb)||(((sel>>(n))&1u)!=0u))
  float mhat=0.f,l_reg=0.f;f32x16 o[2];o[0]=f32x16{};o[1]=f32x16{};f32x16 negm;
  { const bool ok0=OKB(0);
    #pragma unroll
    for(int r=0;r<16;++r)negm[r]=ok0?0.f:NEGB; }
  asm volatile("":"+v"(negm));
  const int qrel=wid*QBLK+r32;
  #define CMASK(P0,P1,t) do{int jb_=(t)-(NT-4); if(jb_>=0)cmask(P0,P1,jb_,qrel,hi);}while(0)
  bool resc=false;
  #define START(P0,P1) do{ const float rm=rowmax(P0,P1); resc=false; \
    { const bool ok0_=OKB(0); const float dl=ok0_?rm:0.f; mhat=fadd_s(mhat,dl); \
      _Pragma("unroll") for(int r=0;r<16;++r){P0[r]=fsub_s(P0[r],dl);P1[r]=fsub_s(P1[r],dl);} \
      _Pragma("unroll") for(int r=0;r<16;++r)negm[r]=ok0_?-mhat:NEGB; asm volatile("":"+v"(negm)); } \
    _Pragma("unroll") for(int r=0;r<16;++r)P0[r]=__builtin_amdgcn_exp2f(P0[r]); }while(0)
  #define RESC() do{ if(resc){ asm volatile("s_waitcnt lgkmcnt(0)":::"memory"); \
      _Pragma("unroll") for(int d_=0;d_<2;++d_) _Pragma("unroll") for(int r=0;r<16;++r)o[d_][r]*=wsf[crow(r,hi)]; } }while(0)
  f32x16 pA0,pA1,pB0,pB1;
  int sl_prev=0,sl_cur=0,sl_next=SLOTB;
  #define ROT() do{sl_prev=sl_cur;sl_cur=sl_next;sl_next=(sl_next==(NSLOT-1)*SLOTB)?0:sl_next+SLOTB;}while(0)
  DMA_K(2,2*SLOTB);
  WAIT_BAR(3);
  qkt(pA0,pA1,Kbase,qr,negm,r32,hi);asm volatile("s_nop 15\n\ts_nop 7":"+v"(pA0),"+v"(pA1));CMASK(pA0,pA1,0);
  START(pA0,pA1);
  _Pragma("unroll") for(int r=0;r<16;++r)pA1[r]=__builtin_amdgcn_exp2f(pA1[r]);
  WAIT_BAR(0);
  DMA_K(3,0);DMA_V(1,SLOTB);
  ROT();
  kload8(kf,kp0+sl_cur);
  WAIT_BAR(2);
  s16x4 vlo[8],vhi[8]; u32x4 pw0,pw1,pw2,pw3;
  #define PKW(P,B) cvtpk_s(P[B],P[B+1])
  #define PAF(k) __builtin_bit_cast(bf16x8,pw##k)
  #define VFR(i) (bf16x8){vlo[i][0],vlo[i][1],vlo[i][2],vlo[i][3],vhi[i][0],vhi[i][1],vhi[i][2],vhi[i][3]}
  #define PIN(x) asm volatile("":"+v"(x))
  #define MX3(a,b,c) __builtin_fmaxf(__builtin_fmaxf((a),(b)),(c))
  #define GAPA(MF,A0,A1,A2,A3,W0,W1,PW) do{ MF; sacc+=A0; sacc+=A1; sacc+=A2; sacc+=A3; PIN(sacc); W0; W1; PIN(PW); SBAR(); }while(0)
  #define EX(v) __builtin_amdgcn_exp2f(v)
  #define GAPB(MF,X,B) do{ MF; X[B]=EX(X[B]); X[B+1]=EX(X[B+1]); X[B+2]=EX(X[B+2]); X[B+3]=EX(X[B+3]); PIN(X); SBAR(); }while(0)
  #define VRD(i) do{ vlo[i]=vtr(vp_+(((i)>>2)*4096+((i)&3)*1024)); vhi[i]=vtr(vp_+(((i)>>2)*4096+((i)&3)*1024+512)); }while(0)
  #define KRD(G,j) do{ if(G){ kload2(kf,kp0+sl_next,j); SBAR(); } }while(0)
  #define STEP(C0,C1,P0,P1,t,GK,GV,GL) do{ SBAR(); \
    const lds_cptr vp_=vp0+sl_prev; \
    VRD(0); SBAR(); float sacc=(P0[0]+P0[1]); \
    GAPA(C0=__builtin_amdgcn_mfma_f32_32x32x16_bf16(kf[0],qr[0],negm,0,0,0), P0[2],P0[3],P0[4],P0[5],     pw0[0]=PKW(P0,0), pw0[1]=PKW(P0,2), pw0); \
    VRD(4); SBAR(); GAPA(C1=__builtin_amdgcn_mfma_f32_32x32x16_bf16(kf[1],qr[0],negm,0,0,0), P0[6],P0[7],P0[8],P0[9],     pw0[2]=PKW(P0,4), pw0[3]=PKW(P0,6), pw0); \
    VRD(1); SBAR(); GAPA(C0=__builtin_amdgcn_mfma_f32_32x32x16_bf16(kf[2],qr[1],C0,0,0,0),   P0[10],P0[11],P0[12],P0[13], pw1[0]=PKW(P0,8), pw1[1]=PKW(P0,10), pw1); \
    VRD(5); SBAR(); GAPA(C1=__builtin_amdgcn_mfma_f32_32x32x16_bf16(kf[3],qr[1],C1,0,0,0),   P0[14],P0[15],P1[0],P1[1],   pw1[2]=PKW(P0,12),pw1[3]=PKW(P0,14), pw1); \
    VRD(2); SBAR(); GAPA(C0=__builtin_amdgcn_mfma_f32_32x32x16_bf16(kf[4],qr[2],C0,0,0,0),   P1[2],P1[3],P1[4],P1[5],     pw2[0]=PKW(P1,0), pw2[1]=PKW(P1,2), pw2); \
    VRD(6); SBAR(); GAPA(C1=__builtin_amdgcn_mfma_f32_32x32x16_bf16(kf[5],qr[2],C1,0,0,0),   P1[6],P1[7],P1[8],P1[9],     pw2[2]=PKW(P1,4), pw2[3]=PKW(P1,6), pw2); \
    VRD(3); SBAR(); GAPA(C0=__builtin_amdgcn_mfma_f32_32x32x16_bf16(kf[6],qr[3],C0,0,0,0),   P1[10],P1[11],P1[12],P1[13], pw3[0]=PKW(P1,8), pw3[1]=PKW(P1,10), pw3); \
    VRD(7); SBAR(); GAPA(C1=__builtin_amdgcn_mfma_f32_32x32x16_bf16(kf[7],qr[3],C1,0,0,0),   P1[14],P1[15],0.f,0.f,       pw3[2]=PKW(P1,12),pw3[3]=PKW(P1,14), pw3); \
    l_reg+=sacc; \
    if(GK){DMA_K((t)+3,sl_cur);} if(GV){DMA_V((t)+1,sl_next);} \
    CMASK(C0,C1,t); \
    { float a=MX3(C0[0],C0[1],C1[0]),b=MX3(C0[2],C0[3],C1[1]); a=MX3(a,C1[2],C1[3]); \
      _Pragma("unroll") for(int r=4;r<16;r+=4){a=MX3(a,C0[r],C0[r+1]);b=MX3(b,C0[r+2],C0[r+3]);a=MX3(a,C1[r],C1[r+1]);b=MX3(b,C1[r+2],C1[r+3]);} \
      float rm=__builtin_fmaxf(a,b); { auto rr=__builtin_amdgcn_permlane32_swap(__float_as_uint(rm),__float_as_uint(rm),false,false); rm=__builtin_fmaxf(__uint_as_float(rr[0]),__uint_as_float(rr[1])); } \
      resc=false; \
      if(__builtin_expect(__any(rm>(float)THRL),0)){ const float dl=__builtin_fmaxf(rm,0.f); mhat+=dl; \
        _Pragma("unroll") for(int r=0;r<16;++r){C0[r]-=dl;C1[r]-=dl;} \
        const float f=__builtin_amdgcn_exp2f(-dl); l_reg*=f; if(hi==0)wsf[r32]=f; resc=true; } \
      if(resc||((((t)+1)&3)==0)){ const bool okn_=OKB(((t)+1)>>2);   \
        _Pragma("unroll") for(int r=0;r<16;++r)negm[r]=okn_?-mhat:NEGB; asm volatile("":"+v"(negm)); } } \
    SBAR(); \
    GAPB(o[0]=__builtin_amdgcn_mfma_f32_32x32x16_bf16(PAF(0),VFR(0),o[0],0,0,0), C0,0); \
    GAPB(o[1]=__builtin_amdgcn_mfma_f32_32x32x16_bf16(PAF(0),VFR(4),o[1],0,0,0), C0,4); \
    KRD(GL,0); GAPB(o[0]=__builtin_amdgcn_mfma_f32_32x32x16_bf16(PAF(1),VFR(1),o[0],0,0,0), C0,8); \
    KRD(GL,1); GAPB(o[1]=__builtin_amdgcn_mfma_f32_32x32x16_bf16(PAF(1),VFR(5),o[1],0,0,0), C0,12); \
    KRD(GL,2); GAPB(o[0]=__builtin_amdgcn_mfma_f32_32x32x16_bf16(PAF(2),VFR(2),o[0],0,0,0), C1,0); \
    KRD(GL,3); GAPB(o[1]=__builtin_amdgcn_mfma_f32_32x32x16_bf16(PAF(2),VFR(6),o[1],0,0,0), C1,4); \
    GAPB(o[0]=__builtin_amdgcn_mfma_f32_32x32x16_bf16(PAF(3),VFR(3),o[0],0,0,0), C1,8); \
    GAPB(o[1]=__builtin_amdgcn_mfma_f32_32x32x16_bf16(PAF(3),VFR(7),o[1],0,0,0), C1,12); \
    }while(0)
  int t=1;
  #undef CMASK
  #define CMASK(P0,P1,t) do{}while(0)
  for(;t+5<NT;t+=2){
    STEP(pB0,pB1,pA0,pA1,t,true,true,true);     WAIT_BAR(2); RESC(); ROT();
    STEP(pA0,pA1,pB0,pB1,t+1,true,true,true);   WAIT_BAR(2); RESC(); ROT();
  }
  #undef CMASK
  const int lane_b=(int)__builtin_amdgcn_mbcnt_hi(~0u,__builtin_amdgcn_mbcnt_lo(~0u,0u)), hi_b=lane_b>>5, qrel_b=wid*QBLK+(lane_b&31);
  #define CMASK(P0,P1,t) do{int jb_=(t)-(NT-4); if(jb_>=0)cmask(P0,P1,jb_,qrel_b,hi_b);}while(0)
  #define ENDW(tt) do{ if((tt)+3<NT){WAIT_BAR(2);} else if((tt)+2<NT){WAIT_BAR(1);} else {WAIT_BAR(0);} }while(0)
  for(;t+1<NT;t+=2){
    STEP(pB0,pB1,pA0,pA1,t,(t+3<NT),(t+1<NT),(t+1<NT));       ENDW(t);   RESC(); ROT();
    STEP(pA0,pA1,pB0,pB1,t+1,(t+4<NT),(t+2<NT),(t+2<NT));     ENDW(t+1); RESC(); ROT();
  }
  STEP(pB0,pB1,pA0,pA1,NT-1,false,false,false); RESC();
  { float sacc=pB0[0]+pB0[1]; _Pragma("unroll") for(int r=2;r<16;++r)sacc+=pB0[r]; _Pragma("unroll") for(int r=0;r<16;++r)sacc+=pB1[r]; l_reg+=sacc;
    pw0=(u32x4){PKW(pB0,0),PKW(pB0,2),PKW(pB0,4),PKW(pB0,6)};pw1=(u32x4){PKW(pB0,8),PKW(pB0,10),PKW(pB0,12),PKW(pB0,14)};pw2=(u32x4){PKW(pB1,0),PKW(pB1,2),PKW(pB1,4),PKW(pB1,6)};pw3=(u32x4){PKW(pB1,8),PKW(pB1,10),PKW(pB1,12),PKW(pB1,14)};
    const int vb0=(int)(lds0+LDS_V)+((lane>>4)&1)*32+(lane&3)*8+(4*hi+((lane&15)>>2))*64;
    SBAR(); pv(o,vb0+sl_cur,PAF(0),PAF(1),PAF(2),PAF(3)); }
  #undef PKW
  #undef PAF
  #undef VFR
  #undef PIN
  #undef MX3
  #undef GAPA
  #undef GAPB
  #undef EX
  #undef VRD
  #undef KRD
  #undef STEP
  #undef ENDW
  {auto rr=__builtin_amdgcn_permlane32_swap(__float_as_uint(l_reg),__float_as_uint(l_reg),false,false);l_reg=__uint_as_float(rr[0])+__uint_as_float(rr[1]);}
  if(hi==0)wsf[32+r32]=l_reg;asm volatile("s_waitcnt lgkmcnt(0)":::"memory");
  float rli[16];
  #pragma unroll
  for(int r=0;r<16;++r)rli[r]=__builtin_amdgcn_rcpf(wsf[32+crow(r,hi)])*YSC;
  unsigned char*Yw=Y+(size_t)(rowbase+q0+wid*QBLK)*2048+h*D;
  { unsigned char*stg=(unsigned char*)(shm+LDS_OST)+wid*4096;
    #pragma unroll
    for(int r=0;r<16;++r){const int orow=crow(r,hi);
      const float a0=__builtin_fminf(__builtin_fmaxf(o[0][r]*rli[r],-448.f),448.f),a1=__builtin_fminf(__builtin_fmaxf(o[1][r]*rli[r],-448.f),448.f);
      const unsigned pk=(unsigned)__builtin_amdgcn_cvt_pk_fp8_f32(a0,a1,0,false);
      stg[orow*64+r32]=(unsigned char)(pk&0xffu); stg[orow*64+32+r32]=(unsigned char)((pk>>8)&0xffu);}
    asm volatile("s_waitcnt lgkmcnt(0)":::"memory");
    #pragma unroll
    for(int i=0;i<2;++i){const int row=i*16+(lane>>2),ch=lane&3; const u32x4 v=*(const u32x4*)(stg+row*64+ch*16); *(u32x4*)(Yw+(size_t)row*2048+ch*16)=v;} }
  asm volatile("s_waitcnt lgkmcnt(0)\n\ts_barrier":::"memory");
  #undef DMA_K
  #undef DMA_V
  #undef CMASK
  #undef START
  #undef RESC
  #undef ROT
  #undef OKB
}
#undef SBAR
#undef WAIT_BAR
#ifdef ATTN_STORE16
#undef ATTN_STORE16
#endif
}

namespace mls {
constexpr int RS = 272, TS = 144;
constexpr float CSC = 8.f, CSC_INV = 0.125f;
struct MW { unsigned char* CC; unsigned char* CP; float* NC; float* NP; float* SC; float* MP; };
__device__ __forceinline__ int cslot(int bh, int c) { return (c + bh) & 31; }
__device__ __forceinline__ float fsilu(float x) { return x * __builtin_amdgcn_rcpf(1.f + __builtin_amdgcn_exp2f(-1.4426950408889634f * x)); }
__device__ __forceinline__ void vt_write(LAS unsigned char* dst, const u32x4 a, const u32x4 bq) {
    *(LAS unsigned*)(dst + 0 * TS) = (a.x & 0xffffu) | (bq.x << 16); *(LAS unsigned*)(dst + 1 * TS) = (a.x >> 16) | (bq.x & 0xffff0000u);
    *(LAS unsigned*)(dst + 2 * TS) = (a.y & 0xffffu) | (bq.y << 16); *(LAS unsigned*)(dst + 3 * TS) = (a.y >> 16) | (bq.y & 0xffff0000u);
    *(LAS unsigned*)(dst + 4 * TS) = (a.z & 0xffffu) | (bq.z << 16); *(LAS unsigned*)(dst + 5 * TS) = (a.z >> 16) | (bq.z & 0xffff0000u);
    *(LAS unsigned*)(dst + 6 * TS) = (a.w & 0xffffu) | (bq.w << 16); *(LAS unsigned*)(dst + 7 * TS) = (a.w >> 16) | (bq.w & 0xffff0000u);
}
constexpr int XKWT = 0, XVT = 18432, XCW = 36864;
__device__ __forceinline__ void x_setup(Frame& F, const float* conv_w, const float* conv_b) {
    __syncthreads();
    for (int i = F.tid; i < 5 * 512; i += NTHR) { const int j = i >> 9, ch = i & 511; ((LAS float*)(F.lds + XCW))[i] = (j < 4) ? conv_w[j * 1024 + 512 + ch] : conv_b[512 + ch]; }
    __syncthreads();
}
struct XL { u32x4 raw[5], vr0, vr1; float li, lf; };
__device__ __forceinline__ void x_load(XL& L, const Frame& F, const bf16_t* proj, const float* gates, int u) {
    const int tid = F.tid, c = u & 31, bh = u >> 5, b = bh >> 2, h = bh & 3; const size_t rb = (size_t)b * SEQ;
    const int cc = tid & 15, rp = tid >> 4, tp = tid & 31, ec = tid >> 5;
#pragma unroll
    for (int i = 0; i < 5; ++i) { const int pos = c * 64 + 2 * rp - 3 + i;
        if (pos >= 0) L.raw[i] = *(const u32x4*)(proj + (rb + pos) * NIN + C_LK + h * 128 + 8 * cc); else L.raw[i] = (u32x4){0u, 0u, 0u, 0u}; }
    L.vr0 = *(const u32x4*)(proj + (rb + c * 64 + 2 * tp) * NIN + C_LV + h * 128 + 8 * ec); L.vr1 = *(const u32x4*)(proj + (rb + c * 64 + 2 * tp + 1) * NIN + C_LV + h * 128 + 8 * ec);
    L.li = gates[(rb + c * 64 + F.lane) * 8 + h]; L.lf = gates[(rb + c * 64 + F.lane) * 8 + 4 + h];
}
__device__ __forceinline__ void x_unit(Frame& F, const bf16_t* proj, const float* gates, const MW& W, int u, XL& cur, XL& nxt, bool has_next, int un) {
    LAS unsigned char* lds = F.lds; const int tid = F.tid, lane = F.lane, r32 = lane & 31, hh = lane >> 5, w = F.wave;
    const int bh = u >> 5, h = bh & 3;
    const int cc = tid & 15, rp = tid >> 4, tp = tid & 31, ec = tid >> 5;
    u32x4 raw[5];
#pragma unroll
    for (int i = 0; i < 5; ++i) raw[i] = cur.raw[i];
    const u32x4 vr0 = cur.vr0, vr1 = cur.vr1; const float li = cur.li, lf = cur.lf;
    const float bcs = scan64<false>(lf), cs = li - bcs, pm = scan64<true>(cs);
    const float blast = lane63(bcs), amax = blast + lane63(pm);
    const float wa = __expf(blast + cs - amax);
    LBAR();
    {   const LAS float* cw = (const LAS float*)(lds + XCW) + h * 128 + 8 * cc;
        u32x4 pk[2];
#pragma unroll
        for (int r = 0; r < 2; ++r) {
            f32x4 oa = *(const LAS f32x4*)(cw + 4 * 512), ob = *(const LAS f32x4*)(cw + 4 * 512 + 4);
#pragma unroll
            for (int j = 0; j < 4; ++j) { const u32x4 uu = raw[r + j]; const f32x4 wa4 = *(const LAS f32x4*)(cw + j * 512), wb4 = *(const LAS f32x4*)(cw + j * 512 + 4);
                oa += wa4 * (f32x4){bflo(uu.x), bfhi(uu.x), bflo(uu.y), bfhi(uu.y)}; ob += wb4 * (f32x4){bflo(uu.z), bfhi(uu.z), bflo(uu.w), bfhi(uu.w)}; }
            const float ws = __shfl(wa, 2 * rp + r) * 0.08838834764831845f;
#pragma unroll
            for (int i = 0; i < 4; ++i) { oa[i] = fsilu(oa[i]) * ws; ob[i] = fsilu(ob[i]) * ws; }
            pk[r].x = cvtpk(oa[0], oa[1]); pk[r].y = cvtpk(oa[2], oa[3]); pk[r].z = cvtpk(ob[0], ob[1]); pk[r].w = cvtpk(ob[2], ob[3]);
        }
#pragma unroll
        for (int i = 0; i < 8; ++i) { const int sh = 16 * (i & 1); const unsigned e0 = (pk[0][i >> 1] >> sh) & 0xffffu, e1 = (pk[1][i >> 1] >> sh) & 0xffffu;
            *(LAS unsigned*)(lds + XKWT + (8 * cc + i) * TS + (2 * rp) * 2) = e0 | (e1 << 16); }
        vt_write(lds + XVT + (8 * ec) * TS + (2 * tp) * 2, vr0, vr1);
    }
    if (has_next) x_load(nxt, F, proj, gates, un);
    LBAR();
#pragma unroll
    for (int i = 0; i < 2; ++i) { const int T = 2 * w + i, dt = T >> 2, e2 = T & 3;
        f32x16 acc;
#pragma unroll
        for (int r = 0; r < 16; ++r) acc[r] = 0.f;
#pragma unroll
        for (int k = 0; k < 4; ++k) { const bf16x8 a = *(const LAS bf16x8*)(lds + XKWT + (32 * dt + r32) * TS + (16 * k + 8 * hh) * 2);
            const bf16x8 bv = *(const LAS bf16x8*)(lds + XVT + (32 * e2 + r32) * TS + (16 * k + 8 * hh) * 2);
            acc = __builtin_amdgcn_mfma_f32_32x32x16_bf16(a, bv, acc, 0, 0, 0); }
        unsigned char* dst = W.CC + (size_t)((u & ~31) + cslot(u >> 5, u & 31)) * 16384 + (size_t)(32 * e2 + r32) * 128 + 32 * dt + 4 * hh;
#pragma unroll
        for (int g = 0; g < 4; ++g) *(unsigned*)(dst + 8 * g) = pg8::pack_fp8x4(acc[4 * g] * CSC, acc[4 * g + 1] * CSC, acc[4 * g + 2] * CSC, acc[4 * g + 3] * CSC); }
    if (tid < 128) { float sN = 0.f;
#pragma unroll
        for (int k = 0; k < 8; ++k) { const u32x4 uu = *(const LAS u32x4*)(lds + XKWT + tid * TS + k * 16);
            sN += (bflo(uu.x) + bfhi(uu.x)) + (bflo(uu.y) + bfhi(uu.y)) + (bflo(uu.z) + bfhi(uu.z)) + (bflo(uu.w) + bfhi(uu.w)); }
        W.NC[(size_t)u * 128 + tid] = sN; }
    if (tid == 0) { W.SC[u * 2] = blast; W.SC[u * 2 + 1] = amax; }
}
constexpr int YK = 4, CONV_Y = YK * 4 * 256;
template <int GRP>
__device__ __forceinline__ void y_phase(Frame& F, const MW& W) {
    for (int base = blockIdx.x * 256; base < 32 * 2048; base += F.G * 256) {
        if (F.tid >= 256) {
            if (base == (int)blockIdx.x * 256 && F.G == 256) {
#pragma unroll 1
                for (int k = 0; k < YK; ++k) conv_item<GRP>(F, (int)blockIdx.x * 4 + (F.wave - 4) + k * 1024);
            }
            continue; }
        const int bh = base >> 11, g = (base & 2047) + F.tid, e = g >> 4, d8 = (g & 15) * 8;
        const float* sc = W.SC + (size_t)bh * 64;
        const size_t off = (size_t)bh * 32 * 16384 + (size_t)e * 128 + d8;
        u32x2 v[32];
#pragma unroll
        for (int c = 0; c < 32; ++c) v[c] = __builtin_nontemporal_load((const u32x2*)(W.CC + off + (size_t)cslot(bh, c) * 16384));
        const bool nsc = (g < 32);
        f32x4 nv[32];
        if (nsc) {
#pragma unroll
            for (int c = 0; c < 32; ++c) nv[c] = *(const f32x4*)(W.NC + ((size_t)bh * 32 + c) * 128 + g * 4); }
        float C[8];
#pragma unroll
        for (int i = 0; i < 8; ++i) C[i] = 0.f;
        float m = 0.f;
#pragma unroll
        for (int c = 0; c < 32; ++c) {
            u32x2 o; o.x = pg8::pack_fp8x4(C[0], C[1], C[2], C[3]); o.y = pg8::pack_fp8x4(C[4], C[5], C[6], C[7]); *(u32x2*)(W.CP + off + (size_t)cslot(bh, c) * 16384) = o;
            const float bl = sc[2 * c], am = sc[2 * c + 1], mn = fmaxf(bl + m, am), dec = __expf(bl + m - mn), inj = __expf(am - mn);
            const auto x0 = __builtin_amdgcn_cvt_pk_f32_fp8((int)v[c].x, false), x1 = __builtin_amdgcn_cvt_pk_f32_fp8((int)v[c].x, true), x2 = __builtin_amdgcn_cvt_pk_f32_fp8((int)v[c].y, false), x3 = __builtin_amdgcn_cvt_pk_f32_fp8((int)v[c].y, true);
            C[0] = C[0] * dec + x0[0] * inj; C[1] = C[1] * dec + x0[1] * inj; C[2] = C[2] * dec + x1[0] * inj; C[3] = C[3] * dec + x1[1] * inj;
            C[4] = C[4] * dec + x2[0] * inj; C[5] = C[5] * dec + x2[1] * inj; C[6] = C[6] * dec + x3[0] * inj; C[7] = C[7] * dec + x3[1] * inj; m = mn; }
        if (nsc) {
            f32x4 N = (f32x4){0.f, 0.f, 0.f, 0.f}; float mm = 0.f;
#pragma unroll
            for (int c = 0; c < 32; ++c) {
                *(f32x4*)(W.NP + ((size_t)bh * 32 + c) * 128 + g * 4) = N; if (g == 0) W.MP[bh * 32 + c] = mm;
                const float bl = sc[2 * c], am = sc[2 * c + 1], mn = fmaxf(bl + mm, am), dec = __expf(bl + mm - mn), inj = __expf(am - mn);
                N = N * dec + nv[c] * inj; mm = mn; }
        }
    }
}
constexpr int QS = 0, QW = 17408, KS = 34816, ZCW = 52224  , VT = 72704, CB = 91136, NS = 125952, CSO = 126464, SSQ = 126720, ZNW = 127744  ;
struct Pre { u32x4 raw[7]; u32x4 vr[2]; float li, lf; };
__device__ __forceinline__ void prefetch(Pre& P, const bf16_t* proj, const float* gates, size_t rb, int c, int h, int tid, int lane) {
    const int cc = tid & 31, rg = tid >> 5;
    const int col = (cc < 16) ? (C_LQ + h * 128 + 8 * cc) : (C_LK + h * 128 + 8 * (cc - 16));
#pragma unroll
    for (int i = 0; i < 7; ++i) { const int pos = c * 64 + 4 * rg - 3 + i;
        if (pos >= 0) P.raw[i] = *(const u32x4*)(proj + (rb + pos) * NIN + col); else P.raw[i] = (u32x4){0u, 0u, 0u, 0u}; }
    const int tp = tid & 31, ec = tid >> 5;
    P.vr[0] = *(const u32x4*)(proj + (rb + c * 64 + 2 * tp) * NIN + C_LV + h * 128 + 8 * ec);
    P.vr[1] = *(const u32x4*)(proj + (rb + c * 64 + 2 * tp + 1) * NIN + C_LV + h * 128 + 8 * ec);
    P.li = gates[(rb + c * 64 + lane) * 8 + h]; P.lf = gates[(rb + c * 64 + lane) * 8 + 4 + h];
}
__device__ __forceinline__ void z_setup(Frame& F, const float* conv_w, const float* conv_b, const float* normw) {
    __syncthreads();
    for (int i = F.tid; i < 5 * 1024; i += NTHR) { const int j = i >> 10, ch = i & 1023; ((LAS float*)(F.lds + ZCW))[i] = (j < 4) ? conv_w[j * 1024 + ch] : conv_b[ch]; }
    ((LAS float*)(F.lds + ZNW))[F.tid] = normw[F.tid];
    __syncthreads();
}
struct ZL { Pre P; u32x4 cpv[2]; float npv, mprev; u32x2 og[4]; };
__device__ __forceinline__ void z_load(ZL& L, const Frame& F, const bf16_t* proj, const float* gates, const MW& W, int u) {
    const int tid = F.tid, lane = F.lane, r32 = lane & 31, hh = lane >> 5, w = F.wave, et = w & 3, tt = w >> 2;
    const int c = u & 31, bh = u >> 5, b = bh >> 2, h = bh & 3; const size_t rb = (size_t)b * SEQ, r0 = rb + (size_t)c * 64; const int trow = 32 * tt + r32;
    prefetch(L.P, proj, gates, rb, c, h, tid, lane);
#pragma unroll
    for (int i = 0; i < 2; ++i) L.cpv[i] = __builtin_nontemporal_load((const u32x4*)(W.CP + (size_t)((u & ~31) + cslot(u >> 5, u & 31)) * 16384 + (size_t)(tid + i * NTHR) * 16));
    L.npv = (tid < 128) ? W.NP[(size_t)u * 128 + tid] : 0.f; L.mprev = W.MP[u];
#pragma unroll
    for (int g = 0; g < 4; ++g) L.og[g] = *(const u32x2*)(proj + (r0 + trow) * NIN + C_LO + h * 128 + 32 * et + 8 * g + 4 * hh);
}
__device__ __forceinline__ void z_unit(Frame& F, const bf16_t* proj, const float* gates, const MW& W, unsigned char* Y, int u, ZL& cur, ZL& nxt, bool has_next, int un) {
    LAS unsigned char* lds = F.lds; const int tid = F.tid, lane = F.lane, r32 = lane & 31, hh = lane >> 5, w = F.wave, et = w & 3, tt = w >> 2;
    const int c = u & 31, bh = u >> 5, b = bh >> 2, h = bh & 3; const size_t rb = (size_t)b * SEQ, r0 = rb + (size_t)c * 64;
    const int trow = 32 * tt + r32;
    const Pre P = cur.P;
    u32x4 cpv[2];
#pragma unroll
    for (int i = 0; i < 2; ++i) cpv[i] = cur.cpv[i];
    const float npv = cur.npv, mprev = cur.mprev;
    u32x2 og[4];
#pragma unroll
    for (int g = 0; g < 4; ++g) og[g] = cur.og[g];
    const float bcs = scan64<false>(P.lf), cs = P.li - bcs, pm = scan64<true>(cs);
    const float il = bcs + mprev, mo = fmaxf(il, bcs + pm), wi = __expf(il - mo);
    const float rt = __shfl(bcs - mo, trow), eo = __shfl(__expf(-mo), trow);
    LBAR();
    if (w == 0) ((LAS float*)(lds + CSO))[lane] = cs;
#pragma unroll
    for (int i = 0; i < 2; ++i) { const int ci = tid + i * NTHR, e = ci >> 3, part = ci & 7;
        unsigned wv[8];
#pragma unroll
        for (int q = 0; q < 4; ++q) { const int uq = (int)cpv[i][q]; const auto lo = __builtin_amdgcn_cvt_pk_f32_fp8(uq, false), hi = __builtin_amdgcn_cvt_pk_f32_fp8(uq, true);
            wv[2 * q] = cvtpk(lo[0] * CSC_INV, lo[1] * CSC_INV); wv[2 * q + 1] = cvtpk(hi[0] * CSC_INV, hi[1] * CSC_INV); }
        u32x4 w0, w1; w0.x = wv[0]; w0.y = wv[1]; w0.z = wv[2]; w0.w = wv[3]; w1.x = wv[4]; w1.y = wv[5]; w1.z = wv[6]; w1.w = wv[7];
        *(LAS u32x4*)(lds + CB + e * RS + part * 32) = w0; *(LAS u32x4*)(lds + CB + e * RS + part * 32 + 16) = w1; }
    if (tid < 128) ((LAS float*)(lds + NS))[tid] = npv;
    {
        const int cc = tid & 31, rg = tid >> 5; const bool isk = cc >= 16; const int dcol = 8 * (cc & 15);
        const LAS float* cw = (const LAS float*)(lds + ZCW) + (isk ? 512 : 0) + h * 128 + dcol;
        const float ksc = isk ? 0.08838834764831845f : 1.f;
#pragma unroll
        for (int r = 0; r < 4; ++r) {
            f32x4 oa = *(const LAS f32x4*)(cw + 4 * 1024), ob = *(const LAS f32x4*)(cw + 4 * 1024 + 4);
#pragma unroll
            for (int j = 0; j < 4; ++j) { const u32x4 uu = P.raw[r + j]; const f32x4 wa4 = *(const LAS f32x4*)(cw + j * 1024), wb4 = *(const LAS f32x4*)(cw + j * 1024 + 4);
                oa += wa4 * (f32x4){bflo(uu.x), bfhi(uu.x), bflo(uu.y), bfhi(uu.y)}; ob += wb4 * (f32x4){bflo(uu.z), bfhi(uu.z), bflo(uu.w), bfhi(uu.w)}; }
#pragma unroll
            for (int i = 0; i < 4; ++i) { oa[i] = fsilu(oa[i]) * ksc; ob[i] = fsilu(ob[i]) * ksc; }
            const int t = 4 * rg + r; const float ws = __shfl(wi, t);
            u32x4 wv; wv.x = cvtpk(oa[0], oa[1]); wv.y = cvtpk(oa[2], oa[3]); wv.z = cvtpk(ob[0], ob[1]); wv.w = cvtpk(ob[2], ob[3]);
            *(LAS u32x4*)(lds + (isk ? KS : QS) + t * RS + dcol * 2) = wv;
            if (!isk) { u32x4 v; v.x = cvtpk(oa[0] * ws, oa[1] * ws); v.y = cvtpk(oa[2] * ws, oa[3] * ws); v.z = cvtpk(ob[0] * ws, ob[1] * ws); v.w = cvtpk(ob[2] * ws, ob[3] * ws);
                *(LAS u32x4*)(lds + QW + t * RS + dcol * 2) = v; }
            asm volatile("" ::: "memory");
        }
        vt_write(lds + VT + (8 * (tid >> 5)) * TS + (2 * (tid & 31)) * 2, P.vr[0], P.vr[1]);
    }
    if (has_next) z_load(nxt, F, proj, gates, W, un);
    LBAR();
    f32x16 acc;
#pragma unroll
    for (int r = 0; r < 16; ++r) acc[r] = 0.f;
    float den = 0.f;
    for (int st = 0; st <= tt; ++st) {
        f32x16 S;
#pragma unroll
        for (int r = 0; r < 16; ++r) S[r] = 0.f;
#pragma unroll
        for (int k = 0; k < 8; ++k) { const bf16x8 a = *(const LAS bf16x8*)(lds + KS + (32 * st + r32) * RS + (16 * k + 8 * hh) * 2); const bf16x8 qk = *(const LAS bf16x8*)(lds + QS + trow * RS + (16 * k + 8 * hh) * 2); S = __builtin_amdgcn_mfma_f32_32x32x16_bf16(a, qk, S, 0, 0, 0); }
        const LAS float* csp = (const LAS float*)(lds + CSO) + 32 * st + 4 * hh;
#pragma unroll
        for (int r = 0; r < 16; ++r) { const int so = (r & 3) + 8 * (r >> 2); const float cv = csp[so];
            const bool ok = (st < tt) || (so + 4 * hh <= r32);
            const float p = ok ? S[r] * __expf(rt + cv) : 0.f; S[r] = p; den += p; }
#pragma unroll
        for (int k2 = 0; k2 < 2; ++k2) {
            u32x4 pw; pw.x = cvtpk(S[8 * k2 + 0], S[8 * k2 + 1]); pw.y = cvtpk(S[8 * k2 + 2], S[8 * k2 + 3]); pw.z = cvtpk(S[8 * k2 + 4], S[8 * k2 + 5]); pw.w = cvtpk(S[8 * k2 + 6], S[8 * k2 + 7]);
            const LAS unsigned char* vp = lds + VT + (32 * et + r32) * TS + (32 * st + 16 * k2 + 4 * hh) * 2;
            const u32x2 lo = *(const LAS u32x2*)vp, hi = *(const LAS u32x2*)(vp + 16); u32x4 aw; aw.x = lo.x; aw.y = lo.y; aw.z = hi.x; aw.w = hi.y;
            acc = __builtin_amdgcn_mfma_f32_32x32x16_bf16(__builtin_bit_cast(bf16x8, aw), __builtin_bit_cast(bf16x8, pw), acc, 0, 0, 0); }
    }
    {
        const LAS float* nsp = (const LAS float*)(lds + NS);
#pragma unroll
        for (int k = 0; k < 8; ++k) {
            const bf16x8 a = *(const LAS bf16x8*)(lds + CB + (32 * et + r32) * RS + (16 * k + 8 * hh) * 2);
            const bf16x8 bq = *(const LAS bf16x8*)(lds + QW + trow * RS + (16 * k + 8 * hh) * 2);
            acc = __builtin_amdgcn_mfma_f32_32x32x16_bf16(a, bq, acc, 0, 0, 0);
            const f32x4 n0 = *(const LAS f32x4*)(nsp + 16 * k + 8 * hh), n1 = *(const LAS f32x4*)(nsp + 16 * k + 8 * hh + 4);
            den += bf1((bf16_t)bq[0]) * n0[0] + bf1((bf16_t)bq[1]) * n0[1] + bf1((bf16_t)bq[2]) * n0[2] + bf1((bf16_t)bq[3]) * n0[3]
                 + bf1((bf16_t)bq[4]) * n1[0] + bf1((bf16_t)bq[5]) * n1[1] + bf1((bf16_t)bq[6]) * n1[2] + bf1((bf16_t)bq[7]) * n1[3]; }
    }
    den += __shfl_xor(den, 32);
    const float hinv = 1.f / fmaxf(fabsf(den), eo);
    float ssq = 0.f;
#pragma unroll
    for (int r = 0; r < 16; ++r) { acc[r] *= hinv; ssq += acc[r] * acc[r]; }
    ssq += __shfl_xor(ssq, 32);
    if (hh == 0) ((LAS float*)(lds + SSQ))[et * 64 + trow] = ssq;
    LBAR();
    {
        const LAS float* sq = (const LAS float*)(lds + SSQ) + trow;
        const float tot = (sq[0] + sq[64]) + (sq[128] + sq[192]);
        const float rn = att::YSC / sqrtf(tot * (1.f / 128.f) + RMS_EPS);
        unsigned char* yrow = Y + (r0 + trow) * D + 512 + h * 128 + 32 * et + 4 * hh;
#pragma unroll
        for (int g = 0; g < 4; ++g) { const f32x4 nwg = *(const LAS f32x4*)(lds + ZNW + (h * 128 + 32 * et + 8 * g + 4 * hh) * 4); const float o0 = bflo(og[g].x), o1 = bfhi(og[g].x), o2 = bflo(og[g].y), o3 = bfhi(og[g].y);
            *(unsigned*)(yrow + 8 * g) = pg8::pack_fp8x4(acc[4 * g] * rn * nwg[0] * sigmoid_f(o0), acc[4 * g + 1] * rn * nwg[1] * sigmoid_f(o1), acc[4 * g + 2] * rn * nwg[2] * sigmoid_f(o2), acc[4 * g + 3] * rn * nwg[3] * sigmoid_f(o3)); }
    }
}
}

__device__ __forceinline__ int wq_pull(Frame& F, unsigned* qctr) {
    volatile LAS int* slot = (volatile LAS int*)(F.lds + LDSCTL_OFF + 256);
    __syncthreads();
    if (F.tid == 0) *slot = (int)__hip_atomic_fetch_add(qctr, 1u, __ATOMIC_RELAXED, __HIP_MEMORY_SCOPE_AGENT);
    __syncthreads();
    return __builtin_amdgcn_readfirstlane(*slot);
}
constexpr int N_PHASES = 18;
constexpr int N_LAUNCHES = MK_N_LAUNCHES;
constexpr int PTAB_OFF = LDSCTL_OFF + 512, MOETAB_OFF = LDSCTL_OFF + 64;
__device__ __forceinline__ const float* inptr(const Frame& F, int i) {
    const LAS unsigned* t = (const LAS unsigned*)(F.lds + PTAB_OFF) + 2 * i;
    const unsigned lo = __builtin_amdgcn_readfirstlane(t[0]), hi = __builtin_amdgcn_readfirstlane(t[1]);
    return (const float*)(((unsigned long long)hi << 32) | lo);
}
#define GRID_BAR() do { if (N_LAUNCHES == 1) xcd_barrier(bar); } while (0)
#define IN(k) (lo <= (k) && (k) < hi)
#define SEAM(k) do { if (IN(k) && IN((k) + 1)) GRID_BAR(); } while (0)
__device__ __forceinline__ void moe_table(Frame& F) {
    LAS int* tab = (LAS int*)(F.lds + MOETAB_OFF);
    __syncthreads();
    if (F.tid == 0) { int cum = 0; for (int e = 0; e < NE; ++e) { const int cn = (int)__hip_atomic_load(F.ctl + CW_CNT + e, __ATOMIC_RELAXED, __HIP_MEMORY_SCOPE_AGENT); tab[e] = cn; tab[8 + e] = cum; cum += (cn + 255) >> 8; } tab[16] = cum; }
    __syncthreads();
}
template <int GRP>
__device__ __forceinline__ void conv_part(Frame& F, int part) {
    constexpr int N = (GRP == 0) ? CONV_N0 : (GRP == 1) ? CONV_N1 : (GRP == 2) ? CONV_N2 : (GRP == 3) ? CONV_N3 : CONV_N4;
    const int niter = (N + F.NGW - 1) / F.NGW, i0 = part * niter / 3, i1 = (part + 1) * niter / 3;
#pragma unroll 1
    for (int i = i0; i < i1; ++i) { const int it = F.gw + i * F.NGW; if (it < N) conv_item<GRP>(F, it); }
}
template <int GRP>
__device__ __forceinline__ void conv_queue(Frame& F, unsigned* qctr) {
    constexpr int N = (GRP == 0) ? CONV_N0 : (GRP == 1) ? CONV_N1 : (GRP == 2) ? CONV_N2 : (GRP == 3) ? CONV_N3 : CONV_N4, BATCH = 32, NBATCH = (N + BATCH - 1) / BATCH;
    volatile LAS int* slot2 = (volatile LAS int*)(F.lds + LDSCTL_OFF + 264);
    int cur = wq_pull(F, qctr), par = 0;
    while (cur < NBATCH) {
        if (F.tid == 0) slot2[par] = (int)__hip_atomic_fetch_add(qctr, 1u, __ATOMIC_RELAXED, __HIP_MEMORY_SCOPE_AGENT);
#pragma unroll 1
        for (int i = F.wave; i < BATCH; i += NWAVES) { const int it = cur * BATCH + i; if (it < N) conv_item<GRP>(F, it); }
        __syncthreads();
        cur = __builtin_amdgcn_readfirstlane(slot2[par]); par ^= 1;
    }
}
template <int L>
__device__ __forceinline__ void layer(Frame& F, const XcdBarrier& bar, float* out, const int lo, const int hi) {
    constexpr int pb = 2 + 8 * L;
    unsigned char* ws = F.ws;
    float* mod = (float*)(ws + WS_MOD); float* gates = (float*)(ws + WS_GATES);
    uint4* tok = (uint4*)(ws + WS_TOK); int* idx = (int*)(ws + WS_TOK + 512 * 1024);
    bf16_t* XN = (bf16_t*)(ws + WS_XN); bf16_t* proj = (bf16_t*)(ws + WS_PROJ); unsigned char* ymix = ws + WS_YMIX; bf16_t* act = (bf16_t*)(ws + WS_ACT);
    bf16_t* yb = (bf16_t*)(ws + WS_YB);
    const float* modl = mod + (size_t)L * NB * 6 * D;
    if (IN(pb + 0)) {
        pg8::DenseSched S{(const char*)XN, (const char*)(ws + WS_WIN + (size_t)L * NIN * D), D, M / 256, NIN / 256, F.G, (int)blockIdx.x};
        pg8::EpiInProjI8 E{proj, NIN, (float*)(ws + WS_CTL + KMEAN_OFF + (size_t)L * 131072), (const float*)(ws + WS_ROWMAX), (const float*)(ws + WS_CTL + COLMAX_OFF) + CMX_WIN + L * NIN};
        pg8::gemm_phase<pg8::EpiInProjI8, pg8::DenseSched, true, 2>(F.lds, D, S, E);
    }
    SEAM(pb + 0);
    const mls::MW mw{ws + WS_CC, ws + WS_CP, (float*)(ws + WS_NC), (float*)(ws + WS_NP), (float*)(ws + WS_SC), (float*)(ws + WS_SC + 65536)};
    const float* km = (const float*)(ws + WS_CTL + KMEAN_OFF + (size_t)L * 131072);
    const int cls = (blockIdx.x >> 3) & 3; const bool odd = (cls & 1) != 0;
    if (IN(pb + 1)) {
        mls::x_setup(F, inptr(F, IN_CONVW) + (size_t)L * 4 * 1024, inptr(F, IN_CONVB) + (size_t)L * 1024);
        { int u = blockIdx.x; mls::XL xa; if (u < 1024) mls::x_load(xa, F, proj, gates, u);
          for (; u < 1024; u += F.G) { mls::XL xb; const bool hn = u + F.G < 1024; mls::x_unit(F, proj, gates, mw, u, xa, xb, hn, u + F.G); xa = xb; } }
        __syncthreads();
    }
    SEAM(pb + 1);
    if (IN(pb + 2)) {
        constexpr int GRP = (L == 0) ? 2 : 3;
        mls::y_phase<GRP>(F, mw);
        GRID_BAR();
        if (cls == 0) { conv_all<GRP>(F, (F.G == 256) ? mls::CONV_Y : 0); __syncthreads(); }
        if (odd) { for (int p = blockIdx.x; p < 256; p += F.G) { const int bh = p >> 2, jj = p & 3; mob::attn_unit<8>(bh >> 3, bh & 7, 7 - jj, (const mob::bf16*)(proj + C_MQ), (const mob::bf16*)(proj + C_MK), (const mob::bf16*)(proj + C_MV), ymix, km, (char*)F.glds); } }
        __syncthreads();
        if (cls == 1) { conv_all<GRP>(F, (F.G == 256) ? mls::CONV_Y : 0); __syncthreads(); }
        mls::z_setup(F, inptr(F, IN_CONVW) + (size_t)L * 4 * 1024, inptr(F, IN_CONVB) + (size_t)L * 1024, inptr(F, IN_MNW) + (size_t)L * 512);
        { int u = blockIdx.x; mls::ZL za; if (u < 1024) mls::z_load(za, F, proj, gates, mw, u);
          for (; u < 1024; u += F.G) { mls::ZL zb; const bool hn = u + F.G < 1024; mls::z_unit(F, proj, gates, mw, ymix, u, za, zb, hn, u + F.G); za = zb; } }
        __syncthreads();
        if (!odd) { for (int p = blockIdx.x; p < 256; p += F.G) { const int bh = p >> 2, jj = p & 3; mob::attn_unit<8>(bh >> 3, bh & 7, 7 - jj, (const mob::bf16*)(proj + C_MQ), (const mob::bf16*)(proj + C_MK), (const mob::bf16*)(proj + C_MV), ymix, km, (char*)F.glds); } }
        __syncthreads();
        if (cls == 2) { conv_all<GRP>(F, (F.G == 256) ? mls::CONV_Y : 0); __syncthreads(); }
        for (int p = blockIdx.x; p < 256; p += F.G) { const int bh = p >> 2, jj = p & 3; mob::attn_unit<8>(bh >> 3, bh & 7, jj, (const mob::bf16*)(proj + C_MQ), (const mob::bf16*)(proj + C_MK), (const mob::bf16*)(proj + C_MV), ymix, km, (char*)F.glds); }
        for (int u = blockIdx.x; u < 256; u += F.G) att::swa_unit(F, proj, inptr(F, IN_SINK) + L * 16, ymix, u >> 5, (u >> 4) & 1, u & 15);
        __syncthreads();
        if (cls == 3) { conv_all<GRP>(F, (F.G == 256) ? mls::CONV_Y : 0); __syncthreads(); }
    }
    SEAM(pb + 2);
    if (IN(pb + 3)) {
        pg8::DenseSched S{(const char*)ymix, (const char*)(ws + WS_WOUT + (size_t)L * D * D), D, M / 256, D / 256, F.G, (int)blockIdx.x};
        pg8::EpiBf16 E{yb, D, WSC_INV / att::YSC};
        pg8::gemm_phase<pg8::EpiBf16, pg8::DenseSched, true, 1>(F.lds, D, S, E);
    }
    SEAM(pb + 3);
    if (IN(pb + 4)) {
        float* xb = (float*)(ws + WS_XB);
        if constexpr (L == 0) row_phase<1, 0, true, true, false, true>(F, inptr(F, IN_X), xb, yb, inptr(F, IN_GPOSTM) + (size_t)L * D, modl + 2 * D, inptr(F, IN_GPREF) + (size_t)L * D, modl + 4 * D, modl + 3 * D, XN,
                                          nullptr, 0, nullptr, nullptr, nullptr, nullptr, nullptr, nullptr, nullptr, (float*)(ws + WS_ROWMAX));
        else        row_phase<1, 2, true, true, true, true>(F, xb, xb, yb, inptr(F, IN_GPOSTM) + (size_t)L * D, modl + 2 * D, inptr(F, IN_GPREF) + (size_t)L * D, modl + 4 * D, modl + 3 * D, XN,
                                          inptr(F, IN_ROUTER), 8, nullptr, nullptr, nullptr, nullptr, tok, idx, F.ctl + CW_CNT, (float*)(ws + WS_ROWMAX));
    }
    SEAM(pb + 4);
    if constexpr (L == 0) {
        if (IN(pb + 5)) {
            pg8::DenseSched S{(const char*)XN, (const char*)(ws + WS_WGU), D, M / 256, 2 * DFF / 256, F.G, (int)blockIdx.x};
            pg8::EpiSwiGLUI8 E{(unsigned char*)act, DFF, (const float*)(ws + WS_ROWMAX), (const float*)(ws + WS_CTL + COLMAX_OFF), nullptr, nullptr};
            pg8::gemm_phase<pg8::EpiSwiGLUI8, pg8::DenseSched, true, 2>(F.lds, D, S, E);
        }
        SEAM(pb + 5);
        if (IN(pb + 6)) {
            pg8::DenseSched S{(const char*)act, (const char*)(ws + WS_WD), DFF, M / 256, D / 256, F.G, (int)blockIdx.x};
            pg8::EpiBf16 E{yb, D, WSC_INV};
            pg8::gemm_phase<pg8::EpiBf16, pg8::DenseSched, true, 1>(F.lds, DFF, S, E);
        }
        SEAM(pb + 6);
        if (IN(pb + 7)) { float* xb = (float*)(ws + WS_XB); row_phase<1, 1, true, true, true, true>(F, xb, xb, yb, inptr(F, IN_GPOSTF), modl + 5 * D, inptr(F, IN_GPREM) + D, mod + (size_t)NB * 6 * D + 1 * D, mod + (size_t)NB * 6 * D + 0 * D, XN,
                                              inptr(F, IN_WIN) + (size_t)D * NIN_SRC + SRC_GATE, NIN_SRC, inptr(F, IN_IGB) + 4, inptr(F, IN_FGB) + 4, gates, nullptr, nullptr, nullptr, nullptr, (float*)(ws + WS_ROWMAX));
            conv_all<4>(F); }
        SEAM(pb + 7);
    } else {
        if (IN(pb + 5)) {
            moe_table(F);
            const LAS int* tab = (const LAS int*)(F.lds + MOETAB_OFF);
            pg8::MoeSched<true> S; S.A = (const char*)XN; S.W = (const char*)(ws + WS_MGU); S.idx = idx; S.tab = tab; S.KB = D; S.nN = 2 * DFE / 256; S.G = F.G; S.c = (int)blockIdx.x; S.wrows = 2 * DFE; S.ntile = tab[16];
            pg8::EpiSwiGLUI8 E{(unsigned char*)act, DFE, (const float*)(ws + WS_RMSLOT), (const float*)(ws + WS_CTL + COLMAX_OFF) + 2 * DFF, idx, tab};
            pg8::gemm_phase<pg8::EpiSwiGLUI8, pg8::MoeSched<true>, true, 2>(F.lds, D, S, E);
        }
        SEAM(pb + 5);
        if (IN(pb + 6)) {
            moe_table(F);
            const LAS int* tab = (const LAS int*)(F.lds + MOETAB_OFF);
            pg8::MoeSched<false> S; S.A = (const char*)act; S.W = (const char*)(ws + WS_MD); S.idx = idx; S.tab = tab; S.KB = DFE; S.nN = D / 256; S.G = F.G; S.c = (int)blockIdx.x; S.wrows = D; S.ntile = tab[16];
            pg8::EpiBf16 E{yb, D, WSC_INV};
            pg8::gemm_phase<pg8::EpiBf16, pg8::MoeSched<false>, true, 1>(F.lds, DFE, S, E);
        }
        SEAM(pb + 6);
        if (IN(pb + 7)) row_phase<2, 0, false, false, true, false>(F, (const float*)(ws + WS_XB), out, yb, inptr(F, IN_GPOSTF) + D, modl + 5 * D, nullptr, nullptr, nullptr, nullptr,
                                               nullptr, 0, nullptr, nullptr, nullptr, tok, nullptr, nullptr, F.ctl + CW_CNT);
    }
}
__global__ void __launch_bounds__(NTHR, 2) fwd(Args args) {
    extern __shared__ __attribute__((aligned(16))) unsigned char lds[];
    Frame F;
    F.lds = (LAS unsigned char*)lds; F.glds = lds; F.ws = args.ws; F.ctl = (unsigned*)(args.ws + WS_CTL);
    F.tid = threadIdx.x; F.lane = F.tid & 63; F.wave = __builtin_amdgcn_readfirstlane(F.tid >> 6);
    F.G = gridDim.x; F.gw = blockIdx.x * NWAVES + F.wave; F.NGW = F.G * NWAVES;
    volatile LAS unsigned* MISC = (volatile LAS unsigned*)(F.lds + MISC_OFF);
    for (int u = F.tid; u < (LDS_BYTES - LDSCTL_OFF) / 4; u += NTHR) ((LAS unsigned*)(F.lds + LDSCTL_OFF))[u] = 0u;
    __syncthreads();
    if (F.tid < N_INPUTS) { const unsigned long long p = (unsigned long long)args.in[F.tid]; LAS unsigned* t = (LAS unsigned*)(F.lds + PTAB_OFF) + 2 * F.tid; t[0] = (unsigned)p; t[1] = (unsigned)(p >> 32); }
    __syncthreads();
    XcdBarrier bar; bar.bar = F.ctl + CW_BAR; bar.x = 0; bar.st = nullptr;
    if (N_LAUNCHES == 1) bar = xcd_barrier_post(F.ctl + CW_BAR, MISC + 8);
    const int lo = args.ph_lo, hi = args.ph_hi;
    float* out = args.out;
    if (IN(0)) { p0_ada(F, inptr(F, IN_C), inptr(F, IN_ADAW), inptr(F, IN_ADAB), (float*)(F.ws + WS_MOD)); __syncthreads(); conv_all<0>(F); }
    SEAM(0);
    if (IN(1)) { float* mod = (float*)(F.ws + WS_MOD); const float* x = inptr(F, IN_X);
        row_phase<0, 1, true, true>(F, x, (float*)x  , nullptr, nullptr, nullptr, inptr(F, IN_GPREM), mod + 1 * D, mod + 0 * D, (bf16_t*)(F.ws + WS_XN),
                              inptr(F, IN_WIN) + SRC_GATE, NIN_SRC, inptr(F, IN_IGB), inptr(F, IN_FGB), (float*)(F.ws + WS_GATES), nullptr, nullptr, nullptr, nullptr, (float*)(F.ws + WS_ROWMAX));
        conv_all<1>(F); }
    SEAM(1);
    layer<0>(F, bar, out, lo, hi);
    layer<1>(F, bar, out, lo, hi);
}
#undef IN
#undef SEAM
#undef GRID_BAR

extern "C" void kernel_launch(void* const* d_in, const int* in_sizes, int n_in, void* d_out, int out_size, void* d_ws, size_t ws_size, hipStream_t stream) {
    static int grid = 0;
    if (grid == 0) {
        if (n_in != N_INPUTS || in_sizes[0] != M * D || out_size != M * D || ws_size < WS_END) { fprintf(stderr, "kernel_launch: unexpected problem (n_in %d, in0 %d, out %d, ws %zu); nothing launched\n", n_in, n_in > 0 ? in_sizes[0] : -1, out_size, ws_size); grid = -1; return; }
        int dev = 0, cus = 0, per_cu = 0;
        if (hipGetDevice(&dev) != hipSuccess || hipDeviceGetAttribute(&cus, hipDeviceAttributeMultiprocessorCount, dev) != hipSuccess) { grid = -1; return; }
        if (hipFuncSetAttribute((const void*)fwd, hipFuncAttributeMaxDynamicSharedMemorySize, LDS_BYTES) != hipSuccess) { fprintf(stderr, "kernel_launch: hipFuncSetAttribute failed\n"); grid = -1; return; }
        if (hipOccupancyMaxActiveBlocksPerMultiprocessor(&per_cu, (const void*)fwd, NTHR, LDS_BYTES) != hipSuccess || per_cu < 1) fprintf(stderr, "kernel_launch: occupancy query reports %d\n", per_cu);
        (void)hipGetLastError();
        grid = cus;
    }
    if (grid < 0) return;
    if (hipMemsetAsync((char*)d_ws + WS_CTL, 0, CTL_ZERO_BYTES, stream) != hipSuccess) return;
    Args a{};
    for (int i = 0; i < N_INPUTS; ++i) a.in[i] = (const float*)d_in[i];
    a.out = (float*)d_out; a.ws = (unsigned char*)d_ws;
    if (N_LAUNCHES == 1) { a.ph_lo = 0; a.ph_hi = N_PHASES; hipLaunchKernelGGL(fwd, dim3(grid), dim3(NTHR), LDS_BYTES, stream, a); }
    else for (int p = 0; p < N_PHASES; ++p) { a.ph_lo = p; a.ph_hi = p + 1; hipLaunchKernelGGL(fwd, dim3(grid), dim3(NTHR), LDS_BYTES, stream, a); }
}
```

```cpp
#include <hip/hip_runtime.h>
#include <cstdio>
#include <cstdint>

#ifndef MK_N_LAUNCHES
#define MK_N_LAUNCHES 1
#endif

#define LAS __attribute__((address_space(3)))
#define GAS __attribute__((address_space(1)))
typedef unsigned short bf16_t;
typedef short bf16x8 __attribute__((ext_vector_type(8)));
typedef float f32x4 __attribute__((ext_vector_type(4)));
typedef float f32x2 __attribute__((ext_vector_type(2)));
typedef float f32x16 __attribute__((ext_vector_type(16)));
typedef unsigned u32x4 __attribute__((ext_vector_type(4)));
typedef unsigned u32x2 __attribute__((ext_vector_type(2)));
typedef __bf16 bf16x2_t __attribute__((ext_vector_type(2)));

constexpr int NB = 8, SEQ = 2048, D = 2048, M = NB * SEQ;
constexpr int NIN_SRC = 4872, NIN = 4864;
constexpr int C_MQ = 0, C_MK = 512, C_MV = 1024, C_LQ = 1536, C_LK = 2048, C_LV = 2560, C_LO = 3072, C_SQ = 3584, C_SK = 4608, C_SV = 4736;
constexpr int SRC_GATE = 3584;
constexpr int DFF = 5632, DFE = 2816, NE = 8, ECAP = M;
constexpr float RMS_EPS = 1e-6f;
constexpr int NWAVES = 8, NTHR = 512;

constexpr size_t MiB = 1u << 20;
constexpr size_t WS_CTL = 0, CTL_ZERO_BYTES = 1 * MiB;
constexpr size_t WS_MOD = 1 * MiB;
constexpr size_t WS_GATES = 2 * MiB;
constexpr size_t WS_ROWMAX = 4 * MiB;
constexpr size_t WS_RMSLOT = 4 * MiB + 131072;
constexpr size_t WS_TOK = 3 * MiB;
constexpr size_t WS_WIN = 8 * MiB;
constexpr size_t WS_WOUT = 48 * MiB;
constexpr size_t WS_WGU = 64 * MiB;
constexpr size_t WS_WD = 108 * MiB;
constexpr size_t WS_MGU = 130 * MiB;
constexpr size_t WS_MD = 306 * MiB;
constexpr size_t WS_XN = 394 * MiB;
constexpr size_t WS_PROJ = 458 * MiB;
constexpr size_t WS_YMIX = 610 * MiB;
constexpr size_t WS_ACT = 458 * MiB;
constexpr size_t WS_YB = 674 * MiB;
constexpr size_t WS_XB = 810 * MiB;
constexpr size_t WS_CC = 874 * MiB;
constexpr size_t WS_CP = 906 * MiB;
constexpr size_t WS_NC = 938 * MiB, WS_NP = 939 * MiB, WS_SC = 940 * MiB;
constexpr size_t WS_END = 941 * MiB;
constexpr int CW_TMO = 0, CW_CODE = 1;
constexpr int CW_CNT = 64;
constexpr int CW_WQ = 128;
constexpr int CW_BAR = 4096;
constexpr size_t KMEAN_OFF = 262144;


__device__ __forceinline__ unsigned cvtpk(float lo, float hi) { f32x2 v = {lo, hi}; bf16x2_t b = __builtin_convertvector(v, bf16x2_t); return __builtin_bit_cast(unsigned, b); }
__device__ __forceinline__ float bflo(unsigned u) { return __uint_as_float(u << 16); }
__device__ __forceinline__ float bfhi(unsigned u) { return __uint_as_float(u & 0xffff0000u); }
__device__ __forceinline__ float bf1(bf16_t u) { return __uint_as_float(((unsigned)u) << 16); }
template <bool MAX>
__device__ __forceinline__ float scan64(float v) {
    constexpr int ident = MAX ? (int)0xff800000 : 0;
#define SCAN_STEP(ctrl, rm) { const float tf = __int_as_float(__builtin_amdgcn_update_dpp(ident, __float_as_int(v), ctrl, rm, 0xf, false)); v = MAX ? fmaxf(v, tf) : v + tf; }
    SCAN_STEP(0x111, 0xf) SCAN_STEP(0x112, 0xf) SCAN_STEP(0x114, 0xf) SCAN_STEP(0x118, 0xf) SCAN_STEP(0x142, 0xa) SCAN_STEP(0x143, 0xc)
#undef SCAN_STEP
    return v;
}
__device__ __forceinline__ float lane63(float v) { return __int_as_float(__builtin_amdgcn_readlane(__float_as_int(v), 63)); }
__device__ __forceinline__ float wave_sum(float v) { return lane63(scan64<false>(v)); }
__device__ __forceinline__ float wave_max(float v) { return lane63(scan64<true>(v)); }
#define LBAR() do { asm volatile("s_waitcnt lgkmcnt(0)" ::: "memory"); __builtin_amdgcn_s_barrier(); asm volatile("" ::: "memory"); } while (0)
__device__ __forceinline__ float silu_f(float x) { return x / (1.f + __expf(-x)); }
__device__ __forceinline__ float sigmoid_f(float x) { return 1.f / (1.f + __expf(-x)); }

namespace pg8 {
constexpr int BM = 256, BK = 64, HALF = 128, HTB = HALF * BK * 2, STAGE_BYTES = 8 * HTB, NXCD = 8, WGM = 8;
__host__ __device__ __forceinline__ int lds_byte(int r, int c) { const int st = (r >> 4) * 2 + (c >> 5), rr = r & 15, cc = c & 31, ob = rr * 64 + cc * 2; return st * 1024 + (ob ^ (((ob >> 9) & 1) << 5)); }
__host__ __device__ __forceinline__ void stage_rc(int b, int& R, int& C) { const int st = b / 1024, sb = b % 1024, swz = sb ^ (((sb >> 9) & 1) << 5); R = (st >> 1) * 16 + swz / 64; C = (st & 1) * 32 + (swz % 64) / 2; }
__host__ __device__ __forceinline__ int perm32(int rho) { const int n = rho >> 4, i = rho & 15; return 8 * (i >> 2) + 4 * n + (i & 3); }

struct Unit { int pm, pn, e; };
__device__ __forceinline__ unsigned pack_fp8x4(float a, float b, float c, float d) {
    a = fminf(fmaxf(a, -448.f), 448.f); b = fminf(fmaxf(b, -448.f), 448.f); c = fminf(fmaxf(c, -448.f), 448.f); d = fminf(fmaxf(d, -448.f), 448.f);
    int p = __builtin_amdgcn_cvt_pk_fp8_f32(a, b, 0, false); p = __builtin_amdgcn_cvt_pk_fp8_f32(c, d, p, true); return (unsigned)p;
}


__device__ __forceinline__ bool static_next(int i, int G, int c, int nM, int nN, int& pm, int& pn) {
    const int nwg = nM * nN; const long L = (long)i * G + c; if (L >= nwg) return false;
    int wgid = (int)L; { const int q = nwg / NXCD, r = nwg % NXCD, xcd = wgid % NXCD, off = wgid / NXCD; wgid = (xcd < r ? xcd * (q + 1) : r * (q + 1) + (xcd - r) * q) + off; }
    const int nig = WGM * nN, gid = wgid / nig, fm = gid * WGM, gsz = (nM - fm) < WGM ? (nM - fm) : WGM;
    pm = fm + ((wgid % nig) % gsz); pn = (wgid % nig) / gsz; return true;
}

struct DenseSched {
    static constexpr bool GATHER = false;
    const char* A; const char* Bt; int KB  , nM, nN, G, c;
    __device__ __forceinline__ bool next(int i, Unit& u) const { u.e = 0; return static_next(i, G, c, nM, nN, u.pm, u.pn); }
    __device__ __forceinline__ const char* a_base() const { return A; }
    __device__ __forceinline__ void a_offsets(const Unit& u, const int (&Rr)[2], const int (&Cc)[2], unsigned (&off)[2][2]) const {
#pragma unroll
        for (int h = 0; h < 2; ++h)
#pragma unroll
            for (int i = 0; i < 2; ++i) off[h][i] = (unsigned)((u.pm * BM + h * HALF + Rr[i]) * KB + Cc[i] * 2);
    }
    __device__ __forceinline__ const char* b_base(const Unit& u) const { return Bt + (size_t)u.pn * BM * KB; }
};
template <bool GATHER_>
struct MoeSched {
    static constexpr bool GATHER = GATHER_;
    const char* A; const char* W; const int* idx; const LAS int* tab  ; int KB, nN, G, c, wrows  , ntile;
    __device__ __forceinline__ bool next(int i, Unit& u) const { if (!static_next(i, G, c, ntile, nN, u.pm, u.pn)) return false; int e = 0;
#pragma unroll
        for (int j = 1; j < NE; ++j) e += (u.pm >= tab[8 + j]) ? 1 : 0;
        u.e = e; return true; }
    __device__ __forceinline__ const char* a_base() const { return A; }
    __device__ __forceinline__ void a_offsets(const Unit& u, const int (&Rr)[2], const int (&Cc)[2], unsigned (&off)[2][2]) const {
        const int cume = tab[8 + u.e], cnte = tab[u.e];
#pragma unroll
        for (int h = 0; h < 2; ++h)
#pragma unroll
            for (int i = 0; i < 2; ++i) {
                if (GATHER_) { const int rl = (u.pm - cume) * BM + h * HALF + Rr[i]; const int tok = (rl < cnte) ? idx[u.e * ECAP + rl] : 0; off[h][i] = (unsigned)(tok * KB + Cc[i] * 2); }
                else off[h][i] = (unsigned)((u.pm * BM + h * HALF + Rr[i]) * KB + Cc[i] * 2);
            }
    }
    __device__ __forceinline__ const char* b_base(const Unit& u) const { return W + ((size_t)u.e * wrows + (size_t)u.pn * BM) * KB; }
};

struct EpiBf16 {
    static constexpr bool PERM = true;
    bf16_t* O; int ldc; float sc;
    __device__ __forceinline__ void operator()(const f32x4 (&acc)[2][2][4][2], const Unit& u, int wr, int wc, int fr, int fq) const {
        const int row0 = u.pm * BM + wr * 64 + fr, col0 = u.pn * BM + wc * 32 + 8 * fq;
#pragma unroll
        for (int ai = 0; ai < 2; ++ai)
#pragma unroll
            for (int m = 0; m < 4; ++m) { bf16_t* rowp = O + (size_t)(row0 + ai * HALF + m * 16) * ldc + col0;
#pragma unroll
                for (int bj = 0; bj < 2; ++bj) { const f32x4 v0 = acc[ai][bj][m][0] * sc, v1 = acc[ai][bj][m][1] * sc;
                    u32x4 w; w.x = cvtpk(v0[0], v0[1]); w.y = cvtpk(v0[2], v0[3]); w.z = cvtpk(v1[0], v1[1]); w.w = cvtpk(v1[2], v1[3]);
                    *(u32x4*)(rowp + bj * HALF) = w; } }
    }
};
struct EpiInProjI8 {
    static constexpr bool PERM = true;
    bf16_t* O; int ldc; float* kmean; const float* rowmax; const float* colmax;
    __device__ __forceinline__ void operator()(const f32x4 (&acc)[2][2][4][2], const Unit& u, int wr, int wc, int fr, int fq) const {
        typedef int i32x4_ __attribute__((ext_vector_type(4)));
        const int row0 = u.pm * BM + wr * 64 + fr, col0 = u.pn * BM + wc * 32 + 8 * fq;
        const float qsc = (u.pn < 2 || (u.pn >= 14 && u.pn < 18)) ? 0.125f * 1.4426950408889634f : 1.f;
        f32x4 cmv[2][2], cs[2][2];
#pragma unroll
        for (int bj = 0; bj < 2; ++bj)
#pragma unroll
            for (int n = 0; n < 2; ++n) { cmv[bj][n] = *(const f32x4*)(colmax + col0 + bj * HALF + 4 * n) * (qsc / (127.f * 127.f)); cs[bj][n] = (f32x4){0.f, 0.f, 0.f, 0.f}; }
#pragma unroll
        for (int ai = 0; ai < 2; ++ai)
#pragma unroll
            for (int m = 0; m < 4; ++m) { const int r = row0 + ai * HALF + m * 16; bf16_t* rowp = O + (size_t)r * ldc + col0; const float sa = rowmax[r];
#pragma unroll
                for (int bj = 0; bj < 2; ++bj) { f32x4 v[2];
#pragma unroll
                    for (int n = 0; n < 2; ++n) { const i32x4_ iv = __builtin_bit_cast(i32x4_, acc[ai][bj][m][n]);
                        v[n] = (f32x4){(float)iv[0], (float)iv[1], (float)iv[2], (float)iv[3]} * (cmv[bj][n] * sa); cs[bj][n] += v[n]; }
                    u32x4 w; w.x = cvtpk(v[0][0], v[0][1]); w.y = cvtpk(v[0][2], v[0][3]); w.z = cvtpk(v[1][0], v[1][1]); w.w = cvtpk(v[1][2], v[1][3]);
                    *(u32x4*)(rowp + bj * HALF) = w; } }
        if (u.pn == 2 || u.pn == 3) {
#pragma unroll
            for (int bj = 0; bj < 2; ++bj)
#pragma unroll
                for (int n = 0; n < 2; ++n) {
#pragma unroll
                    for (int j = 0; j < 4; ++j) { float v = cs[bj][n][j]; v += __shfl_xor(v, 1); v += __shfl_xor(v, 2); v += __shfl_xor(v, 4); v += __shfl_xor(v, 8); cs[bj][n][j] = v; }
                    if (fr == 0) { float* kp = kmean + (size_t)u.pm * 512 + (u.pn - 2) * BM + bj * HALF + wc * 32 + 8 * fq + 4 * n;
#pragma unroll
                        for (int j = 0; j < 4; ++j) atomicAdd(kp + j, cs[bj][n][j] * (1.f / 256.f)); } }
        }
    }
};
typedef int i32x8 __attribute__((ext_vector_type(8)));
typedef int i32x4 __attribute__((ext_vector_type(4)));
struct EpiSwiGLUI8 {
    static constexpr bool PERM = true;
    unsigned char* O; int ldc; const float* rowmax; const float* colmax  ; const int* rowidx  ; const LAS int* tab;
    __device__ __forceinline__ void operator()(const f32x4 (&acc)[2][2][4][2], const Unit& u, int wr, int wc, int fr, int fq) const {
        const int row0 = u.pm * BM + wr * 64 + fr, col0 = u.pn * HALF + wc * 32 + 8 * fq;
        const float* cm = colmax + (size_t)u.e * 2 * ldc + u.pn * BM + wc * 32 + 8 * fq;
        const f32x4 cg0 = *(const f32x4*)(cm), cg1 = *(const f32x4*)(cm + 4), cu0 = *(const f32x4*)(cm + HALF), cu1 = *(const f32x4*)(cm + HALF + 4);
        const float cg[8] = {cg0[0], cg0[1], cg0[2], cg0[3], cg1[0], cg1[1], cg1[2], cg1[3]}, cu[8] = {cu0[0], cu0[1], cu0[2], cu0[3], cu1[0], cu1[1], cu1[2], cu1[3]};
        int cume = 0, cnte = 0x7fffffff; if (rowidx) { cume = tab[8 + u.e]; cnte = tab[u.e]; }
#pragma unroll
        for (int ai = 0; ai < 2; ++ai)
#pragma unroll
            for (int m = 0; m < 4; ++m) { const int r = row0 + ai * HALF + m * 16; unsigned char* rowp = O + (size_t)r * ldc + col0;
                float sa; if (rowidx) { const int rl = r - cume * BM; sa = (rl < cnte) ? rowmax[u.e * ECAP + rl] : 0.f; } else sa = rowmax[r];
                sa *= (1.f / (127.f * 127.f));
                float o[8];
#pragma unroll
                for (int n = 0; n < 2; ++n)
#pragma unroll
                    for (int j = 0; j < 4; ++j) { const float g = (float)__builtin_bit_cast(i32x4, acc[ai][0][m][n])[j] * (sa * cg[n * 4 + j]), up = (float)__builtin_bit_cast(i32x4, acc[ai][1][m][n])[j] * (sa * cu[n * 4 + j]);
                        o[n * 4 + j] = g * __builtin_amdgcn_rcpf(1.f + __builtin_amdgcn_exp2f(-1.4426950408889634f * g)) * up; }
                u32x2 w; w.x = pack_fp8x4(o[0], o[1], o[2], o[3]); w.y = pack_fp8x4(o[4], o[5], o[6], o[7]);
                *(u32x2*)rowp = w; }
    }
};

struct EpiSwiGLU8 {
    static constexpr bool PERM = true;
    unsigned char* O; int ldc; float sc;
    __device__ __forceinline__ void operator()(const f32x4 (&acc)[2][2][4][2], const Unit& u, int wr, int wc, int fr, int fq) const {
        const int row0 = u.pm * BM + wr * 64 + fr, col0 = u.pn * HALF + wc * 32 + 8 * fq;
#pragma unroll
        for (int ai = 0; ai < 2; ++ai)
#pragma unroll
            for (int m = 0; m < 4; ++m) { unsigned char* rowp = O + (size_t)(row0 + ai * HALF + m * 16) * ldc + col0;
                float r[8];
#pragma unroll
                for (int n = 0; n < 2; ++n)
#pragma unroll
                    for (int j = 0; j < 4; ++j) { const float g = acc[ai][0][m][n][j] * sc, up = acc[ai][1][m][n][j] * sc;
                        r[n * 4 + j] = g * __builtin_amdgcn_rcpf(1.f + __builtin_amdgcn_exp2f(-1.4426950408889634f * g)) * up; }
                u32x2 w; w.x = pack_fp8x4(r[0], r[1], r[2], r[3]); w.y = pack_fp8x4(r[4], r[5], r[6], r[7]);
                *(u32x2*)rowp = w; }
    }
};

template <class Epi, class Sched, bool ALIGN_EPI, int DT>
__device__ __forceinline__ void gemm_phase(LAS unsigned char* lds, const int KB, const Sched& S, const Epi& E) {
    const int tid = threadIdx.x, wid = __builtin_amdgcn_readfirstlane(tid >> 6), lane = tid & 63, wr = wid >> 2, wc = wid & 3, fr = lane & 15, fq = lane >> 4;
    const int nt = KB / 128;
    int Rr[2], Cc[2]; unsigned voffB[2];
#pragma unroll
    for (int i = 0; i < 2; ++i) { int R, C; stage_rc(tid * 16 + i * 8192, R, C); Rr[i] = R; Cc[i] = C; const int Rb = Epi::PERM ? ((R & ~31) + perm32(R & 31)) : R; voffB[i] = (unsigned)(Rb * KB + C * 2); }
    const size_t kstep = (size_t)(BK * 2);
    const size_t hstep = (size_t)HALF * KB;
    const unsigned ldsw = (unsigned)wid * 1024u;
    const int aoff = lds_byte(wr * 64 + fr, fq * 8), boff = lds_byte(wc * 32 + fr, fq * 8);
#define PG8_SA(b, h) (((b) * 2 + (h)) * HTB)
#define PG8_SB(b, h) ((4 + (b) * 2 + (h)) * HTB)
#define PG8_STAGE(bufoff, gbase, voff) do { _Pragma("unroll") for (int _i = 0; _i < 2; ++_i) \
        __builtin_amdgcn_global_load_lds((const unsigned*)((const char*)(gbase) + (voff)[_i]), (LAS unsigned*)(lds + (bufoff) + ldsw + _i * 8192), 16, 0, 0); } while (0)
#define PG8_LD32(p) __builtin_shufflevector(*(const LAS i32x4*)(p), *(const LAS i32x4*)((p) + 1024), 0, 1, 2, 3, 4, 5, 6, 7)
#define PG8_LDA(dst, b, h) do { _Pragma("unroll") for (int m = 0; m < 4; ++m) dst[m] = PG8_LD32(lds + PG8_SA(b, h) + aoff + m * 2048); } while (0)
#define PG8_LDB(dst, b, h) do { _Pragma("unroll") for (int n = 0; n < 2; ++n) dst[n] = PG8_LD32(lds + PG8_SB(b, h) + boff + n * 2048); } while (0)
#define PG8_LO(x) __builtin_bit_cast(bf16x8, __builtin_shufflevector((x), (x), 0, 1, 2, 3))
#define PG8_HI(x) __builtin_bit_cast(bf16x8, __builtin_shufflevector((x), (x), 4, 5, 6, 7))
#define PG8_MMA(ai, bj, At, Bt) do { __builtin_amdgcn_s_setprio(1); \
        if constexpr (DT == 2) { _Pragma("unroll") for (int m = 0; m < 4; ++m) _Pragma("unroll") for (int n = 0; n < 2; ++n) { \
            i32x4 _c = __builtin_bit_cast(i32x4, acc[ai][bj][m][n]); \
            _c = __builtin_amdgcn_mfma_i32_16x16x64_i8(__builtin_shufflevector(Bt[n], Bt[n], 0, 1, 2, 3), __builtin_shufflevector(At[m], At[m], 0, 1, 2, 3), _c, 0, 0, 0); \
            _c = __builtin_amdgcn_mfma_i32_16x16x64_i8(__builtin_shufflevector(Bt[n], Bt[n], 4, 5, 6, 7), __builtin_shufflevector(At[m], At[m], 4, 5, 6, 7), _c, 0, 0, 0); \
            acc[ai][bj][m][n] = __builtin_bit_cast(f32x4, _c); } } \
        else if constexpr (DT == 1) { _Pragma("unroll") for (int m = 0; m < 4; ++m) _Pragma("unroll") for (int n = 0; n < 2; ++n) \
            asm volatile("v_mfma_scale_f32_16x16x128_f8f6f4 %0, %1, %2, %0, %3, %3 op_sel_hi:[0,0,0]" : "+v"(acc[ai][bj][m][n]) : "v"(Bt[n]), "v"(At[m]), "v"(scv)); } \
        else { _Pragma("unroll") for (int m = 0; m < 4; ++m) _Pragma("unroll") for (int n = 0; n < 2; ++n) { \
            acc[ai][bj][m][n] = __builtin_amdgcn_mfma_f32_16x16x32_bf16(PG8_LO(Bt[n]), PG8_LO(At[m]), acc[ai][bj][m][n], 0, 0, 0); \
            acc[ai][bj][m][n] = __builtin_amdgcn_mfma_f32_16x16x32_bf16(PG8_HI(Bt[n]), PG8_HI(At[m]), acc[ai][bj][m][n], 0, 0, 0); } } \
        __builtin_amdgcn_s_setprio(0); } while (0)
#define PG8_WAIT_V(n) asm volatile("s_waitcnt vmcnt(" #n ")" ::: "memory")
#define PG8_WAIT_L(n) asm volatile("s_waitcnt lgkmcnt(" #n ")" ::: "memory")
#define PG8_BAR __builtin_amdgcn_s_barrier()
#define PG8_SCHED __builtin_amdgcn_sched_barrier(0)
    Unit cur, nxt; int ui = 0;
    if (!S.next(0, cur)) return;
    f32x4 acc[2][2][4][2];
#pragma unroll
    for (int a = 0; a < 2; ++a)
#pragma unroll
        for (int b = 0; b < 2; ++b)
#pragma unroll
            for (int m = 0; m < 4; ++m)
#pragma unroll
                for (int n = 0; n < 2; ++n) acc[a][b][m][n] = (f32x4){0.f, 0.f, 0.f, 0.f};
    i32x8 At[4], B0[2], B1[2];
    int scv = 0x7F7F7F7F; asm volatile("" : "+v"(scv));
    unsigned curA[2][2], nxtA[2][2], voffA[2];
    const char* const Ab = S.a_base(); const char* cA = Ab; const char* nA = Ab;
    if constexpr (Sched::GATHER) S.a_offsets(cur, Rr, Cc, curA);
    else {
#pragma unroll
        for (int i = 0; i < 2; ++i) voffA[i] = (unsigned)(Rr[i] * KB + Cc[i] * 2);
        cA = Ab + (size_t)cur.pm * 2 * hstep; }
    const char* cB = S.b_base(cur);
#define PG8_STA(bufoff, nextflag, h, koff) do { if constexpr (Sched::GATHER) { unsigned _o[2]; _o[0] = (nextflag) ? nxtA[h][0] : curA[h][0]; _o[1] = (nextflag) ? nxtA[h][1] : curA[h][1]; PG8_STAGE(bufoff, Ab + (koff), _o); } \
        else { PG8_STAGE(bufoff, ((nextflag) ? nA : cA) + (size_t)(h) * hstep + (koff), voffA); } } while (0)
    PG8_STAGE(PG8_SB(0, 0), cB, voffB); PG8_STAGE(PG8_SB(0, 1), cB + hstep, voffB); PG8_STA(PG8_SA(0, 0), false, 0, 0); PG8_STA(PG8_SA(0, 1), false, 1, 0);
    if (wr == 1) PG8_BAR;
    PG8_WAIT_V(2); PG8_BAR;
    PG8_STAGE(PG8_SB(1, 0), cB + kstep, voffB); PG8_STA(PG8_SA(1, 0), false, 0, kstep); PG8_STAGE(PG8_SB(1, 1), cB + hstep + kstep, voffB);
    PG8_WAIT_V(6); PG8_BAR;
    for (;;) {
        const bool has_next = S.next(ui + 1, nxt);
        if constexpr (Sched::GATHER) {
            if (has_next) S.a_offsets(nxt, Rr, Cc, nxtA);
            else {
#pragma unroll
                for (int h = 0; h < 2; ++h)
#pragma unroll
                    for (int i = 0; i < 2; ++i) nxtA[h][i] = curA[h][i]; }
        } else nA = has_next ? Ab + (size_t)nxt.pm * 2 * hstep : cA;
        const char* nB = has_next ? S.b_base(nxt) : cB;
        for (int t = 0; t < nt; t += 2) {
            const bool last = (t == nt - 2);
            const size_t k1 = (size_t)(t + 1) * kstep, k2 = last ? 0 : (size_t)(t + 2) * kstep, k3 = k2 + kstep;
            const char* b2 = last ? nB : cB + (size_t)(t + 2) * kstep; const char* b3 = b2 + kstep;
            PG8_LDB(B0, 0, 0); PG8_LDB(B1, 0, 1); PG8_SCHED; PG8_LDA(At, 0, 0); PG8_STA(PG8_SA(1, 1), false, 1, k1);
            PG8_WAIT_V(8); PG8_WAIT_L(0); PG8_BAR; PG8_MMA(0, 0, At, B0); PG8_MMA(0, 1, At, B1); PG8_BAR; PG8_SCHED;
            PG8_LDA(At, 0, 1); PG8_STAGE(PG8_SB(0, 0), b2, voffB); PG8_STAGE(PG8_SB(0, 1), b2 + hstep, voffB); PG8_STA(PG8_SA(0, 0), last, 0, k2);
            PG8_WAIT_V(8); PG8_WAIT_L(0); PG8_BAR; PG8_MMA(1, 0, At, B0); PG8_MMA(1, 1, At, B1); PG8_BAR; PG8_SCHED;
            PG8_LDB(B0, 1, 0); PG8_LDB(B1, 1, 1); PG8_SCHED; PG8_LDA(At, 1, 0); PG8_STA(PG8_SA(0, 1), last, 1, k2);
            PG8_WAIT_V(8); PG8_WAIT_L(0); PG8_BAR; PG8_MMA(0, 0, At, B0); PG8_MMA(0, 1, At, B1); PG8_BAR; PG8_SCHED;
            PG8_LDA(At, 1, 1); PG8_STAGE(PG8_SB(1, 0), b3, voffB); PG8_STAGE(PG8_SB(1, 1), b3 + hstep, voffB); PG8_STA(PG8_SA(1, 0), last, 0, k3);
            PG8_WAIT_V(8); PG8_WAIT_L(0); PG8_BAR; PG8_MMA(1, 0, At, B0); PG8_MMA(1, 1, At, B1); PG8_BAR; PG8_SCHED;
        }
        if constexpr (ALIGN_EPI) { if (wr == 0) PG8_BAR; }
        if constexpr (DT == 1) asm volatile("s_nop 15\n\ts_nop 15" ::: "memory");
        E(acc, cur, wr, wc, fr, fq);
        if (!has_next) break;
#pragma unroll
        for (int a = 0; a < 2; ++a)
#pragma unroll
            for (int b = 0; b < 2; ++b)
#pragma unroll
                for (int m = 0; m < 4; ++m)
#pragma unroll
                    for (int n = 0; n < 2; ++n) acc[a][b][m][n] = (f32x4){0.f, 0.f, 0.f, 0.f};
        cur = nxt; cB = nB; cA = nA; ++ui;
        if constexpr (Sched::GATHER) {
#pragma unroll
            for (int h = 0; h < 2; ++h)
#pragma unroll
                for (int i = 0; i < 2; ++i) curA[h][i] = nxtA[h][i]; }
        if constexpr (ALIGN_EPI) { if (wr == 1) PG8_BAR; }
    }
    PG8_WAIT_V(0);
    if constexpr (!ALIGN_EPI) { if (wr == 0) PG8_BAR; }
    PG8_BAR;
#undef PG8_SA
#undef PG8_SB
#undef PG8_STAGE
#undef PG8_STA
#undef PG8_LDA
#undef PG8_LDB
#undef PG8_MMA
#undef PG8_LD32
#undef PG8_LO
#undef PG8_HI
#undef PG8_WAIT_V
#undef PG8_WAIT_L
#undef PG8_BAR
#undef PG8_SCHED
}
}

#define XB_TMO      128
#define XB_XCNT(j)  (256  + 64 * (j))
#define XB_XSUB(j)  (1280 + 64 * (j))
#define XB_XGEN(j)  (2304 + 64 * (j))
#define XB_TOP      3328
#define XB_TOPGEN   3392
#define XCD_BAR_WORDS 3456
#define XB_SPIN_CAP (1u << 18)
__device__ __forceinline__ unsigned xb_ld(unsigned* p)              { return __hip_atomic_load(p, __ATOMIC_RELAXED, __HIP_MEMORY_SCOPE_AGENT); }
__device__ __forceinline__ unsigned xb_add(unsigned* p, unsigned v) { return __hip_atomic_fetch_add(p, v, __ATOMIC_RELAXED, __HIP_MEMORY_SCOPE_AGENT); }
__device__ __forceinline__ unsigned xb_xcc_id() { return (unsigned)__builtin_amdgcn_s_getreg((3 << 11) | 20) & 0xFu; }
#define XB_SPIN(cond, bar) do { unsigned _sp = 0; while (cond) { __builtin_amdgcn_s_sleep(1); \
    if ((++_sp & 255u) == 0u) { if (xb_ld(&(bar)[XB_TMO])) break; if (_sp > XB_SPIN_CAP) { atomicAdd(&(bar)[XB_TMO], 1u); break; } } } } while (0)
struct XcdBarrier { unsigned* bar; unsigned x; volatile LAS unsigned* st; };
__device__ __forceinline__ XcdBarrier xcd_barrier_post(unsigned* bar, volatile LAS unsigned* st) {
    XcdBarrier b; b.bar = bar; b.x = xb_xcc_id(); b.st = st;
    if (threadIdx.x == 0) (void)xb_add(&bar[XB_XCNT(b.x)], 1u);
    return b;
}
__device__ __forceinline__ void xcd_barrier_complete(unsigned* bar, unsigned x, unsigned& nloc, unsigned& nx) {
    const unsigned G = gridDim.x * gridDim.y * gridDim.z;
    unsigned sum, cnt, mine, sp = 0u;
    for (;;) {
        sum = 0u; cnt = 0u; mine = 0u;
#pragma unroll
        for (unsigned j = 0; j < 16; ++j) { const unsigned c = xb_ld(&bar[XB_XCNT(j)]); sum += c; cnt += (c > 0u) ? 1u : 0u; mine = (j == x) ? c : mine; }
        if (sum == G) break;
        __builtin_amdgcn_s_sleep(1);
        if ((++sp & 255u) == 0u) { if (xb_ld(&bar[XB_TMO])) break; if (sp > XB_SPIN_CAP) { atomicAdd(&bar[XB_TMO], 1u); break; } }
    }
    nloc = mine > 0u ? mine : 1u; nx = cnt > 0u ? cnt : 1u;
}
__device__ __forceinline__ void xcd_barrier(const XcdBarrier& b) {
    asm volatile("s_waitcnt vmcnt(0)" ::: "memory");
    __syncthreads();
    if (threadIdx.x == 0) {
        unsigned* bar = b.bar;
        __builtin_amdgcn_s_waitcnt(0);
        unsigned nloc = b.st[0], nx = b.st[1];
        if (nloc == 0u) { xcd_barrier_complete(bar, b.x, nloc, nx); b.st[0] = nloc; b.st[1] = nx; }
        const unsigned old = xb_add(&bar[XB_XSUB(b.x)], 1u);
        const unsigned gen = old / nloc;
        if (old + 1u == (gen + 1u) * nloc) {
            __builtin_amdgcn_fence(__ATOMIC_RELEASE, "agent");
            asm volatile("s_waitcnt vmcnt(0)" ::: "memory");
            const unsigned og = xb_add(&bar[XB_TOP], 1u);
            const unsigned tg = og / nx;
            if (og + 1u == (tg + 1u) * nx) xb_add(&bar[XB_TOPGEN], 1u);
            else XB_SPIN(xb_ld(&bar[XB_TOPGEN]) == tg, bar);
            __builtin_amdgcn_fence(__ATOMIC_ACQUIRE, "agent");
            xb_add(&bar[XB_XGEN(b.x)], 1u);
            asm volatile("s_waitcnt vmcnt(0)" ::: "memory");
        } else {
            XB_SPIN(xb_ld(&bar[XB_XGEN(b.x)]) == gen, bar);
            __builtin_amdgcn_fence(__ATOMIC_ACQUIRE, "agent");
            asm volatile("s_waitcnt vmcnt(0)" ::: "memory");
        }
    }
    __syncthreads();
}

constexpr int RING_BYTES = 131072, LDSCTL_OFF = RING_BYTES, MISC_OFF = LDSCTL_OFF + 320, LDS_BYTES = 147456;
enum { IN_X = 0, IN_C, IN_ADAW, IN_ADAB, IN_GPREM, IN_GPOSTM, IN_GPREF, IN_GPOSTF, IN_WIN, IN_WOUT, IN_CONVW, IN_CONVB, IN_IGB, IN_FGB, IN_MNW, IN_SINK,
       IN_FG, IN_FU, IN_FD, IN_ROUTER, IN_MG, IN_MU, IN_MD, N_INPUTS };
struct Args { const float* in[N_INPUTS]; float* out; unsigned char* ws; int ph_lo, ph_hi; };
struct Frame {
    LAS unsigned char* lds; unsigned char* glds; unsigned* ctl; unsigned char* ws;
    int tid, lane, wave, G, gw, NGW;
};

__device__ __forceinline__ void p0_ada(Frame& F, const float* c, const float* ada_w, const float* ada_b, float* mod) {
    float* cond = (float*)F.glds;
    float* part = (float*)(F.glds + 65536);
    for (int i = F.tid; i < NB * D; i += NTHR) { const int b = i / D, k = i % D; cond[k * 8 + b] = silu_f(c[i]); }
    __syncthreads();
    const int cq = F.lane & 7, ks = F.lane >> 3;
    for (int u = blockIdx.x; u < 768; u += F.G) {
        const int l = u / 384, cb = u % 384;
        const float* W = ada_w + (size_t)l * D * 6 * D + cb * 32 + cq * 4;
        f32x4 acc[8];
#pragma unroll
        for (int b = 0; b < 8; ++b) acc[b] = (f32x4){0.f, 0.f, 0.f, 0.f};
        const int kbase = F.wave * 256 + ks;
#pragma unroll 4
        for (int it = 0; it < 32; ++it) {
            const int k = kbase + 8 * it;
            const f32x4 w = __builtin_nontemporal_load((const f32x4*)(W + (size_t)k * 6 * D));
            const f32x4 c0 = *(const f32x4*)(cond + k * 8), c1 = *(const f32x4*)(cond + k * 8 + 4);
            acc[0] += w * c0[0]; acc[1] += w * c0[1]; acc[2] += w * c0[2]; acc[3] += w * c0[3];
            acc[4] += w * c1[0]; acc[5] += w * c1[1]; acc[6] += w * c1[2]; acc[7] += w * c1[3];
        }
#pragma unroll
        for (int b = 0; b < 8; ++b)
#pragma unroll
            for (int j = 0; j < 4; ++j) { float v = acc[b][j]; v += __shfl_xor(v, 8); v += __shfl_xor(v, 16); v += __shfl_xor(v, 32); acc[b][j] = v; }
        if (F.lane < 8) {
#pragma unroll
            for (int b = 0; b < 8; ++b) *(f32x4*)(part + (F.wave * 8 + b) * 32 + cq * 4) = acc[b];
        }
        __syncthreads();
        if (F.tid < 256) { const int b = F.tid >> 5, col = F.tid & 31; float s = ada_b[(size_t)l * 6 * D + cb * 32 + col];
#pragma unroll
          for (int w = 0; w < 8; ++w) s += part[(w * 8 + b) * 32 + col];
          mod[((size_t)l * NB + b) * 6 * D + cb * 32 + col] = s; }
        __syncthreads();
    }
}
__device__ __forceinline__ void cvt_item(const float* src, int ld, int k0, int c0, bf16_t* dst, int Kd, int drow0, unsigned char* scr, int lane) {
    const int c = lane & 15, q = lane >> 4;
    f32x4 v[4][4];
#pragma unroll
    for (int g = 0; g < 4; ++g)
#pragma unroll
        for (int j = 0; j < 4; ++j) v[g][j] = __builtin_nontemporal_load((const f32x4*)(src + (size_t)(k0 + 16 * g + 4 * q + j) * ld + c0 + 4 * c));
#pragma unroll
    for (int g = 0; g < 4; ++g)
#pragma unroll
        for (int i = 0; i < 4; ++i) { u32x2 w; w.x = cvtpk(v[g][0][i], v[g][1][i]); w.y = cvtpk(v[g][2][i], v[g][3][i]);
            *(u32x2*)(scr + (4 * c + i) * 136 + (16 * g + 4 * q) * 2) = w; }
    asm volatile("s_waitcnt lgkmcnt(0)" ::: "memory");
#pragma unroll
    for (int r = 0; r < 8; ++r) { const int n = 8 * r + (lane >> 3), ch = lane & 7;
        const u32x2 a = *(const u32x2*)(scr + n * 136 + ch * 16), b = *(const u32x2*)(scr + n * 136 + ch * 16 + 8);
        u32x4 o; o.x = a.x; o.y = a.y; o.z = b.x; o.w = b.y;
        *(u32x4*)(dst + (size_t)(drow0 + n) * Kd + k0 + 8 * ch) = o; }
    asm volatile("s_waitcnt lgkmcnt(0)" ::: "memory");
}
constexpr float WSC = 64.f, WSC_INV = 1.f / 64.f;
__device__ __forceinline__ void cvt_item8(const float* src, int ld, int k0, int c0, unsigned char* dst, int Kd, int drow0, unsigned char* scr, int lane) {
    const int c = lane & 7, q = lane >> 3;
    f32x4 v[4][4];
#pragma unroll
    for (int g = 0; g < 4; ++g)
#pragma unroll
        for (int j = 0; j < 4; ++j) v[g][j] = __builtin_nontemporal_load((const f32x4*)(src + (size_t)(k0 + 32 * g + 4 * q + j) * ld + c0 + 4 * c));
#pragma unroll
    for (int g = 0; g < 4; ++g)
#pragma unroll
        for (int i = 0; i < 4; ++i) *(unsigned*)(scr + (4 * c + i) * 132 + 32 * g + 4 * q) = pg8::pack_fp8x4(v[g][0][i] * WSC, v[g][1][i] * WSC, v[g][2][i] * WSC, v[g][3][i] * WSC);
    asm volatile("s_waitcnt lgkmcnt(0)" ::: "memory");
#pragma unroll
    for (int r = 0; r < 4; ++r) { const int n = 8 * r + (lane >> 3), ch = lane & 7; const unsigned char* p = scr + n * 132 + ch * 16;
        u32x4 o; o.x = *(const unsigned*)(p); o.y = *(const unsigned*)(p + 4); o.z = *(const unsigned*)(p + 8); o.w = *(const unsigned*)(p + 12);
        *(u32x4*)(dst + (size_t)(drow0 + n) * Kd + k0 + 16 * ch) = o; }
    asm volatile("s_waitcnt lgkmcnt(0)" ::: "memory");
}
__device__ __forceinline__ const float* inptr(const Frame& F, int i);
constexpr int CMS_KB = 2;
constexpr float CMS_F = 1.4f;
constexpr size_t COLMAX_OFF = 524288;
__device__ __forceinline__ void colmax_item(const float* src, int ld, int k0, int c0, float* cmx  , int lane) {
    const int c = lane & 7, q = lane >> 3;
    f32x4 mx = (f32x4){0.f, 0.f, 0.f, 0.f};
#pragma unroll
    for (int g = 0; g < 4; ++g)
#pragma unroll
        for (int j = 0; j < 4; ++j) { const f32x4 v = *(const f32x4*)(src + (size_t)(k0 + 32 * g + 4 * q + j) * ld + c0 + 4 * c);
            mx[0] = fmaxf(mx[0], fabsf(v[0])); mx[1] = fmaxf(mx[1], fabsf(v[1])); mx[2] = fmaxf(mx[2], fabsf(v[2])); mx[3] = fmaxf(mx[3], fabsf(v[3])); }
#pragma unroll
    for (int i = 0; i < 4; ++i) { float v = mx[i]; v = fmaxf(v, __shfl_xor(v, 8)); v = fmaxf(v, __shfl_xor(v, 16)); v = fmaxf(v, __shfl_xor(v, 32)); mx[i] = v; }
    if (q == 0) {
#pragma unroll
        for (int i = 0; i < 4; ++i) atomicMax((unsigned*)(cmx + 4 * c + i), __float_as_uint(mx[i] * CMS_F)); }
}
__device__ __forceinline__ unsigned pack_i8x4(float a, float b, float c, float d) {
    const int ia = (int)rintf(fminf(fmaxf(a, -127.f), 127.f)), ib = (int)rintf(fminf(fmaxf(b, -127.f), 127.f)), ic = (int)rintf(fminf(fmaxf(c, -127.f), 127.f)), id = (int)rintf(fminf(fmaxf(d, -127.f), 127.f));
    return (unsigned)(ia & 0xff) | ((unsigned)(ib & 0xff) << 8) | ((unsigned)(ic & 0xff) << 16) | ((unsigned)(id & 0xff) << 24);
}
__device__ __forceinline__ void cvt_item_i8(const float* src, int ld, int k0, int c0, unsigned char* dst, int Kd, int drow0, const float* cmx  , unsigned char* scr, int lane) {
    const int c = lane & 7, q = lane >> 3;
    const f32x4 cm = *(const f32x4*)(cmx + 4 * c);
    f32x4 inv; inv[0] = cm[0] > 0.f ? 127.f / cm[0] : 0.f; inv[1] = cm[1] > 0.f ? 127.f / cm[1] : 0.f; inv[2] = cm[2] > 0.f ? 127.f / cm[2] : 0.f; inv[3] = cm[3] > 0.f ? 127.f / cm[3] : 0.f;
    f32x4 v[4][4];
#pragma unroll
    for (int g = 0; g < 4; ++g)
#pragma unroll
        for (int j = 0; j < 4; ++j) v[g][j] = __builtin_nontemporal_load((const f32x4*)(src + (size_t)(k0 + 32 * g + 4 * q + j) * ld + c0 + 4 * c));
#pragma unroll
    for (int g = 0; g < 4; ++g)
#pragma unroll
        for (int i = 0; i < 4; ++i) *(unsigned*)(scr + (4 * c + i) * 132 + 32 * g + 4 * q) = pack_i8x4(v[g][0][i] * inv[i], v[g][1][i] * inv[i], v[g][2][i] * inv[i], v[g][3][i] * inv[i]);
    asm volatile("s_waitcnt lgkmcnt(0)" ::: "memory");
#pragma unroll
    for (int r = 0; r < 4; ++r) { const int n = 8 * r + (lane >> 3), ch = lane & 7; const unsigned char* p = scr + n * 132 + ch * 16;
        u32x4 o; o.x = *(const unsigned*)(p); o.y = *(const unsigned*)(p + 4); o.z = *(const unsigned*)(p + 8); o.w = *(const unsigned*)(p + 12);
        *(u32x4*)(dst + (size_t)(drow0 + n) * Kd + k0 + 16 * ch) = o; }
    asm volatile("s_waitcnt lgkmcnt(0)" ::: "memory");
}
constexpr int CI_WI = 16 * 152  , CI_WO = 16 * 64, CI_FD = 44 * 64, CI_FGU = 2 * 16 * 176, CI_MD = 8 * 22 * 64, CI_MGU = 16 * 16 * 88;
constexpr int CS_WI = CMS_KB * 152, CS_FGU = 2 * CMS_KB * 176, CS_MGU = 16 * CMS_KB * 88;
constexpr int CONV_N0 = CS_WI + CI_WO + CI_FD + CS_FGU, CONV_N1 = CI_WI + CI_FGU, CONV_N2 = CS_WI + CI_WO + CI_MD + CS_MGU, CONV_N3 = CI_MGU, CONV_N4 = CI_WI;
constexpr int CMX_WIN = 2 * DFF + 16 * DFE;
template <int GRP>
__device__ __forceinline__ void conv_item(Frame& F, int r) {
    unsigned char* scr = F.glds + F.wave * 8704; unsigned char* ws = F.ws;
    float* cmx = (float*)(ws + WS_CTL + COLMAX_OFF);
    if (GRP == 0 || GRP == 1 || GRP == 2 || GRP == 4) {
        constexpr int l = (GRP == 2 || GRP == 4) ? 1 : 0;
        constexpr bool QUANT = (GRP == 1 || GRP == 4); constexpr int NI = QUANT ? CI_WI : CS_WI;
        if (r < NI) { const int kb = r / 152, nb = r % 152, c0 = (nb < 112) ? nb * 32 : SRC_GATE + 8 + (nb - 112) * 32, drow = nb * 32;
            if (QUANT) cvt_item_i8(inptr(F, IN_WIN) + (size_t)l * D * NIN_SRC, NIN_SRC, kb * 128, c0, ws + WS_WIN + (size_t)l * NIN * D, D, drow, cmx + CMX_WIN + l * NIN + drow, scr, F.lane);
            else colmax_item(inptr(F, IN_WIN) + (size_t)l * D * NIN_SRC, NIN_SRC, kb * 128, c0, cmx + CMX_WIN + l * NIN + drow, F.lane);
            return; }
        r -= NI;
    }
    if (GRP == 0 || GRP == 2) {
        constexpr int l = (GRP == 2) ? 1 : 0;
        if (r < CI_WO) { const int kb = r / 64, nb = r % 64;
            cvt_item8(inptr(F, IN_WOUT) + (size_t)l * D * D, D, kb * 128, nb * 32, ws + WS_WOUT + (size_t)l * D * D, D, nb * 32, scr, F.lane); return; }
        r -= CI_WO;
        if (GRP == 0) {
            if (r < CI_FD) { const int kb = r / 64, nb = r % 64; cvt_item8(inptr(F, IN_FD), D, kb * 128, nb * 32, ws + WS_WD, DFF, nb * 32, scr, F.lane); return; }
            r -= CI_FD;
        } else {
            if (r < CI_MD) { const int e = r / (22 * 64); r %= (22 * 64); const int kb = r / 64, nb = r % 64;
                cvt_item8(inptr(F, IN_MD) + (size_t)e * DFE * D, D, kb * 128, nb * 32, ws + WS_MD + (size_t)e * D * DFE, DFE, nb * 32, scr, F.lane); return; }
            r -= CI_MD;
        }
    }
    if (GRP == 0 || GRP == 1) { constexpr int KBN = (GRP == 1) ? 16 : CMS_KB, I_F = KBN * 176; const int up = r / I_F; r %= I_F; const int kb = r / 176, nb = r % 176, n0 = nb * 32, drow = (n0 >> 7) * 256 + up * 128 + (n0 & 127);
        if (GRP == 1) cvt_item_i8(inptr(F, up ? IN_FU : IN_FG), DFF, kb * 128, n0, ws + WS_WGU, D, drow, cmx + drow, scr, F.lane);
        else colmax_item(inptr(F, up ? IN_FU : IN_FG), DFF, kb * 128, n0, cmx + drow, F.lane); }
    else { constexpr int KBN = (GRP == 3) ? 16 : CMS_KB, I_E = KBN * 88; const int up = r / (8 * I_E); r %= (8 * I_E); const int e = r / I_E; r %= I_E; const int kb = r / 88, nb = r % 88, n0 = nb * 32, drow = (n0 >> 7) * 256 + up * 128 + (n0 & 127);
        if (GRP == 3) cvt_item_i8(inptr(F, up ? IN_MU : IN_MG) + (size_t)e * D * DFE, DFE, kb * 128, n0, ws + WS_MGU + (size_t)e * 2 * DFE * D, D, drow, cmx + 2 * DFF + e * 2 * DFE + drow, scr, F.lane);
        else colmax_item(inptr(F, up ? IN_MU : IN_MG) + (size_t)e * D * DFE, DFE, kb * 128, n0, cmx + 2 * DFF + e * 2 * DFE + drow, F.lane); }
}
template <int GRP>
__device__ __forceinline__ void conv_all(Frame& F, int first = 0) {
    constexpr int N = (GRP == 0) ? CONV_N0 : (GRP == 1) ? CONV_N1 : (GRP == 2) ? CONV_N2 : (GRP == 3) ? CONV_N3 : CONV_N4;
    for (int it = first + F.gw; it < N; it += F.NGW) conv_item<GRP>(F, it);
}
template <int YMODE, int EXTRA, bool NORM_OUT, bool XN8  , bool XIN_BF = false  , bool XOUT_BF = false  >
__device__ __forceinline__ void row_phase(Frame& F, const float* xin, float* xout, const bf16_t* ybuf, const float* gpost, const float* gt  ,
                                          const float* gpre, const float* sc, const float* sh, bf16_t* XN,
                                          const float* wex, int ldw, const float* bi, const float* bfg, float* gates_out,
                                          const uint4* tok_in, uint4* tok_out, int* idx_out, unsigned* cntw, float* rowmax = nullptr) {
    LAS float* we = (LAS float*)F.lds;
    LAS float* vA = (LAS float*)(F.lds + 65536);
    LAS float* vB = (LAS float*)(F.lds + 73728);
    LAS float* vC = (LAS float*)(F.lds + 81920);
    LAS float* route = (LAS float*)(F.lds + 90112);
    LAS int* routei = (LAS int*)route;
    LAS int* cumt = (LAS int*)(F.lds + 90112 + 2048);
    if (EXTRA) {
        for (int k = F.tid; k < D; k += NTHR) { const f32x4 a = *(const f32x4*)(wex + (size_t)k * ldw), b = *(const f32x4*)(wex + (size_t)k * ldw + 4);
            we[0 * D + k] = a[0]; we[1 * D + k] = a[1]; we[2 * D + k] = a[2]; we[3 * D + k] = a[3]; we[4 * D + k] = b[0]; we[5 * D + k] = b[1]; we[6 * D + k] = b[2]; we[7 * D + k] = b[3]; }
    }
    if (YMODE == 2) { if (F.tid == 0) { int cum = 0; for (int e = 0; e < NE; ++e) { cumt[e] = cum; cum += (int)((__hip_atomic_load(cntw + e, __ATOMIC_RELAXED, __HIP_MEMORY_SCOPE_AGENT) + 255u) >> 8); } } }
    for (int blk = blockIdx.x; blk < M / 64; blk += F.G) {
        const int b = (blk * 64) / SEQ;
        __syncthreads();
        { const int col = 4 * F.tid;
            if (YMODE) { const f32x4 g = *(const f32x4*)(gt + (size_t)b * 6 * D + col), p = *(const f32x4*)(gpost + col); *(LAS f32x4*)(vA + col) = g * p; }
            if (NORM_OUT) { const f32x4 g = *(const f32x4*)(gpre + col), s = *(const f32x4*)(sc + (size_t)b * 6 * D + col); *(LAS f32x4*)(vB + col) = g * (1.f + s); *(LAS f32x4*)(vC + col) = *(const f32x4*)(sh + (size_t)b * 6 * D + col); } }
        __syncthreads();
        f32x4 xr[8]; u32x2 xrb[8], yr[8], yr2[8]; float w1n = 0.f, w2n = 0.f;
#define RP_LOAD(rr_) do { const size_t row_ = (size_t)blk * 64 + F.wave * 8 + (((rr_) + blk) & 7);   \
            if (XIN_BF) { _Pragma("unroll") for (int j = 0; j < 8; ++j) xrb[j] = __builtin_nontemporal_load((const u32x2*)((const bf16_t*)xin + row_ * D + 256 * j + 4 * F.lane)); } \
            else { _Pragma("unroll") for (int j = 0; j < 8; ++j) xr[j] = __builtin_nontemporal_load((const f32x4*)(xin + row_ * D + 256 * j + 4 * F.lane)); } \
            if (YMODE == 1) { _Pragma("unroll") for (int j = 0; j < 8; ++j) yr[j] = __builtin_nontemporal_load((const u32x2*)(ybuf + row_ * D + 256 * j + 4 * F.lane)); } \
            if (YMODE == 2) { const uint4 ti = tok_in[row_]; \
                const int e1 = (int)(ti.x >> 16), k1 = (int)(ti.x & 0xffffu), e2 = (int)(ti.y >> 16), k2 = (int)(ti.y & 0xffffu); \
                const size_t r1 = (size_t)cumt[e1] * 256 + k1, r2 = (size_t)cumt[e2] * 256 + k2; w1n = __uint_as_float(ti.z); w2n = __uint_as_float(ti.w); \
                _Pragma("unroll") for (int j = 0; j < 8; ++j) { yr[j] = __builtin_nontemporal_load((const u32x2*)(ybuf + r1 * D + 256 * j + 4 * F.lane)); yr2[j] = __builtin_nontemporal_load((const u32x2*)(ybuf + r2 * D + 256 * j + 4 * F.lane)); } } } while (0)
        RP_LOAD(0);
#pragma unroll 1
        for (int rr = 0; rr < 8; ++rr) {
            const int rl = F.wave * 8 + ((rr + blk) & 7); const size_t row = (size_t)blk * 64 + rl;
            asm volatile("" ::: "memory");
            f32x4 x[8];
#pragma unroll
            for (int j = 0; j < 8; ++j) x[j] = XIN_BF ? (f32x4){bflo(xrb[j].x), bfhi(xrb[j].x), bflo(xrb[j].y), bfhi(xrb[j].y)} : xr[j];
            f32x4 y[8];
            if (YMODE == 1) {
#pragma unroll
                for (int j = 0; j < 8; ++j) y[j] = (f32x4){bflo(yr[j].x), bfhi(yr[j].x), bflo(yr[j].y), bfhi(yr[j].y)};
            }
            if (YMODE == 2) {
#pragma unroll
                for (int j = 0; j < 8; ++j) y[j] = (f32x4){bflo(yr[j].x), bfhi(yr[j].x), bflo(yr[j].y), bfhi(yr[j].y)} * w1n + (f32x4){bflo(yr2[j].x), bfhi(yr2[j].x), bflo(yr2[j].y), bfhi(yr2[j].y)} * w2n;
            }
            if (rr < 7) RP_LOAD(rr + 1);
            if (YMODE) {
                float ss = 0.f;
#pragma unroll
                for (int j = 0; j < 8; ++j) ss += (y[j][0] * y[j][0] + y[j][1] * y[j][1]) + (y[j][2] * y[j][2] + y[j][3] * y[j][3]);
                const float r = 1.f / sqrtf(wave_sum(ss) * (1.f / D) + RMS_EPS);
#pragma unroll
                for (int j = 0; j < 8; ++j) { x[j] += *(const LAS f32x4*)(vA + 256 * j + 4 * F.lane) * (y[j] * r);
                    if (XOUT_BF) { u32x2 w; w.x = cvtpk(x[j][0], x[j][1]); w.y = cvtpk(x[j][2], x[j][3]); *(u32x2*)((bf16_t*)xout + row * D + 256 * j + 4 * F.lane) = w; }
                    else __builtin_nontemporal_store(x[j], (f32x4*)(xout + row * D + 256 * j + 4 * F.lane)); }
            }
            if (NORM_OUT) {
                float ss = 0.f;
#pragma unroll
                for (int j = 0; j < 8; ++j) ss += (x[j][0] * x[j][0] + x[j][1] * x[j][1]) + (x[j][2] * x[j][2] + x[j][3] * x[j][3]);
                const float r = 1.f / sqrtf(wave_sum(ss) * (1.f / D) + RMS_EPS);
#pragma unroll
                for (int j = 0; j < 8; ++j) x[j] = (x[j] * r) * *(const LAS f32x4*)(vB + 256 * j + 4 * F.lane) + *(const LAS f32x4*)(vC + 256 * j + 4 * F.lane);
                if (XN8) {
                    float am = 0.f;
#pragma unroll
                    for (int j = 0; j < 8; ++j) am = fmaxf(fmaxf(am, fmaxf(fabsf(x[j][0]), fabsf(x[j][1]))), fmaxf(fabsf(x[j][2]), fabsf(x[j][3])));
                    am = wave_max(am);
                    const float inv = am > 0.f ? 127.f / am : 0.f;
                    if (F.lane == 0) { rowmax[row] = am; if (EXTRA == 2) route[384 + rl] = am; }
#pragma unroll
                    for (int j = 0; j < 8; ++j) *(unsigned*)((unsigned char*)XN + row * D + 256 * j + 4 * F.lane) = pack_i8x4(x[j][0] * inv, x[j][1] * inv, x[j][2] * inv, x[j][3] * inv);
                } else {
#pragma unroll
                    for (int j = 0; j < 8; ++j) { u32x2 w; w.x = cvtpk(x[j][0], x[j][1]); w.y = cvtpk(x[j][2], x[j][3]); *(u32x2*)(XN + row * D + 256 * j + 4 * F.lane) = w; }
                }
                if (EXTRA) {
                    float d8[8];
#pragma unroll
                    for (int e = 0; e < 8; ++e) { float s = 0.f;
#pragma unroll
                        for (int j = 0; j < 8; ++j) { const f32x4 w = *(const LAS f32x4*)(we + e * D + 256 * j + 4 * F.lane); s += (x[j][0] * w[0] + x[j][1] * w[1]) + (x[j][2] * w[2] + x[j][3] * w[3]); }
                        d8[e] = wave_sum(s); asm volatile("" ::: "memory"); }
                    if (EXTRA == 1) {
                        float v = 0.f;
#pragma unroll
                        for (int e = 0; e < 8; ++e) v = (F.lane == e) ? d8[e] : v;
                        if (F.lane < 8) { const float bb = (F.lane < 4) ? bi[F.lane] : bfg[F.lane - 4]; const float z = 15.f * tanhf((v + bb) * (1.f / 15.f));
                            const float o = (F.lane < 4) ? z : (fminf(z, 0.f) - log1pf(expf(-fabsf(z)))); gates_out[row * 8 + F.lane] = o; }
                    } else {
                        int e1 = 0; float v1 = d8[0];
#pragma unroll
                        for (int e = 1; e < 8; ++e) if (d8[e] > v1) { v1 = d8[e]; e1 = e; }
                        int e2 = -1; float v2 = -3.0e38f;
#pragma unroll
                        for (int e = 0; e < 8; ++e) if (e != e1 && d8[e] > v2) { v2 = d8[e]; e2 = e; }
                        const float w1 = 1.f / (1.f + expf(v2 - v1));
                        if (F.lane == 0) { routei[rl * 4 + 0] = e1; routei[rl * 4 + 1] = e2; route[rl * 4 + 2] = w1; route[rl * 4 + 3] = 1.f - w1; }
                    }
                }
            }
        }
#undef RP_LOAD
        if (EXTRA == 2) {
            __syncthreads();
            if (F.tid < NE) { const int e = F.tid; int c = 0;
                for (int r = 0; r < 64; ++r) c += (routei[r * 4] == e) + (routei[r * 4 + 1] == e);
                int base = (int)__hip_atomic_fetch_add(cntw + e, (unsigned)c, __ATOMIC_RELAXED, __HIP_MEMORY_SCOPE_AGENT);
                float* rms = rowmax + (WS_RMSLOT - WS_ROWMAX) / 4;
                for (int r = 0; r < 64; ++r) { if (routei[r * 4] == e) { idx_out[e * ECAP + base] = blk * 64 + r; rms[e * ECAP + base] = route[384 + r]; routei[256 + r * 2] = base; ++base; }
                                               if (routei[r * 4 + 1] == e) { idx_out[e * ECAP + base] = blk * 64 + r; rms[e * ECAP + base] = route[384 + r]; routei[256 + r * 2 + 1] = base; ++base; } } }
            __syncthreads();
            if (F.tid < 64) { const int r = F.tid; uint4 ti; ti.x = ((unsigned)routei[r * 4] << 16) | (unsigned)routei[256 + r * 2]; ti.y = ((unsigned)routei[r * 4 + 1] << 16) | (unsigned)routei[256 + r * 2 + 1];
                ti.z = __float_as_uint(route[r * 4 + 2]); ti.w = __float_as_uint(route[r * 4 + 3]); tok_out[(size_t)blk * 64 + r] = ti; }
        }
    }
    __syncthreads();
}

namespace att {
constexpr int KROW = 144, VROW = 520, K_OFF = 0, V_OFF = 256 * KROW, KM_OFF = V_OFF + 64 * VROW;
constexpr float C2 = 0.125f * 1.4426950408889634f, NEG = -3.0e38f;
__device__ __forceinline__ void stage_kv(LAS unsigned char* lds, const bf16_t* kcol, const bf16_t* vcol, size_t grow0, int nk, int kc0, int tid) {
    for (int c = tid; c < nk * 8; c += NTHR) { const int key = c >> 3, part = c & 7;
        const u32x4 v = *(const u32x4*)(kcol + (grow0 + key) * NIN + part * 8);
        *(LAS u32x4*)(lds + K_OFF + (kc0 + key) * KROW + part * 16) = v; }
    const int np = nk >> 1;
    for (int it = tid; it < np * 8; it += NTHR) { const int kp = it % np, dp = it / np;
        const u32x4 a = *(const u32x4*)(vcol + (grow0 + 2 * kp) * NIN + dp * 8), b = *(const u32x4*)(vcol + (grow0 + 2 * kp + 1) * NIN + dp * 8);
        LAS unsigned char* dst = lds + V_OFF + (dp * 8) * VROW + (kc0 + 2 * kp) * 2;
        *(LAS unsigned*)(dst + 0 * VROW) = (a.x & 0xffffu) | (b.x << 16); *(LAS unsigned*)(dst + 1 * VROW) = (a.x >> 16) | (b.x & 0xffff0000u);
        *(LAS unsigned*)(dst + 2 * VROW) = (a.y & 0xffffu) | (b.y << 16); *(LAS unsigned*)(dst + 3 * VROW) = (a.y >> 16) | (b.y & 0xffff0000u);
        *(LAS unsigned*)(dst + 4 * VROW) = (a.z & 0xffffu) | (b.z << 16); *(LAS unsigned*)(dst + 5 * VROW) = (a.z >> 16) | (b.z & 0xffff0000u);
        *(LAS unsigned*)(dst + 6 * VROW) = (a.w & 0xffffu) | (b.w << 16); *(LAS unsigned*)(dst + 7 * VROW) = (a.w >> 16) | (b.w & 0xffff0000u); }
}
struct KVRegs { u32x4 k[4], va[2], vb[2]; };
__device__ __forceinline__ void kv_load(KVRegs& R, const bf16_t* kcol, const bf16_t* vcol, size_t grow0, int tid) {
#pragma unroll
    for (int i = 0; i < 4; ++i) { const int c = tid + i * NTHR, key = c >> 3, part = c & 7; R.k[i] = *(const u32x4*)(kcol + (grow0 + key) * NIN + part * 8); }
#pragma unroll
    for (int i = 0; i < 2; ++i) { const int it = tid + i * NTHR, kp = it & 127, dp = it >> 7;
        R.va[i] = *(const u32x4*)(vcol + (grow0 + 2 * kp) * NIN + dp * 8); R.vb[i] = *(const u32x4*)(vcol + (grow0 + 2 * kp + 1) * NIN + dp * 8); }
}
__device__ __forceinline__ void kv_store(LAS unsigned char* lds, const KVRegs& R, int tid) {
#pragma unroll
    for (int i = 0; i < 4; ++i) { const int c = tid + i * NTHR, key = c >> 3, part = c & 7; *(LAS u32x4*)(lds + K_OFF + key * KROW + part * 16) = R.k[i]; }
#pragma unroll
    for (int i = 0; i < 2; ++i) { const int it = tid + i * NTHR, kp = it & 127, dp = it >> 7; const u32x4 a = R.va[i], b = R.vb[i];
        LAS unsigned char* dst = lds + V_OFF + (dp * 8) * VROW + (2 * kp) * 2;
        *(LAS unsigned*)(dst + 0 * VROW) = (a.x & 0xffffu) | (b.x << 16); *(LAS unsigned*)(dst + 1 * VROW) = (a.x >> 16) | (b.x & 0xffff0000u);
        *(LAS unsigned*)(dst + 2 * VROW) = (a.y & 0xffffu) | (b.y << 16); *(LAS unsigned*)(dst + 3 * VROW) = (a.y >> 16) | (b.y & 0xffff0000u);
        *(LAS unsigned*)(dst + 4 * VROW) = (a.z & 0xffffu) | (b.z << 16); *(LAS unsigned*)(dst + 5 * VROW) = (a.z >> 16) | (b.z & 0xffff0000u);
        *(LAS unsigned*)(dst + 6 * VROW) = (a.w & 0xffffu) | (b.w << 16); *(LAS unsigned*)(dst + 7 * VROW) = (a.w >> 16) | (b.w & 0xffff0000u); }
}
struct State { f32x16 o0, o1, negm; float m, l; };
constexpr float THR = 5.f, M0 = -1000.f;
__device__ __forceinline__ void init(State& st) {
#pragma unroll
    for (int r = 0; r < 16; ++r) { st.o0[r] = 0.f; st.o1[r] = 0.f; st.negm[r] = -M0; }
    st.m = M0; st.l = 0.f;
}
__device__ __forceinline__ float xhalf_max(float v) { auto rr = __builtin_amdgcn_permlane32_swap(__float_as_uint(v), __float_as_uint(v), false, false); return fmaxf(__uint_as_float(rr[0]), __uint_as_float(rr[1])); }
__device__ __forceinline__ float xhalf_sum(float v) { auto rr = __builtin_amdgcn_permlane32_swap(__float_as_uint(v), __float_as_uint(v), false, false); return __uint_as_float(rr[0]) + __uint_as_float(rr[1]); }
__device__ __forceinline__ void block_mask(State& st, bool lane_ok) {
#pragma unroll
    for (int r = 0; r < 16; ++r) st.negm[r] = lane_ok ? -st.m : NEG;
}
template <int MODE>
__device__ __forceinline__ void tile(LAS unsigned char* lds, int kt, const bf16x8 (&qf)[4], State& st, int lane) {
    const int r32 = lane & 31, h = lane >> 5;
    f32x16 S;
    if (MODE == 3) S = st.negm;
    else {
#pragma unroll
        for (int r = 0; r < 16; ++r) { const int ko = (r & 3) + 8 * (r >> 2) + 4 * h; const bool ok = (MODE == 1) ? (ko <= r32) : (ko > r32); S[r] = ok ? st.negm[r] : NEG; } }
    const LAS unsigned char* kp = lds + K_OFF + (kt * 32 + r32) * KROW + h * 16;
#pragma unroll
    for (int s = 0; s < 4; ++s) { const bf16x8 a = *(const LAS bf16x8*)(kp + s * 32); S = __builtin_amdgcn_mfma_f32_32x32x16_bf16(a, qf[s], S, 0, 0, 0); }
    float tmax;
    asm volatile("s_nop 15\n\ts_nop 7" : "+v"(S));
    { float m0, m1, m2, m3, m4;
      asm("v_max3_f32 %0, %1, %2, %3" : "=v"(m0) : "v"(S[0]), "v"(S[1]), "v"(S[2]));    asm("v_max3_f32 %0, %1, %2, %3" : "=v"(m1) : "v"(S[3]), "v"(S[4]), "v"(S[5]));
      asm("v_max3_f32 %0, %1, %2, %3" : "=v"(m2) : "v"(S[6]), "v"(S[7]), "v"(S[8]));    asm("v_max3_f32 %0, %1, %2, %3" : "=v"(m3) : "v"(S[9]), "v"(S[10]), "v"(S[11]));
      asm("v_max3_f32 %0, %1, %2, %3" : "=v"(m4) : "v"(S[12]), "v"(S[13]), "v"(S[14])); asm("v_max3_f32 %0, %1, %2, %3" : "=v"(m0) : "v"(m0), "v"(m1), "v"(S[15]));
      asm("v_max3_f32 %0, %1, %2, %3" : "=v"(m2) : "v"(m2), "v"(m3), "v"(m4));          asm("v_max_f32 %0, %1, %2" : "=v"(tmax) : "v"(m0), "v"(m2)); }
    tmax = xhalf_max(tmax);
    if (__any(tmax > THR)) {
        const float d = tmax > THR ? tmax : 0.f, alpha = __builtin_amdgcn_exp2f(-d);
        st.m += d; st.l *= alpha;
#pragma unroll
        for (int r = 0; r < 16; ++r) { S[r] -= d; st.negm[r] -= d; st.o0[r] *= alpha; st.o1[r] *= alpha; }
    }
    float ls0 = 0.f, ls1 = 0.f;
#pragma unroll
    for (int r = 0; r < 16; r += 2) { const float p0 = __builtin_amdgcn_exp2f(S[r]), p1 = __builtin_amdgcn_exp2f(S[r + 1]); S[r] = p0; S[r + 1] = p1; ls0 += p0; ls1 += p1; }
    st.l += ls0 + ls1;
    const LAS unsigned char* vp = lds + V_OFF + r32 * VROW + kt * 64 + h * 8;
#pragma unroll
    for (int s = 0; s < 2; ++s) {
        u32x4 pw; pw.x = cvtpk(S[8 * s + 0], S[8 * s + 1]); pw.y = cvtpk(S[8 * s + 2], S[8 * s + 3]); pw.z = cvtpk(S[8 * s + 4], S[8 * s + 5]); pw.w = cvtpk(S[8 * s + 6], S[8 * s + 7]);
        const bf16x8 pf = __builtin_bit_cast(bf16x8, pw);
        { const u32x2 lo = *(const LAS u32x2*)(vp + s * 32), hi = *(const LAS u32x2*)(vp + s * 32 + 16); u32x4 aw; aw.x = lo.x; aw.y = lo.y; aw.z = hi.x; aw.w = hi.y;
          st.o0 = __builtin_amdgcn_mfma_f32_32x32x16_bf16(__builtin_bit_cast(bf16x8, aw), pf, st.o0, 0, 0, 0); }
        { const u32x2 lo = *(const LAS u32x2*)(vp + 32 * VROW + s * 32), hi = *(const LAS u32x2*)(vp + 32 * VROW + s * 32 + 16); u32x4 aw; aw.x = lo.x; aw.y = lo.y; aw.z = hi.x; aw.w = hi.y;
          st.o1 = __builtin_amdgcn_mfma_f32_32x32x16_bf16(__builtin_bit_cast(bf16x8, aw), pf, st.o1, 0, 0, 0); }
    }
}
constexpr float YSC = 16.f;
__device__ __forceinline__ void store_out(const State& st, float inv, unsigned char* orow  , int lane) {
    const int h = lane >> 5;
#pragma unroll
    for (int g = 0; g < 4; ++g) {
        *(unsigned*)(orow + 8 * g + 4 * h) = pg8::pack_fp8x4(st.o0[4 * g] * inv, st.o0[4 * g + 1] * inv, st.o0[4 * g + 2] * inv, st.o0[4 * g + 3] * inv);
        *(unsigned*)(orow + 32 + 8 * g + 4 * h) = pg8::pack_fp8x4(st.o1[4 * g] * inv, st.o1[4 * g + 1] * inv, st.o1[4 * g + 2] * inv, st.o1[4 * g + 3] * inv); }
}
__device__ __forceinline__ void moba_unit(Frame& F, const bf16_t* proj, const float* kmean, unsigned char* Y, int b, int h, int j) {
    LAS unsigned char* lds = F.lds; const int lane = F.lane, r32 = lane & 31, hh = lane >> 5, w = F.wave;
    const size_t rb = (size_t)b * SEQ; const int t = j * 256 + w * 32 + r32;
    bf16x8 qf[4];
    { const bf16_t* qrow = proj + (rb + t) * NIN + C_MQ + h * 64 + hh * 8;
#pragma unroll
      for (int s = 0; s < 4; ++s) qf[s] = *(const bf16x8*)(qrow + s * 16); }
    LBAR();
    LAS float* km = (LAS float*)(lds + KM_OFF);
    if (F.tid < j * 64) km[F.tid] = kmean[(size_t)(b * 8 + (F.tid >> 6)) * 512 + h * 64 + (F.tid & 63)];
    LBAR();
    unsigned sel;
    if (j <= 3) sel = (1u << j) - 1u;
    else {
        float g[7];
#pragma unroll
        for (int n = 0; n < 7; ++n) { g[n] = NEG;
            if (n < j) { float a = 0.f;
#pragma unroll
                for (int s = 0; s < 4; ++s)
#pragma unroll
                    for (int jj = 0; jj < 8; ++jj) a += bf1((bf16_t)qf[s][jj]) * km[n * 64 + 16 * s + 8 * hh + jj];
                a += __shfl_xor(a, 32); g[n] = a; } }
        sel = 0u;
#pragma unroll
        for (int r = 0; r < 3; ++r) { float best = NEG; int bi = 0;
#pragma unroll
            for (int n = 0; n < 7; ++n) if (n < j && !((sel >> n) & 1u) && g[n] > best) { best = g[n]; bi = n; }
            sel |= 1u << bi; }
    }
    State st; init(st);
    const bf16_t* kcol = proj + C_MK + h * 64; const bf16_t* vcol = proj + C_MV + h * 64;
    KVRegs R; kv_load(R, kcol, vcol, rb, F.tid);
    for (int n = 0; n <= j; ++n) {
        LBAR();
        kv_store(lds, R, F.tid);
        if (n < j) kv_load(R, kcol, vcol, rb + (size_t)(n + 1) * 256, F.tid);
        LBAR();
        if (n < j) { const bool ok = (sel >> n) & 1u;
            if (__any(ok)) { block_mask(st, ok); for (int kt = 0; kt < 8; ++kt) tile<3>(lds, kt, qf, st, lane); } }
        else { block_mask(st, true); for (int kt = 0; kt < w; ++kt) tile<3>(lds, kt, qf, st, lane);
               tile<1>(lds, w, qf, st, lane); }
    }
    const float lt = xhalf_sum(st.l);
    store_out(st, YSC / lt, Y + (rb + t) * D + h * 64, lane);
}
__device__ __forceinline__ void swa_unit(Frame& F, const bf16_t* proj, const float* sinks, unsigned char* Y, int b, int kvh, int qb) {
    LAS unsigned char* lds = F.lds; int lane = F.lane; asm volatile("" : "+v"(lane));
    const int r32 = lane & 31, hh = lane >> 5, w = F.wave, hq = kvh * 8 + w;
    const size_t rb = (size_t)b * SEQ;
    const bf16_t* kcol = proj + C_SK + kvh * 64; const bf16_t* vcol = proj + C_SV + kvh * 64;
    LBAR();
    if (qb > 0) stage_kv(lds, kcol, vcol, rb + (size_t)qb * 128 - 128, 256, 0, F.tid);
    else        stage_kv(lds, kcol, vcol, rb, 128, 128, F.tid);
    LBAR();
    const float sk = sinks[hq] * 1.4426950408889634f;
    for (int sb = 0; sb < 4; ++sb) {
        const int t = qb * 128 + sb * 32 + r32;
        bf16x8 qf[4];
        { const bf16_t* qrow = proj + (rb + t) * NIN + C_SQ + hq * 64 + hh * 8;
#pragma unroll
          for (int s = 0; s < 4; ++s) qf[s] = *(const bf16x8*)(qrow + s * 16); }
        State st; init(st);
        int kt0 = sb; if (qb == 0 && kt0 < 4) kt0 = 4;
        if (kt0 == sb) tile<2>(lds, sb, qf, st, lane);
        for (int kt = (kt0 > sb + 1 ? kt0 : sb + 1); kt < sb + 4; ++kt) tile<3>(lds, kt, qf, st, lane);
        tile<1>(lds, sb + 4, qf, st, lane);
        const float lt = xhalf_sum(st.l) + __builtin_amdgcn_exp2f(sk - st.m);
        store_out(st, YSC / lt, Y + (rb + t) * D + 1024 + hq * 64, lane);
    }
}
}

#include <hip/hip_bf16.h>
#include <cmath>
namespace mob {
using bf16=__hip_bfloat16;
using bf16x8=__attribute__((ext_vector_type(8)))short;
using s16x4=__attribute__((ext_vector_type(4)))short;
using f32x16=__attribute__((ext_vector_type(16)))float;
using u32x4=__attribute__((ext_vector_type(4)))unsigned;
constexpr int SEQ=2048,D=64,DM=4864;
constexpr int NW=8,QBLK=32,QB=QBLK*NW,KVBLK=64,NQB=SEQ/QB;
__device__ __forceinline__ int crow(int r,int hi){return (r&3)+8*(r>>2)+4*hi;}
#define SBAR() __builtin_amdgcn_sched_barrier(0)
__device__ __forceinline__ void cmask(f32x16&p0,f32x16&p1,int jb,int qrel,int hi){
  const float NEG=-INFINITY; int kb=64*jb+4*hi;
  #pragma unroll
  for(int r=0;r<16;++r){int kv=kb+(r&3)+8*(r>>2); if(kv>qrel)p0[r]=NEG; if(kv+32>qrel)p1[r]=NEG;}
}

constexpr int NSLOT=3, SLOTB=8192;
constexpr int LDS_K=0, LDS_V=NSLOT*SLOTB, LDS_WS=2*NSLOT*SLOTB, LDS_OST=LDS_WS+NW*64*4, LDS_BYTES=LDS_OST+NW*4096, LDS_KM=LDS_BYTES  ;
constexpr float NEGB=-3.0e38f, YSC=16.f;
constexpr float C2=0.125f*1.4426950408889634f;
__device__ __forceinline__ void glds16(const void*sbase,unsigned voff,unsigned lds_dst){unsigned keep;
  asm volatile("s_mov_b32 %0, m0\n\ts_mov_b32 m0, %2\n\ts_nop 0\n\tglobal_load_lds_dwordx4 %1, %3\n\ts_mov_b32 m0, %0":"=&s"(keep):"v"(voff),"s"(lds_dst),"s"(sbase):"memory");}
__device__ __forceinline__ float max3f(float a,float b,float c){float r;asm("v_max3_f32 %0, %1, %2, %3":"=v"(r):"v"(a),"v"(b),"v"(c));return r;}
__device__ __forceinline__ float max2f(float a,float b){float r;asm("v_max_f32_e32 %0, %1, %2":"=v"(r):"v"(a),"v"(b));return r;}
__device__ __forceinline__ float fadd_s(float a,float b){float r;asm("v_add_f32_e32 %0, %1, %2":"=v"(r):"v"(a),"v"(b));return r;}
__device__ __forceinline__ float fsub_s(float a,float b){float r;asm("v_sub_f32_e32 %0, %1, %2":"=v"(r):"v"(a),"v"(b));return r;}
typedef float f32x2_t __attribute__((ext_vector_type(2))); typedef __bf16 bf16x2_t __attribute__((ext_vector_type(2)));
__device__ __forceinline__ unsigned cvtpk_s(float lo,float hi){f32x2_t v={lo,hi};bf16x2_t b=__builtin_convertvector(v,bf16x2_t);return __builtin_bit_cast(unsigned,b);}
#define WAIT_BAR(N) asm volatile("s_waitcnt vmcnt(" #N ") lgkmcnt(0)\n\ts_barrier":::"memory")

__device__ __forceinline__ void qkt(f32x16&p0,f32x16&p1,const char*Kslot,const bf16x8*qr,const f32x16&negm,int r32,int hi){
  const char*kb=Kslot+hi*1024+r32*16;
  #pragma unroll
  for(int d0=0;d0<4;++d0){
    const bf16x8 b0=*reinterpret_cast<const bf16x8*>(kb+d0*2048);
    const bf16x8 b1=*reinterpret_cast<const bf16x8*>(kb+d0*2048+512);
    if(d0==0){p0=__builtin_amdgcn_mfma_f32_32x32x16_bf16(b0,qr[0],negm,0,0,0);p1=__builtin_amdgcn_mfma_f32_32x32x16_bf16(b1,qr[0],negm,0,0,0);}
    else{p0=__builtin_amdgcn_mfma_f32_32x32x16_bf16(b0,qr[d0],p0,0,0,0);p1=__builtin_amdgcn_mfma_f32_32x32x16_bf16(b1,qr[d0],p1,0,0,0);}}
}
typedef __attribute__((address_space(3))) const char* lds_cptr;
typedef short v4i16_t __attribute__((ext_vector_type(4)));
__device__ __forceinline__ void kload8(bf16x8*kf,lds_cptr kp){
  kf[0]=*(const __attribute__((address_space(3))) bf16x8*)(kp);      kf[1]=*(const __attribute__((address_space(3))) bf16x8*)(kp+512);
  kf[2]=*(const __attribute__((address_space(3))) bf16x8*)(kp+2048); kf[3]=*(const __attribute__((address_space(3))) bf16x8*)(kp+2560);
  kf[4]=*(const __attribute__((address_space(3))) bf16x8*)(kp+4096); kf[5]=*(const __attribute__((address_space(3))) bf16x8*)(kp+4608);
  kf[6]=*(const __attribute__((address_space(3))) bf16x8*)(kp+6144); kf[7]=*(const __attribute__((address_space(3))) bf16x8*)(kp+6656);
}
__device__ __forceinline__ void kload2(bf16x8*kf,lds_cptr kp,int j){ kf[2*j]=*(const __attribute__((address_space(3))) bf16x8*)(kp+j*2048); kf[2*j+1]=*(const __attribute__((address_space(3))) bf16x8*)(kp+j*2048+512); }
__device__ __forceinline__ s16x4 vtr(lds_cptr p){ return __builtin_bit_cast(s16x4,__builtin_amdgcn_ds_read_tr16_b64_v4i16((__attribute__((address_space(3))) v4i16_t*)p)); }
__device__ __forceinline__ float rowmax(const f32x16&p0,const f32x16&p1){
  float a=max3f(p0[0],p0[1],p1[0]),b=max3f(p0[2],p0[3],p1[1]);a=max3f(a,p1[2],p1[3]);
  #pragma unroll
  for(int r=4;r<16;r+=4){a=max3f(a,p0[r],p0[r+1]);b=max3f(b,p0[r+2],p0[r+3]);a=max3f(a,p1[r],p1[r+1]);b=max3f(b,p1[r+2],p1[r+3]);}
  const float m=max2f(a,b);
  auto rr=__builtin_amdgcn_permlane32_swap(__float_as_uint(m),__float_as_uint(m),false,false);
  return max2f(__uint_as_float(rr[0]),__uint_as_float(rr[1]));
}
__device__ __forceinline__ void pv(f32x16*o,int vb,bf16x8 pa0,bf16x8 pa1,bf16x8 pa2,bf16x8 pa3){
  #pragma unroll
  for(int d0=0;d0<2;++d0){s16x4 lo[4],hi[4];
    #pragma unroll
    for(int ks=0;ks<4;++ks){
      asm volatile("ds_read_b64_tr_b16 %0,%1 offset:%c2":"=&v"(lo[ks]):"v"(vb),"i"(d0*4096+ks*1024):"memory");
      asm volatile("ds_read_b64_tr_b16 %0,%1 offset:%c2":"=&v"(hi[ks]):"v"(vb),"i"(d0*4096+ks*1024+512):"memory");}
    asm volatile("s_waitcnt lgkmcnt(0)":::"memory");SBAR();
    #define PK(k) (bf16x8){lo[k][0],lo[k][1],lo[k][2],lo[k][3],hi[k][0],hi[k][1],hi[k][2],hi[k][3]}
    o[d0]=__builtin_amdgcn_mfma_f32_32x32x16_bf16(pa0,PK(0),o[d0],0,0,0);
    o[d0]=__builtin_amdgcn_mfma_f32_32x32x16_bf16(pa1,PK(1),o[d0],0,0,0);
    o[d0]=__builtin_amdgcn_mfma_f32_32x32x16_bf16(pa2,PK(2),o[d0],0,0,0);
    o[d0]=__builtin_amdgcn_mfma_f32_32x32x16_bf16(pa3,PK(3),o[d0],0,0,0);
    #undef PK
  }
}

#ifndef ATTN_STORE16
#define ATTN_STORE16(p,v) (*(u32x4*)(p)=(v))
#endif
template<int THRL> __device__ __forceinline__ void attn_unit(int b,int h,int qb,const bf16*Q,const bf16*__restrict__ K,const bf16*__restrict__ V,unsigned char*Y,const float*kmean,char*shm){
  const int tid=threadIdx.x,lane=tid&63,r32=lane&31,hi=lane>>5; const int wid=__builtin_amdgcn_readfirstlane(tid>>6);
  const long rowbase=(long)b*SEQ; const int q0=qb*QB;
  const bf16*Qw=Q+(rowbase+q0+wid*QBLK)*DM+h*D;
  const bf16*Kh=K+rowbase*DM+h*D,*Vh=V+rowbase*DM+h*D;
  const unsigned lds0=(unsigned)(uintptr_t)shm;
  float*wsf=(float*)(shm+LDS_WS)+wid*64;
  const unsigned koff=(unsigned)((lane*DM+wid*8)*2);
  const unsigned voff=(unsigned)(((16*(wid&3)+(lane>>2))*DM+(wid>>2)*32+(lane&3)*8)*2);
  const unsigned kdst=lds0+LDS_K+wid*1024, vdst=lds0+LDS_V+wid*1024;
  #define DMA_K(t,slot) glds16(Kh+(long)(t)*KVBLK*DM,koff,(unsigned)__builtin_amdgcn_readfirstlane(kdst+(slot)))
  #define DMA_V(t,slot) glds16(Vh+(long)(t)*KVBLK*DM,voff,(unsigned)__builtin_amdgcn_readfirstlane(vdst+(slot)))
  const char*Kbase=shm+LDS_K; bf16x8 kf[8];
  const lds_cptr shm3=(lds_cptr)shm; const lds_cptr kp0=shm3+LDS_K+hi*1024+r32*16; const lds_cptr vp0=shm3+LDS_V+((lane>>4)&1)*32+(lane&3)*8+(4*hi+((lane&15)>>2))*64;
  const int NT=(q0+QB)/KVBLK;
  DMA_K(0,0);DMA_V(0,0);DMA_K(1,SLOTB);
  bf16x8 qr[4];
  #pragma unroll
  for(int d0=0;d0<4;++d0)qr[d0]=*reinterpret_cast<const bf16x8*>(&Qw[(long)r32*DM+d0*16+hi*8]);
  unsigned sel;
  if(qb<=3) sel=(1u<<qb)-1u;
  else{
    float*km=(float*)(shm+LDS_KM);
    if(tid<qb*64) km[tid]=kmean[(size_t)(b*8+(tid>>6))*512+h*64+(tid&63)];
    asm volatile("s_waitcnt vmcnt(0) lgkmcnt(0)\n\ts_barrier":::"memory");
    float g[7];
    #pragma unroll
    for(int n=0;n<7;++n){ g[n]=NEGB;
      if(n<qb){ float a=0.f;
        #pragma unroll
        for(int s=0;s<4;++s)
          #pragma unroll
          for(int jj=0;jj<8;++jj) a+=__uint_as_float((unsigned)(unsigned short)qr[s][jj]<<16)*km[n*64+16*s+8*hi+jj];
        a+=__shfl_xor(a,32); g[n]=a; } }
    sel=0u;
    #pragma unroll
    for(int r=0;r<3;++r){ float best=NEGB; int bi=0;
      #pragma unroll
      for(int n=0;n<7;++n) if(n<qb&&!((sel>>n)&1u)&&g[n]>best){best=g[n];bi=n;}
      sel|=1u<<bi; }
  }
  #define OKB(n) (((n)>=qb)||(((sel>>(n))&1u)!=0u))
  float mhat=0.f,l_reg=0.f;f32x16 o[2];o[0]=f32x16{};o[1]=f32x16{};f32x16 negm;
  { const bool ok0=OKB(0);
    #pragma unroll
    for(int r=0;r<16;++r)negm[r]=ok0?0.f:NEGB; }
  asm volatile("":"+v"(negm));
  const int qrel=wid*QBLK+r32;
  #define CMASK(P0,P1,t) do{int jb_=(t)-(NT-4); if(jb_>=0)cmask(P0,P1,jb_,qrel,hi);}while(0)
  bool resc=false;
  #define START(P0,P1) do{ const float rm=rowmax(P0,P1); resc=false; \
    { const bool ok0_=OKB(0); const float dl=ok0_?rm:0.f; mhat=fadd_s(mhat,dl); \
      _Pragma("unroll") for(int r=0;r<16;++r){P0[r]=fsub_s(P0[r],dl);P1[r]=fsub_s(P1[r],dl);} \
      _Pragma("unroll") for(int r=0;r<16;++r)negm[r]=ok0_?-mhat:NEGB; asm volatile("":"+v"(negm)); } \
    _Pragma("unroll") for(int r=0;r<16;++r)P0[r]=__builtin_amdgcn_exp2f(P0[r]); }while(0)
  #define RESC() do{ if(resc){ asm volatile("s_waitcnt lgkmcnt(0)":::"memory"); \
      _Pragma("unroll") for(int d_=0;d_<2;++d_) _Pragma("unroll") for(int r=0;r<16;++r)o[d_][r]*=wsf[crow(r,hi)]; } }while(0)
  f32x16 pA0,pA1,pB0,pB1;
  int sl_prev=0,sl_cur=0,sl_next=SLOTB;
  #define ROT() do{sl_prev=sl_cur;sl_cur=sl_next;sl_next=(sl_next==(NSLOT-1)*SLOTB)?0:sl_next+SLOTB;}while(0)
  DMA_K(2,2*SLOTB);
  WAIT_BAR(3);
  qkt(pA0,pA1,Kbase,qr,negm,r32,hi);asm volatile("s_nop 15\n\ts_nop 7":"+v"(pA0),"+v"(pA1));CMASK(pA0,pA1,0);
  START(pA0,pA1);
  _Pragma("unroll") for(int r=0;r<16;++r)pA1[r]=__builtin_amdgcn_exp2f(pA1[r]);
  WAIT_BAR(0);
  DMA_K(3,0);DMA_V(1,SLOTB);
  ROT();
  kload8(kf,kp0+sl_cur);
  WAIT_BAR(2);
  s16x4 vlo[8],vhi[8]; u32x4 pw0,pw1,pw2,pw3;
  #define PKW(P,B) cvtpk_s(P[B],P[B+1])
  #define PAF(k) __builtin_bit_cast(bf16x8,pw##k)
  #define VFR(i) (bf16x8){vlo[i][0],vlo[i][1],vlo[i][2],vlo[i][3],vhi[i][0],vhi[i][1],vhi[i][2],vhi[i][3]}
  #define PIN(x) asm volatile("":"+v"(x))
  #define MX3(a,b,c) __builtin_fmaxf(__builtin_fmaxf((a),(b)),(c))
  #define GAPA(MF,A0,A1,A2,A3,W0,W1,PW) do{ MF; sacc+=A0; sacc+=A1; sacc+=A2; sacc+=A3; PIN(sacc); W0; W1; PIN(PW); SBAR(); }while(0)
  #define EX(v) __builtin_amdgcn_exp2f(v)
  #define GAPB(MF,X,B) do{ MF; X[B]=EX(X[B]); X[B+1]=EX(X[B+1]); X[B+2]=EX(X[B+2]); X[B+3]=EX(X[B+3]); PIN(X); SBAR(); }while(0)
  #define VRD(i) do{ vlo[i]=vtr(vp_+(((i)>>2)*4096+((i)&3)*1024)); vhi[i]=vtr(vp_+(((i)>>2)*4096+((i)&3)*1024+512)); }while(0)
  #define KRD(G,j) do{ if(G){ kload2(kf,kp0+sl_next,j); SBAR(); } }while(0)
  #define STEP(C0,C1,P0,P1,t,GK,GV,GL) do{ SBAR(); \
    const lds_cptr vp_=vp0+sl_prev; \
    VRD(0); SBAR(); float sacc=(P0[0]+P0[1]); \
    GAPA(C0=__builtin_amdgcn_mfma_f32_32x32x16_bf16(kf[0],qr[0],negm,0,0,0), P0[2],P0[3],P0[4],P0[5],     pw0[0]=PKW(P0,0), pw0[1]=PKW(P0,2), pw0); \
    VRD(4); SBAR(); GAPA(C1=__builtin_amdgcn_mfma_f32_32x32x16_bf16(kf[1],qr[0],negm,0,0,0), P0[6],P0[7],P0[8],P0[9],     pw0[2]=PKW(P0,4), pw0[3]=PKW(P0,6), pw0); \
    VRD(1); SBAR(); GAPA(C0=__builtin_amdgcn_mfma_f32_32x32x16_bf16(kf[2],qr[1],C0,0,0,0),   P0[10],P0[11],P0[12],P0[13], pw1[0]=PKW(P0,8), pw1[1]=PKW(P0,10), pw1); \
    VRD(5); SBAR(); GAPA(C1=__builtin_amdgcn_mfma_f32_32x32x16_bf16(kf[3],qr[1],C1,0,0,0),   P0[14],P0[15],P1[0],P1[1],   pw1[2]=PKW(P0,12),pw1[3]=PKW(P0,14), pw1); \
    VRD(2); SBAR(); GAPA(C0=__builtin_amdgcn_mfma_f32_32x32x16_bf16(kf[4],qr[2],C0,0,0,0),   P1[2],P1[3],P1[4],P1[5],     pw2[0]=PKW(P1,0), pw2[1]=PKW(P1,2), pw2); \
    VRD(6); SBAR(); GAPA(C1=__builtin_amdgcn_mfma_f32_32x32x16_bf16(kf[5],qr[2],C1,0,0,0),   P1[6],P1[7],P1[8],P1[9],     pw2[2]=PKW(P1,4), pw2[3]=PKW(P1,6), pw2); \
    VRD(3); SBAR(); GAPA(C0=__builtin_amdgcn_mfma_f32_32x32x16_bf16(kf[6],qr[3],C0,0,0,0),   P1[10],P1[11],P1[12],P1[13], pw3[0]=PKW(P1,8), pw3[1]=PKW(P1,10), pw3); \
    VRD(7); SBAR(); GAPA(C1=__builtin_amdgcn_mfma_f32_32x32x16_bf16(kf[7],qr[3],C1,0,0,0),   P1[14],P1[15],0.f,0.f,       pw3[2]=PKW(P1,12),pw3[3]=PKW(P1,14), pw3); \
    l_reg+=sacc; \
    if(GK){DMA_K((t)+3,sl_cur);} if(GV){DMA_V((t)+1,sl_next);} \
    CMASK(C0,C1,t); \
    { float a=MX3(C0[0],C0[1],C1[0]),b=MX3(C0[2],C0[3],C1[1]); a=MX3(a,C1[2],C1[3]); \
      _Pragma("unroll") for(int r=4;r<16;r+=4){a=MX3(a,C0[r],C0[r+1]);b=MX3(b,C0[r+2],C0[r+3]);a=MX3(a,C1[r],C1[r+1]);b=MX3(b,C1[r+2],C1[r+3]);} \
      float rm=__builtin_fmaxf(a,b); { auto rr=__builtin_amdgcn_permlane32_swap(__float_as_uint(rm),__float_as_uint(rm),false,false); rm=__builtin_fmaxf(__uint_as_float(rr[0]),__uint_as_float(rr[1])); } \
      resc=false; \
      if(__builtin_expect(__any(rm>(float)THRL),0)){ const float dl=__builtin_fmaxf(rm,0.f); mhat+=dl; \
        _Pragma("unroll") for(int r=0;r<16;++r){C0[r]-=dl;C1[r]-=dl;} \
        const float f=__builtin_amdgcn_exp2f(-dl); l_reg*=f; if(hi==0)wsf[r32]=f; resc=true; } \
      if(resc||((((t)+1)&3)==0)){ const bool okn_=OKB(((t)+1)>>2);   \
        _Pragma("unroll") for(int r=0;r<16;++r)negm[r]=okn_?-mhat:NEGB; asm volatile("":"+v"(negm)); } } \
    SBAR(); \
    GAPB(o[0]=__builtin_amdgcn_mfma_f32_32x32x16_bf16(PAF(0),VFR(0),o[0],0,0,0), C0,0); \
    GAPB(o[1]=__builtin_amdgcn_mfma_f32_32x32x16_bf16(PAF(0),VFR(4),o[1],0,0,0), C0,4); \
    KRD(GL,0); GAPB(o[0]=__builtin_amdgcn_mfma_f32_32x32x16_bf16(PAF(1),VFR(1),o[0],0,0,0), C0,8); \
    KRD(GL,1); GAPB(o[1]=__builtin_amdgcn_mfma_f32_32x32x16_bf16(PAF(1),VFR(5),o[1],0,0,0), C0,12); \
    KRD(GL,2); GAPB(o[0]=__builtin_amdgcn_mfma_f32_32x32x16_bf16(PAF(2),VFR(2),o[0],0,0,0), C1,0); \
    KRD(GL,3); GAPB(o[1]=__builtin_amdgcn_mfma_f32_32x32x16_bf16(PAF(2),VFR(6),o[1],0,0,0), C1,4); \
    GAPB(o[0]=__builtin_amdgcn_mfma_f32_32x32x16_bf16(PAF(3),VFR(3),o[0],0,0,0), C1,8); \
    GAPB(o[1]=__builtin_amdgcn_mfma_f32_32x32x16_bf16(PAF(3),VFR(7),o[1],0,0,0), C1,12); \
    }while(0)
  int t=1;
  #undef CMASK
  #define CMASK(P0,P1,t) do{}while(0)
  for(;t+5<NT;t+=2){
    STEP(pB0,pB1,pA0,pA1,t,true,true,true);     WAIT_BAR(2); RESC(); ROT();
    STEP(pA0,pA1,pB0,pB1,t+1,true,true,true);   WAIT_BAR(2); RESC(); ROT();
  }
  #undef CMASK
  const int lane_b=(int)__builtin_amdgcn_mbcnt_hi(~0u,__builtin_amdgcn_mbcnt_lo(~0u,0u)), hi_b=lane_b>>5, qrel_b=wid*QBLK+(lane_b&31);
  #define CMASK(P0,P1,t) do{int jb_=(t)-(NT-4); if(jb_>=0)cmask(P0,P1,jb_,qrel_b,hi_b);}while(0)
  #define ENDW(tt) do{ if((tt)+3<NT){WAIT_BAR(2);} else if((tt)+2<NT){WAIT_BAR(1);} else {WAIT_BAR(0);} }while(0)
  for(;t+1<NT;t+=2){
    STEP(pB0,pB1,pA0,pA1,t,(t+3<NT),(t+1<NT),(t+1<NT));       ENDW(t);   RESC(); ROT();
    STEP(pA0,pA1,pB0,pB1,t+1,(t+4<NT),(t+2<NT),(t+2<NT));     ENDW(t+1); RESC(); ROT();
  }
  STEP(pB0,pB1,pA0,pA1,NT-1,false,false,false); RESC();
  { float sacc=pB0[0]+pB0[1]; _Pragma("unroll") for(int r=2;r<16;++r)sacc+=pB0[r]; _Pragma("unroll") for(int r=0;r<16;++r)sacc+=pB1[r]; l_reg+=sacc;
    pw0=(u32x4){PKW(pB0,0),PKW(pB0,2),PKW(pB0,4),PKW(pB0,6)};pw1=(u32x4){PKW(pB0,8),PKW(pB0,10),PKW(pB0,12),PKW(pB0,14)};pw2=(u32x4){PKW(pB1,0),PKW(pB1,2),PKW(pB1,4),PKW(pB1,6)};pw3=(u32x4){PKW(pB1,8),PKW(pB1,10),PKW(pB1,12),PKW(pB1,14)};
    const int vb0=(int)(lds0+LDS_V)+((lane>>4)&1)*32+(lane&3)*8+(4*hi+((lane&15)>>2))*64;
    SBAR(); pv(o,vb0+sl_cur,PAF(0),PAF(1),PAF(2),PAF(3)); }
  #undef PKW
  #undef PAF
  #undef VFR
  #undef PIN
  #undef MX3
  #undef GAPA
  #undef GAPB
  #undef EX
  #undef VRD
  #undef KRD
  #undef STEP
  #undef ENDW
  {auto rr=__builtin_amdgcn_permlane32_swap(__float_as_uint(l_reg),__float_as_uint(l_reg),false,false);l_reg=__uint_as_float(rr[0])+__uint_as_float(rr[1]);}
  if(hi==0)wsf[32+r32]=l_reg;asm volatile("s_waitcnt lgkmcnt(0)":::"memory");
  float rli[16];
  #pragma unroll
  for(int r=0;r<16;++r)rli[r]=__builtin_amdgcn_rcpf(wsf[32+crow(r,hi)])*YSC;
  unsigned char*Yw=Y+(size_t)(rowbase+q0+wid*QBLK)*2048+h*D;
  { unsigned char*stg=(unsigned char*)(shm+LDS_OST)+wid*4096;
    #pragma unroll
    for(int r=0;r<16;++r){const int orow=crow(r,hi);
      const float a0=__builtin_fminf(__builtin_fmaxf(o[0][r]*rli[r],-448.f),448.f),a1=__builtin_fminf(__builtin_fmaxf(o[1][r]*rli[r],-448.f),448.f);
      const unsigned pk=(unsigned)__builtin_amdgcn_cvt_pk_fp8_f32(a0,a1,0,false);
      stg[orow*64+r32]=(unsigned char)(pk&0xffu); stg[orow*64+32+r32]=(unsigned char)((pk>>8)&0xffu);}
    asm volatile("s_waitcnt lgkmcnt(0)":::"memory");
    #pragma unroll
    for(int i=0;i<2;++i){const int row=i*16+(lane>>2),ch=lane&3; const u32x4 v=*(const u32x4*)(stg+row*64+ch*16); *(u32x4*)(Yw+(size_t)row*2048+ch*16)=v;} }
  asm volatile("s_waitcnt lgkmcnt(0)\n\ts_barrier":::"memory");
  #undef DMA_K
  #undef DMA_V
  #undef CMASK
  #undef START
  #undef RESC
  #undef ROT
  #undef OKB
}
#undef SBAR
#undef WAIT_BAR
#ifdef ATTN_STORE16
#undef ATTN_STORE16
#endif
}

namespace mls {
constexpr int RS = 272, TS = 144;
constexpr float CSC = 8.f, CSC_INV = 0.125f;
struct MW { unsigned char* CC; unsigned char* CP; float* NC; float* NP; float* SC; float* MP; };
__device__ __forceinline__ int cslot(int bh, int c) { return (c + bh) & 31; }
__device__ __forceinline__ float fsilu(float x) { return x * __builtin_amdgcn_rcpf(1.f + __builtin_amdgcn_exp2f(-1.4426950408889634f * x)); }
__device__ __forceinline__ void vt_write(LAS unsigned char* dst, const u32x4 a, const u32x4 bq) {
    *(LAS unsigned*)(dst + 0 * TS) = (a.x & 0xffffu) | (bq.x << 16); *(LAS unsigned*)(dst + 1 * TS) = (a.x >> 16) | (bq.x & 0xffff0000u);
    *(LAS unsigned*)(dst + 2 * TS) = (a.y & 0xffffu) | (bq.y << 16); *(LAS unsigned*)(dst + 3 * TS) = (a.y >> 16) | (bq.y & 0xffff0000u);
    *(LAS unsigned*)(dst + 4 * TS) = (a.z & 0xffffu) | (bq.z << 16); *(LAS unsigned*)(dst + 5 * TS) = (a.z >> 16) | (bq.z & 0xffff0000u);
    *(LAS unsigned*)(dst + 6 * TS) = (a.w & 0xffffu) | (bq.w << 16); *(LAS unsigned*)(dst + 7 * TS) = (a.w >> 16) | (bq.w & 0xffff0000u);
}
constexpr int XKWT = 0, XVT = 18432, XCW = 36864;
__device__ __forceinline__ void x_setup(Frame& F, const float* conv_w, const float* conv_b) {
    __syncthreads();
    for (int i = F.tid; i < 5 * 512; i += NTHR) { const int j = i >> 9, ch = i & 511; ((LAS float*)(F.lds + XCW))[i] = (j < 4) ? conv_w[j * 1024 + 512 + ch] : conv_b[512 + ch]; }
    __syncthreads();
}
struct XL { u32x4 raw[5], vr0, vr1; float li, lf; };
__device__ __forceinline__ void x_load(XL& L, const Frame& F, const bf16_t* proj, const float* gates, int u) {
    const int tid = F.tid, c = u & 31, bh = u >> 5, b = bh >> 2, h = bh & 3; const size_t rb = (size_t)b * SEQ;
    const int cc = tid & 15, rp = tid >> 4, tp = tid & 31, ec = tid >> 5;
#pragma unroll
    for (int i = 0; i < 5; ++i) { const int pos = c * 64 + 2 * rp - 3 + i;
        if (pos >= 0) L.raw[i] = *(const u32x4*)(proj + (rb + pos) * NIN + C_LK + h * 128 + 8 * cc); else L.raw[i] = (u32x4){0u, 0u, 0u, 0u}; }
    L.vr0 = *(const u32x4*)(proj + (rb + c * 64 + 2 * tp) * NIN + C_LV + h * 128 + 8 * ec); L.vr1 = *(const u32x4*)(proj + (rb + c * 64 + 2 * tp + 1) * NIN + C_LV + h * 128 + 8 * ec);
    L.li = gates[(rb + c * 64 + F.lane) * 8 + h]; L.lf = gates[(rb + c * 64 + F.lane) * 8 + 4 + h];
}
__device__ __forceinline__ void x_unit(Frame& F, const bf16_t* proj, const float* gates, const MW& W, int u, XL& cur, XL& nxt, bool has_next, int un) {
    LAS unsigned char* lds = F.lds; const int tid = F.tid, lane = F.lane, r32 = lane & 31, hh = lane >> 5, w = F.wave;
    const int bh = u >> 5, h = bh & 3;
    const int cc = tid & 15, rp = tid >> 4, tp = tid & 31, ec = tid >> 5;
    u32x4 raw[5];
#pragma unroll
    for (int i = 0; i < 5; ++i) raw[i] = cur.raw[i];
    const u32x4 vr0 = cur.vr0, vr1 = cur.vr1; const float li = cur.li, lf = cur.lf;
    const float bcs = scan64<false>(lf), cs = li - bcs, pm = scan64<true>(cs);
    const float blast = lane63(bcs), amax = blast + lane63(pm);
    const float wa = __expf(blast + cs - amax);
    LBAR();
    {   const LAS float* cw = (const LAS float*)(lds + XCW) + h * 128 + 8 * cc;
        u32x4 pk[2];
#pragma unroll
        for (int r = 0; r < 2; ++r) {
            f32x4 oa = *(const LAS f32x4*)(cw + 4 * 512), ob = *(const LAS f32x4*)(cw + 4 * 512 + 4);
#pragma unroll
            for (int j = 0; j < 4; ++j) { const u32x4 uu = raw[r + j]; const f32x4 wa4 = *(const LAS f32x4*)(cw + j * 512), wb4 = *(const LAS f32x4*)(cw + j * 512 + 4);
                oa += wa4 * (f32x4){bflo(uu.x), bfhi(uu.x), bflo(uu.y), bfhi(uu.y)}; ob += wb4 * (f32x4){bflo(uu.z), bfhi(uu.z), bflo(uu.w), bfhi(uu.w)}; }
            const float ws = __shfl(wa, 2 * rp + r) * 0.08838834764831845f;
#pragma unroll
            for (int i = 0; i < 4; ++i) { oa[i] = fsilu(oa[i]) * ws; ob[i] = fsilu(ob[i]) * ws; }
            pk[r].x = cvtpk(oa[0], oa[1]); pk[r].y = cvtpk(oa[2], oa[3]); pk[r].z = cvtpk(ob[0], ob[1]); pk[r].w = cvtpk(ob[2], ob[3]);
        }
#pragma unroll
        for (int i = 0; i < 8; ++i) { const int sh = 16 * (i & 1); const unsigned e0 = (pk[0][i >> 1] >> sh) & 0xffffu, e1 = (pk[1][i >> 1] >> sh) & 0xffffu;
            *(LAS unsigned*)(lds + XKWT + (8 * cc + i) * TS + (2 * rp) * 2) = e0 | (e1 << 16); }
        vt_write(lds + XVT + (8 * ec) * TS + (2 * tp) * 2, vr0, vr1);
    }
    if (has_next) x_load(nxt, F, proj, gates, un);
    LBAR();
#pragma unroll
    for (int i = 0; i < 2; ++i) { const int T = 2 * w + i, dt = T >> 2, e2 = T & 3;
        f32x16 acc;
#pragma unroll
        for (int r = 0; r < 16; ++r) acc[r] = 0.f;
#pragma unroll
        for (int k = 0; k < 4; ++k) { const bf16x8 a = *(const LAS bf16x8*)(lds + XKWT + (32 * dt + r32) * TS + (16 * k + 8 * hh) * 2);
            const bf16x8 bv = *(const LAS bf16x8*)(lds + XVT + (32 * e2 + r32) * TS + (16 * k + 8 * hh) * 2);
            acc = __builtin_amdgcn_mfma_f32_32x32x16_bf16(a, bv, acc, 0, 0, 0); }
        unsigned char* dst = W.CC + (size_t)((u & ~31) + cslot(u >> 5, u & 31)) * 16384 + (size_t)(32 * e2 + r32) * 128 + 32 * dt + 4 * hh;
#pragma unroll
        for (int g = 0; g < 4; ++g) *(unsigned*)(dst + 8 * g) = pg8::pack_fp8x4(acc[4 * g] * CSC, acc[4 * g + 1] * CSC, acc[4 * g + 2] * CSC, acc[4 * g + 3] * CSC); }
    if (tid < 128) { float sN = 0.f;
#pragma unroll
        for (int k = 0; k < 8; ++k) { const u32x4 uu = *(const LAS u32x4*)(lds + XKWT + tid * TS + k * 16);
            sN += (bflo(uu.x) + bfhi(uu.x)) + (bflo(uu.y) + bfhi(uu.y)) + (bflo(uu.z) + bfhi(uu.z)) + (bflo(uu.w) + bfhi(uu.w)); }
        W.NC[(size_t)u * 128 + tid] = sN; }
    if (tid == 0) { W.SC[u * 2] = blast; W.SC[u * 2 + 1] = amax; }
}
constexpr int YK = 4, CONV_Y = YK * 4 * 256;
template <int GRP>
__device__ __forceinline__ void y_phase(Frame& F, const MW& W) {
    for (int base = blockIdx.x * 256; base < 32 * 2048; base += F.G * 256) {
        if (F.tid >= 256) {
            if (base == (int)blockIdx.x * 256 && F.G == 256) {
#pragma unroll 1
                for (int k = 0; k < YK; ++k) conv_item<GRP>(F, (int)blockIdx.x * 4 + (F.wave - 4) + k * 1024);
            }
            continue; }
        const int bh = base >> 11, g = (base & 2047) + F.tid, e = g >> 4, d8 = (g & 15) * 8;
        const float* sc = W.SC + (size_t)bh * 64;
        const size_t off = (size_t)bh * 32 * 16384 + (size_t)e * 128 + d8;
        u32x2 v[32];
#pragma unroll
        for (int c = 0; c < 32; ++c) v[c] = __builtin_nontemporal_load((const u32x2*)(W.CC + off + (size_t)cslot(bh, c) * 16384));
        const bool nsc = (g < 32);
        f32x4 nv[32];
        if (nsc) {
#pragma unroll
            for (int c = 0; c < 32; ++c) nv[c] = *(const f32x4*)(W.NC + ((size_t)bh * 32 + c) * 128 + g * 4); }
        float C[8];
#pragma unroll
        for (int i = 0; i < 8; ++i) C[i] = 0.f;
        float m = 0.f;
#pragma unroll
        for (int c = 0; c < 32; ++c) {
            u32x2 o; o.x = pg8::pack_fp8x4(C[0], C[1], C[2], C[3]); o.y = pg8::pack_fp8x4(C[4], C[5], C[6], C[7]); *(u32x2*)(W.CP + off + (size_t)cslot(bh, c) * 16384) = o;
            const float bl = sc[2 * c], am = sc[2 * c + 1], mn = fmaxf(bl + m, am), dec = __expf(bl + m - mn), inj = __expf(am - mn);
            const auto x0 = __builtin_amdgcn_cvt_pk_f32_fp8((int)v[c].x, false), x1 = __builtin_amdgcn_cvt_pk_f32_fp8((int)v[c].x, true), x2 = __builtin_amdgcn_cvt_pk_f32_fp8((int)v[c].y, false), x3 = __builtin_amdgcn_cvt_pk_f32_fp8((int)v[c].y, true);
            C[0] = C[0] * dec + x0[0] * inj; C[1] = C[1] * dec + x0[1] * inj; C[2] = C[2] * dec + x1[0] * inj; C[3] = C[3] * dec + x1[1] * inj;
            C[4] = C[4] * dec + x2[0] * inj; C[5] = C[5] * dec + x2[1] * inj; C[6] = C[6] * dec + x3[0] * inj; C[7] = C[7] * dec + x3[1] * inj; m = mn; }
        if (nsc) {
            f32x4 N = (f32x4){0.f, 0.f, 0.f, 0.f}; float mm = 0.f;
#pragma unroll
            for (int c = 0; c < 32; ++c) {
                *(f32x4*)(W.NP + ((size_t)bh * 32 + c) * 128 + g * 4) = N; if (g == 0) W.MP[bh * 32 + c] = mm;
                const float bl = sc[2 * c], am = sc[2 * c + 1], mn = fmaxf(bl + mm, am), dec = __expf(bl + mm - mn), inj = __expf(am - mn);
                N = N * dec + nv[c] * inj; mm = mn; }
        }
    }
}
constexpr int QS = 0, QW = 17408, KS = 34816, ZCW = 52224  , VT = 72704, CB = 91136, NS = 125952, CSO = 126464, SSQ = 126720, ZNW = 127744  ;
struct Pre { u32x4 raw[7]; u32x4 vr[2]; float li, lf; };
__device__ __forceinline__ void prefetch(Pre& P, const bf16_t* proj, const float* gates, size_t rb, int c, int h, int tid, int lane) {
    const int cc = tid & 31, rg = tid >> 5;
    const int col = (cc < 16) ? (C_LQ + h * 128 + 8 * cc) : (C_LK + h * 128 + 8 * (cc - 16));
#pragma unroll
    for (int i = 0; i < 7; ++i) { const int pos = c * 64 + 4 * rg - 3 + i;
        if (pos >= 0) P.raw[i] = *(const u32x4*)(proj + (rb + pos) * NIN + col); else P.raw[i] = (u32x4){0u, 0u, 0u, 0u}; }
    const int tp = tid & 31, ec = tid >> 5;
    P.vr[0] = *(const u32x4*)(proj + (rb + c * 64 + 2 * tp) * NIN + C_LV + h * 128 + 8 * ec);
    P.vr[1] = *(const u32x4*)(proj + (rb + c * 64 + 2 * tp + 1) * NIN + C_LV + h * 128 + 8 * ec);
    P.li = gates[(rb + c * 64 + lane) * 8 + h]; P.lf = gates[(rb + c * 64 + lane) * 8 + 4 + h];
}
__device__ __forceinline__ void z_setup(Frame& F, const float* conv_w, const float* conv_b, const float* normw) {
    __syncthreads();
    for (int i = F.tid; i < 5 * 1024; i += NTHR) { const int j = i >> 10, ch = i & 1023; ((LAS float*)(F.lds + ZCW))[i] = (j < 4) ? conv_w[j * 1024 + ch] : conv_b[ch]; }
    ((LAS float*)(F.lds + ZNW))[F.tid] = normw[F.tid];
    __syncthreads();
}
struct ZL { Pre P; u32x4 cpv[2]; float npv, mprev; u32x2 og[4]; };
__device__ __forceinline__ void z_load(ZL& L, const Frame& F, const bf16_t* proj, const float* gates, const MW& W, int u) {
    const int tid = F.tid, lane = F.lane, r32 = lane & 31, hh = lane >> 5, w = F.wave, et = w & 3, tt = w >> 2;
    const int c = u & 31, bh = u >> 5, b = bh >> 2, h = bh & 3; const size_t rb = (size_t)b * SEQ, r0 = rb + (size_t)c * 64; const int trow = 32 * tt + r32;
    prefetch(L.P, proj, gates, rb, c, h, tid, lane);
#pragma unroll
    for (int i = 0; i < 2; ++i) L.cpv[i] = __builtin_nontemporal_load((const u32x4*)(W.CP + (size_t)((u & ~31) + cslot(u >> 5, u & 31)) * 16384 + (size_t)(tid + i * NTHR) * 16));
    L.npv = (tid < 128) ? W.NP[(size_t)u * 128 + tid] : 0.f; L.mprev = W.MP[u];
#pragma unroll
    for (int g = 0; g < 4; ++g) L.og[g] = *(const u32x2*)(proj + (r0 + trow) * NIN + C_LO + h * 128 + 32 * et + 8 * g + 4 * hh);
}
__device__ __forceinline__ void z_unit(Frame& F, const bf16_t* proj, const float* gates, const MW& W, unsigned char* Y, int u, ZL& cur, ZL& nxt, bool has_next, int un) {
    LAS unsigned char* lds = F.lds; const int tid = F.tid, lane = F.lane, r32 = lane & 31, hh = lane >> 5, w = F.wave, et = w & 3, tt = w >> 2;
    const int c = u & 31, bh = u >> 5, b = bh >> 2, h = bh & 3; const size_t rb = (size_t)b * SEQ, r0 = rb + (size_t)c * 64;
    const int trow = 32 * tt + r32;
    const Pre P = cur.P;
    u32x4 cpv[2];
#pragma unroll
    for (int i = 0; i < 2; ++i) cpv[i] = cur.cpv[i];
    const float npv = cur.npv, mprev = cur.mprev;
    u32x2 og[4];
#pragma unroll
    for (int g = 0; g < 4; ++g) og[g] = cur.og[g];
    const float bcs = scan64<false>(P.lf), cs = P.li - bcs, pm = scan64<true>(cs);
    const float il = bcs + mprev, mo = fmaxf(il, bcs + pm), wi = __expf(il - mo);
    const float rt = __shfl(bcs - mo, trow), eo = __shfl(__expf(-mo), trow);
    LBAR();
    if (w == 0) ((LAS float*)(lds + CSO))[lane] = cs;
#pragma unroll
    for (int i = 0; i < 2; ++i) { const int ci = tid + i * NTHR, e = ci >> 3, part = ci & 7;
        unsigned wv[8];
#pragma unroll
        for (int q = 0; q < 4; ++q) { const int uq = (int)cpv[i][q]; const auto lo = __builtin_amdgcn_cvt_pk_f32_fp8(uq, false), hi = __builtin_amdgcn_cvt_pk_f32_fp8(uq, true);
            wv[2 * q] = cvtpk(lo[0] * CSC_INV, lo[1] * CSC_INV); wv[2 * q + 1] = cvtpk(hi[0] * CSC_INV, hi[1] * CSC_INV); }
        u32x4 w0, w1; w0.x = wv[0]; w0.y = wv[1]; w0.z = wv[2]; w0.w = wv[3]; w1.x = wv[4]; w1.y = wv[5]; w1.z = wv[6]; w1.w = wv[7];
        *(LAS u32x4*)(lds + CB + e * RS + part * 32) = w0; *(LAS u32x4*)(lds + CB + e * RS + part * 32 + 16) = w1; }
    if (tid < 128) ((LAS float*)(lds + NS))[tid] = npv;
    {
        const int cc = tid & 31, rg = tid >> 5; const bool isk = cc >= 16; const int dcol = 8 * (cc & 15);
        const LAS float* cw = (const LAS float*)(lds + ZCW) + (isk ? 512 : 0) + h * 128 + dcol;
        const float ksc = isk ? 0.08838834764831845f : 1.f;
#pragma unroll
        for (int r = 0; r < 4; ++r) {
            f32x4 oa = *(const LAS f32x4*)(cw + 4 * 1024), ob = *(const LAS f32x4*)(cw + 4 * 1024 + 4);
#pragma unroll
            for (int j = 0; j < 4; ++j) { const u32x4 uu = P.raw[r + j]; const f32x4 wa4 = *(const LAS f32x4*)(cw + j * 1024), wb4 = *(const LAS f32x4*)(cw + j * 1024 + 4);
                oa += wa4 * (f32x4){bflo(uu.x), bfhi(uu.x), bflo(uu.y), bfhi(uu.y)}; ob += wb4 * (f32x4){bflo(uu.z), bfhi(uu.z), bflo(uu.w), bfhi(uu.w)}; }
#pragma unroll
            for (int i = 0; i < 4; ++i) { oa[i] = fsilu(oa[i]) * ksc; ob[i] = fsilu(ob[i]) * ksc; }
            const int t = 4 * rg + r; const float ws = __shfl(wi, t);
            u32x4 wv; wv.x = cvtpk(oa[0], oa[1]); wv.y = cvtpk(oa[2], oa[3]); wv.z = cvtpk(ob[0], ob[1]); wv.w = cvtpk(ob[2], ob[3]);
            *(LAS u32x4*)(lds + (isk ? KS : QS) + t * RS + dcol * 2) = wv;
            if (!isk) { u32x4 v; v.x = cvtpk(oa[0] * ws, oa[1] * ws); v.y = cvtpk(oa[2] * ws, oa[3] * ws); v.z = cvtpk(ob[0] * ws, ob[1] * ws); v.w = cvtpk(ob[2] * ws, ob[3] * ws);
                *(LAS u32x4*)(lds + QW + t * RS + dcol * 2) = v; }
            asm volatile("" ::: "memory");
        }
        vt_write(lds + VT + (8 * (tid >> 5)) * TS + (2 * (tid & 31)) * 2, P.vr[0], P.vr[1]);
    }
    if (has_next) z_load(nxt, F, proj, gates, W, un);
    LBAR();
    f32x16 acc;
#pragma unroll
    for (int r = 0; r < 16; ++r) acc[r] = 0.f;
    float den = 0.f;
    for (int st = 0; st <= tt; ++st) {
        f32x16 S;
#pragma unroll
        for (int r = 0; r < 16; ++r) S[r] = 0.f;
#pragma unroll
        for (int k = 0; k < 8; ++k) { const bf16x8 a = *(const LAS bf16x8*)(lds + KS + (32 * st + r32) * RS + (16 * k + 8 * hh) * 2); const bf16x8 qk = *(const LAS bf16x8*)(lds + QS + trow * RS + (16 * k + 8 * hh) * 2); S = __builtin_amdgcn_mfma_f32_32x32x16_bf16(a, qk, S, 0, 0, 0); }
        const LAS float* csp = (const LAS float*)(lds + CSO) + 32 * st + 4 * hh;
#pragma unroll
        for (int r = 0; r < 16; ++r) { const int so = (r & 3) + 8 * (r >> 2); const float cv = csp[so];
            const bool ok = (st < tt) || (so + 4 * hh <= r32);
            const float p = ok ? S[r] * __expf(rt + cv) : 0.f; S[r] = p; den += p; }
#pragma unroll
        for (int k2 = 0; k2 < 2; ++k2) {
            u32x4 pw; pw.x = cvtpk(S[8 * k2 + 0], S[8 * k2 + 1]); pw.y = cvtpk(S[8 * k2 + 2], S[8 * k2 + 3]); pw.z = cvtpk(S[8 * k2 + 4], S[8 * k2 + 5]); pw.w = cvtpk(S[8 * k2 + 6], S[8 * k2 + 7]);
            const LAS unsigned char* vp = lds + VT + (32 * et + r32) * TS + (32 * st + 16 * k2 + 4 * hh) * 2;
            const u32x2 lo = *(const LAS u32x2*)vp, hi = *(const LAS u32x2*)(vp + 16); u32x4 aw; aw.x = lo.x; aw.y = lo.y; aw.z = hi.x; aw.w = hi.y;
            acc = __builtin_amdgcn_mfma_f32_32x32x16_bf16(__builtin_bit_cast(bf16x8, aw), __builtin_bit_cast(bf16x8, pw), acc, 0, 0, 0); }
    }
    {
        const LAS float* nsp = (const LAS float*)(lds + NS);
#pragma unroll
        for (int k = 0; k < 8; ++k) {
            const bf16x8 a = *(const LAS bf16x8*)(lds + CB + (32 * et + r32) * RS + (16 * k + 8 * hh) * 2);
            const bf16x8 bq = *(const LAS bf16x8*)(lds + QW + trow * RS + (16 * k + 8 * hh) * 2);
            acc = __builtin_amdgcn_mfma_f32_32x32x16_bf16(a, bq, acc, 0, 0, 0);
            const f32x4 n0 = *(const LAS f32x4*)(nsp + 16 * k + 8 * hh), n1 = *(const LAS f32x4*)(nsp + 16 * k + 8 * hh + 4);
            den += bf1((bf16_t)bq[0]) * n0[0] + bf1((bf16_t)bq[1]) * n0[1] + bf1((bf16_t)bq[2]) * n0[2] + bf1((bf16_t)bq[3]) * n0[3]
                 + bf1((bf16_t)bq[4]) * n1[0] + bf1((bf16_t)bq[5]) * n1[1] + bf1((bf16_t)bq[6]) * n1[2] + bf1((bf16_t)bq[7]) * n1[3]; }
    }
    den += __shfl_xor(den, 32);
    const float hinv = 1.f / fmaxf(fabsf(den), eo);
    float ssq = 0.f;
#pragma unroll
    for (int r = 0; r < 16; ++r) { acc[r] *= hinv; ssq += acc[r] * acc[r]; }
    ssq += __shfl_xor(ssq, 32);
    if (hh == 0) ((LAS float*)(lds + SSQ))[et * 64 + trow] = ssq;
    LBAR();
    {
        const LAS float* sq = (const LAS float*)(lds + SSQ) + trow;
        const float tot = (sq[0] + sq[64]) + (sq[128] + sq[192]);
        const float rn = att::YSC / sqrtf(tot * (1.f / 128.f) + RMS_EPS);
        unsigned char* yrow = Y + (r0 + trow) * D + 512 + h * 128 + 32 * et + 4 * hh;
#pragma unroll
        for (int g = 0; g < 4; ++g) { const f32x4 nwg = *(const LAS f32x4*)(lds + ZNW + (h * 128 + 32 * et + 8 * g + 4 * hh) * 4); const float o0 = bflo(og[g].x), o1 = bfhi(og[g].x), o2 = bflo(og[g].y), o3 = bfhi(og[g].y);
            *(unsigned*)(yrow + 8 * g) = pg8::pack_fp8x4(acc[4 * g] * rn * nwg[0] * sigmoid_f(o0), acc[4 * g + 1] * rn * nwg[1] * sigmoid_f(o1), acc[4 * g + 2] * rn * nwg[2] * sigmoid_f(o2), acc[4 * g + 3] * rn * nwg[3] * sigmoid_f(o3)); }
    }
}
}

__device__ __forceinline__ int wq_pull(Frame& F, unsigned* qctr) {
    volatile LAS int* slot = (volatile LAS int*)(F.lds + LDSCTL_OFF + 256);
    __syncthreads();
    if (F.tid == 0) *slot = (int)__hip_atomic_fetch_add(qctr, 1u, __ATOMIC_RELAXED, __HIP_MEMORY_SCOPE_AGENT);
    __syncthreads();
    return __builtin_amdgcn_readfirstlane(*slot);
}
constexpr int N_PHASES = 18;
constexpr int N_LAUNCHES = MK_N_LAUNCHES;
constexpr int PTAB_OFF = LDSCTL_OFF + 512, MOETAB_OFF = LDSCTL_OFF + 64;
__device__ __forceinline__ const float* inptr(const Frame& F, int i) {
    const LAS unsigned* t = (const LAS unsigned*)(F.lds + PTAB_OFF) + 2 * i;
    const unsigned lo = __builtin_amdgcn_readfirstlane(t[0]), hi = __builtin_amdgcn_readfirstlane(t[1]);
    return (const float*)(((unsigned long long)hi << 32) | lo);
}
#define GRID_BAR() do { if (N_LAUNCHES == 1) xcd_barrier(bar); } while (0)
#define IN(k) (lo <= (k) && (k) < hi)
#define SEAM(k) do { if (IN(k) && IN((k) + 1)) GRID_BAR(); } while (0)
__device__ __forceinline__ void moe_table(Frame& F) {
    LAS int* tab = (LAS int*)(F.lds + MOETAB_OFF);
    __syncthreads();
    if (F.tid == 0) { int cum = 0; for (int e = 0; e < NE; ++e) { const int cn = (int)__hip_atomic_load(F.ctl + CW_CNT + e, __ATOMIC_RELAXED, __HIP_MEMORY_SCOPE_AGENT); tab[e] = cn; tab[8 + e] = cum; cum += (cn + 255) >> 8; } tab[16] = cum; }
    __syncthreads();
}
template <int GRP>
__device__ __forceinline__ void conv_part(Frame& F, int part) {
    constexpr int N = (GRP == 0) ? CONV_N0 : (GRP == 1) ? CONV_N1 : (GRP == 2) ? CONV_N2 : (GRP == 3) ? CONV_N3 : CONV_N4;
    const int niter = (N + F.NGW - 1) / F.NGW, i0 = part * niter / 3, i1 = (part + 1) * niter / 3;
#pragma unroll 1
    for (int i = i0; i < i1; ++i) { const int it = F.gw + i * F.NGW; if (it < N) conv_item<GRP>(F, it); }
}
template <int GRP>
__device__ __forceinline__ void conv_queue(Frame& F, unsigned* qctr) {
    constexpr int N = (GRP == 0) ? CONV_N0 : (GRP == 1) ? CONV_N1 : (GRP == 2) ? CONV_N2 : (GRP == 3) ? CONV_N3 : CONV_N4, BATCH = 32, NBATCH = (N + BATCH - 1) / BATCH;
    volatile LAS int* slot2 = (volatile LAS int*)(F.lds + LDSCTL_OFF + 264);
    int cur = wq_pull(F, qctr), par = 0;
    while (cur < NBATCH) {
        if (F.tid == 0) slot2[par] = (int)__hip_atomic_fetch_add(qctr, 1u, __ATOMIC_RELAXED, __HIP_MEMORY_SCOPE_AGENT);
#pragma unroll 1
        for (int i = F.wave; i < BATCH; i += NWAVES) { const int it = cur * BATCH + i; if (it < N) conv_item<GRP>(F, it); }
        __syncthreads();
        cur = __builtin_amdgcn_readfirstlane(slot2[par]); par ^= 1;
    }
}
constexpr int G4_SLACK0 = CONV_N2 - 4096 - 5 * 2048, G4_TAIL = CONV_N4 - 2048;
static_assert(G4_SLACK0 > 0 && G4_SLACK0 + G4_TAIL <= 2048 && G4_TAIL > 0, "group 4 tail placement");
template <int L>
__device__ __forceinline__ void layer(Frame& F, const XcdBarrier& bar, float* out, const int lo, const int hi) {
    constexpr int pb = 2 + 8 * L;
    unsigned char* ws = F.ws;
    float* mod = (float*)(ws + WS_MOD); float* gates = (float*)(ws + WS_GATES);
    uint4* tok = (uint4*)(ws + WS_TOK); int* idx = (int*)(ws + WS_TOK + 512 * 1024);
    bf16_t* XN = (bf16_t*)(ws + WS_XN); bf16_t* proj = (bf16_t*)(ws + WS_PROJ); unsigned char* ymix = ws + WS_YMIX; bf16_t* act = (bf16_t*)(ws + WS_ACT);
    bf16_t* yb = (bf16_t*)(ws + WS_YB);
    const float* modl = mod + (size_t)L * NB * 6 * D;
    if (IN(pb + 0)) {
        pg8::DenseSched S{(const char*)XN, (const char*)(ws + WS_WIN + (size_t)L * NIN * D), D, M / 256, NIN / 256, F.G, (int)blockIdx.x};
        pg8::EpiInProjI8 E{proj, NIN, (float*)(ws + WS_CTL + KMEAN_OFF + (size_t)L * 131072), (const float*)(ws + WS_ROWMAX), (const float*)(ws + WS_CTL + COLMAX_OFF) + CMX_WIN + L * NIN};
        pg8::gemm_phase<pg8::EpiInProjI8, pg8::DenseSched, true, 2>(F.lds, D, S, E);
    }
    SEAM(pb + 0);
    const mls::MW mw{ws + WS_CC, ws + WS_CP, (float*)(ws + WS_NC), (float*)(ws + WS_NP), (float*)(ws + WS_SC), (float*)(ws + WS_SC + 65536)};
    const float* km = (const float*)(ws + WS_CTL + KMEAN_OFF + (size_t)L * 131072);
    const int cls = (blockIdx.x >> 3) & 3; const bool odd = (cls & 1) != 0;
    if (IN(pb + 1)) {
        mls::x_setup(F, inptr(F, IN_CONVW) + (size_t)L * 4 * 1024, inptr(F, IN_CONVB) + (size_t)L * 1024);
        { int u = blockIdx.x; mls::XL xa; if (u < 1024) mls::x_load(xa, F, proj, gates, u);
          for (; u < 1024; u += F.G) { mls::XL xb; const bool hn = u + F.G < 1024; mls::x_unit(F, proj, gates, mw, u, xa, xb, hn, u + F.G); xa = xb; } }
        __syncthreads();
    }
    SEAM(pb + 1);
    if (IN(pb + 2)) {
        constexpr int GRP = (L == 0) ? 2 : 3;
        mls::y_phase<GRP>(F, mw);
        GRID_BAR();
        if (cls == 0) { conv_all<GRP>(F, (F.G == 256) ? mls::CONV_Y : 0); if (L == 0 && F.G == 256) { const int e4 = F.gw - G4_SLACK0; if (e4 >= 0 && e4 < G4_TAIL) conv_item<4>(F, 2048 + e4); } __syncthreads(); }
        if (odd) { for (int p = blockIdx.x; p < 256; p += F.G) { const int bh = p >> 2, jj = p & 3; mob::attn_unit<8>(bh >> 3, bh & 7, 7 - jj, (const mob::bf16*)(proj + C_MQ), (const mob::bf16*)(proj + C_MK), (const mob::bf16*)(proj + C_MV), ymix, km, (char*)F.glds); } }
        __syncthreads();
        if (cls == 1) { conv_all<GRP>(F, (F.G == 256) ? mls::CONV_Y : 0); if (L == 0 && F.G == 256) { const int e4 = F.gw - G4_SLACK0; if (e4 >= 0 && e4 < G4_TAIL) conv_item<4>(F, 2048 + e4); } __syncthreads(); }
        mls::z_setup(F, inptr(F, IN_CONVW) + (size_t)L * 4 * 1024, inptr(F, IN_CONVB) + (size_t)L * 1024, inptr(F, IN_MNW) + (size_t)L * 512);
        { int u = blockIdx.x; mls::ZL za; if (u < 1024) mls::z_load(za, F, proj, gates, mw, u);
          for (; u < 1024; u += F.G) { mls::ZL zb; const bool hn = u + F.G < 1024; mls::z_unit(F, proj, gates, mw, ymix, u, za, zb, hn, u + F.G); za = zb; } }
        __syncthreads();
        if (!odd) { for (int p = blockIdx.x; p < 256; p += F.G) { const int bh = p >> 2, jj = p & 3; mob::attn_unit<8>(bh >> 3, bh & 7, 7 - jj, (const mob::bf16*)(proj + C_MQ), (const mob::bf16*)(proj + C_MK), (const mob::bf16*)(proj + C_MV), ymix, km, (char*)F.glds); } }
        __syncthreads();
        if (cls == 2) { conv_all<GRP>(F, (F.G == 256) ? mls::CONV_Y : 0); if (L == 0 && F.G == 256) { const int e4 = F.gw - G4_SLACK0; if (e4 >= 0 && e4 < G4_TAIL) conv_item<4>(F, 2048 + e4); } __syncthreads(); }
        for (int p = blockIdx.x; p < 256; p += F.G) { const int bh = p >> 2, jj = p & 3; mob::attn_unit<8>(bh >> 3, bh & 7, jj, (const mob::bf16*)(proj + C_MQ), (const mob::bf16*)(proj + C_MK), (const mob::bf16*)(proj + C_MV), ymix, km, (char*)F.glds); }
        for (int u = blockIdx.x; u < 256; u += F.G) att::swa_unit(F, proj, inptr(F, IN_SINK) + L * 16, ymix, u >> 5, (u >> 4) & 1, u & 15);
        __syncthreads();
        if (cls == 3) { conv_all<GRP>(F, (F.G == 256) ? mls::CONV_Y : 0); if (L == 0 && F.G == 256) { const int e4 = F.gw - G4_SLACK0; if (e4 >= 0 && e4 < G4_TAIL) conv_item<4>(F, 2048 + e4); } __syncthreads(); }
    }
    SEAM(pb + 2);
    if (IN(pb + 3)) {
        pg8::DenseSched S{(const char*)ymix, (const char*)(ws + WS_WOUT + (size_t)L * D * D), D, M / 256, D / 256, F.G, (int)blockIdx.x};
        pg8::EpiBf16 E{yb, D, WSC_INV / att::YSC};
        pg8::gemm_phase<pg8::EpiBf16, pg8::DenseSched, true, 1>(F.lds, D, S, E);
    }
    SEAM(pb + 3);
    if (IN(pb + 4)) {
        float* xb = (float*)(ws + WS_XB);
        if constexpr (L == 0) row_phase<1, 0, true, true, false, true>(F, inptr(F, IN_X), xb, yb, inptr(F, IN_GPOSTM) + (size_t)L * D, modl + 2 * D, inptr(F, IN_GPREF) + (size_t)L * D, modl + 4 * D, modl + 3 * D, XN,
                                          nullptr, 0, nullptr, nullptr, nullptr, nullptr, nullptr, nullptr, nullptr, (float*)(ws + WS_ROWMAX));
        else        row_phase<1, 2, true, true, true, true>(F, xb, xb, yb, inptr(F, IN_GPOSTM) + (size_t)L * D, modl + 2 * D, inptr(F, IN_GPREF) + (size_t)L * D, modl + 4 * D, modl + 3 * D, XN,
                                          inptr(F, IN_ROUTER), 8, nullptr, nullptr, nullptr, nullptr, tok, idx, F.ctl + CW_CNT, (float*)(ws + WS_ROWMAX));
    }
    SEAM(pb + 4);
    if constexpr (L == 0) {
        if (IN(pb + 5)) {
            pg8::DenseSched S{(const char*)XN, (const char*)(ws + WS_WGU), D, M / 256, 2 * DFF / 256, F.G, (int)blockIdx.x};
            pg8::EpiSwiGLUI8 E{(unsigned char*)act, DFF, (const float*)(ws + WS_ROWMAX), (const float*)(ws + WS_CTL + COLMAX_OFF), nullptr, nullptr};
            pg8::gemm_phase<pg8::EpiSwiGLUI8, pg8::DenseSched, true, 2>(F.lds, D, S, E);
        }
        SEAM(pb + 5);
        if (IN(pb + 6)) {
            pg8::DenseSched S{(const char*)act, (const char*)(ws + WS_WD), DFF, M / 256, D / 256, F.G, (int)blockIdx.x};
            pg8::EpiBf16 E{yb, D, WSC_INV};
            pg8::gemm_phase<pg8::EpiBf16, pg8::DenseSched, true, 1>(F.lds, DFF, S, E);
        }
        SEAM(pb + 6);
        if (IN(pb + 7)) { float* xb = (float*)(ws + WS_XB); row_phase<1, 1, true, true, true, true>(F, xb, xb, yb, inptr(F, IN_GPOSTF), modl + 5 * D, inptr(F, IN_GPREM) + D, mod + (size_t)NB * 6 * D + 1 * D, mod + (size_t)NB * 6 * D + 0 * D, XN,
                                              inptr(F, IN_WIN) + (size_t)D * NIN_SRC + SRC_GATE, NIN_SRC, inptr(F, IN_IGB) + 4, inptr(F, IN_FGB) + 4, gates, nullptr, nullptr, nullptr, nullptr, (float*)(ws + WS_ROWMAX));
            for (int it = F.gw; it < ((F.G == 256) ? 2048 : CONV_N4); it += F.NGW) conv_item<4>(F, it); }
        SEAM(pb + 7);
    } else {
        if (IN(pb + 5)) {
            moe_table(F);
            const LAS int* tab = (const LAS int*)(F.lds + MOETAB_OFF);
            pg8::MoeSched<true> S; S.A = (const char*)XN; S.W = (const char*)(ws + WS_MGU); S.idx = idx; S.tab = tab; S.KB = D; S.nN = 2 * DFE / 256; S.G = F.G; S.c = (int)blockIdx.x; S.wrows = 2 * DFE; S.ntile = tab[16];
            pg8::EpiSwiGLUI8 E{(unsigned char*)act, DFE, (const float*)(ws + WS_RMSLOT), (const float*)(ws + WS_CTL + COLMAX_OFF) + 2 * DFF, idx, tab};
            pg8::gemm_phase<pg8::EpiSwiGLUI8, pg8::MoeSched<true>, true, 2>(F.lds, D, S, E);
        }
        SEAM(pb + 5);
        if (IN(pb + 6)) {
            moe_table(F);
            const LAS int* tab = (const LAS int*)(F.lds + MOETAB_OFF);
            pg8::MoeSched<false> S; S.A = (const char*)act; S.W = (const char*)(ws + WS_MD); S.idx = idx; S.tab = tab; S.KB = DFE; S.nN = D / 256; S.G = F.G; S.c = (int)blockIdx.x; S.wrows = D; S.ntile = tab[16];
            pg8::EpiBf16 E{yb, D, WSC_INV};
            pg8::gemm_phase<pg8::EpiBf16, pg8::MoeSched<false>, true, 1>(F.lds, DFE, S, E);
        }
        SEAM(pb + 6);
        if (IN(pb + 7)) row_phase<2, 0, false, false, true, false>(F, (const float*)(ws + WS_XB), out, yb, inptr(F, IN_GPOSTF) + D, modl + 5 * D, nullptr, nullptr, nullptr, nullptr,
                                               nullptr, 0, nullptr, nullptr, nullptr, tok, nullptr, nullptr, F.ctl + CW_CNT);
    }
}
__global__ void __launch_bounds__(NTHR, 2) fwd(Args args) {
    extern __shared__ __attribute__((aligned(16))) unsigned char lds[];
    Frame F;
    F.lds = (LAS unsigned char*)lds; F.glds = lds; F.ws = args.ws; F.ctl = (unsigned*)(args.ws + WS_CTL);
    F.tid = threadIdx.x; F.lane = F.tid & 63; F.wave = __builtin_amdgcn_readfirstlane(F.tid >> 6);
    F.G = gridDim.x; F.gw = blockIdx.x * NWAVES + F.wave; F.NGW = F.G * NWAVES;
    volatile LAS unsigned* MISC = (volatile LAS unsigned*)(F.lds + MISC_OFF);
    for (int u = F.tid; u < (LDS_BYTES - LDSCTL_OFF) / 4; u += NTHR) ((LAS unsigned*)(F.lds + LDSCTL_OFF))[u] = 0u;
    __syncthreads();
    if (F.tid < N_INPUTS) { const unsigned long long p = (unsigned long long)args.in[F.tid]; LAS unsigned* t = (LAS unsigned*)(F.lds + PTAB_OFF) + 2 * F.tid; t[0] = (unsigned)p; t[1] = (unsigned)(p >> 32); }
    __syncthreads();
    XcdBarrier bar; bar.bar = F.ctl + CW_BAR; bar.x = 0; bar.st = nullptr;
    if (N_LAUNCHES == 1) bar = xcd_barrier_post(F.ctl + CW_BAR, MISC + 8);
    const int lo = args.ph_lo, hi = args.ph_hi;
    float* out = args.out;
    if (IN(0)) { p0_ada(F, inptr(F, IN_C), inptr(F, IN_ADAW), inptr(F, IN_ADAB), (float*)(F.ws + WS_MOD)); __syncthreads(); conv_all<0>(F); }
    SEAM(0);
    if (IN(1)) { float* mod = (float*)(F.ws + WS_MOD); const float* x = inptr(F, IN_X);
        row_phase<0, 1, true, true>(F, x, (float*)x  , nullptr, nullptr, nullptr, inptr(F, IN_GPREM), mod + 1 * D, mod + 0 * D, (bf16_t*)(F.ws + WS_XN),
                              inptr(F, IN_WIN) + SRC_GATE, NIN_SRC, inptr(F, IN_IGB), inptr(F, IN_FGB), (float*)(F.ws + WS_GATES), nullptr, nullptr, nullptr, nullptr, (float*)(F.ws + WS_ROWMAX));
        conv_all<1>(F); }
    SEAM(1);
    layer<0>(F, bar, out, lo, hi);
    layer<1>(F, bar, out, lo, hi);
}
#undef IN
#undef SEAM
#undef GRID_BAR

extern "C" void kernel_launch(void* const* d_in, const int* in_sizes, int n_in, void* d_out, int out_size, void* d_ws, size_t ws_size, hipStream_t stream) {
    static int grid = 0;
    if (grid == 0) {
        if (n_in != N_INPUTS || in_sizes[0] != M * D || out_size != M * D || ws_size < WS_END) { fprintf(stderr, "kernel_launch: unexpected problem (n_in %d, in0 %d, out %d, ws %zu); nothing launched\n", n_in, n_in > 0 ? in_sizes[0] : -1, out_size, ws_size); grid = -1; return; }
        int dev = 0, cus = 0, per_cu = 0;
        if (hipGetDevice(&dev) != hipSuccess || hipDeviceGetAttribute(&cus, hipDeviceAttributeMultiprocessorCount, dev) != hipSuccess) { grid = -1; return; }
        if (hipFuncSetAttribute((const void*)fwd, hipFuncAttributeMaxDynamicSharedMemorySize, LDS_BYTES) != hipSuccess) { fprintf(stderr, "kernel_launch: hipFuncSetAttribute failed\n"); grid = -1; return; }
        if (hipOccupancyMaxActiveBlocksPerMultiprocessor(&per_cu, (const void*)fwd, NTHR, LDS_BYTES) != hipSuccess || per_cu < 1) fprintf(stderr, "kernel_launch: occupancy query reports %d\n", per_cu);
        (void)hipGetLastError();
        grid = cus;
    }
    if (grid < 0) return;
    if (hipMemsetAsync((char*)d_ws + WS_CTL, 0, CTL_ZERO_BYTES, stream) != hipSuccess) return;
    Args a{};
    for (int i = 0; i < N_INPUTS; ++i) a.in[i] = (const float*)d_in[i];
    a.out = (float*)d_out; a.ws = (unsigned char*)d_ws;
    if (N_LAUNCHES == 1) { a.ph_lo = 0; a.ph_hi = N_PHASES; hipLaunchKernelGGL(fwd, dim3(grid), dim3(NTHR), LDS_BYTES, stream, a); }
    else for (int p = 0; p < N_PHASES; ++p) { a.ph_lo = p; a.ph_hi = p + 1; hipLaunchKernelGGL(fwd, dim3(grid), dim3(NTHR), LDS_BYTES, stream, a); }
}
```

```cpp
#include <hip/hip_runtime.h>
#include <cstdio>
#include <cstdint>

#ifndef MK_N_LAUNCHES
#define MK_N_LAUNCHES 1
#endif

#define LAS __attribute__((address_space(3)))
#define GAS __attribute__((address_space(1)))
typedef unsigned short bf16_t;
typedef short bf16x8 __attribute__((ext_vector_type(8)));
typedef float f32x4 __attribute__((ext_vector_type(4)));
typedef float f32x2 __attribute__((ext_vector_type(2)));
typedef float f32x16 __attribute__((ext_vector_type(16)));
typedef unsigned u32x4 __attribute__((ext_vector_type(4)));
typedef unsigned u32x2 __attribute__((ext_vector_type(2)));
typedef __bf16 bf16x2_t __attribute__((ext_vector_type(2)));

constexpr int NB = 8, SEQ = 2048, D = 2048, M = NB * SEQ;
constexpr int NIN_SRC = 4872, NIN = 4864;
constexpr int C_MQ = 0, C_MK = 512, C_MV = 1024, C_LQ = 1536, C_LK = 2048, C_LV = 2560, C_LO = 3072, C_SQ = 3584, C_SK = 4608, C_SV = 4736;
constexpr int SRC_GATE = 3584;
constexpr int DFF = 5632, DFE = 2816, NE = 8, ECAP = M;
constexpr float RMS_EPS = 1e-6f;
constexpr int NWAVES = 8, NTHR = 512;

constexpr size_t MiB = 1u << 20;
constexpr size_t WS_CTL = 0, CTL_ZERO_BYTES = 1 * MiB;
constexpr size_t WS_MOD = 1 * MiB;
constexpr size_t WS_GATES = 2 * MiB;
constexpr size_t WS_ROWMAX = 4 * MiB;
constexpr size_t WS_RMSLOT = 4 * MiB + 131072;
constexpr size_t WS_TOK = 3 * MiB;
constexpr size_t WS_WIN = 8 * MiB;
constexpr size_t WS_WOUT = 48 * MiB;
constexpr size_t WS_WGU = 64 * MiB;
constexpr size_t WS_WD = 108 * MiB;
constexpr size_t WS_MGU = 130 * MiB;
constexpr size_t WS_MD = 306 * MiB;
constexpr size_t WS_XN = 394 * MiB;
constexpr size_t WS_PROJ = 458 * MiB;
constexpr size_t WS_YMIX = 610 * MiB;
constexpr size_t WS_ACT = 458 * MiB;
constexpr size_t WS_YB = 674 * MiB;
constexpr size_t WS_XB = 810 * MiB;
constexpr size_t WS_CC = 874 * MiB;
constexpr size_t WS_CP = 906 * MiB;
constexpr size_t WS_NC = 938 * MiB, WS_NP = 939 * MiB, WS_SC = 940 * MiB;
constexpr size_t WS_END = 941 * MiB;
constexpr int CW_TMO = 0, CW_CODE = 1;
constexpr int CW_CNT = 64;
constexpr int CW_WQ = 128;
constexpr int CW_BAR = 4096;
constexpr size_t KMEAN_OFF = 262144;


__device__ __forceinline__ unsigned cvtpk(float lo, float hi) { f32x2 v = {lo, hi}; bf16x2_t b = __builtin_convertvector(v, bf16x2_t); return __builtin_bit_cast(unsigned, b); }
__device__ __forceinline__ float bflo(unsigned u) { return __uint_as_float(u << 16); }
__device__ __forceinline__ float bfhi(unsigned u) { return __uint_as_float(u & 0xffff0000u); }
__device__ __forceinline__ float bf1(bf16_t u) { return __uint_as_float(((unsigned)u) << 16); }
template <bool MAX>
__device__ __forceinline__ float scan64(float v) {
    constexpr int ident = MAX ? (int)0xff800000 : 0;
#define SCAN_STEP(ctrl, rm) { const float tf = __int_as_float(__builtin_amdgcn_update_dpp(ident, __float_as_int(v), ctrl, rm, 0xf, false)); v = MAX ? fmaxf(v, tf) : v + tf; }
    SCAN_STEP(0x111, 0xf) SCAN_STEP(0x112, 0xf) SCAN_STEP(0x114, 0xf) SCAN_STEP(0x118, 0xf) SCAN_STEP(0x142, 0xa) SCAN_STEP(0x143, 0xc)
#undef SCAN_STEP
    return v;
}
__device__ __forceinline__ float lane63(float v) { return __int_as_float(__builtin_amdgcn_readlane(__float_as_int(v), 63)); }
__device__ __forceinline__ float wave_sum(float v) { return lane63(scan64<false>(v)); }
__device__ __forceinline__ float wave_max(float v) { return lane63(scan64<true>(v)); }
#define LBAR() do { asm volatile("s_waitcnt lgkmcnt(0)" ::: "memory"); __builtin_amdgcn_s_barrier(); asm volatile("" ::: "memory"); } while (0)
__device__ __forceinline__ float silu_f(float x) { return x / (1.f + __expf(-x)); }
__device__ __forceinline__ float sigmoid_f(float x) { return 1.f / (1.f + __expf(-x)); }

namespace pg8 {
constexpr int BM = 256, BK = 64, HALF = 128, HTB = HALF * BK * 2, STAGE_BYTES = 8 * HTB, NXCD = 8, WGM = 8;
__host__ __device__ __forceinline__ int lds_byte(int r, int c) { const int st = (r >> 4) * 2 + (c >> 5), rr = r & 15, cc = c & 31, ob = rr * 64 + cc * 2; return st * 1024 + (ob ^ (((ob >> 9) & 1) << 5)); }
__host__ __device__ __forceinline__ void stage_rc(int b, int& R, int& C) { const int st = b / 1024, sb = b % 1024, swz = sb ^ (((sb >> 9) & 1) << 5); R = (st >> 1) * 16 + swz / 64; C = (st & 1) * 32 + (swz % 64) / 2; }
__host__ __device__ __forceinline__ int perm32(int rho) { const int n = rho >> 4, i = rho & 15; return 8 * (i >> 2) + 4 * n + (i & 3); }

struct Unit { int pm, pn, e; };
__device__ __forceinline__ unsigned pack_fp8x4(float a, float b, float c, float d) {
    a = fminf(fmaxf(a, -448.f), 448.f); b = fminf(fmaxf(b, -448.f), 448.f); c = fminf(fmaxf(c, -448.f), 448.f); d = fminf(fmaxf(d, -448.f), 448.f);
    int p = __builtin_amdgcn_cvt_pk_fp8_f32(a, b, 0, false); p = __builtin_amdgcn_cvt_pk_fp8_f32(c, d, p, true); return (unsigned)p;
}


__device__ __forceinline__ bool static_next(int i, int G, int c, int nM, int nN, int& pm, int& pn) {
    const int nwg = nM * nN; const long L = (long)i * G + c; if (L >= nwg) return false;
    int wgid = (int)L; { const int q = nwg / NXCD, r = nwg % NXCD, xcd = wgid % NXCD, off = wgid / NXCD; wgid = (xcd < r ? xcd * (q + 1) : r * (q + 1) + (xcd - r) * q) + off; }
    const int nig = WGM * nN, gid = wgid / nig, fm = gid * WGM, gsz = (nM - fm) < WGM ? (nM - fm) : WGM;
    pm = fm + ((wgid % nig) % gsz); pn = (wgid % nig) / gsz; return true;
}

struct DenseSched {
    static constexpr bool GATHER = false;
    const char* A; const char* Bt; int KB  , nM, nN, G, c;
    __device__ __forceinline__ bool next(int i, Unit& u) const { u.e = 0; return static_next(i, G, c, nM, nN, u.pm, u.pn); }
    __device__ __forceinline__ const char* a_base() const { return A; }
    __device__ __forceinline__ void a_offsets(const Unit& u, const int (&Rr)[2], const int (&Cc)[2], unsigned (&off)[2][2]) const {
#pragma unroll
        for (int h = 0; h < 2; ++h)
#pragma unroll
            for (int i = 0; i < 2; ++i) off[h][i] = (unsigned)((u.pm * BM + h * HALF + Rr[i]) * KB + Cc[i] * 2);
    }
    __device__ __forceinline__ const char* b_base(const Unit& u) const { return Bt + (size_t)u.pn * BM * KB; }
};
template <bool GATHER_>
struct MoeSched {
    static constexpr bool GATHER = GATHER_;
    const char* A; const char* W; const int* idx; const LAS int* tab  ; int KB, nN, G, c, wrows  , ntile;
    __device__ __forceinline__ bool next(int i, Unit& u) const { if (!static_next(i, G, c, ntile, nN, u.pm, u.pn)) return false; int e = 0;
#pragma unroll
        for (int j = 1; j < NE; ++j) e += (u.pm >= tab[8 + j]) ? 1 : 0;
        u.e = e; return true; }
    __device__ __forceinline__ const char* a_base() const { return A; }
    __device__ __forceinline__ void a_offsets(const Unit& u, const int (&Rr)[2], const int (&Cc)[2], unsigned (&off)[2][2]) const {
        const int cume = tab[8 + u.e], cnte = tab[u.e];
#pragma unroll
        for (int h = 0; h < 2; ++h)
#pragma unroll
            for (int i = 0; i < 2; ++i) {
                if (GATHER_) { const int rl = (u.pm - cume) * BM + h * HALF + Rr[i]; const int tok = (rl < cnte) ? idx[u.e * ECAP + rl] : 0; off[h][i] = (unsigned)(tok * KB + Cc[i] * 2); }
                else off[h][i] = (unsigned)((u.pm * BM + h * HALF + Rr[i]) * KB + Cc[i] * 2);
            }
    }
    __device__ __forceinline__ const char* b_base(const Unit& u) const { return W + ((size_t)u.e * wrows + (size_t)u.pn * BM) * KB; }
};

struct EpiBf16 {
    static constexpr bool PERM = true;
    bf16_t* O; int ldc; float sc;
    __device__ __forceinline__ void operator()(const f32x4 (&acc)[2][2][4][2], const Unit& u, int wr, int wc, int fr, int fq) const {
        const int row0 = u.pm * BM + wr * 64 + fr, col0 = u.pn * BM + wc * 32 + 8 * fq;
#pragma unroll
        for (int ai = 0; ai < 2; ++ai)
#pragma unroll
            for (int m = 0; m < 4; ++m) { bf16_t* rowp = O + (size_t)(row0 + ai * HALF + m * 16) * ldc + col0;
#pragma unroll
                for (int bj = 0; bj < 2; ++bj) { const f32x4 v0 = acc[ai][bj][m][0] * sc, v1 = acc[ai][bj][m][1] * sc;
                    u32x4 w; w.x = cvtpk(v0[0], v0[1]); w.y = cvtpk(v0[2], v0[3]); w.z = cvtpk(v1[0], v1[1]); w.w = cvtpk(v1[2], v1[3]);
                    *(u32x4*)(rowp + bj * HALF) = w; } }
    }
};
struct EpiInProjI8 {
    static constexpr bool PERM = true;
    bf16_t* O; int ldc; float* kmean; const float* rowmax; const float* colmax;
    __device__ __forceinline__ void operator()(const f32x4 (&acc)[2][2][4][2], const Unit& u, int wr, int wc, int fr, int fq) const {
        typedef int i32x4_ __attribute__((ext_vector_type(4)));
        const int row0 = u.pm * BM + wr * 64 + fr, col0 = u.pn * BM + wc * 32 + 8 * fq;
        const float qsc = (u.pn < 2 || (u.pn >= 14 && u.pn < 18)) ? 0.125f * 1.4426950408889634f : 1.f;
        f32x4 cmv[2][2], cs[2][2];
#pragma unroll
        for (int bj = 0; bj < 2; ++bj)
#pragma unroll
            for (int n = 0; n < 2; ++n) { cmv[bj][n] = *(const f32x4*)(colmax + col0 + bj * HALF + 4 * n) * (qsc / (127.f * 127.f)); cs[bj][n] = (f32x4){0.f, 0.f, 0.f, 0.f}; }
#pragma unroll
        for (int ai = 0; ai < 2; ++ai)
#pragma unroll
            for (int m = 0; m < 4; ++m) { const int r = row0 + ai * HALF + m * 16; bf16_t* rowp = O + (size_t)r * ldc + col0; const float sa = rowmax[r];
#pragma unroll
                for (int bj = 0; bj < 2; ++bj) { f32x4 v[2];
#pragma unroll
                    for (int n = 0; n < 2; ++n) { const i32x4_ iv = __builtin_bit_cast(i32x4_, acc[ai][bj][m][n]);
                        v[n] = (f32x4){(float)iv[0], (float)iv[1], (float)iv[2], (float)iv[3]} * (cmv[bj][n] * sa); cs[bj][n] += v[n]; }
                    u32x4 w; w.x = cvtpk(v[0][0], v[0][1]); w.y = cvtpk(v[0][2], v[0][3]); w.z = cvtpk(v[1][0], v[1][1]); w.w = cvtpk(v[1][2], v[1][3]);
                    *(u32x4*)(rowp + bj * HALF) = w; } }
        if (u.pn == 2 || u.pn == 3) {
#pragma unroll
            for (int bj = 0; bj < 2; ++bj)
#pragma unroll
                for (int n = 0; n < 2; ++n) {
#pragma unroll
                    for (int j = 0; j < 4; ++j) { float v = cs[bj][n][j]; v += __shfl_xor(v, 1); v += __shfl_xor(v, 2); v += __shfl_xor(v, 4); v += __shfl_xor(v, 8); cs[bj][n][j] = v; }
                    if (fr == 0) { float* kp = kmean + (size_t)u.pm * 512 + (u.pn - 2) * BM + bj * HALF + wc * 32 + 8 * fq + 4 * n;
#pragma unroll
                        for (int j = 0; j < 4; ++j) atomicAdd(kp + j, cs[bj][n][j] * (1.f / 256.f)); } }
        }
    }
};
typedef int i32x8 __attribute__((ext_vector_type(8)));
typedef int i32x4 __attribute__((ext_vector_type(4)));
struct EpiSwiGLUI8 {
    static constexpr bool PERM = true;
    unsigned char* O; int ldc; const float* rowmax; const float* colmax  ; const int* rowidx  ; const LAS int* tab;
    __device__ __forceinline__ void operator()(const f32x4 (&acc)[2][2][4][2], const Unit& u, int wr, int wc, int fr, int fq) const {
        const int row0 = u.pm * BM + wr * 64 + fr, col0 = u.pn * HALF + wc * 32 + 8 * fq;
        const float* cm = colmax + (size_t)u.e * 2 * ldc + u.pn * BM + wc * 32 + 8 * fq;
        const f32x4 cg0 = *(const f32x4*)(cm), cg1 = *(const f32x4*)(cm + 4), cu0 = *(const f32x4*)(cm + HALF), cu1 = *(const f32x4*)(cm + HALF + 4);
        const float cg[8] = {cg0[0], cg0[1], cg0[2], cg0[3], cg1[0], cg1[1], cg1[2], cg1[3]}, cu[8] = {cu0[0], cu0[1], cu0[2], cu0[3], cu1[0], cu1[1], cu1[2], cu1[3]};
        int cume = 0, cnte = 0x7fffffff; if (rowidx) { cume = tab[8 + u.e]; cnte = tab[u.e]; }
#pragma unroll
        for (int ai = 0; ai < 2; ++ai)
#pragma unroll
            for (int m = 0; m < 4; ++m) { const int r = row0 + ai * HALF + m * 16; unsigned char* rowp = O + (size_t)r * ldc + col0;
                float sa; if (rowidx) { const int rl = r - cume * BM; sa = (rl < cnte) ? rowmax[u.e * ECAP + rl] : 0.f; } else sa = rowmax[r];
                sa *= (1.f / (127.f * 127.f));
                float o[8];
#pragma unroll
                for (int n = 0; n < 2; ++n)
#pragma unroll
                    for (int j = 0; j < 4; ++j) { const float g = (float)__builtin_bit_cast(i32x4, acc[ai][0][m][n])[j] * (sa * cg[n * 4 + j]), up = (float)__builtin_bit_cast(i32x4, acc[ai][1][m][n])[j] * (sa * cu[n * 4 + j]);
                        o[n * 4 + j] = g * __builtin_amdgcn_rcpf(1.f + __builtin_amdgcn_exp2f(-1.4426950408889634f * g)) * up; }
                u32x2 w; w.x = pack_fp8x4(o[0], o[1], o[2], o[3]); w.y = pack_fp8x4(o[4], o[5], o[6], o[7]);
                *(u32x2*)rowp = w; }
    }
};

struct EpiSwiGLU8 {
    static constexpr bool PERM = true;
    unsigned char* O; int ldc; float sc;
    __device__ __forceinline__ void operator()(const f32x4 (&acc)[2][2][4][2], const Unit& u, int wr, int wc, int fr, int fq) const {
        const int row0 = u.pm * BM + wr * 64 + fr, col0 = u.pn * HALF + wc * 32 + 8 * fq;
#pragma unroll
        for (int ai = 0; ai < 2; ++ai)
#pragma unroll
            for (int m = 0; m < 4; ++m) { unsigned char* rowp = O + (size_t)(row0 + ai * HALF + m * 16) * ldc + col0;
                float r[8];
#pragma unroll
                for (int n = 0; n < 2; ++n)
#pragma unroll
                    for (int j = 0; j < 4; ++j) { const float g = acc[ai][0][m][n][j] * sc, up = acc[ai][1][m][n][j] * sc;
                        r[n * 4 + j] = g * __builtin_amdgcn_rcpf(1.f + __builtin_amdgcn_exp2f(-1.4426950408889634f * g)) * up; }
                u32x2 w; w.x = pack_fp8x4(r[0], r[1], r[2], r[3]); w.y = pack_fp8x4(r[4], r[5], r[6], r[7]);
                *(u32x2*)rowp = w; }
    }
};

template <class Epi, class Sched, bool ALIGN_EPI, int DT>
__device__ __forceinline__ void gemm_phase(LAS unsigned char* lds, const int KB, const Sched& S, const Epi& E) {
    const int tid = threadIdx.x, wid = __builtin_amdgcn_readfirstlane(tid >> 6), lane = tid & 63, wr = wid >> 2, wc = wid & 3, fr = lane & 15, fq = lane >> 4;
    const int nt = KB / 128;
    int Rr[2], Cc[2]; unsigned voffB[2];
#pragma unroll
    for (int i = 0; i < 2; ++i) { int R, C; stage_rc(tid * 16 + i * 8192, R, C); Rr[i] = R; Cc[i] = C; const int Rb = Epi::PERM ? ((R & ~31) + perm32(R & 31)) : R; voffB[i] = (unsigned)(Rb * KB + C * 2); }
    const size_t kstep = (size_t)(BK * 2);
    const size_t hstep = (size_t)HALF * KB;
    const unsigned ldsw = (unsigned)wid * 1024u;
    const int aoff = lds_byte(wr * 64 + fr, fq * 8), boff = lds_byte(wc * 32 + fr, fq * 8);
#define PG8_SA(b, h) (((b) * 2 + (h)) * HTB)
#define PG8_SB(b, h) ((4 + (b) * 2 + (h)) * HTB)
#define PG8_STAGE(bufoff, gbase, voff) do { _Pragma("unroll") for (int _i = 0; _i < 2; ++_i) \
        __builtin_amdgcn_global_load_lds((const unsigned*)((const char*)(gbase) + (voff)[_i]), (LAS unsigned*)(lds + (bufoff) + ldsw + _i * 8192), 16, 0, 0); } while (0)
#define PG8_LD32(p) __builtin_shufflevector(*(const LAS i32x4*)(p), *(const LAS i32x4*)((p) + 1024), 0, 1, 2, 3, 4, 5, 6, 7)
#define PG8_LDA(dst, b, h) do { _Pragma("unroll") for (int m = 0; m < 4; ++m) dst[m] = PG8_LD32(lds + PG8_SA(b, h) + aoff + m * 2048); } while (0)
#define PG8_LDB(dst, b, h) do { _Pragma("unroll") for (int n = 0; n < 2; ++n) dst[n] = PG8_LD32(lds + PG8_SB(b, h) + boff + n * 2048); } while (0)
#define PG8_LO(x) __builtin_bit_cast(bf16x8, __builtin_shufflevector((x), (x), 0, 1, 2, 3))
#define PG8_HI(x) __builtin_bit_cast(bf16x8, __builtin_shufflevector((x), (x), 4, 5, 6, 7))
#define PG8_MMA(ai, bj, At, Bt) do { __builtin_amdgcn_s_setprio(1); \
        if constexpr (DT == 2) { _Pragma("unroll") for (int m = 0; m < 4; ++m) _Pragma("unroll") for (int n = 0; n < 2; ++n) { \
            i32x4 _c = __builtin_bit_cast(i32x4, acc[ai][bj][m][n]); \
            _c = __builtin_amdgcn_mfma_i32_16x16x64_i8(__builtin_shufflevector(Bt[n], Bt[n], 0, 1, 2, 3), __builtin_shufflevector(At[m], At[m], 0, 1, 2, 3), _c, 0, 0, 0); \
            _c = __builtin_amdgcn_mfma_i32_16x16x64_i8(__builtin_shufflevector(Bt[n], Bt[n], 4, 5, 6, 7), __builtin_shufflevector(At[m], At[m], 4, 5, 6, 7), _c, 0, 0, 0); \
            acc[ai][bj][m][n] = __builtin_bit_cast(f32x4, _c); } } \
        else if constexpr (DT == 1) { _Pragma("unroll") for (int m = 0; m < 4; ++m) _Pragma("unroll") for (int n = 0; n < 2; ++n) \
            asm volatile("v_mfma_scale_f32_16x16x128_f8f6f4 %0, %1, %2, %0, %3, %3 op_sel_hi:[0,0,0]" : "+v"(acc[ai][bj][m][n]) : "v"(Bt[n]), "v"(At[m]), "v"(scv)); } \
        else { _Pragma("unroll") for (int m = 0; m < 4; ++m) _Pragma("unroll") for (int n = 0; n < 2; ++n) { \
            acc[ai][bj][m][n] = __builtin_amdgcn_mfma_f32_16x16x32_bf16(PG8_LO(Bt[n]), PG8_LO(At[m]), acc[ai][bj][m][n], 0, 0, 0); \
            acc[ai][bj][m][n] = __builtin_amdgcn_mfma_f32_16x16x32_bf16(PG8_HI(Bt[n]), PG8_HI(At[m]), acc[ai][bj][m][n], 0, 0, 0); } } \
        __builtin_amdgcn_s_setprio(0); } while (0)
#define PG8_WAIT_V(n) asm volatile("s_waitcnt vmcnt(" #n ")" ::: "memory")
#define PG8_WAIT_L(n) asm volatile("s_waitcnt lgkmcnt(" #n ")" ::: "memory")
#define PG8_BAR __builtin_amdgcn_s_barrier()
#define PG8_SCHED __builtin_amdgcn_sched_barrier(0)
    Unit cur, nxt; int ui = 0;
    if (!S.next(0, cur)) return;
    f32x4 acc[2][2][4][2];
#pragma unroll
    for (int a = 0; a < 2; ++a)
#pragma unroll
        for (int b = 0; b < 2; ++b)
#pragma unroll
            for (int m = 0; m < 4; ++m)
#pragma unroll
                for (int n = 0; n < 2; ++n) acc[a][b][m][n] = (f32x4){0.f, 0.f, 0.f, 0.f};
    i32x8 At[4], B0[2], B1[2];
    int scv = 0x7F7F7F7F; asm volatile("" : "+v"(scv));
    unsigned curA[2][2], nxtA[2][2], voffA[2];
    const char* const Ab = S.a_base(); const char* cA = Ab; const char* nA = Ab;
    if constexpr (Sched::GATHER) S.a_offsets(cur, Rr, Cc, curA);
    else {
#pragma unroll
        for (int i = 0; i < 2; ++i) voffA[i] = (unsigned)(Rr[i] * KB + Cc[i] * 2);
        cA = Ab + (size_t)cur.pm * 2 * hstep; }
    const char* cB = S.b_base(cur);
#define PG8_STA(bufoff, nextflag, h, koff) do { if constexpr (Sched::GATHER) { unsigned _o[2]; _o[0] = (nextflag) ? nxtA[h][0] : curA[h][0]; _o[1] = (nextflag) ? nxtA[h][1] : curA[h][1]; PG8_STAGE(bufoff, Ab + (koff), _o); } \
        else { PG8_STAGE(bufoff, ((nextflag) ? nA : cA) + (size_t)(h) * hstep + (koff), voffA); } } while (0)
    PG8_STAGE(PG8_SB(0, 0), cB, voffB); PG8_STAGE(PG8_SB(0, 1), cB + hstep, voffB); PG8_STA(PG8_SA(0, 0), false, 0, 0); PG8_STA(PG8_SA(0, 1), false, 1, 0);
    if (wr == 1) PG8_BAR;
    PG8_WAIT_V(2); PG8_BAR;
    PG8_STAGE(PG8_SB(1, 0), cB + kstep, voffB); PG8_STA(PG8_SA(1, 0), false, 0, kstep); PG8_STAGE(PG8_SB(1, 1), cB + hstep + kstep, voffB);
    PG8_WAIT_V(6); PG8_BAR;
    for (;;) {
        const bool has_next = S.next(ui + 1, nxt);
        if constexpr (Sched::GATHER) {
            if (has_next) S.a_offsets(nxt, Rr, Cc, nxtA);
            else {
#pragma unroll
                for (int h = 0; h < 2; ++h)
#pragma unroll
                    for (int i = 0; i < 2; ++i) nxtA[h][i] = curA[h][i]; }
        } else nA = has_next ? Ab + (size_t)nxt.pm * 2 * hstep : cA;
        const char* nB = has_next ? S.b_base(nxt) : cB;
        for (int t = 0; t < nt; t += 2) {
            const bool last = (t == nt - 2);
            const size_t k1 = (size_t)(t + 1) * kstep, k2 = last ? 0 : (size_t)(t + 2) * kstep, k3 = k2 + kstep;
            const char* b2 = last ? nB : cB + (size_t)(t + 2) * kstep; const char* b3 = b2 + kstep;
            PG8_LDB(B0, 0, 0); PG8_LDB(B1, 0, 1); PG8_SCHED; PG8_LDA(At, 0, 0); PG8_STA(PG8_SA(1, 1), false, 1, k1);
            PG8_WAIT_V(8); PG8_WAIT_L(0); PG8_BAR; PG8_MMA(0, 0, At, B0); PG8_MMA(0, 1, At, B1); PG8_BAR; PG8_SCHED;
            PG8_LDA(At, 0, 1); PG8_STAGE(PG8_SB(0, 0), b2, voffB); PG8_STAGE(PG8_SB(0, 1), b2 + hstep, voffB); PG8_STA(PG8_SA(0, 0), last, 0, k2);
            PG8_WAIT_V(8); PG8_WAIT_L(0); PG8_BAR; PG8_MMA(1, 0, At, B0); PG8_MMA(1, 1, At, B1); PG8_BAR; PG8_SCHED;
            PG8_LDB(B0, 1, 0); PG8_LDB(B1, 1, 1); PG8_SCHED; PG8_LDA(At, 1, 0); PG8_STA(PG8_SA(0, 1), last, 1, k2);
            PG8_WAIT_V(8); PG8_WAIT_L(0); PG8_BAR; PG8_MMA(0, 0, At, B0); PG8_MMA(0, 1, At, B1); PG8_BAR; PG8_SCHED;
            PG8_LDA(At, 1, 1); PG8_STAGE(PG8_SB(1, 0), b3, voffB); PG8_STAGE(PG8_SB(1, 1), b3 + hstep, voffB); PG8_STA(PG8_SA(1, 0), last, 0, k3);
            PG8_WAIT_V(8); PG8_WAIT_L(0); PG8_BAR; PG8_MMA(1, 0, At, B0); PG8_MMA(1, 1, At, B1); PG8_BAR; PG8_SCHED;
        }
        if constexpr (ALIGN_EPI) { if (wr == 0) PG8_BAR; }
        if constexpr (DT == 1) asm volatile("s_nop 15\n\ts_nop 15" ::: "memory");
        E(acc, cur, wr, wc, fr, fq);
        if (!has_next) break;
#pragma unroll
        for (int a = 0; a < 2; ++a)
#pragma unroll
            for (int b = 0; b < 2; ++b)
#pragma unroll
                for (int m = 0; m < 4; ++m)
#pragma unroll
                    for (int n = 0; n < 2; ++n) acc[a][b][m][n] = (f32x4){0.f, 0.f, 0.f, 0.f};
        cur = nxt; cB = nB; cA = nA; ++ui;
        if constexpr (Sched::GATHER) {
#pragma unroll
            for (int h = 0; h < 2; ++h)
#pragma unroll
                for (int i = 0; i < 2; ++i) curA[h][i] = nxtA[h][i]; }
        if constexpr (ALIGN_EPI) { if (wr == 1) PG8_BAR; }
    }
    PG8_WAIT_V(0);
    if constexpr (!ALIGN_EPI) { if (wr == 0) PG8_BAR; }
    PG8_BAR;
#undef PG8_SA
#undef PG8_SB
#undef PG8_STAGE
#undef PG8_STA
#undef PG8_LDA
#undef PG8_LDB
#undef PG8_MMA
#undef PG8_LD32
#undef PG8_LO
#undef PG8_HI
#undef PG8_WAIT_V
#undef PG8_WAIT_L
#undef PG8_BAR
#undef PG8_SCHED
}
}

#define XB_TMO      128
#define XB_XCNT(j)  (256  + 64 * (j))
#define XB_XSUB(j)  (1280 + 64 * (j))
#define XB_XGEN(j)  (2304 + 64 * (j))
#define XB_TOP      3328
#define XB_TOPGEN   3392
#define XCD_BAR_WORDS 3456
#define XB_SPIN_CAP (1u << 18)
__device__ __forceinline__ unsigned xb_ld(unsigned* p)              { return __hip_atomic_load(p, __ATOMIC_RELAXED, __HIP_MEMORY_SCOPE_AGENT); }
__device__ __forceinline__ unsigned xb_add(unsigned* p, unsigned v) { return __hip_atomic_fetch_add(p, v, __ATOMIC_RELAXED, __HIP_MEMORY_SCOPE_AGENT); }
__device__ __forceinline__ unsigned xb_xcc_id() { return (unsigned)__builtin_amdgcn_s_getreg((3 << 11) | 20) & 0xFu; }
#define XB_SPIN(cond, bar) do { unsigned _sp = 0; while (cond) { __builtin_amdgcn_s_sleep(1); \
    if ((++_sp & 255u) == 0u) { if (xb_ld(&(bar)[XB_TMO])) break; if (_sp > XB_SPIN_CAP) { atomicAdd(&(bar)[XB_TMO], 1u); break; } } } } while (0)
struct XcdBarrier { unsigned* bar; unsigned x; volatile LAS unsigned* st; };
__device__ __forceinline__ XcdBarrier xcd_barrier_post(unsigned* bar, volatile LAS unsigned* st) {
    XcdBarrier b; b.bar = bar; b.x = xb_xcc_id(); b.st = st;
    if (threadIdx.x == 0) (void)xb_add(&bar[XB_XCNT(b.x)], 1u);
    return b;
}
__device__ __forceinline__ void xcd_barrier_complete(unsigned* bar, unsigned x, unsigned& nloc, unsigned& nx) {
    const unsigned G = gridDim.x * gridDim.y * gridDim.z;
    unsigned sum, cnt, mine, sp = 0u;
    for (;;) {
        sum = 0u; cnt = 0u; mine = 0u;
#pragma unroll
        for (unsigned j = 0; j < 16; ++j) { const unsigned c = xb_ld(&bar[XB_XCNT(j)]); sum += c; cnt += (c > 0u) ? 1u : 0u; mine = (j == x) ? c : mine; }
        if (sum == G) break;
        __builtin_amdgcn_s_sleep(1);
        if ((++sp & 255u) == 0u) { if (xb_ld(&bar[XB_TMO])) break; if (sp > XB_SPIN_CAP) { atomicAdd(&bar[XB_TMO], 1u); break; } }
    }
    nloc = mine > 0u ? mine : 1u; nx = cnt > 0u ? cnt : 1u;
}
__device__ __forceinline__ void xcd_barrier(const XcdBarrier& b) {
    asm volatile("s_waitcnt vmcnt(0)" ::: "memory");
    __syncthreads();
    if (threadIdx.x == 0) {
        unsigned* bar = b.bar;
        __builtin_amdgcn_s_waitcnt(0);
        unsigned nloc = b.st[0], nx = b.st[1];
        if (nloc == 0u) { xcd_barrier_complete(bar, b.x, nloc, nx); b.st[0] = nloc; b.st[1] = nx; }
        const unsigned old = xb_add(&bar[XB_XSUB(b.x)], 1u);
        const unsigned gen = old / nloc;
        if (old + 1u == (gen + 1u) * nloc) {
            __builtin_amdgcn_fence(__ATOMIC_RELEASE, "agent");
            asm volatile("s_waitcnt vmcnt(0)" ::: "memory");
            const unsigned og = xb_add(&bar[XB_TOP], 1u);
            const unsigned tg = og / nx;
            if (og + 1u == (tg + 1u) * nx) xb_add(&bar[XB_TOPGEN], 1u);
            else XB_SPIN(xb_ld(&bar[XB_TOPGEN]) == tg, bar);
            __builtin_amdgcn_fence(__ATOMIC_ACQUIRE, "agent");
            xb_add(&bar[XB_XGEN(b.x)], 1u);
            asm volatile("s_waitcnt vmcnt(0)" ::: "memory");
        } else {
            XB_SPIN(xb_ld(&bar[XB_XGEN(b.x)]) == gen, bar);
            __builtin_amdgcn_fence(__ATOMIC_ACQUIRE, "agent");
            asm volatile("s_waitcnt vmcnt(0)" ::: "memory");
        }
    }
    __syncthreads();
}

constexpr int RING_BYTES = 131072, LDSCTL_OFF = RING_BYTES, MISC_OFF = LDSCTL_OFF + 320, LDS_BYTES = 147456;
enum { IN_X = 0, IN_C, IN_ADAW, IN_ADAB, IN_GPREM, IN_GPOSTM, IN_GPREF, IN_GPOSTF, IN_WIN, IN_WOUT, IN_CONVW, IN_CONVB, IN_IGB, IN_FGB, IN_MNW, IN_SINK,
       IN_FG, IN_FU, IN_FD, IN_ROUTER, IN_MG, IN_MU, IN_MD, N_INPUTS };
struct Args { const float* in[N_INPUTS]; float* out; unsigned char* ws; int ph_lo, ph_hi; };
struct Frame {
    LAS unsigned char* lds; unsigned char* glds; unsigned* ctl; unsigned char* ws;
    int tid, lane, wave, G, gw, NGW;
};

__device__ __forceinline__ void p0_ada(Frame& F, const float* c, const float* ada_w, const float* ada_b, float* mod) {
    float* cond = (float*)F.glds;
    float* part = (float*)(F.glds + 65536);
    for (int i = F.tid; i < NB * D; i += NTHR) { const int b = i / D, k = i % D; cond[k * 8 + b] = silu_f(c[i]); }
    __syncthreads();
    const int cq = F.lane & 7, ks = F.lane >> 3;
    for (int u = blockIdx.x; u < 768; u += F.G) {
        const int l = u / 384, cb = u % 384;
        const float* W = ada_w + (size_t)l * D * 6 * D + cb * 32 + cq * 4;
        f32x4 acc[8];
#pragma unroll
        for (int b = 0; b < 8; ++b) acc[b] = (f32x4){0.f, 0.f, 0.f, 0.f};
        const int kbase = F.wave * 256 + ks;
#pragma unroll 4
        for (int it = 0; it < 32; ++it) {
            const int k = kbase + 8 * it;
            const f32x4 w = __builtin_nontemporal_load((const f32x4*)(W + (size_t)k * 6 * D));
            const f32x4 c0 = *(const f32x4*)(cond + k * 8), c1 = *(const f32x4*)(cond + k * 8 + 4);
            acc[0] += w * c0[0]; acc[1] += w * c0[1]; acc[2] += w * c0[2]; acc[3] += w * c0[3];
            acc[4] += w * c1[0]; acc[5] += w * c1[1]; acc[6] += w * c1[2]; acc[7] += w * c1[3];
        }
#pragma unroll
        for (int b = 0; b < 8; ++b)
#pragma unroll
            for (int j = 0; j < 4; ++j) { float v = acc[b][j]; v += __shfl_xor(v, 8); v += __shfl_xor(v, 16); v += __shfl_xor(v, 32); acc[b][j] = v; }
        if (F.lane < 8) {
#pragma unroll
            for (int b = 0; b < 8; ++b) *(f32x4*)(part + (F.wave * 8 + b) * 32 + cq * 4) = acc[b];
        }
        __syncthreads();
        if (F.tid < 256) { const int b = F.tid >> 5, col = F.tid & 31; float s = ada_b[(size_t)l * 6 * D + cb * 32 + col];
#pragma unroll
          for (int w = 0; w < 8; ++w) s += part[(w * 8 + b) * 32 + col];
          mod[((size_t)l * NB + b) * 6 * D + cb * 32 + col] = s; }
        __syncthreads();
    }
}
__device__ __forceinline__ void cvt_item(const float* src, int ld, int k0, int c0, bf16_t* dst, int Kd, int drow0, unsigned char* scr, int lane) {
    const int c = lane & 15, q = lane >> 4;
    f32x4 v[4][4];
#pragma unroll
    for (int g = 0; g < 4; ++g)
#pragma unroll
        for (int j = 0; j < 4; ++j) v[g][j] = __builtin_nontemporal_load((const f32x4*)(src + (size_t)(k0 + 16 * g + 4 * q + j) * ld + c0 + 4 * c));
#pragma unroll
    for (int g = 0; g < 4; ++g)
#pragma unroll
        for (int i = 0; i < 4; ++i) { u32x2 w; w.x = cvtpk(v[g][0][i], v[g][1][i]); w.y = cvtpk(v[g][2][i], v[g][3][i]);
            *(u32x2*)(scr + (4 * c + i) * 136 + (16 * g + 4 * q) * 2) = w; }
    asm volatile("s_waitcnt lgkmcnt(0)" ::: "memory");
#pragma unroll
    for (int r = 0; r < 8; ++r) { const int n = 8 * r + (lane >> 3), ch = lane & 7;
        const u32x2 a = *(const u32x2*)(scr + n * 136 + ch * 16), b = *(const u32x2*)(scr + n * 136 + ch * 16 + 8);
        u32x4 o; o.x = a.x; o.y = a.y; o.z = b.x; o.w = b.y;
        *(u32x4*)(dst + (size_t)(drow0 + n) * Kd + k0 + 8 * ch) = o; }
    asm volatile("s_waitcnt lgkmcnt(0)" ::: "memory");
}
constexpr float WSC = 64.f, WSC_INV = 1.f / 64.f;
__device__ __forceinline__ void cvt_item8(const float* src, int ld, int k0, int c0, unsigned char* dst, int Kd, int drow0, unsigned char* scr, int lane) {
    const int c = lane & 7, q = lane >> 3;
    f32x4 v[4][4];
#pragma unroll
    for (int g = 0; g < 4; ++g)
#pragma unroll
        for (int j = 0; j < 4; ++j) v[g][j] = __builtin_nontemporal_load((const f32x4*)(src + (size_t)(k0 + 32 * g + 4 * q + j) * ld + c0 + 4 * c));
#pragma unroll
    for (int g = 0; g < 4; ++g)
#pragma unroll
        for (int i = 0; i < 4; ++i) *(unsigned*)(scr + (4 * c + i) * 132 + 32 * g + 4 * q) = pg8::pack_fp8x4(v[g][0][i] * WSC, v[g][1][i] * WSC, v[g][2][i] * WSC, v[g][3][i] * WSC);
    asm volatile("s_waitcnt lgkmcnt(0)" ::: "memory");
#pragma unroll
    for (int r = 0; r < 4; ++r) { const int n = 8 * r + (lane >> 3), ch = lane & 7; const unsigned char* p = scr + n * 132 + ch * 16;
        u32x4 o; o.x = *(const unsigned*)(p); o.y = *(const unsigned*)(p + 4); o.z = *(const unsigned*)(p + 8); o.w = *(const unsigned*)(p + 12);
        *(u32x4*)(dst + (size_t)(drow0 + n) * Kd + k0 + 16 * ch) = o; }
    asm volatile("s_waitcnt lgkmcnt(0)" ::: "memory");
}
__device__ __forceinline__ const float* inptr(const Frame& F, int i);
constexpr int CMS_KB = 2;
constexpr float CMS_F = 1.4f;
constexpr size_t COLMAX_OFF = 524288;
__device__ __forceinline__ void colmax_item(const float* src, int ld, int k0, int c0, float* cmx  , int lane) {
    const int c = lane & 7, q = lane >> 3;
    f32x4 mx = (f32x4){0.f, 0.f, 0.f, 0.f};
#pragma unroll
    for (int g = 0; g < 4; ++g)
#pragma unroll
        for (int j = 0; j < 4; ++j) { const f32x4 v = *(const f32x4*)(src + (size_t)(k0 + 32 * g + 4 * q + j) * ld + c0 + 4 * c);
            mx[0] = fmaxf(mx[0], fabsf(v[0])); mx[1] = fmaxf(mx[1], fabsf(v[1])); mx[2] = fmaxf(mx[2], fabsf(v[2])); mx[3] = fmaxf(mx[3], fabsf(v[3])); }
#pragma unroll
    for (int i = 0; i < 4; ++i) { float v = mx[i]; v = fmaxf(v, __shfl_xor(v, 8)); v = fmaxf(v, __shfl_xor(v, 16)); v = fmaxf(v, __shfl_xor(v, 32)); mx[i] = v; }
    if (q == 0) {
#pragma unroll
        for (int i = 0; i < 4; ++i) atomicMax((unsigned*)(cmx + 4 * c + i), __float_as_uint(mx[i] * CMS_F)); }
}
__device__ __forceinline__ unsigned pack_i8x4(float a, float b, float c, float d) {
    const int ia = (int)rintf(fminf(fmaxf(a, -127.f), 127.f)), ib = (int)rintf(fminf(fmaxf(b, -127.f), 127.f)), ic = (int)rintf(fminf(fmaxf(c, -127.f), 127.f)), id = (int)rintf(fminf(fmaxf(d, -127.f), 127.f));
    return (unsigned)(ia & 0xff) | ((unsigned)(ib & 0xff) << 8) | ((unsigned)(ic & 0xff) << 16) | ((unsigned)(id & 0xff) << 24);
}
__device__ __forceinline__ void cvt_item_i8(const float* src, int ld, int k0, int c0, unsigned char* dst, int Kd, int drow0, const float* cmx  , unsigned char* scr, int lane) {
    const int c = lane & 7, q = lane >> 3;
    const f32x4 cm = *(const f32x4*)(cmx + 4 * c);
    f32x4 inv; inv[0] = cm[0] > 0.f ? 127.f / cm[0] : 0.f; inv[1] = cm[1] > 0.f ? 127.f / cm[1] : 0.f; inv[2] = cm[2] > 0.f ? 127.f / cm[2] : 0.f; inv[3] = cm[3] > 0.f ? 127.f / cm[3] : 0.f;
    f32x4 v[4][4];
#pragma unroll
    for (int g = 0; g < 4; ++g)
#pragma unroll
        for (int j = 0; j < 4; ++j) v[g][j] = __builtin_nontemporal_load((const f32x4*)(src + (size_t)(k0 + 32 * g + 4 * q + j) * ld + c0 + 4 * c));
#pragma unroll
    for (int g = 0; g < 4; ++g)
#pragma unroll
        for (int i = 0; i < 4; ++i) *(unsigned*)(scr + (4 * c + i) * 132 + 32 * g + 4 * q) = pack_i8x4(v[g][0][i] * inv[i], v[g][1][i] * inv[i], v[g][2][i] * inv[i], v[g][3][i] * inv[i]);
    asm volatile("s_waitcnt lgkmcnt(0)" ::: "memory");
#pragma unroll
    for (int r = 0; r < 4; ++r) { const int n = 8 * r + (lane >> 3), ch = lane & 7; const unsigned char* p = scr + n * 132 + ch * 16;
        u32x4 o; o.x = *(const unsigned*)(p); o.y = *(const unsigned*)(p + 4); o.z = *(const unsigned*)(p + 8); o.w = *(const unsigned*)(p + 12);
        *(u32x4*)(dst + (size_t)(drow0 + n) * Kd + k0 + 16 * ch) = o; }
    asm volatile("s_waitcnt lgkmcnt(0)" ::: "memory");
}
constexpr int CI_WI = 16 * 152  , CI_WO = 16 * 64, CI_FD = 44 * 64, CI_FGU = 2 * 16 * 176, CI_MD = 8 * 22 * 64, CI_MGU = 16 * 16 * 88;
constexpr int CS_WI = CMS_KB * 152, CS_FGU = 2 * CMS_KB * 176, CS_MGU = 16 * CMS_KB * 88;
constexpr int CONV_N0 = CS_WI + CI_WO + CI_FD + CS_FGU, CONV_N1 = CI_WI + CI_FGU, CONV_N2 = CS_WI + CI_WO + CI_MD + CS_MGU, CONV_N3 = CI_MGU, CONV_N4 = CI_WI;
constexpr int CMX_WIN = 2 * DFF + 16 * DFE;
template <int GRP>
__device__ __forceinline__ void conv_item(Frame& F, int r) {
    unsigned char* scr = F.glds + F.wave * 8704; unsigned char* ws = F.ws;
    float* cmx = (float*)(ws + WS_CTL + COLMAX_OFF);
    if (GRP == 0 || GRP == 1 || GRP == 2 || GRP == 4) {
        constexpr int l = (GRP == 2 || GRP == 4) ? 1 : 0;
        constexpr bool QUANT = (GRP == 1 || GRP == 4); constexpr int NI = QUANT ? CI_WI : CS_WI;
        if (r < NI) { const int kb = r / 152, nb = r % 152, c0 = (nb < 112) ? nb * 32 : SRC_GATE + 8 + (nb - 112) * 32, drow = nb * 32;
            if (QUANT) cvt_item_i8(inptr(F, IN_WIN) + (size_t)l * D * NIN_SRC, NIN_SRC, kb * 128, c0, ws + WS_WIN + (size_t)l * NIN * D, D, drow, cmx + CMX_WIN + l * NIN + drow, scr, F.lane);
            else colmax_item(inptr(F, IN_WIN) + (size_t)l * D * NIN_SRC, NIN_SRC, kb * 128, c0, cmx + CMX_WIN + l * NIN + drow, F.lane);
            return; }
        r -= NI;
    }
    if (GRP == 0 || GRP == 2) {
        constexpr int l = (GRP == 2) ? 1 : 0;
        if (r < CI_WO) { const int kb = r / 64, nb = r % 64;
            cvt_item8(inptr(F, IN_WOUT) + (size_t)l * D * D, D, kb * 128, nb * 32, ws + WS_WOUT + (size_t)l * D * D, D, nb * 32, scr, F.lane); return; }
        r -= CI_WO;
        if (GRP == 0) {
            if (r < CI_FD) { const int kb = r / 64, nb = r % 64; cvt_item8(inptr(F, IN_FD), D, kb * 128, nb * 32, ws + WS_WD, DFF, nb * 32, scr, F.lane); return; }
            r -= CI_FD;
        } else {
            if (r < CI_MD) { const int e = r / (22 * 64); r %= (22 * 64); const int kb = r / 64, nb = r % 64;
                cvt_item8(inptr(F, IN_MD) + (size_t)e * DFE * D, D, kb * 128, nb * 32, ws + WS_MD + (size_t)e * D * DFE, DFE, nb * 32, scr, F.lane); return; }
            r -= CI_MD;
        }
    }
    if (GRP == 0 || GRP == 1) { constexpr int KBN = (GRP == 1) ? 16 : CMS_KB, I_F = KBN * 176; const int up = r / I_F; r %= I_F; const int kb = r / 176, nb = r % 176, n0 = nb * 32, drow = (n0 >> 7) * 256 + up * 128 + (n0 & 127);
        if (GRP == 1) cvt_item_i8(inptr(F, up ? IN_FU : IN_FG), DFF, kb * 128, n0, ws + WS_WGU, D, drow, cmx + drow, scr, F.lane);
        else colmax_item(inptr(F, up ? IN_FU : IN_FG), DFF, kb * 128, n0, cmx + drow, F.lane); }
    else { constexpr int KBN = (GRP == 3) ? 16 : CMS_KB, I_E = KBN * 88; const int up = r / (8 * I_E); r %= (8 * I_E); const int e = r / I_E; r %= I_E; const int kb = r / 88, nb = r % 88, n0 = nb * 32, drow = (n0 >> 7) * 256 + up * 128 + (n0 & 127);
        if (GRP == 3) cvt_item_i8(inptr(F, up ? IN_MU : IN_MG) + (size_t)e * D * DFE, DFE, kb * 128, n0, ws + WS_MGU + (size_t)e * 2 * DFE * D, D, drow, cmx + 2 * DFF + e * 2 * DFE + drow, scr, F.lane);
        else colmax_item(inptr(F, up ? IN_MU : IN_MG) + (size_t)e * D * DFE, DFE, kb * 128, n0, cmx + 2 * DFF + e * 2 * DFE + drow, F.lane); }
}
template <int GRP>
__device__ __forceinline__ void conv_all(Frame& F, int first = 0) {
    constexpr int N = (GRP == 0) ? CONV_N0 : (GRP == 1) ? CONV_N1 : (GRP == 2) ? CONV_N2 : (GRP == 3) ? CONV_N3 : CONV_N4;
    for (int it = first + F.gw; it < N; it += F.NGW) conv_item<GRP>(F, it);
}
template <int YMODE, int EXTRA, bool NORM_OUT, bool XN8  , bool XIN_BF = false  , bool XOUT_BF = false  >
__device__ __forceinline__ void row_phase(Frame& F, const float* xin, float* xout, const bf16_t* ybuf, const float* gpost, const float* gt  ,
                                          const float* gpre, const float* sc, const float* sh, bf16_t* XN,
                                          const float* wex, int ldw, const float* bi, const float* bfg, float* gates_out,
                                          const uint4* tok_in, uint4* tok_out, int* idx_out, unsigned* cntw, float* rowmax = nullptr) {
    LAS float* we = (LAS float*)F.lds;
    LAS float* vA = (LAS float*)(F.lds + 65536);
    LAS float* vB = (LAS float*)(F.lds + 73728);
    LAS float* vC = (LAS float*)(F.lds + 81920);
    LAS float* route = (LAS float*)(F.lds + 90112);
    LAS int* routei = (LAS int*)route;
    LAS int* cumt = (LAS int*)(F.lds + 90112 + 2048);
    if (EXTRA) {
        for (int k = F.tid; k < D; k += NTHR) { const f32x4 a = *(const f32x4*)(wex + (size_t)k * ldw), b = *(const f32x4*)(wex + (size_t)k * ldw + 4);
            we[0 * D + k] = a[0]; we[1 * D + k] = a[1]; we[2 * D + k] = a[2]; we[3 * D + k] = a[3]; we[4 * D + k] = b[0]; we[5 * D + k] = b[1]; we[6 * D + k] = b[2]; we[7 * D + k] = b[3]; }
    }
    if (YMODE == 2) { if (F.tid == 0) { int cum = 0; for (int e = 0; e < NE; ++e) { cumt[e] = cum; cum += (int)((__hip_atomic_load(cntw + e, __ATOMIC_RELAXED, __HIP_MEMORY_SCOPE_AGENT) + 255u) >> 8); } } }
    for (int blk = blockIdx.x; blk < M / 64; blk += F.G) {
        const int b = (blk * 64) / SEQ;
        __syncthreads();
        { const int col = 4 * F.tid;
            if (YMODE) { const f32x4 g = *(const f32x4*)(gt + (size_t)b * 6 * D + col), p = *(const f32x4*)(gpost + col); *(LAS f32x4*)(vA + col) = g * p; }
            if (NORM_OUT) { const f32x4 g = *(const f32x4*)(gpre + col), s = *(const f32x4*)(sc + (size_t)b * 6 * D + col); *(LAS f32x4*)(vB + col) = g * (1.f + s); *(LAS f32x4*)(vC + col) = *(const f32x4*)(sh + (size_t)b * 6 * D + col); } }
        __syncthreads();
        f32x4 xr[8]; u32x2 xrb[8], yr[8], yr2[8]; float w1n = 0.f, w2n = 0.f;
#define RP_LOAD(rr_) do { const size_t row_ = (size_t)blk * 64 + F.wave * 8 + (((rr_) + blk) & 7);   \
            if (XIN_BF) { _Pragma("unroll") for (int j = 0; j < 8; ++j) xrb[j] = __builtin_nontemporal_load((const u32x2*)((const bf16_t*)xin + row_ * D + 256 * j + 4 * F.lane)); } \
            else { _Pragma("unroll") for (int j = 0; j < 8; ++j) xr[j] = __builtin_nontemporal_load((const f32x4*)(xin + row_ * D + 256 * j + 4 * F.lane)); } \
            if (YMODE == 1) { _Pragma("unroll") for (int j = 0; j < 8; ++j) yr[j] = __builtin_nontemporal_load((const u32x2*)(ybuf + row_ * D + 256 * j + 4 * F.lane)); } \
            if (YMODE == 2) { const uint4 ti = tok_in[row_]; \
                const int e1 = (int)(ti.x >> 16), k1 = (int)(ti.x & 0xffffu), e2 = (int)(ti.y >> 16), k2 = (int)(ti.y & 0xffffu); \
                const size_t r1 = (size_t)cumt[e1] * 256 + k1, r2 = (size_t)cumt[e2] * 256 + k2; w1n = __uint_as_float(ti.z); w2n = __uint_as_float(ti.w); \
                _Pragma("unroll") for (int j = 0; j < 8; ++j) { yr[j] = __builtin_nontemporal_load((const u32x2*)(ybuf + r1 * D + 256 * j + 4 * F.lane)); yr2[j] = __builtin_nontemporal_load((const u32x2*)(ybuf + r2 * D + 256 * j + 4 * F.lane)); } } } while (0)
        RP_LOAD(0);
#pragma unroll 1
        for (int rr = 0; rr < 8; ++rr) {
            const int rl = F.wave * 8 + ((rr + blk) & 7); const size_t row = (size_t)blk * 64 + rl;
            asm volatile("" ::: "memory");
            f32x4 x[8];
#pragma unroll
            for (int j = 0; j < 8; ++j) x[j] = XIN_BF ? (f32x4){bflo(xrb[j].x), bfhi(xrb[j].x), bflo(xrb[j].y), bfhi(xrb[j].y)} : xr[j];
            f32x4 y[8];
            if (YMODE == 1) {
#pragma unroll
                for (int j = 0; j < 8; ++j) y[j] = (f32x4){bflo(yr[j].x), bfhi(yr[j].x), bflo(yr[j].y), bfhi(yr[j].y)};
            }
            if (YMODE == 2) {
#pragma unroll
                for (int j = 0; j < 8; ++j) y[j] = (f32x4){bflo(yr[j].x), bfhi(yr[j].x), bflo(yr[j].y), bfhi(yr[j].y)} * w1n + (f32x4){bflo(yr2[j].x), bfhi(yr2[j].x), bflo(yr2[j].y), bfhi(yr2[j].y)} * w2n;
            }
            if (rr < 7) RP_LOAD(rr + 1);
            if (YMODE) {
                float ss = 0.f;
#pragma unroll
                for (int j = 0; j < 8; ++j) ss += (y[j][0] * y[j][0] + y[j][1] * y[j][1]) + (y[j][2] * y[j][2] + y[j][3] * y[j][3]);
                const float r = 1.f / sqrtf(wave_sum(ss) * (1.f / D) + RMS_EPS);
#pragma unroll
                for (int j = 0; j < 8; ++j) { x[j] += *(const LAS f32x4*)(vA + 256 * j + 4 * F.lane) * (y[j] * r);
                    if (XOUT_BF) { u32x2 w; w.x = cvtpk(x[j][0], x[j][1]); w.y = cvtpk(x[j][2], x[j][3]); *(u32x2*)((bf16_t*)xout + row * D + 256 * j + 4 * F.lane) = w; }
                    else __builtin_nontemporal_store(x[j], (f32x4*)(xout + row * D + 256 * j + 4 * F.lane)); }
            }
            if (NORM_OUT) {
                float ss = 0.f;
#pragma unroll
                for (int j = 0; j < 8; ++j) ss += (x[j][0] * x[j][0] + x[j][1] * x[j][1]) + (x[j][2] * x[j][2] + x[j][3] * x[j][3]);
                const float r = 1.f / sqrtf(wave_sum(ss) * (1.f / D) + RMS_EPS);
#pragma unroll
                for (int j = 0; j < 8; ++j) x[j] = (x[j] * r) * *(const LAS f32x4*)(vB + 256 * j + 4 * F.lane) + *(const LAS f32x4*)(vC + 256 * j + 4 * F.lane);
                if (XN8) {
                    float am = 0.f;
#pragma unroll
                    for (int j = 0; j < 8; ++j) am = fmaxf(fmaxf(am, fmaxf(fabsf(x[j][0]), fabsf(x[j][1]))), fmaxf(fabsf(x[j][2]), fabsf(x[j][3])));
                    am = wave_max(am);
                    const float inv = am > 0.f ? 127.f / am : 0.f;
                    if (F.lane == 0) { rowmax[row] = am; if (EXTRA == 2) route[384 + rl] = am; }
#pragma unroll
                    for (int j = 0; j < 8; ++j) *(unsigned*)((unsigned char*)XN + row * D + 256 * j + 4 * F.lane) = pack_i8x4(x[j][0] * inv, x[j][1] * inv, x[j][2] * inv, x[j][3] * inv);
                } else {
#pragma unroll
                    for (int j = 0; j < 8; ++j) { u32x2 w; w.x = cvtpk(x[j][0], x[j][1]); w.y = cvtpk(x[j][2], x[j][3]); *(u32x2*)(XN + row * D + 256 * j + 4 * F.lane) = w; }
                }
                if (EXTRA) {
                    float d8[8];
#pragma unroll
                    for (int e = 0; e < 8; ++e) { float s = 0.f;
#pragma unroll
                        for (int j = 0; j < 8; ++j) { const f32x4 w = *(const LAS f32x4*)(we + e * D + 256 * j + 4 * F.lane); s += (x[j][0] * w[0] + x[j][1] * w[1]) + (x[j][2] * w[2] + x[j][3] * w[3]); }
                        d8[e] = wave_sum(s); asm volatile("" ::: "memory"); }
                    if (EXTRA == 1) {
                        float v = 0.f;
#pragma unroll
                        for (int e = 0; e < 8; ++e) v = (F.lane == e) ? d8[e] : v;
                        if (F.lane < 8) { const float bb = (F.lane < 4) ? bi[F.lane] : bfg[F.lane - 4]; const float z = 15.f * tanhf((v + bb) * (1.f / 15.f));
                            const float o = (F.lane < 4) ? z : (fminf(z, 0.f) - log1pf(expf(-fabsf(z)))); gates_out[row * 8 + F.lane] = o; }
                    } else {
                        int e1 = 0; float v1 = d8[0];
#pragma unroll
                        for (int e = 1; e < 8; ++e) if (d8[e] > v1) { v1 = d8[e]; e1 = e; }
                        int e2 = -1; float v2 = -3.0e38f;
#pragma unroll
                        for (int e = 0; e < 8; ++e) if (e != e1 && d8[e] > v2) { v2 = d8[e]; e2 = e; }
                        const float w1 = 1.f / (1.f + expf(v2 - v1));
                        if (F.lane == 0) { routei[rl * 4 + 0] = e1; routei[rl * 4 + 1] = e2; route[rl * 4 + 2] = w1; route[rl * 4 + 3] = 1.f - w1; }
                    }
                }
            }
        }
#undef RP_LOAD
        if (EXTRA == 2) {
            __syncthreads();
            if (F.tid < NE) { const int e = F.tid; int c = 0;
                for (int r = 0; r < 64; ++r) c += (routei[r * 4] == e) + (routei[r * 4 + 1] == e);
                int base = (int)__hip_atomic_fetch_add(cntw + e, (unsigned)c, __ATOMIC_RELAXED, __HIP_MEMORY_SCOPE_AGENT);
                float* rms = rowmax + (WS_RMSLOT - WS_ROWMAX) / 4;
                for (int r = 0; r < 64; ++r) { if (routei[r * 4] == e) { idx_out[e * ECAP + base] = blk * 64 + r; rms[e * ECAP + base] = route[384 + r]; routei[256 + r * 2] = base; ++base; }
                                               if (routei[r * 4 + 1] == e) { idx_out[e * ECAP + base] = blk * 64 + r; rms[e * ECAP + base] = route[384 + r]; routei[256 + r * 2 + 1] = base; ++base; } } }
            __syncthreads();
            if (F.tid < 64) { const int r = F.tid; uint4 ti; ti.x = ((unsigned)routei[r * 4] << 16) | (unsigned)routei[256 + r * 2]; ti.y = ((unsigned)routei[r * 4 + 1] << 16) | (unsigned)routei[256 + r * 2 + 1];
                ti.z = __float_as_uint(route[r * 4 + 2]); ti.w = __float_as_uint(route[r * 4 + 3]); tok_out[(size_t)blk * 64 + r] = ti; }
        }
    }
    __syncthreads();
}

namespace att {
constexpr int KROW = 144, VROW = 520, K_OFF = 0, V_OFF = 256 * KROW, KM_OFF = V_OFF + 64 * VROW;
constexpr float C2 = 0.125f * 1.4426950408889634f, NEG = -3.0e38f;
__device__ __forceinline__ void stage_kv(LAS unsigned char* lds, const bf16_t* kcol, const bf16_t* vcol, size_t grow0, int nk, int kc0, int tid) {
    for (int c = tid; c < nk * 8; c += NTHR) { const int key = c >> 3, part = c & 7;
        const u32x4 v = *(const u32x4*)(kcol + (grow0 + key) * NIN + part * 8);
        *(LAS u32x4*)(lds + K_OFF + (kc0 + key) * KROW + part * 16) = v; }
    const int np = nk >> 1;
    for (int it = tid; it < np * 8; it += NTHR) { const int kp = it % np, dp = it / np;
        const u32x4 a = *(const u32x4*)(vcol + (grow0 + 2 * kp) * NIN + dp * 8), b = *(const u32x4*)(vcol + (grow0 + 2 * kp + 1) * NIN + dp * 8);
        LAS unsigned char* dst = lds + V_OFF + (dp * 8) * VROW + (kc0 + 2 * kp) * 2;
        *(LAS unsigned*)(dst + 0 * VROW) = (a.x & 0xffffu) | (b.x << 16); *(LAS unsigned*)(dst + 1 * VROW) = (a.x >> 16) | (b.x & 0xffff0000u);
        *(LAS unsigned*)(dst + 2 * VROW) = (a.y & 0xffffu) | (b.y << 16); *(LAS unsigned*)(dst + 3 * VROW) = (a.y >> 16) | (b.y & 0xffff0000u);
        *(LAS unsigned*)(dst + 4 * VROW) = (a.z & 0xffffu) | (b.z << 16); *(LAS unsigned*)(dst + 5 * VROW) = (a.z >> 16) | (b.z & 0xffff0000u);
        *(LAS unsigned*)(dst + 6 * VROW) = (a.w & 0xffffu) | (b.w << 16); *(LAS unsigned*)(dst + 7 * VROW) = (a.w >> 16) | (b.w & 0xffff0000u); }
}
struct KVRegs { u32x4 k[4], va[2], vb[2]; };
__device__ __forceinline__ void kv_load(KVRegs& R, const bf16_t* kcol, const bf16_t* vcol, size_t grow0, int tid) {
#pragma unroll
    for (int i = 0; i < 4; ++i) { const int c = tid + i * NTHR, key = c >> 3, part = c & 7; R.k[i] = *(const u32x4*)(kcol + (grow0 + key) * NIN + part * 8); }
#pragma unroll
    for (int i = 0; i < 2; ++i) { const int it = tid + i * NTHR, kp = it & 127, dp = it >> 7;
        R.va[i] = *(const u32x4*)(vcol + (grow0 + 2 * kp) * NIN + dp * 8); R.vb[i] = *(const u32x4*)(vcol + (grow0 + 2 * kp + 1) * NIN + dp * 8); }
}
__device__ __forceinline__ void kv_store(LAS unsigned char* lds, const KVRegs& R, int tid) {
#pragma unroll
    for (int i = 0; i < 4; ++i) { const int c = tid + i * NTHR, key = c >> 3, part = c & 7; *(LAS u32x4*)(lds + K_OFF + key * KROW + part * 16) = R.k[i]; }
#pragma unroll
    for (int i = 0; i < 2; ++i) { const int it = tid + i * NTHR, kp = it & 127, dp = it >> 7; const u32x4 a = R.va[i], b = R.vb[i];
        LAS unsigned char* dst = lds + V_OFF + (dp * 8) * VROW + (2 * kp) * 2;
        *(LAS unsigned*)(dst + 0 * VROW) = (a.x & 0xffffu) | (b.x << 16); *(LAS unsigned*)(dst + 1 * VROW) = (a.x >> 16) | (b.x & 0xffff0000u);
        *(LAS unsigned*)(dst + 2 * VROW) = (a.y & 0xffffu) | (b.y << 16); *(LAS unsigned*)(dst + 3 * VROW) = (a.y >> 16) | (b.y & 0xffff0000u);
        *(LAS unsigned*)(dst + 4 * VROW) = (a.z & 0xffffu) | (b.z << 16); *(LAS unsigned*)(dst + 5 * VROW) = (a.z >> 16) | (b.z & 0xffff0000u);
        *(LAS unsigned*)(dst + 6 * VROW) = (a.w & 0xffffu) | (b.w << 16); *(LAS unsigned*)(dst + 7 * VROW) = (a.w >> 16) | (b.w & 0xffff0000u); }
}
struct State { f32x16 o0, o1, negm; float m, l; };
constexpr float THR = 5.f, M0 = -1000.f;
__device__ __forceinline__ void init(State& st) {
#pragma unroll
    for (int r = 0; r < 16; ++r) { st.o0[r] = 0.f; st.o1[r] = 0.f; st.negm[r] = -M0; }
    st.m = M0; st.l = 0.f;
}
__device__ __forceinline__ float xhalf_max(float v) { auto rr = __builtin_amdgcn_permlane32_swap(__float_as_uint(v), __float_as_uint(v), false, false); return fmaxf(__uint_as_float(rr[0]), __uint_as_float(rr[1])); }
__device__ __forceinline__ float xhalf_sum(float v) { auto rr = __builtin_amdgcn_permlane32_swap(__float_as_uint(v), __float_as_uint(v), false, false); return __uint_as_float(rr[0]) + __uint_as_float(rr[1]); }
__device__ __forceinline__ void block_mask(State& st, bool lane_ok) {
#pragma unroll
    for (int r = 0; r < 16; ++r) st.negm[r] = lane_ok ? -st.m : NEG;
}
template <int MODE>
__device__ __forceinline__ void tile(LAS unsigned char* lds, int kt, const bf16x8 (&qf)[4], State& st, int lane) {
    const int r32 = lane & 31, h = lane >> 5;
    f32x16 S;
    if (MODE == 3) S = st.negm;
    else {
#pragma unroll
        for (int r = 0; r < 16; ++r) { const int ko = (r & 3) + 8 * (r >> 2) + 4 * h; const bool ok = (MODE == 1) ? (ko <= r32) : (ko > r32); S[r] = ok ? st.negm[r] : NEG; } }
    const LAS unsigned char* kp = lds + K_OFF + (kt * 32 + r32) * KROW + h * 16;
#pragma unroll
    for (int s = 0; s < 4; ++s) { const bf16x8 a = *(const LAS bf16x8*)(kp + s * 32); S = __builtin_amdgcn_mfma_f32_32x32x16_bf16(a, qf[s], S, 0, 0, 0); }
    float tmax;
    asm volatile("s_nop 15\n\ts_nop 7" : "+v"(S));
    { float m0, m1, m2, m3, m4;
      asm("v_max3_f32 %0, %1, %2, %3" : "=v"(m0) : "v"(S[0]), "v"(S[1]), "v"(S[2]));    asm("v_max3_f32 %0, %1, %2, %3" : "=v"(m1) : "v"(S[3]), "v"(S[4]), "v"(S[5]));
      asm("v_max3_f32 %0, %1, %2, %3" : "=v"(m2) : "v"(S[6]), "v"(S[7]), "v"(S[8]));    asm("v_max3_f32 %0, %1, %2, %3" : "=v"(m3) : "v"(S[9]), "v"(S[10]), "v"(S[11]));
      asm("v_max3_f32 %0, %1, %2, %3" : "=v"(m4) : "v"(S[12]), "v"(S[13]), "v"(S[14])); asm("v_max3_f32 %0, %1, %2, %3" : "=v"(m0) : "v"(m0), "v"(m1), "v"(S[15]));
      asm("v_max3_f32 %0, %1, %2, %3" : "=v"(m2) : "v"(m2), "v"(m3), "v"(m4));          asm("v_max_f32 %0, %1, %2" : "=v"(tmax) : "v"(m0), "v"(m2)); }
    tmax = xhalf_max(tmax);
    if (__any(tmax > THR)) {
        const float d = tmax > THR ? tmax : 0.f, alpha = __builtin_amdgcn_exp2f(-d);
        st.m += d; st.l *= alpha;
#pragma unroll
        for (int r = 0; r < 16; ++r) { S[r] -= d; st.negm[r] -= d; st.o0[r] *= alpha; st.o1[r] *= alpha; }
    }
    float ls0 = 0.f, ls1 = 0.f;
#pragma unroll
    for (int r = 0; r < 16; r += 2) { const float p0 = __builtin_amdgcn_exp2f(S[r]), p1 = __builtin_amdgcn_exp2f(S[r + 1]); S[r] = p0; S[r + 1] = p1; ls0 += p0; ls1 += p1; }
    st.l += ls0 + ls1;
    const LAS unsigned char* vp = lds + V_OFF + r32 * VROW + kt * 64 + h * 8;
#pragma unroll
    for (int s = 0; s < 2; ++s) {
        u32x4 pw; pw.x = cvtpk(S[8 * s + 0], S[8 * s + 1]); pw.y = cvtpk(S[8 * s + 2], S[8 * s + 3]); pw.z = cvtpk(S[8 * s + 4], S[8 * s + 5]); pw.w = cvtpk(S[8 * s + 6], S[8 * s + 7]);
        const bf16x8 pf = __builtin_bit_cast(bf16x8, pw);
        { const u32x2 lo = *(const LAS u32x2*)(vp + s * 32), hi = *(const LAS u32x2*)(vp + s * 32 + 16); u32x4 aw; aw.x = lo.x; aw.y = lo.y; aw.z = hi.x; aw.w = hi.y;
          st.o0 = __builtin_amdgcn_mfma_f32_32x32x16_bf16(__builtin_bit_cast(bf16x8, aw), pf, st.o0, 0, 0, 0); }
        { const u32x2 lo = *(const LAS u32x2*)(vp + 32 * VROW + s * 32), hi = *(const LAS u32x2*)(vp + 32 * VROW + s * 32 + 16); u32x4 aw; aw.x = lo.x; aw.y = lo.y; aw.z = hi.x; aw.w = hi.y;
          st.o1 = __builtin_amdgcn_mfma_f32_32x32x16_bf16(__builtin_bit_cast(bf16x8, aw), pf, st.o1, 0, 0, 0); }
    }
}
constexpr float YSC = 16.f;
__device__ __forceinline__ void store_out(const State& st, float inv, unsigned char* orow  , int lane) {
    const int h = lane >> 5;
#pragma unroll
    for (int g = 0; g < 4; ++g) {
        *(unsigned*)(orow + 8 * g + 4 * h) = pg8::pack_fp8x4(st.o0[4 * g] * inv, st.o0[4 * g + 1] * inv, st.o0[4 * g + 2] * inv, st.o0[4 * g + 3] * inv);
        *(unsigned*)(orow + 32 + 8 * g + 4 * h) = pg8::pack_fp8x4(st.o1[4 * g] * inv, st.o1[4 * g + 1] * inv, st.o1[4 * g + 2] * inv, st.o1[4 * g + 3] * inv); }
}
__device__ __forceinline__ void moba_unit(Frame& F, const bf16_t* proj, const float* kmean, unsigned char* Y, int b, int h, int j) {
    LAS unsigned char* lds = F.lds; const int lane = F.lane, r32 = lane & 31, hh = lane >> 5, w = F.wave;
    const size_t rb = (size_t)b * SEQ; const int t = j * 256 + w * 32 + r32;
    bf16x8 qf[4];
    { const bf16_t* qrow = proj + (rb + t) * NIN + C_MQ + h * 64 + hh * 8;
#pragma unroll
      for (int s = 0; s < 4; ++s) qf[s] = *(const bf16x8*)(qrow + s * 16); }
    LBAR();
    LAS float* km = (LAS float*)(lds + KM_OFF);
    if (F.tid < j * 64) km[F.tid] = kmean[(size_t)(b * 8 + (F.tid >> 6)) * 512 + h * 64 + (F.tid & 63)];
    LBAR();
    unsigned sel;
    if (j <= 3) sel = (1u << j) - 1u;
    else {
        float g[7];
#pragma unroll
        for (int n = 0; n < 7; ++n) { g[n] = NEG;
            if (n < j) { float a = 0.f;
#pragma unroll
                for (int s = 0; s < 4; ++s)
#pragma unroll
                    for (int jj = 0; jj < 8; ++jj) a += bf1((bf16_t)qf[s][jj]) * km[n * 64 + 16 * s + 8 * hh + jj];
                a += __shfl_xor(a, 32); g[n] = a; } }
        sel = 0u;
#pragma unroll
        for (int r = 0; r < 3; ++r) { float best = NEG; int bi = 0;
#pragma unroll
            for (int n = 0; n < 7; ++n) if (n < j && !((sel >> n) & 1u) && g[n] > best) { best = g[n]; bi = n; }
            sel |= 1u << bi; }
    }
    State st; init(st);
    const bf16_t* kcol = proj + C_MK + h * 64; const bf16_t* vcol = proj + C_MV + h * 64;
    KVRegs R; kv_load(R, kcol, vcol, rb, F.tid);
    for (int n = 0; n <= j; ++n) {
        LBAR();
        kv_store(lds, R, F.tid);
        if (n < j) kv_load(R, kcol, vcol, rb + (size_t)(n + 1) * 256, F.tid);
        LBAR();
        if (n < j) { const bool ok = (sel >> n) & 1u;
            if (__any(ok)) { block_mask(st, ok); for (int kt = 0; kt < 8; ++kt) tile<3>(lds, kt, qf, st, lane); } }
        else { block_mask(st, true); for (int kt = 0; kt < w; ++kt) tile<3>(lds, kt, qf, st, lane);
               tile<1>(lds, w, qf, st, lane); }
    }
    const float lt = xhalf_sum(st.l);
    store_out(st, YSC / lt, Y + (rb + t) * D + h * 64, lane);
}
__device__ __forceinline__ void swa_unit(Frame& F, const bf16_t* proj, const float* sinks, unsigned char* Y, int b, int kvh, int qb) {
    LAS unsigned char* lds = F.lds; int lane = F.lane; asm volatile("" : "+v"(lane));
    const int r32 = lane & 31, hh = lane >> 5, w = F.wave, hq = kvh * 8 + w;
    const size_t rb = (size_t)b * SEQ;
    const bf16_t* kcol = proj + C_SK + kvh * 64; const bf16_t* vcol = proj + C_SV + kvh * 64;
    LBAR();
    if (qb > 0) stage_kv(lds, kcol, vcol, rb + (size_t)qb * 128 - 128, 256, 0, F.tid);
    else        stage_kv(lds, kcol, vcol, rb, 128, 128, F.tid);
    LBAR();
    const float sk = sinks[hq] * 1.4426950408889634f;
    for (int sb = 0; sb < 4; ++sb) {
        const int t = qb * 128 + sb * 32 + r32;
        bf16x8 qf[4];
        { const bf16_t* qrow = proj + (rb + t) * NIN + C_SQ + hq * 64 + hh * 8;
#pragma unroll
          for (int s = 0; s < 4; ++s) qf[s] = *(const bf16x8*)(qrow + s * 16); }
        State st; init(st);
        int kt0 = sb; if (qb == 0 && kt0 < 4) kt0 = 4;
        if (kt0 == sb) tile<2>(lds, sb, qf, st, lane);
        for (int kt = (kt0 > sb + 1 ? kt0 : sb + 1); kt < sb + 4; ++kt) tile<3>(lds, kt, qf, st, lane);
        tile<1>(lds, sb + 4, qf, st, lane);
        const float lt = xhalf_sum(st.l) + __builtin_amdgcn_exp2f(sk - st.m);
        store_out(st, YSC / lt, Y + (rb + t) * D + 1024 + hq * 64, lane);
    }
}
}

#include <hip/hip_bf16.h>
#include <cmath>
namespace mob {
using bf16=__hip_bfloat16;
using bf16x8=__attribute__((ext_vector_type(8)))short;
using s16x4=__attribute__((ext_vector_type(4)))short;
using f32x16=__attribute__((ext_vector_type(16)))float;
using u32x4=__attribute__((ext_vector_type(4)))unsigned;
constexpr int SEQ=2048,D=64,DM=4864;
constexpr int NW=8,QBLK=32,QB=QBLK*NW,KVBLK=64,NQB=SEQ/QB;
__device__ __forceinline__ int crow(int r,int hi){return (r&3)+8*(r>>2)+4*hi;}
#define SBAR() __builtin_amdgcn_sched_barrier(0)
__device__ __forceinline__ void cmask(f32x16&p0,f32x16&p1,int jb,int qrel,int hi){
  const float NEG=-INFINITY; int kb=64*jb+4*hi;
  #pragma unroll
  for(int r=0;r<16;++r){int kv=kb+(r&3)+8*(r>>2); if(kv>qrel)p0[r]=NEG; if(kv+32>qrel)p1[r]=NEG;}
}

constexpr int NSLOT=3, SLOTB=8192;
constexpr int LDS_K=0, LDS_V=NSLOT*SLOTB, LDS_WS=2*NSLOT*SLOTB, LDS_OST=LDS_WS+NW*64*4, LDS_BYTES=LDS_OST+NW*4096, LDS_KM=LDS_BYTES  ;
constexpr float NEGB=-3.0e38f, YSC=16.f;
constexpr float C2=0.125f*1.4426950408889634f;
__device__ __forceinline__ void glds16(const void*sbase,unsigned voff,unsigned lds_dst){unsigned keep;
  asm volatile("s_mov_b32 %0, m0\n\ts_mov_b32 m0, %2\n\ts_nop 0\n\tglobal_load_lds_dwordx4 %1, %3\n\ts_mov_b32 m0, %0":"=&s"(keep):"v"(voff),"s"(lds_dst),"s"(sbase):"memory");}
__device__ __forceinline__ float max3f(float a,float b,float c){float r;asm("v_max3_f32 %0, %1, %2, %3":"=v"(r):"v"(a),"v"(b),"v"(c));return r;}
__device__ __forceinline__ float max2f(float a,float b){float r;asm("v_max_f32_e32 %0, %1, %2":"=v"(r):"v"(a),"v"(b));return r;}
__device__ __forceinline__ float fadd_s(float a,float b){float r;asm("v_add_f32_e32 %0, %1, %2":"=v"(r):"v"(a),"v"(b));return r;}
__device__ __forceinline__ float fsub_s(float a,float b){float r;asm("v_sub_f32_e32 %0, %1, %2":"=v"(r):"v"(a),"v"(b));return r;}
typedef float f32x2_t __attribute__((ext_vector_type(2))); typedef __bf16 bf16x2_t __attribute__((ext_vector_type(2)));
__device__ __forceinline__ unsigned cvtpk_s(float lo,float hi){f32x2_t v={lo,hi};bf16x2_t b=__builtin_convertvector(v,bf16x2_t);return __builtin_bit_cast(unsigned,b);}
#define WAIT_BAR(N) asm volatile("s_waitcnt vmcnt(" #N ") lgkmcnt(0)\n\ts_barrier":::"memory")

__device__ __forceinline__ void qkt(f32x16&p0,f32x16&p1,const char*Kslot,const bf16x8*qr,const f32x16&negm,int r32,int hi){
  const char*kb=Kslot+hi*1024+r32*16;
  #pragma unroll
  for(int d0=0;d0<4;++d0){
    const bf16x8 b0=*reinterpret_cast<const bf16x8*>(kb+d0*2048);
    const bf16x8 b1=*reinterpret_cast<const bf16x8*>(kb+d0*2048+512);
    if(d0==0){p0=__builtin_amdgcn_mfma_f32_32x32x16_bf16(b0,qr[0],negm,0,0,0);p1=__builtin_amdgcn_mfma_f32_32x32x16_bf16(b1,qr[0],negm,0,0,0);}
    else{p0=__builtin_amdgcn_mfma_f32_32x32x16_bf16(b0,qr[d0],p0,0,0,0);p1=__builtin_amdgcn_mfma_f32_32x32x16_bf16(b1,qr[d0],p1,0,0,0);}}
}
typedef __attribute__((address_space(3))) const char* lds_cptr;
typedef short v4i16_t __attribute__((ext_vector_type(4)));
__device__ __forceinline__ void kload8(bf16x8*kf,lds_cptr kp){
  kf[0]=*(const __attribute__((address_space(3))) bf16x8*)(kp);      kf[1]=*(const __attribute__((address_space(3))) bf16x8*)(kp+512);
  kf[2]=*(const __attribute__((address_space(3))) bf16x8*)(kp+2048); kf[3]=*(const __attribute__((address_space(3))) bf16x8*)(kp+2560);
  kf[4]=*(const __attribute__((address_space(3))) bf16x8*)(kp+4096); kf[5]=*(const __attribute__((address_space(3))) bf16x8*)(kp+4608);
  kf[6]=*(const __attribute__((address_space(3))) bf16x8*)(kp+6144); kf[7]=*(const __attribute__((address_space(3))) bf16x8*)(kp+6656);
}
__device__ __forceinline__ void kload2(bf16x8*kf,lds_cptr kp,int j){ kf[2*j]=*(const __attribute__((address_space(3))) bf16x8*)(kp+j*2048); kf[2*j+1]=*(const __attribute__((address_space(3))) bf16x8*)(kp+j*2048+512); }
__device__ __forceinline__ s16x4 vtr(lds_cptr p){ return __builtin_bit_cast(s16x4,__builtin_amdgcn_ds_read_tr16_b64_v4i16((__attribute__((address_space(3))) v4i16_t*)p)); }
__device__ __forceinline__ float rowmax(const f32x16&p0,const f32x16&p1){
  float a=max3f(p0[0],p0[1],p1[0]),b=max3f(p0[2],p0[3],p1[1]);a=max3f(a,p1[2],p1[3]);
  #pragma unroll
  for(int r=4;r<16;r+=4){a=max3f(a,p0[r],p0[r+1]);b=max3f(b,p0[r+2],p0[r+3]);a=max3f(a,p1[r],p1[r+1]);b=max3f(b,p1[r+2],p1[r+3]);}
  const float m=max2f(a,b);
  auto rr=__builtin_amdgcn_permlane32_swap(__float_as_uint(m),__float_as_uint(m),false,false);
  return max2f(__uint_as_float(rr[0]),__uint_as_float(rr[1]));
}
__device__ __forceinline__ void pv(f32x16*o,int vb,bf16x8 pa0,bf16x8 pa1,bf16x8 pa2,bf16x8 pa3){
  #pragma unroll
  for(int d0=0;d0<2;++d0){s16x4 lo[4],hi[4];
    #pragma unroll
    for(int ks=0;ks<4;++ks){
      asm volatile("ds_read_b64_tr_b16 %0,%1 offset:%c2":"=&v"(lo[ks]):"v"(vb),"i"(d0*4096+ks*1024):"memory");
      asm volatile("ds_read_b64_tr_b16 %0,%1 offset:%c2":"=&v"(hi[ks]):"v"(vb),"i"(d0*4096+ks*1024+512):"memory");}
    asm volatile("s_waitcnt lgkmcnt(0)":::"memory");SBAR();
    #define PK(k) (bf16x8){lo[k][0],lo[k][1],lo[k][2],lo[k][3],hi[k][0],hi[k][1],hi[k][2],hi[k][3]}
    o[d0]=__builtin_amdgcn_mfma_f32_32x32x16_bf16(pa0,PK(0),o[d0],0,0,0);
    o[d0]=__builtin_amdgcn_mfma_f32_32x32x16_bf16(pa1,PK(1),o[d0],0,0,0);
    o[d0]=__builtin_amdgcn_mfma_f32_32x32x16_bf16(pa2,PK(2),o[d0],0,0,0);
    o[d0]=__builtin_amdgcn_mfma_f32_32x32x16_bf16(pa3,PK(3),o[d0],0,0,0);
    #undef PK
  }
}

#ifndef ATTN_STORE16
#define ATTN_STORE16(p,v) (*(u32x4*)(p)=(v))
#endif
template<int THRL> __device__ __forceinline__ void attn_unit(int b,int h,int qb,const bf16*Q,const bf16*__restrict__ K,const bf16*__restrict__ V,unsigned char*Y,const float*kmean,char*shm){
  const int tid=threadIdx.x,lane=tid&63,r32=lane&31,hi=lane>>5; const int wid=__builtin_amdgcn_readfirstlane(tid>>6);
  const long rowbase=(long)b*SEQ; const int q0=qb*QB;
  const bf16*Qw=Q+(rowbase+q0+wid*QBLK)*DM+h*D;
  const bf16*Kh=K+rowbase*DM+h*D,*Vh=V+rowbase*DM+h*D;
  const unsigned lds0=(unsigned)(uintptr_t)shm;
  float*wsf=(float*)(shm+LDS_WS)+wid*64;
  const unsigned koff=(unsigned)((lane*DM+wid*8)*2);
  const unsigned voff=(unsigned)(((16*(wid&3)+(lane>>2))*DM+(wid>>2)*32+(lane&3)*8)*2);
  const unsigned kdst=lds0+LDS_K+wid*1024, vdst=lds0+LDS_V+wid*1024;
  #define DMA_K(t,slot) glds16(Kh+(long)(t)*KVBLK*DM,koff,(unsigned)__builtin_amdgcn_readfirstlane(kdst+(slot)))
  #define DMA_V(t,slot) glds16(Vh+(long)(t)*KVBLK*DM,voff,(unsigned)__builtin_amdgcn_readfirstlane(vdst+(slot)))
  const char*Kbase=shm+LDS_K; bf16x8 kf[8];
  const lds_cptr shm3=(lds_cptr)shm; const lds_cptr kp0=shm3+LDS_K+hi*1024+r32*16; const lds_cptr vp0=shm3+LDS_V+((lane>>4)&1)*32+(lane&3)*8+(4*hi+((lane&15)>>2))*64;
  const int NT=(q0+QB)/KVBLK;
  DMA_K(0,0);DMA_V(0,0);DMA_K(1,SLOTB);
  bf16x8 qr[4];
  #pragma unroll
  for(int d0=0;d0<4;++d0)qr[d0]=*reinterpret_cast<const bf16x8*>(&Qw[(long)r32*DM+d0*16+hi*8]);
  unsigned sel;
  if(qb<=3) sel=(1u<<qb)-1u;
  else{
    float*km=(float*)(shm+LDS_KM);
    if(tid<qb*64) km[tid]=kmean[(size_t)(b*8+(tid>>6))*512+h*64+(tid&63)];
    asm volatile("s_waitcnt vmcnt(0) lgkmcnt(0)\n\ts_barrier":::"memory");
    float g[7];
    #pragma unroll
    for(int n=0;n<7;++n){ g[n]=NEGB;
      if(n<qb){ float a=0.f;
        #pragma unroll
        for(int s=0;s<4;++s)
          #pragma unroll
          for(int jj=0;jj<8;++jj) a+=__uint_as_float((unsigned)(unsigned short)qr[s][jj]<<16)*km[n*64+16*s+8*hi+jj];
        a+=__shfl_xor(a,32); g[n]=a; } }
    sel=0u;
    #pragma unroll
    for(int r=0;r<3;++r){ float best=NEGB; int bi=0;
      #pragma unroll
      for(int n=0;n<7;++n) if(n<qb&&!((sel>>n)&1u)&&g[n]>best){best=g[n];bi=n;}
      sel|=1u<<bi; }
  }
  #define OKB(n) (((n)>=qb)||(((sel>>(n))&1u)!=0u))
  float mhat=0.f,l_reg=0.f;f32x16 o[2];o[0]=f32x16{};o[1]=f32x16{};f32x16 negm;
  { const bool ok0=OKB(0);
    #pragma unroll
    for(int r=0;r<16;++r)negm[r]=ok0?0.f:NEGB; }
  asm volatile("":"+v"(negm));
  const int qrel=wid*QBLK+r32;
  #define CMASK(P0,P1,t) do{int jb_=(t)-(NT-4); if(jb_>=0)cmask(P0,P1,jb_,qrel,hi);}while(0)
  bool resc=false;
  #define START(P0,P1) do{ const float rm=rowmax(P0,P1); resc=false; \
    { const bool ok0_=OKB(0); const float dl=ok0_?rm:0.f; mhat=fadd_s(mhat,dl); \
      _Pragma("unroll") for(int r=0;r<16;++r){P0[r]=fsub_s(P0[r],dl);P1[r]=fsub_s(P1[r],dl);} \
      _Pragma("unroll") for(int r=0;r<16;++r)negm[r]=ok0_?-mhat:NEGB; asm volatile("":"+v"(negm)); } \
    _Pragma("unroll") for(int r=0;r<16;++r)P0[r]=__builtin_amdgcn_exp2f(P0[r]); }while(0)
  #define RESC() do{ if(resc){ asm volatile("s_waitcnt lgkmcnt(0)":::"memory"); \
      _Pragma("unroll") for(int d_=0;d_<2;++d_) _Pragma("unroll") for(int r=0;r<16;++r)o[d_][r]*=wsf[crow(r,hi)]; } }while(0)
  f32x16 pA0,pA1,pB0,pB1;
  int sl_prev=0,sl_cur=0,sl_next=SLOTB;
  #define ROT() do{sl_prev=sl_cur;sl_cur=sl_next;sl_next=(sl_next==(NSLOT-1)*SLOTB)?0:sl_next+SLOTB;}while(0)
  DMA_K(2,2*SLOTB);
  WAIT_BAR(3);
  qkt(pA0,pA1,Kbase,qr,negm,r32,hi);asm volatile("s_nop 15\n\ts_nop 7":"+v"(pA0),"+v"(pA1));CMASK(pA0,pA1,0);
  START(pA0,pA1);
  _Pragma("unroll") for(int r=0;r<16;++r)pA1[r]=__builtin_amdgcn_exp2f(pA1[r]);
  WAIT_BAR(0);
  DMA_K(3,0);DMA_V(1,SLOTB);
  ROT();
  kload8(kf,kp0+sl_cur);
  WAIT_BAR(2);
  s16x4 vlo[8],vhi[8]; u32x4 pw0,pw1,pw2,pw3;
  #define PKW(P,B) cvtpk_s(P[B],P[B+1])
  #define PAF(k) __builtin_bit_cast(bf16x8,pw##k)
  #define VFR(i) (bf16x8){vlo[i][0],vlo[i][1],vlo[i][2],vlo[i][3],vhi[i][0],vhi[i][1],vhi[i][2],vhi[i][3]}
  #define PIN(x) asm volatile("":"+v"(x))
  #define MX3(a,b,c) __builtin_fmaxf(__builtin_fmaxf((a),(b)),(c))
  #define GAPA(MF,A0,A1,A2,A3,W0,W1,PW) do{ MF; sacc+=A0; sacc+=A1; sacc+=A2; sacc+=A3; PIN(sacc); W0; W1; PIN(PW); SBAR(); }while(0)
  #define EX(v) __builtin_amdgcn_exp2f(v)
  #define GAPB(MF,X,B) do{ MF; X[B]=EX(X[B]); X[B+1]=EX(X[B+1]); X[B+2]=EX(X[B+2]); X[B+3]=EX(X[B+3]); PIN(X); SBAR(); }while(0)
  #define VRD(i) do{ vlo[i]=vtr(vp_+(((i)>>2)*4096+((i)&3)*1024)); vhi[i]=vtr(vp_+(((i)>>2)*4096+((i)&3)*1024+512)); }while(0)
  #define KRD(G,j) do{ if(G){ kload2(kf,kp0+sl_next,j); SBAR(); } }while(0)
  #define STEP(C0,C1,P0,P1,t,GK,GV,GL) do{ SBAR(); \
    const lds_cptr vp_=vp0+sl_prev; \
    VRD(0); SBAR(); float sacc=(P0[0]+P0[1]); \
    GAPA(C0=__builtin_amdgcn_mfma_f32_32x32x16_bf16(kf[0],qr[0],negm,0,0,0), P0[2],P0[3],P0[4],P0[5],     pw0[0]=PKW(P0,0), pw0[1]=PKW(P0,2), pw0); \
    VRD(4); SBAR(); GAPA(C1=__builtin_amdgcn_mfma_f32_32x32x16_bf16(kf[1],qr[0],negm,0,0,0), P0[6],P0[7],P0[8],P0[9],     pw0[2]=PKW(P0,4), pw0[3]=PKW(P0,6), pw0); \
    VRD(1); SBAR(); GAPA(C0=__builtin_amdgcn_mfma_f32_32x32x16_bf16(kf[2],qr[1],C0,0,0,0),   P0[10],P0[11],P0[12],P0[13], pw1[0]=PKW(P0,8), pw1[1]=PKW(P0,10), pw1); \
    VRD(5); SBAR(); GAPA(C1=__builtin_amdgcn_mfma_f32_32x32x16_bf16(kf[3],qr[1],C1,0,0,0),   P0[14],P0[15],P1[0],P1[1],   pw1[2]=PKW(P0,12),pw1[3]=PKW(P0,14), pw1); \
    VRD(2); SBAR(); GAPA(C0=__builtin_amdgcn_mfma_f32_32x32x16_bf16(kf[4],qr[2],C0,0,0,0),   P1[2],P1[3],P1[4],P1[5],     pw2[0]=PKW(P1,0), pw2[1]=PKW(P1,2), pw2); \
    VRD(6); SBAR(); GAPA(C1=__builtin_amdgcn_mfma_f32_32x32x16_bf16(kf[5],qr[2],C1,0,0,0),   P1[6],P1[7],P1[8],P1[9],     pw2[2]=PKW(P1,4), pw2[3]=PKW(P1,6), pw2); \
    VRD(3); SBAR(); GAPA(C0=__builtin_amdgcn_mfma_f32_32x32x16_bf16(kf[6],qr[3],C0,0,0,0),   P1[10],P1[11],P1[12],P1[13], pw3[0]=PKW(P1,8), pw3[1]=PKW(P1,10), pw3); \
    VRD(7); SBAR(); GAPA(C1=__builtin_amdgcn_mfma_f32_32x32x16_bf16(kf[7],qr[3],C1,0,0,0),   P1[14],P1[15],0.f,0.f,       pw3[2]=PKW(P1,12),pw3[3]=PKW(P1,14), pw3); \
    l_reg+=sacc; \
    if(GK){DMA_K((t)+3,sl_cur);} if(GV){DMA_V((t)+1,sl_next);} \
    CMASK(C0,C1,t); \
    { float a=MX3(C0[0],C0[1],C1[0]),b=MX3(C0[2],C0[3],C1[1]); a=MX3(a,C1[2],C1[3]); \
      _Pragma("unroll") for(int r=4;r<16;r+=4){a=MX3(a,C0[r],C0[r+1]);b=MX3(b,C0[r+2],C0[r+3]);a=MX3(a,C1[r],C1[r+1]);b=MX3(b,C1[r+2],C1[r+3]);} \
      float rm=__builtin_fmaxf(a,b); { auto rr=__builtin_amdgcn_permlane32_swap(__float_as_uint(rm),__float_as_uint(rm),false,false); rm=__builtin_fmaxf(__uint_as_float(rr[0]),__uint_as_float(rr[1])); } \
      resc=false; \
      if(__builtin_expect(__any(rm>(float)THRL),0)){ const float dl=__builtin_fmaxf(rm,0.f); mhat+=dl; \
        _Pragma("unroll") for(int r=0;r<16;++r){C0[r]-=dl;C1[r]-=dl;} \
        const float f=__builtin_amdgcn_exp2f(-dl); l_reg*=f; if(hi==0)wsf[r32]=f; resc=true; } \
      if(resc||((((t)+1)&3)==0)){ const bool okn_=OKB(((t)+1)>>2);   \
        _Pragma("unroll") for(int r=0;r<16;++r)negm[r]=okn_?-mhat:NEGB; asm volatile("":"+v"(negm)); } } \
    SBAR(); \
    GAPB(o[0]=__builtin_amdgcn_mfma_f32_32x32x16_bf16(PAF(0),VFR(0),o[0],0,0,0), C0,0); \
    GAPB(o[1]=__builtin_amdgcn_mfma_f32_32x32x16_bf16(PAF(0),VFR(4),o[1],0,0,0), C0,4); \
    KRD(GL,0); GAPB(o[0]=__builtin_amdgcn_mfma_f32_32x32x16_bf16(PAF(1),VFR(1),o[0],0,0,0), C0,8); \
    KRD(GL,1); GAPB(o[1]=__builtin_amdgcn_mfma_f32_32x32x16_bf16(PAF(1),VFR(5),o[1],0,0,0), C0,12); \
    KRD(GL,2); GAPB(o[0]=__builtin_amdgcn_mfma_f32_32x32x16_bf16(PAF(2),VFR(2),o[0],0,0,0), C1,0); \
    KRD(GL,3); GAPB(o[1]=__builtin_amdgcn_mfma_f32_32x32x16_bf16(PAF(2),VFR(6),o[1],0,0,0), C1,4); \
    GAPB(o[0]=__builtin_amdgcn_mfma_f32_32x32x16_bf16(PAF(3),VFR(3),o[0],0,0,0), C1,8); \
    GAPB(o[1]=__builtin_amdgcn_mfma_f32_32x32x16_bf16(PAF(3),VFR(7),o[1],0,0,0), C1,12); \
    }while(0)
  int t=1;
  #undef CMASK
  #define CMASK(P0,P1,t) do{}while(0)
  for(;t+5<NT;t+=2){
    STEP(pB0,pB1,pA0,pA1,t,true,true,true);     WAIT_BAR(2); RESC(); ROT();
    STEP(pA0,pA1,pB0,pB1,t+1,true,true,true);   WAIT_BAR(2); RESC(); ROT();
  }
  #undef CMASK
  const int lane_b=(int)__builtin_amdgcn_mbcnt_hi(~0u,__builtin_amdgcn_mbcnt_lo(~0u,0u)), hi_b=lane_b>>5, qrel_b=wid*QBLK+(lane_b&31);
  #define CMASK(P0,P1,t) do{int jb_=(t)-(NT-4); if(jb_>=0)cmask(P0,P1,jb_,qrel_b,hi_b);}while(0)
  #define ENDW(tt) do{ if((tt)+3<NT){WAIT_BAR(2);} else if((tt)+2<NT){WAIT_BAR(1);} else {WAIT_BAR(0);} }while(0)
  for(;t+1<NT;t+=2){
    STEP(pB0,pB1,pA0,pA1,t,(t+3<NT),(t+1<NT),(t+1<NT));       ENDW(t);   RESC(); ROT();
    STEP(pA0,pA1,pB0,pB1,t+1,(t+4<NT),(t+2<NT),(t+2<NT));     ENDW(t+1); RESC(); ROT();
  }
  STEP(pB0,pB1,pA0,pA1,NT-1,false,false,false); RESC();
  { float sacc=pB0[0]+pB0[1]; _Pragma("unroll") for(int r=2;r<16;++r)sacc+=pB0[r]; _Pragma("unroll") for(int r=0;r<16;++r)sacc+=pB1[r]; l_reg+=sacc;
    pw0=(u32x4){PKW(pB0,0),PKW(pB0,2),PKW(pB0,4),PKW(pB0,6)};pw1=(u32x4){PKW(pB0,8),PKW(pB0,10),PKW(pB0,12),PKW(pB0,14)};pw2=(u32x4){PKW(pB1,0),PKW(pB1,2),PKW(pB1,4),PKW(pB1,6)};pw3=(u32x4){PKW(pB1,8),PKW(pB1,10),PKW(pB1,12),PKW(pB1,14)};
    const int vb0=(int)(lds0+LDS_V)+((lane>>4)&1)*32+(lane&3)*8+(4*hi+((lane&15)>>2))*64;
    SBAR(); pv(o,vb0+sl_cur,PAF(0),PAF(1),PAF(2),PAF(3)); }
  #undef PKW
  #undef PAF
  #undef VFR
  #undef PIN
  #undef MX3
  #undef GAPA
  #undef GAPB
  #undef EX
  #undef VRD
  #undef KRD
  #undef STEP
  #undef ENDW
  {auto rr=__builtin_amdgcn_permlane32_swap(__float_as_uint(l_reg),__float_as_uint(l_reg),false,false);l_reg=__uint_as_float(rr[0])+__uint_as_float(rr[1]);}
  if(hi==0)wsf[32+r32]=l_reg;asm volatile("s_waitcnt lgkmcnt(0)":::"memory");
  float rli[16];
  #pragma unroll
  for(int r=0;r<16;++r)rli[r]=__builtin_amdgcn_rcpf(wsf[32+crow(r,hi)])*YSC;
  unsigned char*Yw=Y+(size_t)(rowbase+q0+wid*QBLK)*2048+h*D;
  { unsigned char*stg=(unsigned char*)(shm+LDS_OST)+wid*4096;
    #pragma unroll
    for(int r=0;r<16;++r){const int orow=crow(r,hi);
      const float a0=__builtin_fminf(__builtin_fmaxf(o[0][r]*rli[r],-448.f),448.f),a1=__builtin_fminf(__builtin_fmaxf(o[1][r]*rli[r],-448.f),448.f);
      const unsigned pk=(unsigned)__builtin_amdgcn_cvt_pk_fp8_f32(a0,a1,0,false);
      stg[orow*64+r32]=(unsigned char)(pk&0xffu); stg[orow*64+32+r32]=(unsigned char)((pk>>8)&0xffu);}
    asm volatile("s_waitcnt lgkmcnt(0)":::"memory");
    #pragma unroll
    for(int i=0;i<2;++i){const int row=i*16+(lane>>2),ch=lane&3; const u32x4 v=*(const u32x4*)(stg+row*64+ch*16); *(u32x4*)(Yw+(size_t)row*2048+ch*16)=v;} }
  asm volatile("s_waitcnt lgkmcnt(0)\n\ts_barrier":::"memory");
  #undef DMA_K
  #undef DMA_V
  #undef CMASK
  #undef START
  #undef RESC
  #undef ROT
  #undef OKB
}
#undef SBAR
#undef WAIT_BAR
#ifdef ATTN_STORE16
#undef ATTN_STORE16
#endif
}

namespace mls {
constexpr int RS = 272, TS = 144;
constexpr float CSC = 8.f, CSC_INV = 0.125f;
struct MW { unsigned char* CC; unsigned char* CP; float* NC; float* NP; float* SC; float* MP; };
__device__ __forceinline__ int cslot(int bh, int c) { return (c + bh) & 31; }
__device__ __forceinline__ float fsilu(float x) { return x * __builtin_amdgcn_rcpf(1.f + __builtin_amdgcn_exp2f(-1.4426950408889634f * x)); }
__device__ __forceinline__ void vt_write(LAS unsigned char* dst, const u32x4 a, const u32x4 bq) {
    *(LAS unsigned*)(dst + 0 * TS) = (a.x & 0xffffu) | (bq.x << 16); *(LAS unsigned*)(dst + 1 * TS) = (a.x >> 16) | (bq.x & 0xffff0000u);
    *(LAS unsigned*)(dst + 2 * TS) = (a.y & 0xffffu) | (bq.y << 16); *(LAS unsigned*)(dst + 3 * TS) = (a.y >> 16) | (bq.y & 0xffff0000u);
    *(LAS unsigned*)(dst + 4 * TS) = (a.z & 0xffffu) | (bq.z << 16); *(LAS unsigned*)(dst + 5 * TS) = (a.z >> 16) | (bq.z & 0xffff0000u);
    *(LAS unsigned*)(dst + 6 * TS) = (a.w & 0xffffu) | (bq.w << 16); *(LAS unsigned*)(dst + 7 * TS) = (a.w >> 16) | (bq.w & 0xffff0000u);
}
constexpr int XKWT = 0, XVT = 18432, XCW = 36864;
__device__ __forceinline__ void x_setup(Frame& F, const float* conv_w, const float* conv_b) {
    __syncthreads();
    for (int i = F.tid; i < 5 * 512; i += NTHR) { const int j = i >> 9, ch = i & 511; ((LAS float*)(F.lds + XCW))[i] = (j < 4) ? conv_w[j * 1024 + 512 + ch] : conv_b[512 + ch]; }
    __syncthreads();
}
struct XL { u32x4 raw[5], vr0, vr1; float li, lf; };
__device__ __forceinline__ void x_load(XL& L, const Frame& F, const bf16_t* proj, const float* gates, int u) {
    const int tid = F.tid, c = u & 31, bh = u >> 5, b = bh >> 2, h = bh & 3; const size_t rb = (size_t)b * SEQ;
    const int cc = tid & 15, rp = tid >> 4, tp = tid & 31, ec = tid >> 5;
#pragma unroll
    for (int i = 0; i < 5; ++i) { const int pos = c * 64 + 2 * rp - 3 + i;
        if (pos >= 0) L.raw[i] = *(const u32x4*)(proj + (rb + pos) * NIN + C_LK + h * 128 + 8 * cc); else L.raw[i] = (u32x4){0u, 0u, 0u, 0u}; }
    L.vr0 = *(const u32x4*)(proj + (rb + c * 64 + 2 * tp) * NIN + C_LV + h * 128 + 8 * ec); L.vr1 = *(const u32x4*)(proj + (rb + c * 64 + 2 * tp + 1) * NIN + C_LV + h * 128 + 8 * ec);
    L.li = gates[(rb + c * 64 + F.lane) * 8 + h]; L.lf = gates[(rb + c * 64 + F.lane) * 8 + 4 + h];
}
__device__ __forceinline__ void x_unit(Frame& F, const bf16_t* proj, const float* gates, const MW& W, int u, XL& cur, XL& nxt, bool has_next, int un) {
    LAS unsigned char* lds = F.lds; const int tid = F.tid, lane = F.lane, r32 = lane & 31, hh = lane >> 5, w = F.wave;
    const int bh = u >> 5, h = bh & 3;
    const int cc = tid & 15, rp = tid >> 4, tp = tid & 31, ec = tid >> 5;
    u32x4 raw[5];
#pragma unroll
    for (int i = 0; i < 5; ++i) raw[i] = cur.raw[i];
    const u32x4 vr0 = cur.vr0, vr1 = cur.vr1; const float li = cur.li, lf = cur.lf;
    const float bcs = scan64<false>(lf), cs = li - bcs, pm = scan64<true>(cs);
    const float blast = lane63(bcs), amax = blast + lane63(pm);
    const float wa = __expf(blast + cs - amax);
    LBAR();
    {   const LAS float* cw = (const LAS float*)(lds + XCW) + h * 128 + 8 * cc;
        u32x4 pk[2];
#pragma unroll
        for (int r = 0; r < 2; ++r) {
            f32x4 oa = *(const LAS f32x4*)(cw + 4 * 512), ob = *(const LAS f32x4*)(cw + 4 * 512 + 4);
#pragma unroll
            for (int j = 0; j < 4; ++j) { const u32x4 uu = raw[r + j]; const f32x4 wa4 = *(const LAS f32x4*)(cw + j * 512), wb4 = *(const LAS f32x4*)(cw + j * 512 + 4);
                oa += wa4 * (f32x4){bflo(uu.x), bfhi(uu.x), bflo(uu.y), bfhi(uu.y)}; ob += wb4 * (f32x4){bflo(uu.z), bfhi(uu.z), bflo(uu.w), bfhi(uu.w)}; }
            const float ws = __shfl(wa, 2 * rp + r) * 0.08838834764831845f;
#pragma unroll
            for (int i = 0; i < 4; ++i) { oa[i] = fsilu(oa[i]) * ws; ob[i] = fsilu(ob[i]) * ws; }
            pk[r].x = cvtpk(oa[0], oa[1]); pk[r].y = cvtpk(oa[2], oa[3]); pk[r].z = cvtpk(ob[0], ob[1]); pk[r].w = cvtpk(ob[2], ob[3]);
        }
#pragma unroll
        for (int i = 0; i < 8; ++i) { const int sh = 16 * (i & 1); const unsigned e0 = (pk[0][i >> 1] >> sh) & 0xffffu, e1 = (pk[1][i >> 1] >> sh) & 0xffffu;
            *(LAS unsigned*)(lds + XKWT + (8 * cc + i) * TS + (2 * rp) * 2) = e0 | (e1 << 16); }
        vt_write(lds + XVT + (8 * ec) * TS + (2 * tp) * 2, vr0, vr1);
    }
    if (has_next) x_load(nxt, F, proj, gates, un);
    LBAR();
#pragma unroll
    for (int i = 0; i < 2; ++i) { const int T = 2 * w + i, dt = T >> 2, e2 = T & 3;
        f32x16 acc;
#pragma unroll
        for (int r = 0; r < 16; ++r) acc[r] = 0.f;
#pragma unroll
        for (int k = 0; k < 4; ++k) { const bf16x8 a = *(const LAS bf16x8*)(lds + XKWT + (32 * dt + r32) * TS + (16 * k + 8 * hh) * 2);
            const bf16x8 bv = *(const LAS bf16x8*)(lds + XVT + (32 * e2 + r32) * TS + (16 * k + 8 * hh) * 2);
            acc = __builtin_amdgcn_mfma_f32_32x32x16_bf16(a, bv, acc, 0, 0, 0); }
        unsigned char* dst = W.CC + (size_t)((u & ~31) + cslot(u >> 5, u & 31)) * 16384 + (size_t)(32 * e2 + r32) * 128 + 32 * dt + 4 * hh;
#pragma unroll
        for (int g = 0; g < 4; ++g) *(unsigned*)(dst + 8 * g) = pg8::pack_fp8x4(acc[4 * g] * CSC, acc[4 * g + 1] * CSC, acc[4 * g + 2] * CSC, acc[4 * g + 3] * CSC); }
    if (tid < 128) { float sN = 0.f;
#pragma unroll
        for (int k = 0; k < 8; ++k) { const u32x4 uu = *(const LAS u32x4*)(lds + XKWT + tid * TS + k * 16);
            sN += (bflo(uu.x) + bfhi(uu.x)) + (bflo(uu.y) + bfhi(uu.y)) + (bflo(uu.z) + bfhi(uu.z)) + (bflo(uu.w) + bfhi(uu.w)); }
        W.NC[(size_t)u * 128 + tid] = sN; }
    if (tid == 0) { W.SC[u * 2] = blast; W.SC[u * 2 + 1] = amax; }
}
constexpr int YK = 4, CONV_Y = YK * 4 * 256;
template <int GRP>
__device__ __forceinline__ void y_phase(Frame& F, const MW& W) {
    for (int base = blockIdx.x * 256; base < 32 * 2048; base += F.G * 256) {
        if (F.tid >= 256) {
            if (base == (int)blockIdx.x * 256 && F.G == 256) {
#pragma unroll 1
                for (int k = 0; k < YK; ++k) conv_item<GRP>(F, (int)blockIdx.x * 4 + (F.wave - 4) + k * 1024);
            }
            continue; }
        const int bh = base >> 11, g = (base & 2047) + F.tid, e = g >> 4, d8 = (g & 15) * 8;
        const float* sc = W.SC + (size_t)bh * 64;
        const size_t off = (size_t)bh * 32 * 16384 + (size_t)e * 128 + d8;
        u32x2 v[32];
#pragma unroll
        for (int c = 0; c < 32; ++c) v[c] = __builtin_nontemporal_load((const u32x2*)(W.CC + off + (size_t)cslot(bh, c) * 16384));
        const bool nsc = (g < 32);
        f32x4 nv[32];
        if (nsc) {
#pragma unroll
            for (int c = 0; c < 32; ++c) nv[c] = *(const f32x4*)(W.NC + ((size_t)bh * 32 + c) * 128 + g * 4); }
        float C[8];
#pragma unroll
        for (int i = 0; i < 8; ++i) C[i] = 0.f;
        float m = 0.f;
#pragma unroll
        for (int c = 0; c < 32; ++c) {
            u32x2 o; o.x = pg8::pack_fp8x4(C[0], C[1], C[2], C[3]); o.y = pg8::pack_fp8x4(C[4], C[5], C[6], C[7]); *(u32x2*)(W.CP + off + (size_t)cslot(bh, c) * 16384) = o;
            const float bl = sc[2 * c], am = sc[2 * c + 1], mn = fmaxf(bl + m, am), dec = __expf(bl + m - mn), inj = __expf(am - mn);
            const auto x0 = __builtin_amdgcn_cvt_pk_f32_fp8((int)v[c].x, false), x1 = __builtin_amdgcn_cvt_pk_f32_fp8((int)v[c].x, true), x2 = __builtin_amdgcn_cvt_pk_f32_fp8((int)v[c].y, false), x3 = __builtin_amdgcn_cvt_pk_f32_fp8((int)v[c].y, true);
            C[0] = C[0] * dec + x0[0] * inj; C[1] = C[1] * dec + x0[1] * inj; C[2] = C[2] * dec + x1[0] * inj; C[3] = C[3] * dec + x1[1] * inj;
            C[4] = C[4] * dec + x2[0] * inj; C[5] = C[5] * dec + x2[1] * inj; C[6] = C[6] * dec + x3[0] * inj; C[7] = C[7] * dec + x3[1] * inj; m = mn; }
        if (nsc) {
            f32x4 N = (f32x4){0.f, 0.f, 0.f, 0.f}; float mm = 0.f;
#pragma unroll
            for (int c = 0; c < 32; ++c) {
                *(f32x4*)(W.NP + ((size_t)bh * 32 + c) * 128 + g * 4) = N; if (g == 0) W.MP[bh * 32 + c] = mm;
                const float bl = sc[2 * c], am = sc[2 * c + 1], mn = fmaxf(bl + mm, am), dec = __expf(bl + mm - mn), inj = __expf(am - mn);
                N = N * dec + nv[c] * inj; mm = mn; }
        }
    }
}
constexpr int QS = 0, QW = 17408, KS = 34816, ZCW = 52224  , VT = 72704, CB = 91136, NS = 125952, CSO = 126464, SSQ = 126720, ZNW = 127744  ;
struct Pre { u32x4 raw[7]; u32x4 vr[2]; float li, lf; };
__device__ __forceinline__ void prefetch(Pre& P, const bf16_t* proj, const float* gates, size_t rb, int c, int h, int tid, int lane) {
    const int cc = tid & 31, rg = tid >> 5;
    const int col = (cc < 16) ? (C_LQ + h * 128 + 8 * cc) : (C_LK + h * 128 + 8 * (cc - 16));
#pragma unroll
    for (int i = 0; i < 7; ++i) { const int pos = c * 64 + 4 * rg - 3 + i;
        if (pos >= 0) P.raw[i] = *(const u32x4*)(proj + (rb + pos) * NIN + col); else P.raw[i] = (u32x4){0u, 0u, 0u, 0u}; }
    const int tp = tid & 31, ec = tid >> 5;
    P.vr[0] = *(const u32x4*)(proj + (rb + c * 64 + 2 * tp) * NIN + C_LV + h * 128 + 8 * ec);
    P.vr[1] = *(const u32x4*)(proj + (rb + c * 64 + 2 * tp + 1) * NIN + C_LV + h * 128 + 8 * ec);
    P.li = gates[(rb + c * 64 + lane) * 8 + h]; P.lf = gates[(rb + c * 64 + lane) * 8 + 4 + h];
}
__device__ __forceinline__ void z_setup(Frame& F, const float* conv_w, const float* conv_b, const float* normw) {
    __syncthreads();
    for (int i = F.tid; i < 5 * 1024; i += NTHR) { const int j = i >> 10, ch = i & 1023; ((LAS float*)(F.lds + ZCW))[i] = (j < 4) ? conv_w[j * 1024 + ch] : conv_b[ch]; }
    ((LAS float*)(F.lds + ZNW))[F.tid] = normw[F.tid];
    __syncthreads();
}
struct ZL { Pre P; u32x4 cpv[2]; float npv, mprev; u32x2 og[4]; };
__device__ __forceinline__ void z_load(ZL& L, const Frame& F, const bf16_t* proj, const float* gates, const MW& W, int u) {
    const int tid = F.tid, lane = F.lane, r32 = lane & 31, hh = lane >> 5, w = F.wave, et = w & 3, tt = w >> 2;
    const int c = u & 31, bh = u >> 5, b = bh >> 2, h = bh & 3; const size_t rb = (size_t)b * SEQ, r0 = rb + (size_t)c * 64; const int trow = 32 * tt + r32;
    prefetch(L.P, proj, gates, rb, c, h, tid, lane);
#pragma unroll
    for (int i = 0; i < 2; ++i) L.cpv[i] = __builtin_nontemporal_load((const u32x4*)(W.CP + (size_t)((u & ~31) + cslot(u >> 5, u & 31)) * 16384 + (size_t)(tid + i * NTHR) * 16));
    L.npv = (tid < 128) ? W.NP[(size_t)u * 128 + tid] : 0.f; L.mprev = W.MP[u];
#pragma unroll
    for (int g = 0; g < 4; ++g) L.og[g] = *(const u32x2*)(proj + (r0 + trow) * NIN + C_LO + h * 128 + 32 * et + 8 * g + 4 * hh);
}
__device__ __forceinline__ void z_unit(Frame& F, const bf16_t* proj, const float* gates, const MW& W, unsigned char* Y, int u, ZL& cur, ZL& nxt, bool has_next, int un) {
    LAS unsigned char* lds = F.lds; const int tid = F.tid, lane = F.lane, r32 = lane & 31, hh = lane >> 5, w = F.wave, et = w & 3, tt = w >> 2;
    const int c = u & 31, bh = u >> 5, b = bh >> 2, h = bh & 3; const size_t rb = (size_t)b * SEQ, r0 = rb + (size_t)c * 64;
    const int trow = 32 * tt + r32;
    const Pre P = cur.P;
    u32x4 cpv[2];
#pragma unroll
    for (int i = 0; i < 2; ++i) cpv[i] = cur.cpv[i];
    const float npv = cur.npv, mprev = cur.mprev;
    u32x2 og[4];
#pragma unroll
    for (int g = 0; g < 4; ++g) og[g] = cur.og[g];
    const float bcs = scan64<false>(P.lf), cs = P.li - bcs, pm = scan64<true>(cs);
    const float il = bcs + mprev, mo = fmaxf(il, bcs + pm), wi = __expf(il - mo);
    const float rt = __shfl(bcs - mo, trow), eo = __shfl(__expf(-mo), trow);
    LBAR();
    if (w == 0) ((LAS float*)(lds + CSO))[lane] = cs;
#pragma unroll
    for (int i = 0; i < 2; ++i) { const int ci = tid + i * NTHR, e = ci >> 3, part = ci & 7;
        unsigned wv[8];
#pragma unroll
        for (int q = 0; q < 4; ++q) { const int uq = (int)cpv[i][q]; const auto lo = __builtin_amdgcn_cvt_pk_f32_fp8(uq, false), hi = __builtin_amdgcn_cvt_pk_f32_fp8(uq, true);
            wv[2 * q] = cvtpk(lo[0] * CSC_INV, lo[1] * CSC_INV); wv[2 * q + 1] = cvtpk(hi[0] * CSC_INV, hi[1] * CSC_INV); }
        u32x4 w0, w1; w0.x = wv[0]; w0.y = wv[1]; w0.z = wv[2]; w0.w = wv[3]; w1.x = wv[4]; w1.y = wv[5]; w1.z = wv[6]; w1.w = wv[7];
        *(LAS u32x4*)(lds + CB + e * RS + part * 32) = w0; *(LAS u32x4*)(lds + CB + e * RS + part * 32 + 16) = w1; }
    if (tid < 128) ((LAS float*)(lds + NS))[tid] = npv;
    {
        const int cc = tid & 31, rg = tid >> 5; const bool isk = cc >= 16; const int dcol = 8 * (cc & 15);
        const LAS float* cw = (const LAS float*)(lds + ZCW) + (isk ? 512 : 0) + h * 128 + dcol;
        const float ksc = isk ? 0.08838834764831845f : 1.f;
#pragma unroll
        for (int r = 0; r < 4; ++r) {
            f32x4 oa = *(const LAS f32x4*)(cw + 4 * 1024), ob = *(const LAS f32x4*)(cw + 4 * 1024 + 4);
#pragma unroll
            for (int j = 0; j < 4; ++j) { const u32x4 uu = P.raw[r + j]; const f32x4 wa4 = *(const LAS f32x4*)(cw + j * 1024), wb4 = *(const LAS f32x4*)(cw + j * 1024 + 4);
                oa += wa4 * (f32x4){bflo(uu.x), bfhi(uu.x), bflo(uu.y), bfhi(uu.y)}; ob += wb4 * (f32x4){bflo(uu.z), bfhi(uu.z), bflo(uu.w), bfhi(uu.w)}; }
#pragma unroll
            for (int i = 0; i < 4; ++i) { oa[i] = fsilu(oa[i]) * ksc; ob[i] = fsilu(ob[i]) * ksc; }
            const int t = 4 * rg + r; const float ws = __shfl(wi, t);
            u32x4 wv; wv.x = cvtpk(oa[0], oa[1]); wv.y = cvtpk(oa[2], oa[3]); wv.z = cvtpk(ob[0], ob[1]); wv.w = cvtpk(ob[2], ob[3]);
            *(LAS u32x4*)(lds + (isk ? KS : QS) + t * RS + dcol * 2) = wv;
            if (!isk) { u32x4 v; v.x = cvtpk(oa[0] * ws, oa[1] * ws); v.y = cvtpk(oa[2] * ws, oa[3] * ws); v.z = cvtpk(ob[0] * ws, ob[1] * ws); v.w = cvtpk(ob[2] * ws, ob[3] * ws);
                *(LAS u32x4*)(lds + QW + t * RS + dcol * 2) = v; }
            asm volatile("" ::: "memory");
        }
        vt_write(lds + VT + (8 * (tid >> 5)) * TS + (2 * (tid & 31)) * 2, P.vr[0], P.vr[1]);
    }
    if (has_next) z_load(nxt, F, proj, gates, W, un);
    LBAR();
    f32x16 acc;
#pragma unroll
    for (int r = 0; r < 16; ++r) acc[r] = 0.f;
    float den = 0.f;
    for (int st = 0; st <= tt; ++st) {
        f32x16 S;
#pragma unroll
        for (int r = 0; r < 16; ++r) S[r] = 0.f;
#pragma unroll
        for (int k = 0; k < 8; ++k) { const bf16x8 a = *(const LAS bf16x8*)(lds + KS + (32 * st + r32) * RS + (16 * k + 8 * hh) * 2); const bf16x8 qk = *(const LAS bf16x8*)(lds + QS + trow * RS + (16 * k + 8 * hh) * 2); S = __builtin_amdgcn_mfma_f32_32x32x16_bf16(a, qk, S, 0, 0, 0); }
        const LAS float* csp = (const LAS float*)(lds + CSO) + 32 * st + 4 * hh;
#pragma unroll
        for (int r = 0; r < 16; ++r) { const int so = (r & 3) + 8 * (r >> 2); const float cv = csp[so];
            const bool ok = (st < tt) || (so + 4 * hh <= r32);
            const float p = ok ? S[r] * __expf(rt + cv) : 0.f; S[r] = p; den += p; }
#pragma unroll
        for (int k2 = 0; k2 < 2; ++k2) {
            u32x4 pw; pw.x = cvtpk(S[8 * k2 + 0], S[8 * k2 + 1]); pw.y = cvtpk(S[8 * k2 + 2], S[8 * k2 + 3]); pw.z = cvtpk(S[8 * k2 + 4], S[8 * k2 + 5]); pw.w = cvtpk(S[8 * k2 + 6], S[8 * k2 + 7]);
            const LAS unsigned char* vp = lds + VT + (32 * et + r32) * TS + (32 * st + 16 * k2 + 4 * hh) * 2;
            const u32x2 lo = *(const LAS u32x2*)vp, hi = *(const LAS u32x2*)(vp + 16); u32x4 aw; aw.x = lo.x; aw.y = lo.y; aw.z = hi.x; aw.w = hi.y;
            acc = __builtin_amdgcn_mfma_f32_32x32x16_bf16(__builtin_bit_cast(bf16x8, aw), __builtin_bit_cast(bf16x8, pw), acc, 0, 0, 0); }
    }
    {
        const LAS float* nsp = (const LAS float*)(lds + NS);
#pragma unroll
        for (int k = 0; k < 8; ++k) {
            const bf16x8 a = *(const LAS bf16x8*)(lds + CB + (32 * et + r32) * RS + (16 * k + 8 * hh) * 2);
            const bf16x8 bq = *(const LAS bf16x8*)(lds + QW + trow * RS + (16 * k + 8 * hh) * 2);
            acc = __builtin_amdgcn_mfma_f32_32x32x16_bf16(a, bq, acc, 0, 0, 0);
            const f32x4 n0 = *(const LAS f32x4*)(nsp + 16 * k + 8 * hh), n1 = *(const LAS f32x4*)(nsp + 16 * k + 8 * hh + 4);
            den += bf1((bf16_t)bq[0]) * n0[0] + bf1((bf16_t)bq[1]) * n0[1] + bf1((bf16_t)bq[2]) * n0[2] + bf1((bf16_t)bq[3]) * n0[3]
                 + bf1((bf16_t)bq[4]) * n1[0] + bf1((bf16_t)bq[5]) * n1[1] + bf1((bf16_t)bq[6]) * n1[2] + bf1((bf16_t)bq[7]) * n1[3]; }
    }
    den += __shfl_xor(den, 32);
    const float hinv = 1.f / fmaxf(fabsf(den), eo);
    float ssq = 0.f;
#pragma unroll
    for (int r = 0; r < 16; ++r) { acc[r] *= hinv; ssq += acc[r] * acc[r]; }
    ssq += __shfl_xor(ssq, 32);
    if (hh == 0) ((LAS float*)(lds + SSQ))[et * 64 + trow] = ssq;
    LBAR();
    {
        const LAS float* sq = (const LAS float*)(lds + SSQ) + trow;
        const float tot = (sq[0] + sq[64]) + (sq[128] + sq[192]);
        const float rn = att::YSC / sqrtf(tot * (1.f / 128.f) + RMS_EPS);
        unsigned char* yrow = Y + (r0 + trow) * D + 512 + h * 128 + 32 * et + 4 * hh;
#pragma unroll
        for (int g = 0; g < 4; ++g) { const f32x4 nwg = *(const LAS f32x4*)(lds + ZNW + (h * 128 + 32 * et + 8 * g + 4 * hh) * 4); const float o0 = bflo(og[g].x), o1 = bfhi(og[g].x), o2 = bflo(og[g].y), o3 = bfhi(og[g].y);
            *(unsigned*)(yrow + 8 * g) = pg8::pack_fp8x4(acc[4 * g] * rn * nwg[0] * sigmoid_f(o0), acc[4 * g + 1] * rn * nwg[1] * sigmoid_f(o1), acc[4 * g + 2] * rn * nwg[2] * sigmoid_f(o2), acc[4 * g + 3] * rn * nwg[3] * sigmoid_f(o3)); }
    }
}
}

__device__ __forceinline__ int wq_pull(Frame& F, unsigned* qctr) {
    volatile LAS int* slot = (volatile LAS int*)(F.lds + LDSCTL_OFF + 256);
    __syncthreads();
    if (F.tid == 0) *slot = (int)__hip_atomic_fetch_add(qctr, 1u, __ATOMIC_RELAXED, __HIP_MEMORY_SCOPE_AGENT);
    __syncthreads();
    return __builtin_amdgcn_readfirstlane(*slot);
}
constexpr int N_PHASES = 18;
constexpr int N_LAUNCHES = MK_N_LAUNCHES;
constexpr int PTAB_OFF = LDSCTL_OFF + 512, MOETAB_OFF = LDSCTL_OFF + 64;
__device__ __forceinline__ const float* inptr(const Frame& F, int i) {
    const LAS unsigned* t = (const LAS unsigned*)(F.lds + PTAB_OFF) + 2 * i;
    const unsigned lo = __builtin_amdgcn_readfirstlane(t[0]), hi = __builtin_amdgcn_readfirstlane(t[1]);
    return (const float*)(((unsigned long long)hi << 32) | lo);
}
#define GRID_BAR() do { if (N_LAUNCHES == 1) xcd_barrier(bar); } while (0)
#define IN(k) (lo <= (k) && (k) < hi)
#define SEAM(k) do { if (IN(k) && IN((k) + 1)) GRID_BAR(); } while (0)
__device__ __forceinline__ void moe_table(Frame& F) {
    LAS int* tab = (LAS int*)(F.lds + MOETAB_OFF);
    __syncthreads();
    if (F.tid == 0) { int cum = 0; for (int e = 0; e < NE; ++e) { const int cn = (int)__hip_atomic_load(F.ctl + CW_CNT + e, __ATOMIC_RELAXED, __HIP_MEMORY_SCOPE_AGENT); tab[e] = cn; tab[8 + e] = cum; cum += (cn + 255) >> 8; } tab[16] = cum; }
    __syncthreads();
}
template <int GRP>
__device__ __forceinline__ void conv_part(Frame& F, int part) {
    constexpr int N = (GRP == 0) ? CONV_N0 : (GRP == 1) ? CONV_N1 : (GRP == 2) ? CONV_N2 : (GRP == 3) ? CONV_N3 : CONV_N4;
    const int niter = (N + F.NGW - 1) / F.NGW, i0 = part * niter / 3, i1 = (part + 1) * niter / 3;
#pragma unroll 1
    for (int i = i0; i < i1; ++i) { const int it = F.gw + i * F.NGW; if (it < N) conv_item<GRP>(F, it); }
}
template <int GRP>
__device__ __forceinline__ void conv_queue(Frame& F, unsigned* qctr) {
    constexpr int N = (GRP == 0) ? CONV_N0 : (GRP == 1) ? CONV_N1 : (GRP == 2) ? CONV_N2 : (GRP == 3) ? CONV_N3 : CONV_N4, BATCH = 32, NBATCH = (N + BATCH - 1) / BATCH;
    volatile LAS int* slot2 = (volatile LAS int*)(F.lds + LDSCTL_OFF + 264);
    int cur = wq_pull(F, qctr), par = 0;
    while (cur < NBATCH) {
        if (F.tid == 0) slot2[par] = (int)__hip_atomic_fetch_add(qctr, 1u, __ATOMIC_RELAXED, __HIP_MEMORY_SCOPE_AGENT);
#pragma unroll 1
        for (int i = F.wave; i < BATCH; i += NWAVES) { const int it = cur * BATCH + i; if (it < N) conv_item<GRP>(F, it); }
        __syncthreads();
        cur = __builtin_amdgcn_readfirstlane(slot2[par]); par ^= 1;
    }
}
constexpr int TAIL_FIRST = 4096, TAIL_N0 = 1456, TAIL_N1 = 2048, SLOT_FIRST0 = TAIL_FIRST + TAIL_N0, SLOT_FIRST1 = TAIL_FIRST + TAIL_N1;
static_assert((CONV_N3 - SLOT_FIRST1) % 2048 == 0 && (M / 256) * (NIN / 256) == 1216, "tail plan");
constexpr int G4_SLACK0 = CONV_N2 - SLOT_FIRST0 - 4 * 2048, G4_TAIL = CONV_N4 - 2048;
static_assert(G4_SLACK0 > 0 && G4_SLACK0 + G4_TAIL <= 2048 && G4_TAIL > 0, "group 4 tail placement");
template <int L>
__device__ __forceinline__ void layer(Frame& F, const XcdBarrier& bar, float* out, const int lo, const int hi) {
    constexpr int pb = 2 + 8 * L;
    unsigned char* ws = F.ws;
    float* mod = (float*)(ws + WS_MOD); float* gates = (float*)(ws + WS_GATES);
    uint4* tok = (uint4*)(ws + WS_TOK); int* idx = (int*)(ws + WS_TOK + 512 * 1024);
    bf16_t* XN = (bf16_t*)(ws + WS_XN); bf16_t* proj = (bf16_t*)(ws + WS_PROJ); unsigned char* ymix = ws + WS_YMIX; bf16_t* act = (bf16_t*)(ws + WS_ACT);
    bf16_t* yb = (bf16_t*)(ws + WS_YB);
    const float* modl = mod + (size_t)L * NB * 6 * D;
    if (IN(pb + 0)) {
        pg8::DenseSched S{(const char*)XN, (const char*)(ws + WS_WIN + (size_t)L * NIN * D), D, M / 256, NIN / 256, F.G, (int)blockIdx.x};
        pg8::EpiInProjI8 E{proj, NIN, (float*)(ws + WS_CTL + KMEAN_OFF + (size_t)L * 131072), (const float*)(ws + WS_ROWMAX), (const float*)(ws + WS_CTL + COLMAX_OFF) + CMX_WIN + L * NIN};
        pg8::gemm_phase<pg8::EpiInProjI8, pg8::DenseSched, true, 2>(F.lds, D, S, E);
        if (F.G == 256 && blockIdx.x >= 192) {
            constexpr int TG = (L == 0) ? 2 : 3, TN = (L == 0) ? TAIL_N0 : TAIL_N1;
            __syncthreads();
            const int wv = ((int)blockIdx.x - 192) * 8 + F.wave;
#pragma unroll 1
            for (int it = wv; it < TN; it += 512) conv_item<TG>(F, TAIL_FIRST + it);
            __syncthreads(); }
    }
    SEAM(pb + 0);
    const mls::MW mw{ws + WS_CC, ws + WS_CP, (float*)(ws + WS_NC), (float*)(ws + WS_NP), (float*)(ws + WS_SC), (float*)(ws + WS_SC + 65536)};
    const float* km = (const float*)(ws + WS_CTL + KMEAN_OFF + (size_t)L * 131072);
    const int cls = (blockIdx.x >> 3) & 3; const bool odd = (cls & 1) != 0;
    if (IN(pb + 1)) {
        mls::x_setup(F, inptr(F, IN_CONVW) + (size_t)L * 4 * 1024, inptr(F, IN_CONVB) + (size_t)L * 1024);
        { int u = blockIdx.x; mls::XL xa; if (u < 1024) mls::x_load(xa, F, proj, gates, u);
          for (; u < 1024; u += F.G) { mls::XL xb; const bool hn = u + F.G < 1024; mls::x_unit(F, proj, gates, mw, u, xa, xb, hn, u + F.G); xa = xb; } }
        __syncthreads();
    }
    SEAM(pb + 1);
    if (IN(pb + 2)) {
        constexpr int GRP = (L == 0) ? 2 : 3;
        mls::y_phase<GRP>(F, mw);
        GRID_BAR();
        if (cls == 0) { conv_all<GRP>(F, (F.G == 256) ? ((L == 0) ? SLOT_FIRST0 : SLOT_FIRST1) : 0); if (L == 0 && F.G == 256) { const int e4 = F.gw - G4_SLACK0; if (e4 >= 0 && e4 < G4_TAIL) conv_item<4>(F, 2048 + e4); } __syncthreads(); }
        if (odd) { for (int p = blockIdx.x; p < 256; p += F.G) { const int bh = p >> 2, jj = p & 3; mob::attn_unit<8>(bh >> 3, bh & 7, 7 - jj, (const mob::bf16*)(proj + C_MQ), (const mob::bf16*)(proj + C_MK), (const mob::bf16*)(proj + C_MV), ymix, km, (char*)F.glds); } }
        __syncthreads();
        if (cls == 1) { conv_all<GRP>(F, (F.G == 256) ? ((L == 0) ? SLOT_FIRST0 : SLOT_FIRST1) : 0); if (L == 0 && F.G == 256) { const int e4 = F.gw - G4_SLACK0; if (e4 >= 0 && e4 < G4_TAIL) conv_item<4>(F, 2048 + e4); } __syncthreads(); }
        mls::z_setup(F, inptr(F, IN_CONVW) + (size_t)L * 4 * 1024, inptr(F, IN_CONVB) + (size_t)L * 1024, inptr(F, IN_MNW) + (size_t)L * 512);
        { int u = blockIdx.x; mls::ZL za; if (u < 1024) mls::z_load(za, F, proj, gates, mw, u);
          for (; u < 1024; u += F.G) { mls::ZL zb; const bool hn = u + F.G < 1024; mls::z_unit(F, proj, gates, mw, ymix, u, za, zb, hn, u + F.G); za = zb; } }
        __syncthreads();
        if (!odd) { for (int p = blockIdx.x; p < 256; p += F.G) { const int bh = p >> 2, jj = p & 3; mob::attn_unit<8>(bh >> 3, bh & 7, 7 - jj, (const mob::bf16*)(proj + C_MQ), (const mob::bf16*)(proj + C_MK), (const mob::bf16*)(proj + C_MV), ymix, km, (char*)F.glds); } }
        __syncthreads();
        if (cls == 2) { conv_all<GRP>(F, (F.G == 256) ? ((L == 0) ? SLOT_FIRST0 : SLOT_FIRST1) : 0); if (L == 0 && F.G == 256) { const int e4 = F.gw - G4_SLACK0; if (e4 >= 0 && e4 < G4_TAIL) conv_item<4>(F, 2048 + e4); } __syncthreads(); }
        for (int p = blockIdx.x; p < 256; p += F.G) { const int bh = p >> 2, jj = p & 3; mob::attn_unit<8>(bh >> 3, bh & 7, jj, (const mob::bf16*)(proj + C_MQ), (const mob::bf16*)(proj + C_MK), (const mob::bf16*)(proj + C_MV), ymix, km, (char*)F.glds); }
        for (int u = blockIdx.x; u < 256; u += F.G) att::swa_unit(F, proj, inptr(F, IN_SINK) + L * 16, ymix, u >> 5, (u >> 4) & 1, u & 15);
        __syncthreads();
        if (cls == 3) { conv_all<GRP>(F, (F.G == 256) ? ((L == 0) ? SLOT_FIRST0 : SLOT_FIRST1) : 0); if (L == 0 && F.G == 256) { const int e4 = F.gw - G4_SLACK0; if (e4 >= 0 && e4 < G4_TAIL) conv_item<4>(F, 2048 + e4); } __syncthreads(); }
    }
    SEAM(pb + 2);
    if (IN(pb + 3)) {
        pg8::DenseSched S{(const char*)ymix, (const char*)(ws + WS_WOUT + (size_t)L * D * D), D, M / 256, D / 256, F.G, (int)blockIdx.x};
        pg8::EpiBf16 E{yb, D, WSC_INV / att::YSC};
        pg8::gemm_phase<pg8::EpiBf16, pg8::DenseSched, true, 1>(F.lds, D, S, E);
    }
    SEAM(pb + 3);
    if (IN(pb + 4)) {
        float* xb = (float*)(ws + WS_XB);
        if constexpr (L == 0) row_phase<1, 0, true, true, false, true>(F, inptr(F, IN_X), xb, yb, inptr(F, IN_GPOSTM) + (size_t)L * D, modl + 2 * D, inptr(F, IN_GPREF) + (size_t)L * D, modl + 4 * D, modl + 3 * D, XN,
                                          nullptr, 0, nullptr, nullptr, nullptr, nullptr, nullptr, nullptr, nullptr, (float*)(ws + WS_ROWMAX));
        else        row_phase<1, 2, true, true, true, true>(F, xb, xb, yb, inptr(F, IN_GPOSTM) + (size_t)L * D, modl + 2 * D, inptr(F, IN_GPREF) + (size_t)L * D, modl + 4 * D, modl + 3 * D, XN,
                                          inptr(F, IN_ROUTER), 8, nullptr, nullptr, nullptr, nullptr, tok, idx, F.ctl + CW_CNT, (float*)(ws + WS_ROWMAX));
    }
    SEAM(pb + 4);
    if constexpr (L == 0) {
        if (IN(pb + 5)) {
            pg8::DenseSched S{(const char*)XN, (const char*)(ws + WS_WGU), D, M / 256, 2 * DFF / 256, F.G, (int)blockIdx.x};
            pg8::EpiSwiGLUI8 E{(unsigned char*)act, DFF, (const float*)(ws + WS_ROWMAX), (const float*)(ws + WS_CTL + COLMAX_OFF), nullptr, nullptr};
            pg8::gemm_phase<pg8::EpiSwiGLUI8, pg8::DenseSched, true, 2>(F.lds, D, S, E);
        }
        SEAM(pb + 5);
        if (IN(pb + 6)) {
            pg8::DenseSched S{(const char*)act, (const char*)(ws + WS_WD), DFF, M / 256, D / 256, F.G, (int)blockIdx.x};
            pg8::EpiBf16 E{yb, D, WSC_INV};
            pg8::gemm_phase<pg8::EpiBf16, pg8::DenseSched, true, 1>(F.lds, DFF, S, E);
        }
        SEAM(pb + 6);
        if (IN(pb + 7)) { float* xb = (float*)(ws + WS_XB); row_phase<1, 1, true, true, true, true>(F, xb, xb, yb, inptr(F, IN_GPOSTF), modl + 5 * D, inptr(F, IN_GPREM) + D, mod + (size_t)NB * 6 * D + 1 * D, mod + (size_t)NB * 6 * D + 0 * D, XN,
                                              inptr(F, IN_WIN) + (size_t)D * NIN_SRC + SRC_GATE, NIN_SRC, inptr(F, IN_IGB) + 4, inptr(F, IN_FGB) + 4, gates, nullptr, nullptr, nullptr, nullptr, (float*)(ws + WS_ROWMAX));
            for (int it = F.gw; it < ((F.G == 256) ? 2048 : CONV_N4); it += F.NGW) conv_item<4>(F, it); }
        SEAM(pb + 7);
    } else {
        if (IN(pb + 5)) {
            moe_table(F);
            const LAS int* tab = (const LAS int*)(F.lds + MOETAB_OFF);
            pg8::MoeSched<true> S; S.A = (const char*)XN; S.W = (const char*)(ws + WS_MGU); S.idx = idx; S.tab = tab; S.KB = D; S.nN = 2 * DFE / 256; S.G = F.G; S.c = (int)blockIdx.x; S.wrows = 2 * DFE; S.ntile = tab[16];
            pg8::EpiSwiGLUI8 E{(unsigned char*)act, DFE, (const float*)(ws + WS_RMSLOT), (const float*)(ws + WS_CTL + COLMAX_OFF) + 2 * DFF, idx, tab};
            pg8::gemm_phase<pg8::EpiSwiGLUI8, pg8::MoeSched<true>, true, 2>(F.lds, D, S, E);
        }
        SEAM(pb + 5);
        if (IN(pb + 6)) {
            moe_table(F);
            const LAS int* tab = (const LAS int*)(F.lds + MOETAB_OFF);
            pg8::MoeSched<false> S; S.A = (const char*)act; S.W = (const char*)(ws + WS_MD); S.idx = idx; S.tab = tab; S.KB = DFE; S.nN = D / 256; S.G = F.G; S.c = (int)blockIdx.x; S.wrows = D; S.ntile = tab[16];
            pg8::EpiBf16 E{yb, D, WSC_INV};
            pg8::gemm_phase<pg8::EpiBf16, pg8::MoeSched<false>, true, 1>(F.lds, DFE, S, E);
        }
        SEAM(pb + 6);
        if (IN(pb + 7)) row_phase<2, 0, false, false, true, false>(F, (const float*)(ws + WS_XB), out, yb, inptr(F, IN_GPOSTF) + D, modl + 5 * D, nullptr, nullptr, nullptr, nullptr,
                                               nullptr, 0, nullptr, nullptr, nullptr, tok, nullptr, nullptr, F.ctl + CW_CNT);
    }
}
__global__ void __launch_bounds__(NTHR, 2) fwd(Args args) {
    extern __shared__ __attribute__((aligned(16))) unsigned char lds[];
    Frame F;
    F.lds = (LAS unsigned char*)lds; F.glds = lds; F.ws = args.ws; F.ctl = (unsigned*)(args.ws + WS_CTL);
    F.tid = threadIdx.x; F.lane = F.tid & 63; F.wave = __builtin_amdgcn_readfirstlane(F.tid >> 6);
    F.G = gridDim.x; F.gw = blockIdx.x * NWAVES + F.wave; F.NGW = F.G * NWAVES;
    volatile LAS unsigned* MISC = (volatile LAS unsigned*)(F.lds + MISC_OFF);
    for (int u = F.tid; u < (LDS_BYTES - LDSCTL_OFF) / 4; u += NTHR) ((LAS unsigned*)(F.lds + LDSCTL_OFF))[u] = 0u;
    __syncthreads();
    if (F.tid < N_INPUTS) { const unsigned long long p = (unsigned long long)args.in[F.tid]; LAS unsigned* t = (LAS unsigned*)(F.lds + PTAB_OFF) + 2 * F.tid; t[0] = (unsigned)p; t[1] = (unsigned)(p >> 32); }
    __syncthreads();
    XcdBarrier bar; bar.bar = F.ctl + CW_BAR; bar.x = 0; bar.st = nullptr;
    if (N_LAUNCHES == 1) bar = xcd_barrier_post(F.ctl + CW_BAR, MISC + 8);
    const int lo = args.ph_lo, hi = args.ph_hi;
    float* out = args.out;
    if (IN(0)) { p0_ada(F, inptr(F, IN_C), inptr(F, IN_ADAW), inptr(F, IN_ADAB), (float*)(F.ws + WS_MOD)); __syncthreads(); conv_all<0>(F); }
    SEAM(0);
    if (IN(1)) { float* mod = (float*)(F.ws + WS_MOD); const float* x = inptr(F, IN_X);
        row_phase<0, 1, true, true>(F, x, (float*)x  , nullptr, nullptr, nullptr, inptr(F, IN_GPREM), mod + 1 * D, mod + 0 * D, (bf16_t*)(F.ws + WS_XN),
                              inptr(F, IN_WIN) + SRC_GATE, NIN_SRC, inptr(F, IN_IGB), inptr(F, IN_FGB), (float*)(F.ws + WS_GATES), nullptr, nullptr, nullptr, nullptr, (float*)(F.ws + WS_ROWMAX));
        conv_all<1>(F); }
    SEAM(1);
    layer<0>(F, bar, out, lo, hi);
    layer<1>(F, bar, out, lo, hi);
}
#undef IN
#undef SEAM
#undef GRID_BAR

extern "C" void kernel_launch(void* const* d_in, const int* in_sizes, int n_in, void* d_out, int out_size, void* d_ws, size_t ws_size, hipStream_t stream) {
    static int grid = 0;
    if (grid == 0) {
        if (n_in != N_INPUTS || in_sizes[0] != M * D || out_size != M * D || ws_size < WS_END) { fprintf(stderr, "kernel_launch: unexpected problem (n_in %d, in0 %d, out %d, ws %zu); nothing launched\n", n_in, n_in > 0 ? in_sizes[0] : -1, out_size, ws_size); grid = -1; return; }
        int dev = 0, cus = 0, per_cu = 0;
        if (hipGetDevice(&dev) != hipSuccess || hipDeviceGetAttribute(&cus, hipDeviceAttributeMultiprocessorCount, dev) != hipSuccess) { grid = -1; return; }
        if (hipFuncSetAttribute((const void*)fwd, hipFuncAttributeMaxDynamicSharedMemorySize, LDS_BYTES) != hipSuccess) { fprintf(stderr, "kernel_launch: hipFuncSetAttribute failed\n"); grid = -1; return; }
        if (hipOccupancyMaxActiveBlocksPerMultiprocessor(&per_cu, (const void*)fwd, NTHR, LDS_BYTES) != hipSuccess || per_cu < 1) fprintf(stderr, "kernel_launch: occupancy query reports %d\n", per_cu);
        (void)hipGetLastError();
        grid = cus;
    }
    if (grid < 0) return;
    if (hipMemsetAsync((char*)d_ws + WS_CTL, 0, CTL_ZERO_BYTES, stream) != hipSuccess) return;
    Args a{};
    for (int i = 0; i < N_INPUTS; ++i) a.in[i] = (const float*)d_in[i];
    a.out = (float*)d_out; a.ws = (unsigned char*)d_ws;
    if (N_LAUNCHES == 1) { a.ph_lo = 0; a.ph_hi = N_PHASES; hipLaunchKernelGGL(fwd, dim3(grid), dim3(NTHR), LDS_BYTES, stream, a); }
    else for (int p = 0; p < N_PHASES; ++p) { a.ph_lo = p; a.ph_hi = p + 1; hipLaunchKernelGGL(fwd, dim3(grid), dim3(NTHR), LDS_BYTES, stream, a); }
}
```

```cpp
#include <hip/hip_runtime.h>
#include <cstdio>
#include <cstdint>

#ifndef MK_N_LAUNCHES
#define MK_N_LAUNCHES 1
#endif

#define LAS __attribute__((address_space(3)))
#define GAS __attribute__((address_space(1)))
typedef unsigned short bf16_t;
typedef short bf16x8 __attribute__((ext_vector_type(8)));
typedef float f32x4 __attribute__((ext_vector_type(4)));
typedef float f32x2 __attribute__((ext_vector_type(2)));
typedef float f32x16 __attribute__((ext_vector_type(16)));
typedef unsigned u32x4 __attribute__((ext_vector_type(4)));
typedef unsigned u32x2 __attribute__((ext_vector_type(2)));
typedef __bf16 bf16x2_t __attribute__((ext_vector_type(2)));

constexpr int NB = 8, SEQ = 2048, D = 2048, M = NB * SEQ;
constexpr int NIN_SRC = 4872, NIN = 4864;
constexpr int C_MQ = 0, C_MK = 512, C_MV = 1024, C_LQ = 1536, C_LK = 2048, C_LV = 2560, C_LO = 3072, C_SQ = 3584, C_SK = 4608, C_SV = 4736;
constexpr int SRC_GATE = 3584;
constexpr int DFF = 5632, DFE = 2816, NE = 8, ECAP = M;
constexpr float RMS_EPS = 1e-6f;
constexpr int NWAVES = 8, NTHR = 512;

constexpr size_t MiB = 1u << 20;
constexpr size_t WS_CTL = 0, CTL_ZERO_BYTES = 1 * MiB;
constexpr size_t WS_MOD = 1 * MiB;
constexpr size_t WS_GATES = 2 * MiB;
constexpr size_t WS_ROWMAX = 4 * MiB;
constexpr size_t WS_RMSLOT = 4 * MiB + 131072;
constexpr size_t WS_TOK = 3 * MiB;
constexpr size_t WS_WIN = 8 * MiB;
constexpr size_t WS_WOUT = 48 * MiB;
constexpr size_t WS_WGU = 64 * MiB;
constexpr size_t WS_WD = 108 * MiB;
constexpr size_t WS_MGU = 130 * MiB;
constexpr size_t WS_MD = 306 * MiB;
constexpr size_t WS_XN = 394 * MiB;
constexpr size_t WS_PROJ = 458 * MiB;
constexpr size_t WS_YMIX = 610 * MiB;
constexpr size_t WS_ACT = 458 * MiB;
constexpr size_t WS_YB = 674 * MiB;
constexpr size_t WS_XB = 810 * MiB;
constexpr size_t WS_CC = 874 * MiB;
constexpr size_t WS_CP = 906 * MiB;
constexpr size_t WS_NC = 938 * MiB, WS_NP = 939 * MiB, WS_SC = 940 * MiB;
constexpr size_t WS_END = 941 * MiB;
constexpr int CW_TMO = 0, CW_CODE = 1;
constexpr int CW_CNT = 64;
constexpr int CW_WQ = 128;
constexpr int CW_BAR = 4096;
constexpr size_t KMEAN_OFF = 262144;


__device__ __forceinline__ unsigned cvtpk(float lo, float hi) { f32x2 v = {lo, hi}; bf16x2_t b = __builtin_convertvector(v, bf16x2_t); return __builtin_bit_cast(unsigned, b); }
__device__ __forceinline__ float bflo(unsigned u) { return __uint_as_float(u << 16); }
__device__ __forceinline__ float bfhi(unsigned u) { return __uint_as_float(u & 0xffff0000u); }
__device__ __forceinline__ float bf1(bf16_t u) { return __uint_as_float(((unsigned)u) << 16); }
template <bool MAX>
__device__ __forceinline__ float scan64(float v) {
    constexpr int ident = MAX ? (int)0xff800000 : 0;
#define SCAN_STEP(ctrl, rm) { const float tf = __int_as_float(__builtin_amdgcn_update_dpp(ident, __float_as_int(v), ctrl, rm, 0xf, false)); v = MAX ? fmaxf(v, tf) : v + tf; }
    SCAN_STEP(0x111, 0xf) SCAN_STEP(0x112, 0xf) SCAN_STEP(0x114, 0xf) SCAN_STEP(0x118, 0xf) SCAN_STEP(0x142, 0xa) SCAN_STEP(0x143, 0xc)
#undef SCAN_STEP
    return v;
}
__device__ __forceinline__ float lane63(float v) { return __int_as_float(__builtin_amdgcn_readlane(__float_as_int(v), 63)); }
__device__ __forceinline__ float wave_sum(float v) { return lane63(scan64<false>(v)); }
__device__ __forceinline__ float wave_max(float v) { return lane63(scan64<true>(v)); }
#define LBAR() do { asm volatile("s_waitcnt lgkmcnt(0)" ::: "memory"); __builtin_amdgcn_s_barrier(); asm volatile("" ::: "memory"); } while (0)
__device__ __forceinline__ float silu_f(float x) { return x / (1.f + __expf(-x)); }
__device__ __forceinline__ float sigmoid_f(float x) { return 1.f / (1.f + __expf(-x)); }

namespace pg8 {
constexpr int BM = 256, BK = 64, HALF = 128, HTB = HALF * BK * 2, STAGE_BYTES = 8 * HTB, NXCD = 8, WGM = 8;
__host__ __device__ __forceinline__ int lds_byte(int r, int c) { const int st = (r >> 4) * 2 + (c >> 5), rr = r & 15, cc = c & 31, ob = rr * 64 + cc * 2; return st * 1024 + (ob ^ (((ob >> 9) & 1) << 5)); }
__host__ __device__ __forceinline__ void stage_rc(int b, int& R, int& C) { const int st = b / 1024, sb = b % 1024, swz = sb ^ (((sb >> 9) & 1) << 5); R = (st >> 1) * 16 + swz / 64; C = (st & 1) * 32 + (swz % 64) / 2; }
__host__ __device__ __forceinline__ int perm32(int rho) { const int n = rho >> 4, i = rho & 15; return 8 * (i >> 2) + 4 * n + (i & 3); }

struct Unit { int pm, pn, e; };
__device__ __forceinline__ unsigned pack_fp8x4(float a, float b, float c, float d) {
    a = fminf(fmaxf(a, -448.f), 448.f); b = fminf(fmaxf(b, -448.f), 448.f); c = fminf(fmaxf(c, -448.f), 448.f); d = fminf(fmaxf(d, -448.f), 448.f);
    int p = __builtin_amdgcn_cvt_pk_fp8_f32(a, b, 0, false); p = __builtin_amdgcn_cvt_pk_fp8_f32(c, d, p, true); return (unsigned)p;
}


__device__ __forceinline__ bool static_next(int i, int G, int c, int nM, int nN, int& pm, int& pn) {
    const int nwg = nM * nN; const long L = (long)i * G + c; if (L >= nwg) return false;
    int wgid = (int)L; { const int q = nwg / NXCD, r = nwg % NXCD, xcd = wgid % NXCD, off = wgid / NXCD; wgid = (xcd < r ? xcd * (q + 1) : r * (q + 1) + (xcd - r) * q) + off; }
    const int nig = WGM * nN, gid = wgid / nig, fm = gid * WGM, gsz = (nM - fm) < WGM ? (nM - fm) : WGM;
    pm = fm + ((wgid % nig) % gsz); pn = (wgid % nig) / gsz; return true;
}

struct DenseSched {
    static constexpr bool GATHER = false;
    const char* A; const char* Bt; int KB  , nM, nN, G, c;
    __device__ __forceinline__ bool next(int i, Unit& u) const { u.e = 0; return static_next(i, G, c, nM, nN, u.pm, u.pn); }
    __device__ __forceinline__ const char* a_base() const { return A; }
    __device__ __forceinline__ void a_offsets(const Unit& u, const int (&Rr)[2], const int (&Cc)[2], unsigned (&off)[2][2]) const {
#pragma unroll
        for (int h = 0; h < 2; ++h)
#pragma unroll
            for (int i = 0; i < 2; ++i) off[h][i] = (unsigned)((u.pm * BM + h * HALF + Rr[i]) * KB + Cc[i] * 2);
    }
    __device__ __forceinline__ const char* b_base(const Unit& u) const { return Bt + (size_t)u.pn * BM * KB; }
};
template <bool GATHER_>
struct MoeSched {
    static constexpr bool GATHER = GATHER_;
    const char* A; const char* W; const int* idx; const LAS int* tab  ; int KB, nN, G, c, wrows  , ntile;
    __device__ __forceinline__ bool next(int i, Unit& u) const { if (!static_next(i, G, c, ntile, nN, u.pm, u.pn)) return false; int e = 0;
#pragma unroll
        for (int j = 1; j < NE; ++j) e += (u.pm >= tab[8 + j]) ? 1 : 0;
        u.e = e; return true; }
    __device__ __forceinline__ const char* a_base() const { return A; }
    __device__ __forceinline__ void a_offsets(const Unit& u, const int (&Rr)[2], const int (&Cc)[2], unsigned (&off)[2][2]) const {
        const int cume = tab[8 + u.e], cnte = tab[u.e];
#pragma unroll
        for (int h = 0; h < 2; ++h)
#pragma unroll
            for (int i = 0; i < 2; ++i) {
                if (GATHER_) { const int rl = (u.pm - cume) * BM + h * HALF + Rr[i]; const int tok = (rl < cnte) ? idx[u.e * ECAP + rl] : 0; off[h][i] = (unsigned)(tok * KB + Cc[i] * 2); }
                else off[h][i] = (unsigned)((u.pm * BM + h * HALF + Rr[i]) * KB + Cc[i] * 2);
            }
    }
    __device__ __forceinline__ const char* b_base(const Unit& u) const { return W + ((size_t)u.e * wrows + (size_t)u.pn * BM) * KB; }
};

struct EpiBf16 {
    static constexpr bool PERM = true;
    bf16_t* O; int ldc; float sc;
    __device__ __forceinline__ void operator()(const f32x4 (&acc)[2][2][4][2], const Unit& u, int wr, int wc, int fr, int fq) const {
        const int row0 = u.pm * BM + wr * 64 + fr, col0 = u.pn * BM + wc * 32 + 8 * fq;
#pragma unroll
        for (int ai = 0; ai < 2; ++ai)
#pragma unroll
            for (int m = 0; m < 4; ++m) { bf16_t* rowp = O + (size_t)(row0 + ai * HALF + m * 16) * ldc + col0;
#pragma unroll
                for (int bj = 0; bj < 2; ++bj) { const f32x4 v0 = acc[ai][bj][m][0] * sc, v1 = acc[ai][bj][m][1] * sc;
                    u32x4 w; w.x = cvtpk(v0[0], v0[1]); w.y = cvtpk(v0[2], v0[3]); w.z = cvtpk(v1[0], v1[1]); w.w = cvtpk(v1[2], v1[3]);
                    *(u32x4*)(rowp + bj * HALF) = w; } }
    }
};
struct EpiInProjI8 {
    static constexpr bool PERM = true;
    bf16_t* O; int ldc; float* kmean; const float* rowmax; const float* colmax;
    __device__ __forceinline__ void operator()(const f32x4 (&acc)[2][2][4][2], const Unit& u, int wr, int wc, int fr, int fq) const {
        typedef int i32x4_ __attribute__((ext_vector_type(4)));
        const int row0 = u.pm * BM + wr * 64 + fr, col0 = u.pn * BM + wc * 32 + 8 * fq;
        const float qsc = (u.pn < 2 || (u.pn >= 14 && u.pn < 18)) ? 0.125f * 1.4426950408889634f : 1.f;
        f32x4 cmv[2][2], cs[2][2];
#pragma unroll
        for (int bj = 0; bj < 2; ++bj)
#pragma unroll
            for (int n = 0; n < 2; ++n) { cmv[bj][n] = *(const f32x4*)(colmax + col0 + bj * HALF + 4 * n) * (qsc / (127.f * 127.f)); cs[bj][n] = (f32x4){0.f, 0.f, 0.f, 0.f}; }
#pragma unroll
        for (int ai = 0; ai < 2; ++ai)
#pragma unroll
            for (int m = 0; m < 4; ++m) { const int r = row0 + ai * HALF + m * 16; bf16_t* rowp = O + (size_t)r * ldc + col0; const float sa = rowmax[r];
#pragma unroll
                for (int bj = 0; bj < 2; ++bj) { f32x4 v[2];
#pragma unroll
                    for (int n = 0; n < 2; ++n) { const i32x4_ iv = __builtin_bit_cast(i32x4_, acc[ai][bj][m][n]);
                        v[n] = (f32x4){(float)iv[0], (float)iv[1], (float)iv[2], (float)iv[3]} * (cmv[bj][n] * sa); cs[bj][n] += v[n]; }
                    u32x4 w; w.x = cvtpk(v[0][0], v[0][1]); w.y = cvtpk(v[0][2], v[0][3]); w.z = cvtpk(v[1][0], v[1][1]); w.w = cvtpk(v[1][2], v[1][3]);
                    *(u32x4*)(rowp + bj * HALF) = w; } }
        if (u.pn == 2 || u.pn == 3) {
#pragma unroll
            for (int bj = 0; bj < 2; ++bj)
#pragma unroll
                for (int n = 0; n < 2; ++n) {
#pragma unroll
                    for (int j = 0; j < 4; ++j) { float v = cs[bj][n][j]; v += __shfl_xor(v, 1); v += __shfl_xor(v, 2); v += __shfl_xor(v, 4); v += __shfl_xor(v, 8); cs[bj][n][j] = v; }
                    if (fr == 0) { float* kp = kmean + (size_t)u.pm * 512 + (u.pn - 2) * BM + bj * HALF + wc * 32 + 8 * fq + 4 * n;
#pragma unroll
                        for (int j = 0; j < 4; ++j) atomicAdd(kp + j, cs[bj][n][j] * (1.f / 256.f)); } }
        }
    }
};
typedef int i32x8 __attribute__((ext_vector_type(8)));
typedef int i32x4 __attribute__((ext_vector_type(4)));
struct EpiSwiGLUI8 {
    static constexpr bool PERM = true;
    unsigned char* O; int ldc; const float* rowmax; const float* colmax  ; const int* rowidx  ; const LAS int* tab;
    __device__ __forceinline__ void operator()(const f32x4 (&acc)[2][2][4][2], const Unit& u, int wr, int wc, int fr, int fq) const {
        const int row0 = u.pm * BM + wr * 64 + fr, col0 = u.pn * HALF + wc * 32 + 8 * fq;
        const float* cm = colmax + (size_t)u.e * 2 * ldc + u.pn * BM + wc * 32 + 8 * fq;
        const f32x4 cg0 = *(const f32x4*)(cm), cg1 = *(const f32x4*)(cm + 4), cu0 = *(const f32x4*)(cm + HALF), cu1 = *(const f32x4*)(cm + HALF + 4);
        const float cg[8] = {cg0[0], cg0[1], cg0[2], cg0[3], cg1[0], cg1[1], cg1[2], cg1[3]}, cu[8] = {cu0[0], cu0[1], cu0[2], cu0[3], cu1[0], cu1[1], cu1[2], cu1[3]};
        int cume = 0, cnte = 0x7fffffff; if (rowidx) { cume = tab[8 + u.e]; cnte = tab[u.e]; }
#pragma unroll
        for (int ai = 0; ai < 2; ++ai)
#pragma unroll
            for (int m = 0; m < 4; ++m) { const int r = row0 + ai * HALF + m * 16; unsigned char* rowp = O + (size_t)r * ldc + col0;
                float sa; if (rowidx) { const int rl = r - cume * BM; sa = (rl < cnte) ? rowmax[u.e * ECAP + rl] : 0.f; } else sa = rowmax[r];
                sa *= (1.f / (127.f * 127.f));
                float o[8];
#pragma unroll
                for (int n = 0; n < 2; ++n)
#pragma unroll
                    for (int j = 0; j < 4; ++j) { const float g = (float)__builtin_bit_cast(i32x4, acc[ai][0][m][n])[j] * (sa * cg[n * 4 + j]), up = (float)__builtin_bit_cast(i32x4, acc[ai][1][m][n])[j] * (sa * cu[n * 4 + j]);
                        o[n * 4 + j] = g * __builtin_amdgcn_rcpf(1.f + __builtin_amdgcn_exp2f(-1.4426950408889634f * g)) * up; }
                u32x2 w; w.x = pack_fp8x4(o[0], o[1], o[2], o[3]); w.y = pack_fp8x4(o[4], o[5], o[6], o[7]);
                *(u32x2*)rowp = w; }
    }
};

struct EpiSwiGLU8 {
    static constexpr bool PERM = true;
    unsigned char* O; int ldc; float sc;
    __device__ __forceinline__ void operator()(const f32x4 (&acc)[2][2][4][2], const Unit& u, int wr, int wc, int fr, int fq) const {
        const int row0 = u.pm * BM + wr * 64 + fr, col0 = u.pn * HALF + wc * 32 + 8 * fq;
#pragma unroll
        for (int ai = 0; ai < 2; ++ai)
#pragma unroll
            for (int m = 0; m < 4; ++m) { unsigned char* rowp = O + (size_t)(row0 + ai * HALF + m * 16) * ldc + col0;
                float r[8];
#pragma unroll
                for (int n = 0; n < 2; ++n)
#pragma unroll
                    for (int j = 0; j < 4; ++j) { const float g = acc[ai][0][m][n][j] * sc, up = acc[ai][1][m][n][j] * sc;
                        r[n * 4 + j] = g * __builtin_amdgcn_rcpf(1.f + __builtin_amdgcn_exp2f(-1.4426950408889634f * g)) * up; }
                u32x2 w; w.x = pack_fp8x4(r[0], r[1], r[2], r[3]); w.y = pack_fp8x4(r[4], r[5], r[6], r[7]);
                *(u32x2*)rowp = w; }
    }
};

template <class Epi, class Sched, bool ALIGN_EPI, int DT>
__device__ __forceinline__ void gemm_phase(LAS unsigned char* lds, const int KB, const Sched& S, const Epi& E) {
    const int tid = threadIdx.x, wid = __builtin_amdgcn_readfirstlane(tid >> 6), lane = tid & 63, wr = wid >> 2, wc = wid & 3, fr = lane & 15, fq = lane >> 4;
    const int nt = KB / 128;
    int Rr[2], Cc[2]; unsigned voffB[2];
#pragma unroll
    for (int i = 0; i < 2; ++i) { int R, C; stage_rc(tid * 16 + i * 8192, R, C); Rr[i] = R; Cc[i] = C; const int Rb = Epi::PERM ? ((R & ~31) + perm32(R & 31)) : R; voffB[i] = (unsigned)(Rb * KB + C * 2); }
    const size_t kstep = (size_t)(BK * 2);
    const size_t hstep = (size_t)HALF * KB;
    const unsigned ldsw = (unsigned)wid * 1024u;
    const int aoff = lds_byte(wr * 64 + fr, fq * 8), boff = lds_byte(wc * 32 + fr, fq * 8);
#define PG8_SA(b, h) (((b) * 2 + (h)) * HTB)
#define PG8_SB(b, h) ((4 + (b) * 2 + (h)) * HTB)
#define PG8_STAGE(bufoff, gbase, voff) do { _Pragma("unroll") for (int _i = 0; _i < 2; ++_i) \
        __builtin_amdgcn_global_load_lds((const unsigned*)((const char*)(gbase) + (voff)[_i]), (LAS unsigned*)(lds + (bufoff) + ldsw + _i * 8192), 16, 0, 0); } while (0)
#define PG8_LD32(p) __builtin_shufflevector(*(const LAS i32x4*)(p), *(const LAS i32x4*)((p) + 1024), 0, 1, 2, 3, 4, 5, 6, 7)
#define PG8_LDA(dst, b, h) do { _Pragma("unroll") for (int m = 0; m < 4; ++m) dst[m] = PG8_LD32(lds + PG8_SA(b, h) + aoff + m * 2048); } while (0)
#define PG8_LDB(dst, b, h) do { _Pragma("unroll") for (int n = 0; n < 2; ++n) dst[n] = PG8_LD32(lds + PG8_SB(b, h) + boff + n * 2048); } while (0)
#define PG8_LO(x) __builtin_bit_cast(bf16x8, __builtin_shufflevector((x), (x), 0, 1, 2, 3))
#define PG8_HI(x) __builtin_bit_cast(bf16x8, __builtin_shufflevector((x), (x), 4, 5, 6, 7))
#define PG8_MMA(ai, bj, At, Bt) do { __builtin_amdgcn_s_setprio(1); \
        if constexpr (DT == 2) { _Pragma("unroll") for (int m = 0; m < 4; ++m) _Pragma("unroll") for (int n = 0; n < 2; ++n) { \
            i32x4 _c = __builtin_bit_cast(i32x4, acc[ai][bj][m][n]); \
            _c = __builtin_amdgcn_mfma_i32_16x16x64_i8(__builtin_shufflevector(Bt[n], Bt[n], 0, 1, 2, 3), __builtin_shufflevector(At[m], At[m], 0, 1, 2, 3), _c, 0, 0, 0); \
            _c = __builtin_amdgcn_mfma_i32_16x16x64_i8(__builtin_shufflevector(Bt[n], Bt[n], 4, 5, 6, 7), __builtin_shufflevector(At[m], At[m], 4, 5, 6, 7), _c, 0, 0, 0); \
            acc[ai][bj][m][n] = __builtin_bit_cast(f32x4, _c); } } \
        else if constexpr (DT == 1) { _Pragma("unroll") for (int m = 0; m < 4; ++m) _Pragma("unroll") for (int n = 0; n < 2; ++n) \
            asm volatile("v_mfma_scale_f32_16x16x128_f8f6f4 %0, %1, %2, %0, %3, %3 op_sel_hi:[0,0,0]" : "+v"(acc[ai][bj][m][n]) : "v"(Bt[n]), "v"(At[m]), "v"(scv)); } \
        else { _Pragma("unroll") for (int m = 0; m < 4; ++m) _Pragma("unroll") for (int n = 0; n < 2; ++n) { \
            acc[ai][bj][m][n] = __builtin_amdgcn_mfma_f32_16x16x32_bf16(PG8_LO(Bt[n]), PG8_LO(At[m]), acc[ai][bj][m][n], 0, 0, 0); \
            acc[ai][bj][m][n] = __builtin_amdgcn_mfma_f32_16x16x32_bf16(PG8_HI(Bt[n]), PG8_HI(At[m]), acc[ai][bj][m][n], 0, 0, 0); } } \
        __builtin_amdgcn_s_setprio(0); } while (0)
#define PG8_WAIT_V(n) asm volatile("s_waitcnt vmcnt(" #n ")" ::: "memory")
#define PG8_WAIT_L(n) asm volatile("s_waitcnt lgkmcnt(" #n ")" ::: "memory")
#define PG8_BAR __builtin_amdgcn_s_barrier()
#define PG8_SCHED __builtin_amdgcn_sched_barrier(0)
    Unit cur, nxt; int ui = 0;
    if (!S.next(0, cur)) return;
    f32x4 acc[2][2][4][2];
#pragma unroll
    for (int a = 0; a < 2; ++a)
#pragma unroll
        for (int b = 0; b < 2; ++b)
#pragma unroll
            for (int m = 0; m < 4; ++m)
#pragma unroll
                for (int n = 0; n < 2; ++n) acc[a][b][m][n] = (f32x4){0.f, 0.f, 0.f, 0.f};
    i32x8 At[4], B0[2], B1[2];
    int scv = 0x7F7F7F7F; asm volatile("" : "+v"(scv));
    unsigned curA[2][2], nxtA[2][2], voffA[2];
    const char* const Ab = S.a_base(); const char* cA = Ab; const char* nA = Ab;
    if constexpr (Sched::GATHER) S.a_offsets(cur, Rr, Cc, curA);
    else {
#pragma unroll
        for (int i = 0; i < 2; ++i) voffA[i] = (unsigned)(Rr[i] * KB + Cc[i] * 2);
        cA = Ab + (size_t)cur.pm * 2 * hstep; }
    const char* cB = S.b_base(cur);
#define PG8_STA(bufoff, nextflag, h, koff) do { if constexpr (Sched::GATHER) { unsigned _o[2]; _o[0] = (nextflag) ? nxtA[h][0] : curA[h][0]; _o[1] = (nextflag) ? nxtA[h][1] : curA[h][1]; PG8_STAGE(bufoff, Ab + (koff), _o); } \
        else { PG8_STAGE(bufoff, ((nextflag) ? nA : cA) + (size_t)(h) * hstep + (koff), voffA); } } while (0)
    PG8_STAGE(PG8_SB(0, 0), cB, voffB); PG8_STAGE(PG8_SB(0, 1), cB + hstep, voffB); PG8_STA(PG8_SA(0, 0), false, 0, 0); PG8_STA(PG8_SA(0, 1), false, 1, 0);
    if (wr == 1) PG8_BAR;
    PG8_WAIT_V(2); PG8_BAR;
    PG8_STAGE(PG8_SB(1, 0), cB + kstep, voffB); PG8_STA(PG8_SA(1, 0), false, 0, kstep); PG8_STAGE(PG8_SB(1, 1), cB + hstep + kstep, voffB);
    PG8_WAIT_V(6); PG8_BAR;
    for (;;) {
        const bool has_next = S.next(ui + 1, nxt);
        if constexpr (Sched::GATHER) {
            if (has_next) S.a_offsets(nxt, Rr, Cc, nxtA);
            else {
#pragma unroll
                for (int h = 0; h < 2; ++h)
#pragma unroll
                    for (int i = 0; i < 2; ++i) nxtA[h][i] = curA[h][i]; }
        } else nA = has_next ? Ab + (size_t)nxt.pm * 2 * hstep : cA;
        const char* nB = has_next ? S.b_base(nxt) : cB;
        for (int t = 0; t < nt; t += 2) {
            const bool last = (t == nt - 2);
            const size_t k1 = (size_t)(t + 1) * kstep, k2 = last ? 0 : (size_t)(t + 2) * kstep, k3 = k2 + kstep;
            const char* b2 = last ? nB : cB + (size_t)(t + 2) * kstep; const char* b3 = b2 + kstep;
            PG8_LDB(B0, 0, 0); PG8_LDB(B1, 0, 1); PG8_SCHED; PG8_LDA(At, 0, 0); PG8_STA(PG8_SA(1, 1), false, 1, k1);
            PG8_WAIT_V(8); PG8_WAIT_L(0); PG8_BAR; PG8_MMA(0, 0, At, B0); PG8_MMA(0, 1, At, B1); PG8_BAR; PG8_SCHED;
            PG8_LDA(At, 0, 1); PG8_STAGE(PG8_SB(0, 0), b2, voffB); PG8_STAGE(PG8_SB(0, 1), b2 + hstep, voffB); PG8_STA(PG8_SA(0, 0), last, 0, k2);
            PG8_WAIT_V(8); PG8_WAIT_L(0); PG8_BAR; PG8_MMA(1, 0, At, B0); PG8_MMA(1, 1, At, B1); PG8_BAR; PG8_SCHED;
            PG8_LDB(B0, 1, 0); PG8_LDB(B1, 1, 1); PG8_SCHED; PG8_LDA(At, 1, 0); PG8_STA(PG8_SA(0, 1), last, 1, k2);
            PG8_WAIT_V(8); PG8_WAIT_L(0); PG8_BAR; PG8_MMA(0, 0, At, B0); PG8_MMA(0, 1, At, B1); PG8_BAR; PG8_SCHED;
            PG8_LDA(At, 1, 1); PG8_STAGE(PG8_SB(1, 0), b3, voffB); PG8_STAGE(PG8_SB(1, 1), b3 + hstep, voffB); PG8_STA(PG8_SA(1, 0), last, 0, k3);
            PG8_WAIT_V(8); PG8_WAIT_L(0); PG8_BAR; PG8_MMA(1, 0, At, B0); PG8_MMA(1, 1, At, B1); PG8_BAR; PG8_SCHED;
        }
        if constexpr (ALIGN_EPI) { if (wr == 0) PG8_BAR; }
        if constexpr (DT == 1) asm volatile("s_nop 15\n\ts_nop 15" ::: "memory");
        E(acc, cur, wr, wc, fr, fq);
        if (!has_next) break;
#pragma unroll
        for (int a = 0; a < 2; ++a)
#pragma unroll
            for (int b = 0; b < 2; ++b)
#pragma unroll
                for (int m = 0; m < 4; ++m)
#pragma unroll
                    for (int n = 0; n < 2; ++n) acc[a][b][m][n] = (f32x4){0.f, 0.f, 0.f, 0.f};
        cur = nxt; cB = nB; cA = nA; ++ui;
        if constexpr (Sched::GATHER) {
#pragma unroll
            for (int h = 0; h < 2; ++h)
#pragma unroll
                for (int i = 0; i < 2; ++i) curA[h][i] = nxtA[h][i]; }
        if constexpr (ALIGN_EPI) { if (wr == 1) PG8_BAR; }
    }
    PG8_WAIT_V(0);
    if constexpr (!ALIGN_EPI) { if (wr == 0) PG8_BAR; }
    PG8_BAR;
#undef PG8_SA
#undef PG8_SB
#undef PG8_STAGE
#undef PG8_STA
#undef PG8_LDA
#undef PG8_LDB
#undef PG8_MMA
#undef PG8_LD32
#undef PG8_LO
#undef PG8_HI
#undef PG8_WAIT_V
#undef PG8_WAIT_L
#undef PG8_BAR
#undef PG8_SCHED
}
}

#define XB_TMO      128
#define XB_XCNT(j)  (256  + 64 * (j))
#define XB_XSUB(j)  (1280 + 64 * (j))
#define XB_XGEN(j)  (2304 + 64 * (j))
#define XB_TOP      3328
#define XB_TOPGEN   3392
#define XCD_BAR_WORDS 3456
#define XB_SPIN_CAP (1u << 18)
__device__ __forceinline__ unsigned xb_ld(unsigned* p)              { return __hip_atomic_load(p, __ATOMIC_RELAXED, __HIP_MEMORY_SCOPE_AGENT); }
__device__ __forceinline__ unsigned xb_add(unsigned* p, unsigned v) { return __hip_atomic_fetch_add(p, v, __ATOMIC_RELAXED, __HIP_MEMORY_SCOPE_AGENT); }
__device__ __forceinline__ unsigned xb_xcc_id() { return (unsigned)__builtin_amdgcn_s_getreg((3 << 11) | 20) & 0xFu; }
#define XB_SPIN(cond, bar) do { unsigned _sp = 0; while (cond) { __builtin_amdgcn_s_sleep(1); \
    if ((++_sp & 255u) == 0u) { if (xb_ld(&(bar)[XB_TMO])) break; if (_sp > XB_SPIN_CAP) { atomicAdd(&(bar)[XB_TMO], 1u); break; } } } } while (0)
struct XcdBarrier { unsigned* bar; unsigned x; volatile LAS unsigned* st; };
__device__ __forceinline__ XcdBarrier xcd_barrier_post(unsigned* bar, volatile LAS unsigned* st) {
    XcdBarrier b; b.bar = bar; b.x = xb_xcc_id(); b.st = st;
    if (threadIdx.x == 0) (void)xb_add(&bar[XB_XCNT(b.x)], 1u);
    return b;
}
__device__ __forceinline__ void xcd_barrier_complete(unsigned* bar, unsigned x, unsigned& nloc, unsigned& nx) {
    const unsigned G = gridDim.x * gridDim.y * gridDim.z;
    unsigned sum, cnt, mine, sp = 0u;
    for (;;) {
        sum = 0u; cnt = 0u; mine = 0u;
#pragma unroll
        for (unsigned j = 0; j < 16; ++j) { const unsigned c = xb_ld(&bar[XB_XCNT(j)]); sum += c; cnt += (c > 0u) ? 1u : 0u; mine = (j == x) ? c : mine; }
        if (sum == G) break;
        __builtin_amdgcn_s_sleep(1);
        if ((++sp & 255u) == 0u) { if (xb_ld(&bar[XB_TMO])) break; if (sp > XB_SPIN_CAP) { atomicAdd(&bar[XB_TMO], 1u); break; } }
    }
    nloc = mine > 0u ? mine : 1u; nx = cnt > 0u ? cnt : 1u;
}
__device__ __forceinline__ void xcd_barrier(const XcdBarrier& b) {
    asm volatile("s_waitcnt vmcnt(0)" ::: "memory");
    __syncthreads();
    if (threadIdx.x == 0) {
        unsigned* bar = b.bar;
        __builtin_amdgcn_s_waitcnt(0);
        unsigned nloc = b.st[0], nx = b.st[1];
        if (nloc == 0u) { xcd_barrier_complete(bar, b.x, nloc, nx); b.st[0] = nloc; b.st[1] = nx; }
        const unsigned old = xb_add(&bar[XB_XSUB(b.x)], 1u);
        const unsigned gen = old / nloc;
        if (old + 1u == (gen + 1u) * nloc) {
            __builtin_amdgcn_fence(__ATOMIC_RELEASE, "agent");
            asm volatile("s_waitcnt vmcnt(0)" ::: "memory");
            const unsigned og = xb_add(&bar[XB_TOP], 1u);
            const unsigned tg = og / nx;
            if (og + 1u == (tg + 1u) * nx) xb_add(&bar[XB_TOPGEN], 1u);
            else XB_SPIN(xb_ld(&bar[XB_TOPGEN]) == tg, bar);
            __builtin_amdgcn_fence(__ATOMIC_ACQUIRE, "agent");
            xb_add(&bar[XB_XGEN(b.x)], 1u);
            asm volatile("s_waitcnt vmcnt(0)" ::: "memory");
        } else {
            XB_SPIN(xb_ld(&bar[XB_XGEN(b.x)]) == gen, bar);
            __builtin_amdgcn_fence(__ATOMIC_ACQUIRE, "agent");
            asm volatile("s_waitcnt vmcnt(0)" ::: "memory");
        }
    }
    __syncthreads();
}

constexpr int RING_BYTES = 131072, LDSCTL_OFF = RING_BYTES, MISC_OFF = LDSCTL_OFF + 320, LDS_BYTES = 147456;
enum { IN_X = 0, IN_C, IN_ADAW, IN_ADAB, IN_GPREM, IN_GPOSTM, IN_GPREF, IN_GPOSTF, IN_WIN, IN_WOUT, IN_CONVW, IN_CONVB, IN_IGB, IN_FGB, IN_MNW, IN_SINK,
       IN_FG, IN_FU, IN_FD, IN_ROUTER, IN_MG, IN_MU, IN_MD, N_INPUTS };
struct Args { const float* in[N_INPUTS]; float* out; unsigned char* ws; int ph_lo, ph_hi; };
struct Frame {
    LAS unsigned char* lds; unsigned char* glds; unsigned* ctl; unsigned char* ws;
    int tid, lane, wave, G, gw, NGW;
};

__device__ __forceinline__ void p0_ada(Frame& F, const float* c, const float* ada_w, const float* ada_b, float* mod) {
    float* cond = (float*)F.glds;
    float* part = (float*)(F.glds + 65536);
    for (int i = F.tid; i < NB * D; i += NTHR) { const int b = i / D, k = i % D; cond[k * 8 + b] = silu_f(c[i]); }
    __syncthreads();
    const int cq = F.lane & 7, ks = F.lane >> 3;
    for (int u = blockIdx.x; u < 768; u += F.G) {
        const int l = u / 384, cb = u % 384;
        const float* W = ada_w + (size_t)l * D * 6 * D + cb * 32 + cq * 4;
        f32x4 acc[8];
#pragma unroll
        for (int b = 0; b < 8; ++b) acc[b] = (f32x4){0.f, 0.f, 0.f, 0.f};
        const int kbase = F.wave * 256 + ks;
#pragma unroll 4
        for (int it = 0; it < 32; ++it) {
            const int k = kbase + 8 * it;
            const f32x4 w = __builtin_nontemporal_load((const f32x4*)(W + (size_t)k * 6 * D));
            const f32x4 c0 = *(const f32x4*)(cond + k * 8), c1 = *(const f32x4*)(cond + k * 8 + 4);
            acc[0] += w * c0[0]; acc[1] += w * c0[1]; acc[2] += w * c0[2]; acc[3] += w * c0[3];
            acc[4] += w * c1[0]; acc[5] += w * c1[1]; acc[6] += w * c1[2]; acc[7] += w * c1[3];
        }
#pragma unroll
        for (int b = 0; b < 8; ++b)
#pragma unroll
            for (int j = 0; j < 4; ++j) { float v = acc[b][j]; v += __shfl_xor(v, 8); v += __shfl_xor(v, 16); v += __shfl_xor(v, 32); acc[b][j] = v; }
        if (F.lane < 8) {
#pragma unroll
            for (int b = 0; b < 8; ++b) *(f32x4*)(part + (F.wave * 8 + b) * 32 + cq * 4) = acc[b];
        }
        __syncthreads();
        if (F.tid < 256) { const int b = F.tid >> 5, col = F.tid & 31; float s = ada_b[(size_t)l * 6 * D + cb * 32 + col];
#pragma unroll
          for (int w = 0; w < 8; ++w) s += part[(w * 8 + b) * 32 + col];
          mod[((size_t)l * NB + b) * 6 * D + cb * 32 + col] = s; }
        __syncthreads();
    }
}
__device__ __forceinline__ void cvt_item(const float* src, int ld, int k0, int c0, bf16_t* dst, int Kd, int drow0, unsigned char* scr, int lane) {
    const int c = lane & 15, q = lane >> 4;
    f32x4 v[4][4];
#pragma unroll
    for (int g = 0; g < 4; ++g)
#pragma unroll
        for (int j = 0; j < 4; ++j) v[g][j] = __builtin_nontemporal_load((const f32x4*)(src + (size_t)(k0 + 16 * g + 4 * q + j) * ld + c0 + 4 * c));
#pragma unroll
    for (int g = 0; g < 4; ++g)
#pragma unroll
        for (int i = 0; i < 4; ++i) { u32x2 w; w.x = cvtpk(v[g][0][i], v[g][1][i]); w.y = cvtpk(v[g][2][i], v[g][3][i]);
            *(u32x2*)(scr + (4 * c + i) * 136 + (16 * g + 4 * q) * 2) = w; }
    asm volatile("s_waitcnt lgkmcnt(0)" ::: "memory");
#pragma unroll
    for (int r = 0; r < 8; ++r) { const int n = 8 * r + (lane >> 3), ch = lane & 7;
        const u32x2 a = *(const u32x2*)(scr + n * 136 + ch * 16), b = *(const u32x2*)(scr + n * 136 + ch * 16 + 8);
        u32x4 o; o.x = a.x; o.y = a.y; o.z = b.x; o.w = b.y;
        *(u32x4*)(dst + (size_t)(drow0 + n) * Kd + k0 + 8 * ch) = o; }
    asm volatile("s_waitcnt lgkmcnt(0)" ::: "memory");
}
constexpr float WSC = 64.f, WSC_INV = 1.f / 64.f;
__device__ __forceinline__ void cvt_item8(const float* src, int ld, int k0, int c0, unsigned char* dst, int Kd, int drow0, unsigned char* scr, int lane) {
    const int c = lane & 7, q = lane >> 3;
    f32x4 v[4][4];
#pragma unroll
    for (int g = 0; g < 4; ++g)
#pragma unroll
        for (int j = 0; j < 4; ++j) v[g][j] = __builtin_nontemporal_load((const f32x4*)(src + (size_t)(k0 + 32 * g + 4 * q + j) * ld + c0 + 4 * c));
#pragma unroll
    for (int g = 0; g < 4; ++g)
#pragma unroll
        for (int i = 0; i < 4; ++i) *(unsigned*)(scr + (4 * c + i) * 132 + 32 * g + 4 * q) = pg8::pack_fp8x4(v[g][0][i] * WSC, v[g][1][i] * WSC, v[g][2][i] * WSC, v[g][3][i] * WSC);
    asm volatile("s_waitcnt lgkmcnt(0)" ::: "memory");
#pragma unroll
    for (int r = 0; r < 4; ++r) { const int n = 8 * r + (lane >> 3), ch = lane & 7; const unsigned char* p = scr + n * 132 + ch * 16;
        u32x4 o; o.x = *(const unsigned*)(p); o.y = *(const unsigned*)(p + 4); o.z = *(const unsigned*)(p + 8); o.w = *(const unsigned*)(p + 12);
        *(u32x4*)(dst + (size_t)(drow0 + n) * Kd + k0 + 16 * ch) = o; }
    asm volatile("s_waitcnt lgkmcnt(0)" ::: "memory");
}
__device__ __forceinline__ const float* inptr(const Frame& F, int i);
constexpr int CMS_KB = 2;
constexpr float CMS_F = 1.4f;
constexpr size_t COLMAX_OFF = 524288;
__device__ __forceinline__ void colmax_item(const float* src, int ld, int k0, int c0, float* cmx  , int lane) {
    const int c = lane & 7, q = lane >> 3;
    f32x4 mx = (f32x4){0.f, 0.f, 0.f, 0.f};
#pragma unroll
    for (int g = 0; g < 4; ++g)
#pragma unroll
        for (int j = 0; j < 4; ++j) { const f32x4 v = *(const f32x4*)(src + (size_t)(k0 + 32 * g + 4 * q + j) * ld + c0 + 4 * c);
            mx[0] = fmaxf(mx[0], fabsf(v[0])); mx[1] = fmaxf(mx[1], fabsf(v[1])); mx[2] = fmaxf(mx[2], fabsf(v[2])); mx[3] = fmaxf(mx[3], fabsf(v[3])); }
#pragma unroll
    for (int i = 0; i < 4; ++i) { float v = mx[i]; v = fmaxf(v, __shfl_xor(v, 8)); v = fmaxf(v, __shfl_xor(v, 16)); v = fmaxf(v, __shfl_xor(v, 32)); mx[i] = v; }
    if (q == 0) {
#pragma unroll
        for (int i = 0; i < 4; ++i) atomicMax((unsigned*)(cmx + 4 * c + i), __float_as_uint(mx[i] * CMS_F)); }
}
__device__ __forceinline__ unsigned pack_i8x4(float a, float b, float c, float d) {
    const int ia = (int)rintf(fminf(fmaxf(a, -127.f), 127.f)), ib = (int)rintf(fminf(fmaxf(b, -127.f), 127.f)), ic = (int)rintf(fminf(fmaxf(c, -127.f), 127.f)), id = (int)rintf(fminf(fmaxf(d, -127.f), 127.f));
    return (unsigned)(ia & 0xff) | ((unsigned)(ib & 0xff) << 8) | ((unsigned)(ic & 0xff) << 16) | ((unsigned)(id & 0xff) << 24);
}
__device__ __forceinline__ void cvt_item_i8(const float* src, int ld, int k0, int c0, unsigned char* dst, int Kd, int drow0, const float* cmx  , unsigned char* scr, int lane) {
    const int c = lane & 7, q = lane >> 3;
    const f32x4 cm = *(const f32x4*)(cmx + 4 * c);
    f32x4 inv; inv[0] = cm[0] > 0.f ? 127.f / cm[0] : 0.f; inv[1] = cm[1] > 0.f ? 127.f / cm[1] : 0.f; inv[2] = cm[2] > 0.f ? 127.f / cm[2] : 0.f; inv[3] = cm[3] > 0.f ? 127.f / cm[3] : 0.f;
    f32x4 v[4][4];
#pragma unroll
    for (int g = 0; g < 4; ++g)
#pragma unroll
        for (int j = 0; j < 4; ++j) v[g][j] = __builtin_nontemporal_load((const f32x4*)(src + (size_t)(k0 + 32 * g + 4 * q + j) * ld + c0 + 4 * c));
#pragma unroll
    for (int g = 0; g < 4; ++g)
#pragma unroll
        for (int i = 0; i < 4; ++i) *(unsigned*)(scr + (4 * c + i) * 132 + 32 * g + 4 * q) = pack_i8x4(v[g][0][i] * inv[i], v[g][1][i] * inv[i], v[g][2][i] * inv[i], v[g][3][i] * inv[i]);
    asm volatile("s_waitcnt lgkmcnt(0)" ::: "memory");
#pragma unroll
    for (int r = 0; r < 4; ++r) { const int n = 8 * r + (lane >> 3), ch = lane & 7; const unsigned char* p = scr + n * 132 + ch * 16;
        u32x4 o; o.x = *(const unsigned*)(p); o.y = *(const unsigned*)(p + 4); o.z = *(const unsigned*)(p + 8); o.w = *(const unsigned*)(p + 12);
        *(u32x4*)(dst + (size_t)(drow0 + n) * Kd + k0 + 16 * ch) = o; }
    asm volatile("s_waitcnt lgkmcnt(0)" ::: "memory");
}
constexpr int CI_WI = 16 * 152  , CI_WO = 16 * 64, CI_FD = 44 * 64, CI_FGU = 2 * 16 * 176, CI_MD = 8 * 22 * 64, CI_MGU = 16 * 16 * 88;
constexpr int CS_WI = CMS_KB * 152, CS_FGU = 2 * CMS_KB * 176, CS_MGU = 16 * CMS_KB * 88;
constexpr int CONV_N0 = CS_WI + CI_WO + CI_FD + CS_FGU, CONV_N1 = CI_WI + CI_FGU, CONV_N2 = CS_WI + CI_WO + CI_MD + CS_MGU, CONV_N3 = CI_MGU, CONV_N4 = CI_WI;
constexpr int CMX_WIN = 2 * DFF + 16 * DFE;
template <int GRP>
__device__ __forceinline__ void conv_item(Frame& F, int r) {
    unsigned char* scr = F.glds + F.wave * 8704; unsigned char* ws = F.ws;
    float* cmx = (float*)(ws + WS_CTL + COLMAX_OFF);
    if (GRP == 0 || GRP == 1 || GRP == 2 || GRP == 4) {
        constexpr int l = (GRP == 2 || GRP == 4) ? 1 : 0;
        constexpr bool QUANT = (GRP == 1 || GRP == 4); constexpr int NI = QUANT ? CI_WI : CS_WI;
        if (r < NI) { const int kb = r / 152, nb = r % 152, c0 = (nb < 112) ? nb * 32 : SRC_GATE + 8 + (nb - 112) * 32, drow = nb * 32;
            if (QUANT) cvt_item_i8(inptr(F, IN_WIN) + (size_t)l * D * NIN_SRC, NIN_SRC, kb * 128, c0, ws + WS_WIN + (size_t)l * NIN * D, D, drow, cmx + CMX_WIN + l * NIN + drow, scr, F.lane);
            else colmax_item(inptr(F, IN_WIN) + (size_t)l * D * NIN_SRC, NIN_SRC, kb * 128, c0, cmx + CMX_WIN + l * NIN + drow, F.lane);
            return; }
        r -= NI;
    }
    if (GRP == 0 || GRP == 2) {
        constexpr int l = (GRP == 2) ? 1 : 0;
        if (r < CI_WO) { const int kb = r / 64, nb = r % 64;
            cvt_item8(inptr(F, IN_WOUT) + (size_t)l * D * D, D, kb * 128, nb * 32, ws + WS_WOUT + (size_t)l * D * D, D, nb * 32, scr, F.lane); return; }
        r -= CI_WO;
        if (GRP == 0) {
            if (r < CI_FD) { const int kb = r / 64, nb = r % 64; cvt_item8(inptr(F, IN_FD), D, kb * 128, nb * 32, ws + WS_WD, DFF, nb * 32, scr, F.lane); return; }
            r -= CI_FD;
        } else {
            if (r < CI_MD) { const int e = r / (22 * 64); r %= (22 * 64); const int kb = r / 64, nb = r % 64;
                cvt_item8(inptr(F, IN_MD) + (size_t)e * DFE * D, D, kb * 128, nb * 32, ws + WS_MD + (size_t)e * D * DFE, DFE, nb * 32, scr, F.lane); return; }
            r -= CI_MD;
        }
    }
    if (GRP == 0 || GRP == 1) { constexpr int KBN = (GRP == 1) ? 16 : CMS_KB, I_F = KBN * 176; const int up = r / I_F; r %= I_F; const int kb = r / 176, nb = r % 176, n0 = nb * 32, drow = (n0 >> 7) * 256 + up * 128 + (n0 & 127);
        if (GRP == 1) cvt_item_i8(inptr(F, up ? IN_FU : IN_FG), DFF, kb * 128, n0, ws + WS_WGU, D, drow, cmx + drow, scr, F.lane);
        else colmax_item(inptr(F, up ? IN_FU : IN_FG), DFF, kb * 128, n0, cmx + drow, F.lane); }
    else { constexpr int KBN = (GRP == 3) ? 16 : CMS_KB, I_E = KBN * 88; const int up = r / (8 * I_E); r %= (8 * I_E); const int e = r / I_E; r %= I_E; const int kb = r / 88, nb = r % 88, n0 = nb * 32, drow = (n0 >> 7) * 256 + up * 128 + (n0 & 127);
        if (GRP == 3) cvt_item_i8(inptr(F, up ? IN_MU : IN_MG) + (size_t)e * D * DFE, DFE, kb * 128, n0, ws + WS_MGU + (size_t)e * 2 * DFE * D, D, drow, cmx + 2 * DFF + e * 2 * DFE + drow, scr, F.lane);
        else colmax_item(inptr(F, up ? IN_MU : IN_MG) + (size_t)e * D * DFE, DFE, kb * 128, n0, cmx + 2 * DFF + e * 2 * DFE + drow, F.lane); }
}
template <int GRP>
__device__ __forceinline__ void conv_all(Frame& F, int first = 0) {
    constexpr int N = (GRP == 0) ? CONV_N0 : (GRP == 1) ? CONV_N1 : (GRP == 2) ? CONV_N2 : (GRP == 3) ? CONV_N3 : CONV_N4;
    for (int it = first + F.gw; it < N; it += F.NGW) conv_item<GRP>(F, it);
}
template <int YMODE, int EXTRA, bool NORM_OUT, bool XN8  , bool XIN_BF = false  , bool XOUT_BF = false  >
__device__ __forceinline__ void row_phase(Frame& F, const float* xin, float* xout, const bf16_t* ybuf, const float* gpost, const float* gt  ,
                                          const float* gpre, const float* sc, const float* sh, bf16_t* XN,
                                          const float* wex, int ldw, const float* bi, const float* bfg, float* gates_out,
                                          const uint4* tok_in, uint4* tok_out, int* idx_out, unsigned* cntw, float* rowmax = nullptr) {
    LAS float* we = (LAS float*)F.lds;
    LAS float* vA = (LAS float*)(F.lds + 65536);
    LAS float* vB = (LAS float*)(F.lds + 73728);
    LAS float* vC = (LAS float*)(F.lds + 81920);
    LAS float* route = (LAS float*)(F.lds + 90112);
    LAS int* routei = (LAS int*)route;
    LAS int* cumt = (LAS int*)(F.lds + 90112 + 2048);
    if (EXTRA) {
        for (int k = F.tid; k < D; k += NTHR) { const f32x4 a = *(const f32x4*)(wex + (size_t)k * ldw), b = *(const f32x4*)(wex + (size_t)k * ldw + 4);
            we[0 * D + k] = a[0]; we[1 * D + k] = a[1]; we[2 * D + k] = a[2]; we[3 * D + k] = a[3]; we[4 * D + k] = b[0]; we[5 * D + k] = b[1]; we[6 * D + k] = b[2]; we[7 * D + k] = b[3]; }
    }
    if (YMODE == 2) { if (F.tid == 0) { int cum = 0; for (int e = 0; e < NE; ++e) { cumt[e] = cum; cum += (int)((__hip_atomic_load(cntw + e, __ATOMIC_RELAXED, __HIP_MEMORY_SCOPE_AGENT) + 255u) >> 8); } } }
    for (int blk = blockIdx.x; blk < M / 64; blk += F.G) {
        const int b = (blk * 64) / SEQ;
        __syncthreads();
        { const int col = 4 * F.tid;
            if (YMODE) { const f32x4 g = *(const f32x4*)(gt + (size_t)b * 6 * D + col), p = *(const f32x4*)(gpost + col); *(LAS f32x4*)(vA + col) = g * p; }
            if (NORM_OUT) { const f32x4 g = *(const f32x4*)(gpre + col), s = *(const f32x4*)(sc + (size_t)b * 6 * D + col); *(LAS f32x4*)(vB + col) = g * (1.f + s); *(LAS f32x4*)(vC + col) = *(const f32x4*)(sh + (size_t)b * 6 * D + col); } }
        __syncthreads();
        f32x4 xr[8]; u32x2 xrb[8], yr[8], yr2[8]; float w1n = 0.f, w2n = 0.f;
#define RP_LOAD(rr_) do { const size_t row_ = (size_t)blk * 64 + F.wave * 8 + (((rr_) + blk) & 7);   \
            if (XIN_BF) { _Pragma("unroll") for (int j = 0; j < 8; ++j) xrb[j] = __builtin_nontemporal_load((const u32x2*)((const bf16_t*)xin + row_ * D + 256 * j + 4 * F.lane)); } \
            else { _Pragma("unroll") for (int j = 0; j < 8; ++j) xr[j] = __builtin_nontemporal_load((const f32x4*)(xin + row_ * D + 256 * j + 4 * F.lane)); } \
            if (YMODE == 1) { _Pragma("unroll") for (int j = 0; j < 8; ++j) yr[j] = __builtin_nontemporal_load((const u32x2*)(ybuf + row_ * D + 256 * j + 4 * F.lane)); } \
            if (YMODE == 2) { const uint4 ti = tok_in[row_]; \
                const int e1 = (int)(ti.x >> 16), k1 = (int)(ti.x & 0xffffu), e2 = (int)(ti.y >> 16), k2 = (int)(ti.y & 0xffffu); \
                const size_t r1 = (size_t)cumt[e1] * 256 + k1, r2 = (size_t)cumt[e2] * 256 + k2; w1n = __uint_as_float(ti.z); w2n = __uint_as_float(ti.w); \
                _Pragma("unroll") for (int j = 0; j < 8; ++j) { yr[j] = __builtin_nontemporal_load((const u32x2*)(ybuf + r1 * D + 256 * j + 4 * F.lane)); yr2[j] = __builtin_nontemporal_load((const u32x2*)(ybuf + r2 * D + 256 * j + 4 * F.lane)); } } } while (0)
        RP_LOAD(0);
#pragma unroll 1
        for (int rr = 0; rr < 8; ++rr) {
            const int rl = F.wave * 8 + ((rr + blk) & 7); const size_t row = (size_t)blk * 64 + rl;
            asm volatile("" ::: "memory");
            f32x4 x[8];
#pragma unroll
            for (int j = 0; j < 8; ++j) x[j] = XIN_BF ? (f32x4){bflo(xrb[j].x), bfhi(xrb[j].x), bflo(xrb[j].y), bfhi(xrb[j].y)} : xr[j];
            f32x4 y[8];
            if (YMODE == 1) {
#pragma unroll
                for (int j = 0; j < 8; ++j) y[j] = (f32x4){bflo(yr[j].x), bfhi(yr[j].x), bflo(yr[j].y), bfhi(yr[j].y)};
            }
            if (YMODE == 2) {
#pragma unroll
                for (int j = 0; j < 8; ++j) y[j] = (f32x4){bflo(yr[j].x), bfhi(yr[j].x), bflo(yr[j].y), bfhi(yr[j].y)} * w1n + (f32x4){bflo(yr2[j].x), bfhi(yr2[j].x), bflo(yr2[j].y), bfhi(yr2[j].y)} * w2n;
            }
            if (rr < 7) RP_LOAD(rr + 1);
            if (YMODE) {
                float ss = 0.f;
#pragma unroll
                for (int j = 0; j < 8; ++j) ss += (y[j][0] * y[j][0] + y[j][1] * y[j][1]) + (y[j][2] * y[j][2] + y[j][3] * y[j][3]);
                const float r = 1.f / sqrtf(wave_sum(ss) * (1.f / D) + RMS_EPS);
#pragma unroll
                for (int j = 0; j < 8; ++j) { x[j] += *(const LAS f32x4*)(vA + 256 * j + 4 * F.lane) * (y[j] * r);
                    if (XOUT_BF) { u32x2 w; w.x = cvtpk(x[j][0], x[j][1]); w.y = cvtpk(x[j][2], x[j][3]); *(u32x2*)((bf16_t*)xout + row * D + 256 * j + 4 * F.lane) = w; }
                    else __builtin_nontemporal_store(x[j], (f32x4*)(xout + row * D + 256 * j + 4 * F.lane)); }
            }
            if (NORM_OUT) {
                float ss = 0.f;
#pragma unroll
                for (int j = 0; j < 8; ++j) ss += (x[j][0] * x[j][0] + x[j][1] * x[j][1]) + (x[j][2] * x[j][2] + x[j][3] * x[j][3]);
                const float r = 1.f / sqrtf(wave_sum(ss) * (1.f / D) + RMS_EPS);
#pragma unroll
                for (int j = 0; j < 8; ++j) x[j] = (x[j] * r) * *(const LAS f32x4*)(vB + 256 * j + 4 * F.lane) + *(const LAS f32x4*)(vC + 256 * j + 4 * F.lane);
                if (XN8) {
                    float am = 0.f;
#pragma unroll
                    for (int j = 0; j < 8; ++j) am = fmaxf(fmaxf(am, fmaxf(fabsf(x[j][0]), fabsf(x[j][1]))), fmaxf(fabsf(x[j][2]), fabsf(x[j][3])));
                    am = wave_max(am);
                    const float inv = am > 0.f ? 127.f / am : 0.f;
                    if (F.lane == 0) { rowmax[row] = am; if (EXTRA == 2) route[384 + rl] = am; }
#pragma unroll
                    for (int j = 0; j < 8; ++j) *(unsigned*)((unsigned char*)XN + row * D + 256 * j + 4 * F.lane) = pack_i8x4(x[j][0] * inv, x[j][1] * inv, x[j][2] * inv, x[j][3] * inv);
                } else {
#pragma unroll
                    for (int j = 0; j < 8; ++j) { u32x2 w; w.x = cvtpk(x[j][0], x[j][1]); w.y = cvtpk(x[j][2], x[j][3]); *(u32x2*)(XN + row * D + 256 * j + 4 * F.lane) = w; }
                }
                if (EXTRA) {
                    float d8[8];
#pragma unroll
                    for (int e = 0; e < 8; ++e) { float s = 0.f;
#pragma unroll
                        for (int j = 0; j < 8; ++j) { const f32x4 w = *(const LAS f32x4*)(we + e * D + 256 * j + 4 * F.lane); s += (x[j][0] * w[0] + x[j][1] * w[1]) + (x[j][2] * w[2] + x[j][3] * w[3]); }
                        d8[e] = wave_sum(s); asm volatile("" ::: "memory"); }
                    if (EXTRA == 1) {
                        float v = 0.f;
#pragma unroll
                        for (int e = 0; e < 8; ++e) v = (F.lane == e) ? d8[e] : v;
                        if (F.lane < 8) { const float bb = (F.lane < 4) ? bi[F.lane] : bfg[F.lane - 4]; const float z = 15.f * tanhf((v + bb) * (1.f / 15.f));
                            const float o = (F.lane < 4) ? z : (fminf(z, 0.f) - log1pf(expf(-fabsf(z)))); gates_out[row * 8 + F.lane] = o; }
                    } else {
                        int e1 = 0; float v1 = d8[0];
#pragma unroll
                        for (int e = 1; e < 8; ++e) if (d8[e] > v1) { v1 = d8[e]; e1 = e; }
                        int e2 = -1; float v2 = -3.0e38f;
#pragma unroll
                        for (int e = 0; e < 8; ++e) if (e != e1 && d8[e] > v2) { v2 = d8[e]; e2 = e; }
                        const float w1 = 1.f / (1.f + expf(v2 - v1));
                        if (F.lane == 0) { routei[rl * 4 + 0] = e1; routei[rl * 4 + 1] = e2; route[rl * 4 + 2] = w1; route[rl * 4 + 3] = 1.f - w1; }
                    }
                }
            }
        }
#undef RP_LOAD
        if (EXTRA == 2) {
            __syncthreads();
            if (F.tid < NE) { const int e = F.tid; int c = 0;
                for (int r = 0; r < 64; ++r) c += (routei[r * 4] == e) + (routei[r * 4 + 1] == e);
                int base = (int)__hip_atomic_fetch_add(cntw + e, (unsigned)c, __ATOMIC_RELAXED, __HIP_MEMORY_SCOPE_AGENT);
                float* rms = rowmax + (WS_RMSLOT - WS_ROWMAX) / 4;
                for (int r = 0; r < 64; ++r) { if (routei[r * 4] == e) { idx_out[e * ECAP + base] = blk * 64 + r; rms[e * ECAP + base] = route[384 + r]; routei[256 + r * 2] = base; ++base; }
                                               if (routei[r * 4 + 1] == e) { idx_out[e * ECAP + base] = blk * 64 + r; rms[e * ECAP + base] = route[384 + r]; routei[256 + r * 2 + 1] = base; ++base; } } }
            __syncthreads();
            if (F.tid < 64) { const int r = F.tid; uint4 ti; ti.x = ((unsigned)routei[r * 4] << 16) | (unsigned)routei[256 + r * 2]; ti.y = ((unsigned)routei[r * 4 + 1] << 16) | (unsigned)routei[256 + r * 2 + 1];
                ti.z = __float_as_uint(route[r * 4 + 2]); ti.w = __float_as_uint(route[r * 4 + 3]); tok_out[(size_t)blk * 64 + r] = ti; }
        }
    }
    __syncthreads();
}

namespace att {
constexpr int KROW = 144, VROW = 520, K_OFF = 0, V_OFF = 256 * KROW, KM_OFF = V_OFF + 64 * VROW;
constexpr float C2 = 0.125f * 1.4426950408889634f, NEG = -3.0e38f;
__device__ __forceinline__ void stage_kv(LAS unsigned char* lds, const bf16_t* kcol, const bf16_t* vcol, size_t grow0, int nk, int kc0, int tid) {
    for (int c = tid; c < nk * 8; c += NTHR) { const int key = c >> 3, part = c & 7;
        const u32x4 v = *(const u32x4*)(kcol + (grow0 + key) * NIN + part * 8);
        *(LAS u32x4*)(lds + K_OFF + (kc0 + key) * KROW + part * 16) = v; }
    const int np = nk >> 1;
    for (int it = tid; it < np * 8; it += NTHR) { const int kp = it % np, dp = it / np;
        const u32x4 a = *(const u32x4*)(vcol + (grow0 + 2 * kp) * NIN + dp * 8), b = *(const u32x4*)(vcol + (grow0 + 2 * kp + 1) * NIN + dp * 8);
        LAS unsigned char* dst = lds + V_OFF + (dp * 8) * VROW + (kc0 + 2 * kp) * 2;
        *(LAS unsigned*)(dst + 0 * VROW) = (a.x & 0xffffu) | (b.x << 16); *(LAS unsigned*)(dst + 1 * VROW) = (a.x >> 16) | (b.x & 0xffff0000u);
        *(LAS unsigned*)(dst + 2 * VROW) = (a.y & 0xffffu) | (b.y << 16); *(LAS unsigned*)(dst + 3 * VROW) = (a.y >> 16) | (b.y & 0xffff0000u);
        *(LAS unsigned*)(dst + 4 * VROW) = (a.z & 0xffffu) | (b.z << 16); *(LAS unsigned*)(dst + 5 * VROW) = (a.z >> 16) | (b.z & 0xffff0000u);
        *(LAS unsigned*)(dst + 6 * VROW) = (a.w & 0xffffu) | (b.w << 16); *(LAS unsigned*)(dst + 7 * VROW) = (a.w >> 16) | (b.w & 0xffff0000u); }
}
struct KVRegs { u32x4 k[4], va[2], vb[2]; };
__device__ __forceinline__ void kv_load(KVRegs& R, const bf16_t* kcol, const bf16_t* vcol, size_t grow0, int tid) {
#pragma unroll
    for (int i = 0; i < 4; ++i) { const int c = tid + i * NTHR, key = c >> 3, part = c & 7; R.k[i] = *(const u32x4*)(kcol + (grow0 + key) * NIN + part * 8); }
#pragma unroll
    for (int i = 0; i < 2; ++i) { const int it = tid + i * NTHR, kp = it & 127, dp = it >> 7;
        R.va[i] = *(const u32x4*)(vcol + (grow0 + 2 * kp) * NIN + dp * 8); R.vb[i] = *(const u32x4*)(vcol + (grow0 + 2 * kp + 1) * NIN + dp * 8); }
}
__device__ __forceinline__ void kv_store(LAS unsigned char* lds, const KVRegs& R, int tid) {
#pragma unroll
    for (int i = 0; i < 4; ++i) { const int c = tid + i * NTHR, key = c >> 3, part = c & 7; *(LAS u32x4*)(lds + K_OFF + key * KROW + part * 16) = R.k[i]; }
#pragma unroll
    for (int i = 0; i < 2; ++i) { const int it = tid + i * NTHR, kp = it & 127, dp = it >> 7; const u32x4 a = R.va[i], b = R.vb[i];
        LAS unsigned char* dst = lds + V_OFF + (dp * 8) * VROW + (2 * kp) * 2;
        *(LAS unsigned*)(dst + 0 * VROW) = (a.x & 0xffffu) | (b.x << 16); *(LAS unsigned*)(dst + 1 * VROW) = (a.x >> 16) | (b.x & 0xffff0000u);
        *(LAS unsigned*)(dst + 2 * VROW) = (a.y & 0xffffu) | (b.y << 16); *(LAS unsigned*)(dst + 3 * VROW) = (a.y >> 16) | (b.y & 0xffff0000u);
        *(LAS unsigned*)(dst + 4 * VROW) = (a.z & 0xffffu) | (b.z << 16); *(LAS unsigned*)(dst + 5 * VROW) = (a.z >> 16) | (b.z & 0xffff0000u);
        *(LAS unsigned*)(dst + 6 * VROW) = (a.w & 0xffffu) | (b.w << 16); *(LAS unsigned*)(dst + 7 * VROW) = (a.w >> 16) | (b.w & 0xffff0000u); }
}
struct State { f32x16 o0, o1, negm; float m, l; };
constexpr float THR = 5.f, M0 = -1000.f;
__device__ __forceinline__ void init(State& st) {
#pragma unroll
    for (int r = 0; r < 16; ++r) { st.o0[r] = 0.f; st.o1[r] = 0.f; st.negm[r] = -M0; }
    st.m = M0; st.l = 0.f;
}
__device__ __forceinline__ float xhalf_max(float v) { auto rr = __builtin_amdgcn_permlane32_swap(__float_as_uint(v), __float_as_uint(v), false, false); return fmaxf(__uint_as_float(rr[0]), __uint_as_float(rr[1])); }
__device__ __forceinline__ float xhalf_sum(float v) { auto rr = __builtin_amdgcn_permlane32_swap(__float_as_uint(v), __float_as_uint(v), false, false); return __uint_as_float(rr[0]) + __uint_as_float(rr[1]); }
__device__ __forceinline__ void block_mask(State& st, bool lane_ok) {
#pragma unroll
    for (int r = 0; r < 16; ++r) st.negm[r] = lane_ok ? -st.m : NEG;
}
template <int MODE>
__device__ __forceinline__ void tile(LAS unsigned char* lds, int kt, const bf16x8 (&qf)[4], State& st, int lane) {
    const int r32 = lane & 31, h = lane >> 5;
    f32x16 S;
    if (MODE == 3) S = st.negm;
    else {
#pragma unroll
        for (int r = 0; r < 16; ++r) { const int ko = (r & 3) + 8 * (r >> 2) + 4 * h; const bool ok = (MODE == 1) ? (ko <= r32) : (ko > r32); S[r] = ok ? st.negm[r] : NEG; } }
    const LAS unsigned char* kp = lds + K_OFF + (kt * 32 + r32) * KROW + h * 16;
#pragma unroll
    for (int s = 0; s < 4; ++s) { const bf16x8 a = *(const LAS bf16x8*)(kp + s * 32); S = __builtin_amdgcn_mfma_f32_32x32x16_bf16(a, qf[s], S, 0, 0, 0); }
    float tmax;
    asm volatile("s_nop 15\n\ts_nop 7" : "+v"(S));
    { float m0, m1, m2, m3, m4;
      asm("v_max3_f32 %0, %1, %2, %3" : "=v"(m0) : "v"(S[0]), "v"(S[1]), "v"(S[2]));    asm("v_max3_f32 %0, %1, %2, %3" : "=v"(m1) : "v"(S[3]), "v"(S[4]), "v"(S[5]));
      asm("v_max3_f32 %0, %1, %2, %3" : "=v"(m2) : "v"(S[6]), "v"(S[7]), "v"(S[8]));    asm("v_max3_f32 %0, %1, %2, %3" : "=v"(m3) : "v"(S[9]), "v"(S[10]), "v"(S[11]));
      asm("v_max3_f32 %0, %1, %2, %3" : "=v"(m4) : "v"(S[12]), "v"(S[13]), "v"(S[14])); asm("v_max3_f32 %0, %1, %2, %3" : "=v"(m0) : "v"(m0), "v"(m1), "v"(S[15]));
      asm("v_max3_f32 %0, %1, %2, %3" : "=v"(m2) : "v"(m2), "v"(m3), "v"(m4));          asm("v_max_f32 %0, %1, %2" : "=v"(tmax) : "v"(m0), "v"(m2)); }
    tmax = xhalf_max(tmax);
    if (__any(tmax > THR)) {
        const float d = tmax > THR ? tmax : 0.f, alpha = __builtin_amdgcn_exp2f(-d);
        st.m += d; st.l *= alpha;
#pragma unroll
        for (int r = 0; r < 16; ++r) { S[r] -= d; st.negm[r] -= d; st.o0[r] *= alpha; st.o1[r] *= alpha; }
    }
    float ls0 = 0.f, ls1 = 0.f;
#pragma unroll
    for (int r = 0; r < 16; r += 2) { const float p0 = __builtin_amdgcn_exp2f(S[r]), p1 = __builtin_amdgcn_exp2f(S[r + 1]); S[r] = p0; S[r + 1] = p1; ls0 += p0; ls1 += p1; }
    st.l += ls0 + ls1;
    const LAS unsigned char* vp = lds + V_OFF + r32 * VROW + kt * 64 + h * 8;
#pragma unroll
    for (int s = 0; s < 2; ++s) {
        u32x4 pw; pw.x = cvtpk(S[8 * s + 0], S[8 * s + 1]); pw.y = cvtpk(S[8 * s + 2], S[8 * s + 3]); pw.z = cvtpk(S[8 * s + 4], S[8 * s + 5]); pw.w = cvtpk(S[8 * s + 6], S[8 * s + 7]);
        const bf16x8 pf = __builtin_bit_cast(bf16x8, pw);
        { const u32x2 lo = *(const LAS u32x2*)(vp + s * 32), hi = *(const LAS u32x2*)(vp + s * 32 + 16); u32x4 aw; aw.x = lo.x; aw.y = lo.y; aw.z = hi.x; aw.w = hi.y;
          st.o0 = __builtin_amdgcn_mfma_f32_32x32x16_bf16(__builtin_bit_cast(bf16x8, aw), pf, st.o0, 0, 0, 0); }
        { const u32x2 lo = *(const LAS u32x2*)(vp + 32 * VROW + s * 32), hi = *(const LAS u32x2*)(vp + 32 * VROW + s * 32 + 16); u32x4 aw; aw.x = lo.x; aw.y = lo.y; aw.z = hi.x; aw.w = hi.y;
          st.o1 = __builtin_amdgcn_mfma_f32_32x32x16_bf16(__builtin_bit_cast(bf16x8, aw), pf, st.o1, 0, 0, 0); }
    }
}
constexpr float YSC = 16.f;
__device__ __forceinline__ void store_out(const State& st, float inv, unsigned char* orow  , int lane) {
    const int h = lane >> 5;
#pragma unroll
    for (int g = 0; g < 4; ++g) {
        *(unsigned*)(orow + 8 * g + 4 * h) = pg8::pack_fp8x4(st.o0[4 * g] * inv, st.o0[4 * g + 1] * inv, st.o0[4 * g + 2] * inv, st.o0[4 * g + 3] * inv);
        *(unsigned*)(orow + 32 + 8 * g + 4 * h) = pg8::pack_fp8x4(st.o1[4 * g] * inv, st.o1[4 * g + 1] * inv, st.o1[4 * g + 2] * inv, st.o1[4 * g + 3] * inv); }
}
__device__ __forceinline__ void moba_unit(Frame& F, const bf16_t* proj, const float* kmean, unsigned char* Y, int b, int h, int j) {
    LAS unsigned char* lds = F.lds; const int lane = F.lane, r32 = lane & 31, hh = lane >> 5, w = F.wave;
    const size_t rb = (size_t)b * SEQ; const int t = j * 256 + w * 32 + r32;
    bf16x8 qf[4];
    { const bf16_t* qrow = proj + (rb + t) * NIN + C_MQ + h * 64 + hh * 8;
#pragma unroll
      for (int s = 0; s < 4; ++s) qf[s] = *(const bf16x8*)(qrow + s * 16); }
    LBAR();
    LAS float* km = (LAS float*)(lds + KM_OFF);
    if (F.tid < j * 64) km[F.tid] = kmean[(size_t)(b * 8 + (F.tid >> 6)) * 512 + h * 64 + (F.tid & 63)];
    LBAR();
    unsigned sel;
    if (j <= 3) sel = (1u << j) - 1u;
    else {
        float g[7];
#pragma unroll
        for (int n = 0; n < 7; ++n) { g[n] = NEG;
            if (n < j) { float a = 0.f;
#pragma unroll
                for (int s = 0; s < 4; ++s)
#pragma unroll
                    for (int jj = 0; jj < 8; ++jj) a += bf1((bf16_t)qf[s][jj]) * km[n * 64 + 16 * s + 8 * hh + jj];
                a += __shfl_xor(a, 32); g[n] = a; } }
        sel = 0u;
#pragma unroll
        for (int r = 0; r < 3; ++r) { float best = NEG; int bi = 0;
#pragma unroll
            for (int n = 0; n < 7; ++n) if (n < j && !((sel >> n) & 1u) && g[n] > best) { best = g[n]; bi = n; }
            sel |= 1u << bi; }
    }
    State st; init(st);
    const bf16_t* kcol = proj + C_MK + h * 64; const bf16_t* vcol = proj + C_MV + h * 64;
    KVRegs R; kv_load(R, kcol, vcol, rb, F.tid);
    for (int n = 0; n <= j; ++n) {
        LBAR();
        kv_store(lds, R, F.tid);
        if (n < j) kv_load(R, kcol, vcol, rb + (size_t)(n + 1) * 256, F.tid);
        LBAR();
        if (n < j) { const bool ok = (sel >> n) & 1u;
            if (__any(ok)) { block_mask(st, ok); for (int kt = 0; kt < 8; ++kt) tile<3>(lds, kt, qf, st, lane); } }
        else { block_mask(st, true); for (int kt = 0; kt < w; ++kt) tile<3>(lds, kt, qf, st, lane);
               tile<1>(lds, w, qf, st, lane); }
    }
    const float lt = xhalf_sum(st.l);
    store_out(st, YSC / lt, Y + (rb + t) * D + h * 64, lane);
}
__device__ __forceinline__ void swa_unit(Frame& F, const bf16_t* proj, const float* sinks, unsigned char* Y, int b, int kvh, int qb) {
    LAS unsigned char* lds = F.lds; int lane = F.lane; asm volatile("" : "+v"(lane));
    const int r32 = lane & 31, hh = lane >> 5, w = F.wave, hq = kvh * 8 + w;
    const size_t rb = (size_t)b * SEQ;
    const bf16_t* kcol = proj + C_SK + kvh * 64; const bf16_t* vcol = proj + C_SV + kvh * 64;
    LBAR();
    if (qb > 0) stage_kv(lds, kcol, vcol, rb + (size_t)qb * 128 - 128, 256, 0, F.tid);
    else        stage_kv(lds, kcol, vcol, rb, 128, 128, F.tid);
    LBAR();
    const float sk = sinks[hq] * 1.4426950408889634f;
    for (int sb = 0; sb < 4; ++sb) {
        const int t = qb * 128 + sb * 32 + r32;
        bf16x8 qf[4];
        { const bf16_t* qrow = proj + (rb + t) * NIN + C_SQ + hq * 64 + hh * 8;
#pragma unroll
          for (int s = 0; s < 4; ++s) qf[s] = *(const bf16x8*)(qrow + s * 16); }
        State st; init(st);
        int kt0 = sb; if (qb == 0 && kt0 < 4) kt0 = 4;
        if (kt0 == sb) tile<2>(lds, sb, qf, st, lane);
        for (int kt = (kt0 > sb + 1 ? kt0 : sb + 1); kt < sb + 4; ++kt) tile<3>(lds, kt, qf, st, lane);
        tile<1>(lds, sb + 4, qf, st, lane);
        const float lt = xhalf_sum(st.l) + __builtin_amdgcn_exp2f(sk - st.m);
        store_out(st, YSC / lt, Y + (rb + t) * D + 1024 + hq * 64, lane);
    }
}
}

#include <hip/hip_bf16.h>
#include <cmath>
namespace mob {
using bf16=__hip_bfloat16;
using bf16x8=__attribute__((ext_vector_type(8)))short;
using s16x4=__attribute__((ext_vector_type(4)))short;
using f32x16=__attribute__((ext_vector_type(16)))float;
using u32x4=__attribute__((ext_vector_type(4)))unsigned;
constexpr int SEQ=2048,D=64,DM=4864;
constexpr int NW=8,QBLK=32,QB=QBLK*NW,KVBLK=64,NQB=SEQ/QB;
__device__ __forceinline__ int crow(int r,int hi){return (r&3)+8*(r>>2)+4*hi;}
#define SBAR() __builtin_amdgcn_sched_barrier(0)
__device__ __forceinline__ void cmask(f32x16&p0,f32x16&p1,int jb,int qrel,int hi){
  const float NEG=-INFINITY; int kb=64*jb+4*hi;
  #pragma unroll
  for(int r=0;r<16;++r){int kv=kb+(r&3)+8*(r>>2); if(kv>qrel)p0[r]=NEG; if(kv+32>qrel)p1[r]=NEG;}
}

constexpr int NSLOT=3, SLOTB=8192;
constexpr int LDS_K=0, LDS_V=NSLOT*SLOTB, LDS_WS=2*NSLOT*SLOTB, LDS_OST=LDS_WS+NW*64*4, LDS_BYTES=LDS_OST+NW*4096, LDS_KM=LDS_BYTES  ;
constexpr float NEGB=-3.0e38f, YSC=16.f;
constexpr float C2=0.125f*1.4426950408889634f;
__device__ __forceinline__ void glds16(const void*sbase,unsigned voff,unsigned lds_dst){unsigned keep;
  asm volatile("s_mov_b32 %0, m0\n\ts_mov_b32 m0, %2\n\ts_nop 0\n\tglobal_load_lds_dwordx4 %1, %3\n\ts_mov_b32 m0, %0":"=&s"(keep):"v"(voff),"s"(lds_dst),"s"(sbase):"memory");}
__device__ __forceinline__ float max3f(float a,float b,float c){float r;asm("v_max3_f32 %0, %1, %2, %3":"=v"(r):"v"(a),"v"(b),"v"(c));return r;}
__device__ __forceinline__ float max2f(float a,float b){float r;asm("v_max_f32_e32 %0, %1, %2":"=v"(r):"v"(a),"v"(b));return r;}
__device__ __forceinline__ float fadd_s(float a,float b){float r;asm("v_add_f32_e32 %0, %1, %2":"=v"(r):"v"(a),"v"(b));return r;}
__device__ __forceinline__ float fsub_s(float a,float b){float r;asm("v_sub_f32_e32 %0, %1, %2":"=v"(r):"v"(a),"v"(b));return r;}
typedef float f32x2_t __attribute__((ext_vector_type(2))); typedef __bf16 bf16x2_t __attribute__((ext_vector_type(2)));
__device__ __forceinline__ unsigned cvtpk_s(float lo,float hi){f32x2_t v={lo,hi};bf16x2_t b=__builtin_convertvector(v,bf16x2_t);return __builtin_bit_cast(unsigned,b);}
#define WAIT_BAR(N) asm volatile("s_waitcnt vmcnt(" #N ") lgkmcnt(0)\n\ts_barrier":::"memory")

__device__ __forceinline__ void qkt(f32x16&p0,f32x16&p1,const char*Kslot,const bf16x8*qr,const f32x16&negm,int r32,int hi){
  const char*kb=Kslot+hi*1024+r32*16;
  #pragma unroll
  for(int d0=0;d0<4;++d0){
    const bf16x8 b0=*reinterpret_cast<const bf16x8*>(kb+d0*2048);
    const bf16x8 b1=*reinterpret_cast<const bf16x8*>(kb+d0*2048+512);
    if(d0==0){p0=__builtin_amdgcn_mfma_f32_32x32x16_bf16(b0,qr[0],negm,0,0,0);p1=__builtin_amdgcn_mfma_f32_32x32x16_bf16(b1,qr[0],negm,0,0,0);}
    else{p0=__builtin_amdgcn_mfma_f32_32x32x16_bf16(b0,qr[d0],p0,0,0,0);p1=__builtin_amdgcn_mfma_f32_32x32x16_bf16(b1,qr[d0],p1,0,0,0);}}
}
typedef __attribute__((address_space(3))) const char* lds_cptr;
typedef short v4i16_t __attribute__((ext_vector_type(4)));
__device__ __forceinline__ void kload8(bf16x8*kf,lds_cptr kp){
  kf[0]=*(const __attribute__((address_space(3))) bf16x8*)(kp);      kf[1]=*(const __attribute__((address_space(3))) bf16x8*)(kp+512);
  kf[2]=*(const __attribute__((address_space(3))) bf16x8*)(kp+2048); kf[3]=*(const __attribute__((address_space(3))) bf16x8*)(kp+2560);
  kf[4]=*(const __attribute__((address_space(3))) bf16x8*)(kp+4096); kf[5]=*(const __attribute__((address_space(3))) bf16x8*)(kp+4608);
  kf[6]=*(const __attribute__((address_space(3))) bf16x8*)(kp+6144); kf[7]=*(const __attribute__((address_space(3))) bf16x8*)(kp+6656);
}
__device__ __forceinline__ void kload2(bf16x8*kf,lds_cptr kp,int j){ kf[2*j]=*(const __attribute__((address_space(3))) bf16x8*)(kp+j*2048); kf[2*j+1]=*(const __attribute__((address_space(3))) bf16x8*)(kp+j*2048+512); }
__device__ __forceinline__ s16x4 vtr(lds_cptr p){ return __builtin_bit_cast(s16x4,__builtin_amdgcn_ds_read_tr16_b64_v4i16((__attribute__((address_space(3))) v4i16_t*)p)); }
__device__ __forceinline__ float rowmax(const f32x16&p0,const f32x16&p1){
  float a=max3f(p0[0],p0[1],p1[0]),b=max3f(p0[2],p0[3],p1[1]);a=max3f(a,p1[2],p1[3]);
  #pragma unroll
  for(int r=4;r<16;r+=4){a=max3f(a,p0[r],p0[r+1]);b=max3f(b,p0[r+2],p0[r+3]);a=max3f(a,p1[r],p1[r+1]);b=max3f(b,p1[r+2],p1[r+3]);}
  const float m=max2f(a,b);
  auto rr=__builtin_amdgcn_permlane32_swap(__float_as_uint(m),__float_as_uint(m),false,false);
  return max2f(__uint_as_float(rr[0]),__uint_as_float(rr[1]));
}
__device__ __forceinline__ void pv(f32x16*o,int vb,bf16x8 pa0,bf16x8 pa1,bf16x8 pa2,bf16x8 pa3){
  #pragma unroll
  for(int d0=0;d0<2;++d0){s16x4 lo[4],hi[4];
    #pragma unroll
    for(int ks=0;ks<4;++ks){
      asm volatile("ds_read_b64_tr_b16 %0,%1 offset:%c2":"=&v"(lo[ks]):"v"(vb),"i"(d0*4096+ks*1024):"memory");
      asm volatile("ds_read_b64_tr_b16 %0,%1 offset:%c2":"=&v"(hi[ks]):"v"(vb),"i"(d0*4096+ks*1024+512):"memory");}
    asm volatile("s_waitcnt lgkmcnt(0)":::"memory");SBAR();
    #define PK(k) (bf16x8){lo[k][0],lo[k][1],lo[k][2],lo[k][3],hi[k][0],hi[k][1],hi[k][2],hi[k][3]}
    o[d0]=__builtin_amdgcn_mfma_f32_32x32x16_bf16(pa0,PK(0),o[d0],0,0,0);
    o[d0]=__builtin_amdgcn_mfma_f32_32x32x16_bf16(pa1,PK(1),o[d0],0,0,0);
    o[d0]=__builtin_amdgcn_mfma_f32_32x32x16_bf16(pa2,PK(2),o[d0],0,0,0);
    o[d0]=__builtin_amdgcn_mfma_f32_32x32x16_bf16(pa3,PK(3),o[d0],0,0,0);
    #undef PK
  }
}

#ifndef ATTN_STORE16
#define ATTN_STORE16(p,v) (*(u32x4*)(p)=(v))
#endif
template<int THRL> __device__ __forceinline__ void attn_unit(int b,int h,int qb,const bf16*Q,const bf16*__restrict__ K,const bf16*__restrict__ V,unsigned char*Y,const float*kmean,char*shm){
  const int tid=threadIdx.x,lane=tid&63,r32=lane&31,hi=lane>>5; const int wid=__builtin_amdgcn_readfirstlane(tid>>6);
  const long rowbase=(long)b*SEQ; const int q0=qb*QB;
  const bf16*Qw=Q+(rowbase+q0+wid*QBLK)*DM+h*D;
  const bf16*Kh=K+rowbase*DM+h*D,*Vh=V+rowbase*DM+h*D;
  const unsigned lds0=(unsigned)(uintptr_t)shm;
  float*wsf=(float*)(shm+LDS_WS)+wid*64;
  const unsigned koff=(unsigned)((lane*DM+wid*8)*2);
  const unsigned voff=(unsigned)(((16*(wid&3)+(lane>>2))*DM+(wid>>2)*32+(lane&3)*8)*2);
  const unsigned kdst=lds0+LDS_K+wid*1024, vdst=lds0+LDS_V+wid*1024;
  #define DMA_K(t,slot) glds16(Kh+(long)(t)*KVBLK*DM,koff,(unsigned)__builtin_amdgcn_readfirstlane(kdst+(slot)))
  #define DMA_V(t,slot) glds16(Vh+(long)(t)*KVBLK*DM,voff,(unsigned)__builtin_amdgcn_readfirstlane(vdst+(slot)))
  const char*Kbase=shm+LDS_K; bf16x8 kf[8];
  const lds_cptr shm3=(lds_cptr)shm; const lds_cptr kp0=shm3+LDS_K+hi*1024+r32*16; const lds_cptr vp0=shm3+LDS_V+((lane>>4)&1)*32+(lane&3)*8+(4*hi+((lane&15)>>2))*64;
  const int NT=(q0+QB)/KVBLK;
  DMA_K(0,0);DMA_V(0,0);DMA_K(1,SLOTB);
  bf16x8 qr[4];
  #pragma unroll
  for(int d0=0;d0<4;++d0)qr[d0]=*reinterpret_cast<const bf16x8*>(&Qw[(long)r32*DM+d0*16+hi*8]);
  unsigned sel;
  if(qb<=3) sel=(1u<<qb)-1u;
  else{
    float*km=(float*)(shm+LDS_KM);
    if(tid<qb*64) km[tid]=kmean[(size_t)(b*8+(tid>>6))*512+h*64+(tid&63)];
    asm volatile("s_waitcnt vmcnt(0) lgkmcnt(0)\n\ts_barrier":::"memory");
    float g[7];
    #pragma unroll
    for(int n=0;n<7;++n){ g[n]=NEGB;
      if(n<qb){ float a=0.f;
        #pragma unroll
        for(int s=0;s<4;++s)
          #pragma unroll
          for(int jj=0;jj<8;++jj) a+=__uint_as_float((unsigned)(unsigned short)qr[s][jj]<<16)*km[n*64+16*s+8*hi+jj];
        a+=__shfl_xor(a,32); g[n]=a; } }
    sel=0u;
    #pragma unroll
    for(int r=0;r<3;++r){ float best=NEGB; int bi=0;
      #pragma unroll
      for(int n=0;n<7;++n) if(n<qb&&!((sel>>n)&1u)&&g[n]>best){best=g[n];bi=n;}
      sel|=1u<<bi; }
  }
  #define OKB(n) (((n)>=qb)||(((sel>>(n))&1u)!=0u))
  float mhat=0.f,l_reg=0.f;f32x16 o[2];o[0]=f32x16{};o[1]=f32x16{};f32x16 negm;
  { const bool ok0=OKB(0);
    #pragma unroll
    for(int r=0;r<16;++r)negm[r]=ok0?0.f:NEGB; }
  asm volatile("":"+v"(negm));
  const int qrel=wid*QBLK+r32;
  #define CMASK(P0,P1,t) do{int jb_=(t)-(NT-4); if(jb_>=0)cmask(P0,P1,jb_,qrel,hi);}while(0)
  bool resc=false;
  #define START(P0,P1) do{ const float rm=rowmax(P0,P1); resc=false; \
    { const bool ok0_=OKB(0); const float dl=ok0_?rm:0.f; mhat=fadd_s(mhat,dl); \
      _Pragma("unroll") for(int r=0;r<16;++r){P0[r]=fsub_s(P0[r],dl);P1[r]=fsub_s(P1[r],dl);} \
      _Pragma("unroll") for(int r=0;r<16;++r)negm[r]=ok0_?-mhat:NEGB; asm volatile("":"+v"(negm)); } \
    _Pragma("unroll") for(int r=0;r<16;++r)P0[r]=__builtin_amdgcn_exp2f(P0[r]); }while(0)
  #define RESC() do{ if(resc){ asm volatile("s_waitcnt lgkmcnt(0)":::"memory"); \
      _Pragma("unroll") for(int d_=0;d_<2;++d_) _Pragma("unroll") for(int r=0;r<16;++r)o[d_][r]*=wsf[crow(r,hi)]; } }while(0)
  f32x16 pA0,pA1,pB0,pB1;
  int sl_prev=0,sl_cur=0,sl_next=SLOTB;
  #define ROT() do{sl_prev=sl_cur;sl_cur=sl_next;sl_next=(sl_next==(NSLOT-1)*SLOTB)?0:sl_next+SLOTB;}while(0)
  DMA_K(2,2*SLOTB);
  WAIT_BAR(3);
  qkt(pA0,pA1,Kbase,qr,negm,r32,hi);asm volatile("s_nop 15\n\ts_nop 7":"+v"(pA0),"+v"(pA1));CMASK(pA0,pA1,0);
  START(pA0,pA1);
  _Pragma("unroll") for(int r=0;r<16;++r)pA1[r]=__builtin_amdgcn_exp2f(pA1[r]);
  WAIT_BAR(0);
  DMA_K(3,0);DMA_V(1,SLOTB);
  ROT();
  kload8(kf,kp0+sl_cur);
  WAIT_BAR(2);
  s16x4 vlo[8],vhi[8]; u32x4 pw0,pw1,pw2,pw3;
  #define PKW(P,B) cvtpk_s(P[B],P[B+1])
  #define PAF(k) __builtin_bit_cast(bf16x8,pw##k)
  #define VFR(i) (bf16x8){vlo[i][0],vlo[i][1],vlo[i][2],vlo[i][3],vhi[i][0],vhi[i][1],vhi[i][2],vhi[i][3]}
  #define PIN(x) asm volatile("":"+v"(x))
  #define MX3(a,b,c) __builtin_fmaxf(__builtin_fmaxf((a),(b)),(c))
  #define GAPA(MF,A0,A1,A2,A3,W0,W1,PW) do{ MF; sacc+=A0; sacc+=A1; sacc+=A2; sacc+=A3; PIN(sacc); W0; W1; PIN(PW); SBAR(); }while(0)
  #define EX(v) __builtin_amdgcn_exp2f(v)
  #define GAPB(MF,X,B) do{ MF; X[B]=EX(X[B]); X[B+1]=EX(X[B+1]); X[B+2]=EX(X[B+2]); X[B+3]=EX(X[B+3]); PIN(X); SBAR(); }while(0)
  #define VRD(i) do{ vlo[i]=vtr(vp_+(((i)>>2)*4096+((i)&3)*1024)); vhi[i]=vtr(vp_+(((i)>>2)*4096+((i)&3)*1024+512)); }while(0)
  #define KRD(G,j) do{ if(G){ kload2(kf,kp0+sl_next,j); SBAR(); } }while(0)
  #define STEP(C0,C1,P0,P1,t,GK,GV,GL) do{ SBAR(); \
    const lds_cptr vp_=vp0+sl_prev; \
    VRD(0); SBAR(); float sacc=(P0[0]+P0[1]); \
    GAPA(C0=__builtin_amdgcn_mfma_f32_32x32x16_bf16(kf[0],qr[0],negm,0,0,0), P0[2],P0[3],P0[4],P0[5],     pw0[0]=PKW(P0,0), pw0[1]=PKW(P0,2), pw0); \
    VRD(4); SBAR(); GAPA(C1=__builtin_amdgcn_mfma_f32_32x32x16_bf16(kf[1],qr[0],negm,0,0,0), P0[6],P0[7],P0[8],P0[9],     pw0[2]=PKW(P0,4), pw0[3]=PKW(P0,6), pw0); \
    VRD(1); SBAR(); GAPA(C0=__builtin_amdgcn_mfma_f32_32x32x16_bf16(kf[2],qr[1],C0,0,0,0),   P0[10],P0[11],P0[12],P0[13], pw1[0]=PKW(P0,8), pw1[1]=PKW(P0,10), pw1); \
    VRD(5); SBAR(); GAPA(C1=__builtin_amdgcn_mfma_f32_32x32x16_bf16(kf[3],qr[1],C1,0,0,0),   P0[14],P0[15],P1[0],P1[1],   pw1[2]=PKW(P0,12),pw1[3]=PKW(P0,14), pw1); \
    VRD(2); SBAR(); GAPA(C0=__builtin_amdgcn_mfma_f32_32x32x16_bf16(kf[4],qr[2],C0,0,0,0),   P1[2],P1[3],P1[4],P1[5],     pw2[0]=PKW(P1,0), pw2[1]=PKW(P1,2), pw2); \
    VRD(6); SBAR(); GAPA(C1=__builtin_amdgcn_mfma_f32_32x32x16_bf16(kf[5],qr[2],C1,0,0,0),   P1[6],P1[7],P1[8],P1[9],     pw2[2]=PKW(P1,4), pw2[3]=PKW(P1,6), pw2); \
    VRD(3); SBAR(); GAPA(C0=__builtin_amdgcn_mfma_f32_32x32x16_bf16(kf[6],qr[3],C0,0,0,0),   P1[10],P1[11],P1[12],P1[13], pw3[0]=PKW(P1,8), pw3[1]=PKW(P1,10), pw3); \
    VRD(7); SBAR(); GAPA(C1=__builtin_amdgcn_mfma_f32_32x32x16_bf16(kf[7],qr[3],C1,0,0,0),   P1[14],P1[15],0.f,0.f,       pw3[2]=PKW(P1,12),pw3[3]=PKW(P1,14), pw3); \
    l_reg+=sacc; \
    if(GK){DMA_K((t)+3,sl_cur);} if(GV){DMA_V((t)+1,sl_next);} \
    CMASK(C0,C1,t); \
    { float a=MX3(C0[0],C0[1],C1[0]),b=MX3(C0[2],C0[3],C1[1]); a=MX3(a,C1[2],C1[3]); \
      _Pragma("unroll") for(int r=4;r<16;r+=4){a=MX3(a,C0[r],C0[r+1]);b=MX3(b,C0[r+2],C0[r+3]);a=MX3(a,C1[r],C1[r+1]);b=MX3(b,C1[r+2],C1[r+3]);} \
      float rm=__builtin_fmaxf(a,b); { auto rr=__builtin_amdgcn_permlane32_swap(__float_as_uint(rm),__float_as_uint(rm),false,false); rm=__builtin_fmaxf(__uint_as_float(rr[0]),__uint_as_float(rr[1])); } \
      resc=false; \
      if(__builtin_expect(__any(rm>(float)THRL),0)){ const float dl=__builtin_fmaxf(rm,0.f); mhat+=dl; \
        _Pragma("unroll") for(int r=0;r<16;++r){C0[r]-=dl;C1[r]-=dl;} \
        const float f=__builtin_amdgcn_exp2f(-dl); l_reg*=f; if(hi==0)wsf[r32]=f; resc=true; } \
      if(resc||((((t)+1)&3)==0)){ const bool okn_=OKB(((t)+1)>>2);   \
        _Pragma("unroll") for(int r=0;r<16;++r)negm[r]=okn_?-mhat:NEGB; asm volatile("":"+v"(negm)); } } \
    SBAR(); \
    GAPB(o[0]=__builtin_amdgcn_mfma_f32_32x32x16_bf16(PAF(0),VFR(0),o[0],0,0,0), C0,0); \
    GAPB(o[1]=__builtin_amdgcn_mfma_f32_32x32x16_bf16(PAF(0),VFR(4),o[1],0,0,0), C0,4); \
    KRD(GL,0); GAPB(o[0]=__builtin_amdgcn_mfma_f32_32x32x16_bf16(PAF(1),VFR(1),o[0],0,0,0), C0,8); \
    KRD(GL,1); GAPB(o[1]=__builtin_amdgcn_mfma_f32_32x32x16_bf16(PAF(1),VFR(5),o[1],0,0,0), C0,12); \
    KRD(GL,2); GAPB(o[0]=__builtin_amdgcn_mfma_f32_32x32x16_bf16(PAF(2),VFR(2),o[0],0,0,0), C1,0); \
    KRD(GL,3); GAPB(o[1]=__builtin_amdgcn_mfma_f32_32x32x16_bf16(PAF(2),VFR(6),o[1],0,0,0), C1,4); \
    GAPB(o[0]=__builtin_amdgcn_mfma_f32_32x32x16_bf16(PAF(3),VFR(3),o[0],0,0,0), C1,8); \
    GAPB(o[1]=__builtin_amdgcn_mfma_f32_32x32x16_bf16(PAF(3),VFR(7),o[1],0,0,0), C1,12); \
    }while(0)
  int t=1;
  #undef CMASK
  #define CMASK(P0,P1,t) do{}while(0)
  for(;t+5<NT;t+=2){
    STEP(pB0,pB1,pA0,pA1,t,true,true,true);     WAIT_BAR(2); RESC(); ROT();
    STEP(pA0,pA1,pB0,pB1,t+1,true,true,true);   WAIT_BAR(2); RESC(); ROT();
  }
  #undef CMASK
  const int lane_b=(int)__builtin_amdgcn_mbcnt_hi(~0u,__builtin_amdgcn_mbcnt_lo(~0u,0u)), hi_b=lane_b>>5, qrel_b=wid*QBLK+(lane_b&31);
  #define CMASK(P0,P1,t) do{int jb_=(t)-(NT-4); if(jb_>=0)cmask(P0,P1,jb_,qrel_b,hi_b);}while(0)
  #define ENDW(tt) do{ if((tt)+3<NT){WAIT_BAR(2);} else if((tt)+2<NT){WAIT_BAR(1);} else {WAIT_BAR(0);} }while(0)
  for(;t+1<NT;t+=2){
    STEP(pB0,pB1,pA0,pA1,t,(t+3<NT),(t+1<NT),(t+1<NT));       ENDW(t);   RESC(); ROT();
    STEP(pA0,pA1,pB0,pB1,t+1,(t+4<NT),(t+2<NT),(t+2<NT));     ENDW(t+1); RESC(); ROT();
  }
  STEP(pB0,pB1,pA0,pA1,NT-1,false,false,false); RESC();
  { float sacc=pB0[0]+pB0[1]; _Pragma("unroll") for(int r=2;r<16;++r)sacc+=pB0[r]; _Pragma("unroll") for(int r=0;r<16;++r)sacc+=pB1[r]; l_reg+=sacc;
    pw0=(u32x4){PKW(pB0,0),PKW(pB0,2),PKW(pB0,4),PKW(pB0,6)};pw1=(u32x4){PKW(pB0,8),PKW(pB0,10),PKW(pB0,12),PKW(pB0,14)};pw2=(u32x4){PKW(pB1,0),PKW(pB1,2),PKW(pB1,4),PKW(pB1,6)};pw3=(u32x4){PKW(pB1,8),PKW(pB1,10),PKW(pB1,12),PKW(pB1,14)};
    const int vb0=(int)(lds0+LDS_V)+((lane>>4)&1)*32+(lane&3)*8+(4*hi+((lane&15)>>2))*64;
    SBAR(); pv(o,vb0+sl_cur,PAF(0),PAF(1),PAF(2),PAF(3)); }
  #undef PKW
  #undef PAF
  #undef VFR
  #undef PIN
  #undef MX3
  #undef GAPA
  #undef GAPB
  #undef EX
  #undef VRD
  #undef KRD
  #undef STEP
  #undef ENDW
  {auto rr=__builtin_amdgcn_permlane32_swap(__float_as_uint(l_reg),__float_as_uint(l_reg),false,false);l_reg=__uint_as_float(rr[0])+__uint_as_float(rr[1]);}
  if(hi==0)wsf[32+r32]=l_reg;asm volatile("s_waitcnt lgkmcnt(0)":::"memory");
  float rli[16];
  #pragma unroll
  for(int r=0;r<16;++r)rli[r]=__builtin_amdgcn_rcpf(wsf[32+crow(r,hi)])*YSC;
  unsigned char*Yw=Y+(size_t)(rowbase+q0+wid*QBLK)*2048+h*D;
  { unsigned char*stg=(unsigned char*)(shm+LDS_OST)+wid*4096;
    #pragma unroll
    for(int r=0;r<16;++r){const int orow=crow(r,hi);
      const float a0=__builtin_fminf(__builtin_fmaxf(o[0][r]*rli[r],-448.f),448.f),a1=__builtin_fminf(__builtin_fmaxf(o[1][r]*rli[r],-448.f),448.f);
      const unsigned pk=(unsigned)__builtin_amdgcn_cvt_pk_fp8_f32(a0,a1,0,false);
      stg[orow*64+r32]=(unsigned char)(pk&0xffu); stg[orow*64+32+r32]=(unsigned char)((pk>>8)&0xffu);}
    asm volatile("s_waitcnt lgkmcnt(0)":::"memory");
    #pragma unroll
    for(int i=0;i<2;++i){const int row=i*16+(lane>>2),ch=lane&3; const u32x4 v=*(const u32x4*)(stg+row*64+ch*16); *(u32x4*)(Yw+(size_t)row*2048+ch*16)=v;} }
  asm volatile("s_waitcnt lgkmcnt(0)\n\ts_barrier":::"memory");
  #undef DMA_K
  #undef DMA_V
  #undef CMASK
  #undef START
  #undef RESC
  #undef ROT
  #undef OKB
}
#undef SBAR
#undef WAIT_BAR
#ifdef ATTN_STORE16
#undef ATTN_STORE16
#endif
}

namespace mls {
constexpr int RS = 272, TS = 144;
constexpr float CSC = 8.f, CSC_INV = 0.125f;
struct MW { unsigned char* CC; unsigned char* CP; float* NC; float* NP; float* SC; float* MP; };
__device__ __forceinline__ int cslot(int bh, int c) { return (c + bh) & 31; }
__device__ __forceinline__ float fsilu(float x) { return x * __builtin_amdgcn_rcpf(1.f + __builtin_amdgcn_exp2f(-1.4426950408889634f * x)); }
__device__ __forceinline__ void vt_write(LAS unsigned char* dst, const u32x4 a, const u32x4 bq) {
    *(LAS unsigned*)(dst + 0 * TS) = (a.x & 0xffffu) | (bq.x << 16); *(LAS unsigned*)(dst + 1 * TS) = (a.x >> 16) | (bq.x & 0xffff0000u);
    *(LAS unsigned*)(dst + 2 * TS) = (a.y & 0xffffu) | (bq.y << 16); *(LAS unsigned*)(dst + 3 * TS) = (a.y >> 16) | (bq.y & 0xffff0000u);
    *(LAS unsigned*)(dst + 4 * TS) = (a.z & 0xffffu) | (bq.z << 16); *(LAS unsigned*)(dst + 5 * TS) = (a.z >> 16) | (bq.z & 0xffff0000u);
    *(LAS unsigned*)(dst + 6 * TS) = (a.w & 0xffffu) | (bq.w << 16); *(LAS unsigned*)(dst + 7 * TS) = (a.w >> 16) | (bq.w & 0xffff0000u);
}
constexpr int XKWT = 0, XVT = 18432, XCW = 36864;
__device__ __forceinline__ void x_setup(Frame& F, const float* conv_w, const float* conv_b) {
    __syncthreads();
    for (int i = F.tid; i < 5 * 512; i += NTHR) { const int j = i >> 9, ch = i & 511; ((LAS float*)(F.lds + XCW))[i] = (j < 4) ? conv_w[j * 1024 + 512 + ch] : conv_b[512 + ch]; }
    __syncthreads();
}
struct XL { u32x4 raw[5], vr0, vr1; float li, lf; };
__device__ __forceinline__ void x_load(XL& L, const Frame& F, const bf16_t* proj, const float* gates, int u) {
    const int tid = F.tid, c = u & 31, bh = u >> 5, b = bh >> 2, h = bh & 3; const size_t rb = (size_t)b * SEQ;
    const int cc = tid & 15, rp = tid >> 4, tp = tid & 31, ec = tid >> 5;
#pragma unroll
    for (int i = 0; i < 5; ++i) { const int pos = c * 64 + 2 * rp - 3 + i;
        if (pos >= 0) L.raw[i] = *(const u32x4*)(proj + (rb + pos) * NIN + C_LK + h * 128 + 8 * cc); else L.raw[i] = (u32x4){0u, 0u, 0u, 0u}; }
    L.vr0 = *(const u32x4*)(proj + (rb + c * 64 + 2 * tp) * NIN + C_LV + h * 128 + 8 * ec); L.vr1 = *(const u32x4*)(proj + (rb + c * 64 + 2 * tp + 1) * NIN + C_LV + h * 128 + 8 * ec);
    L.li = gates[(rb + c * 64 + F.lane) * 8 + h]; L.lf = gates[(rb + c * 64 + F.lane) * 8 + 4 + h];
}
__device__ __forceinline__ void x_unit(Frame& F, const bf16_t* proj, const float* gates, const MW& W, int u, XL& cur, XL& nxt, bool has_next, int un) {
    LAS unsigned char* lds = F.lds; const int tid = F.tid, lane = F.lane, r32 = lane & 31, hh = lane >> 5, w = F.wave;
    const int bh = u >> 5, h = bh & 3;
    const int cc = tid & 15, rp = tid >> 4, tp = tid & 31, ec = tid >> 5;
    u32x4 raw[5];
#pragma unroll
    for (int i = 0; i < 5; ++i) raw[i] = cur.raw[i];
    const u32x4 vr0 = cur.vr0, vr1 = cur.vr1; const float li = cur.li, lf = cur.lf;
    const float bcs = scan64<false>(lf), cs = li - bcs, pm = scan64<true>(cs);
    const float blast = lane63(bcs), amax = blast + lane63(pm);
    const float wa = __expf(blast + cs - amax);
    LBAR();
    {   const LAS float* cw = (const LAS float*)(lds + XCW) + h * 128 + 8 * cc;
        u32x4 pk[2];
#pragma unroll
        for (int r = 0; r < 2; ++r) {
            f32x4 oa = *(const LAS f32x4*)(cw + 4 * 512), ob = *(const LAS f32x4*)(cw + 4 * 512 + 4);
#pragma unroll
            for (int j = 0; j < 4; ++j) { const u32x4 uu = raw[r + j]; const f32x4 wa4 = *(const LAS f32x4*)(cw + j * 512), wb4 = *(const LAS f32x4*)(cw + j * 512 + 4);
                oa += wa4 * (f32x4){bflo(uu.x), bfhi(uu.x), bflo(uu.y), bfhi(uu.y)}; ob += wb4 * (f32x4){bflo(uu.z), bfhi(uu.z), bflo(uu.w), bfhi(uu.w)}; }
            const float ws = __shfl(wa, 2 * rp + r) * 0.08838834764831845f;
#pragma unroll
            for (int i = 0; i < 4; ++i) { oa[i] = fsilu(oa[i]) * ws; ob[i] = fsilu(ob[i]) * ws; }
            pk[r].x = cvtpk(oa[0], oa[1]); pk[r].y = cvtpk(oa[2], oa[3]); pk[r].z = cvtpk(ob[0], ob[1]); pk[r].w = cvtpk(ob[2], ob[3]);
        }
#pragma unroll
        for (int i = 0; i < 8; ++i) { const int sh = 16 * (i & 1); const unsigned e0 = (pk[0][i >> 1] >> sh) & 0xffffu, e1 = (pk[1][i >> 1] >> sh) & 0xffffu;
            *(LAS unsigned*)(lds + XKWT + (8 * cc + i) * TS + (2 * rp) * 2) = e0 | (e1 << 16); }
        vt_write(lds + XVT + (8 * ec) * TS + (2 * tp) * 2, vr0, vr1);
    }
    if (has_next) x_load(nxt, F, proj, gates, un);
    LBAR();
#pragma unroll
    for (int i = 0; i < 2; ++i) { const int T = 2 * w + i, dt = T >> 2, e2 = T & 3;
        f32x16 acc;
#pragma unroll
        for (int r = 0; r < 16; ++r) acc[r] = 0.f;
#pragma unroll
        for (int k = 0; k < 4; ++k) { const bf16x8 a = *(const LAS bf16x8*)(lds + XKWT + (32 * dt + r32) * TS + (16 * k + 8 * hh) * 2);
            const bf16x8 bv = *(const LAS bf16x8*)(lds + XVT + (32 * e2 + r32) * TS + (16 * k + 8 * hh) * 2);
            acc = __builtin_amdgcn_mfma_f32_32x32x16_bf16(a, bv, acc, 0, 0, 0); }
        unsigned char* dst = W.CC + (size_t)((u & ~31) + cslot(u >> 5, u & 31)) * 16384 + (size_t)(32 * e2 + r32) * 128 + 32 * dt + 4 * hh;
#pragma unroll
        for (int g = 0; g < 4; ++g) *(unsigned*)(dst + 8 * g) = pg8::pack_fp8x4(acc[4 * g] * CSC, acc[4 * g + 1] * CSC, acc[4 * g + 2] * CSC, acc[4 * g + 3] * CSC); }
    if (tid < 128) { float sN = 0.f;
#pragma unroll
        for (int k = 0; k < 8; ++k) { const u32x4 uu = *(const LAS u32x4*)(lds + XKWT + tid * TS + k * 16);
            sN += (bflo(uu.x) + bfhi(uu.x)) + (bflo(uu.y) + bfhi(uu.y)) + (bflo(uu.z) + bfhi(uu.z)) + (bflo(uu.w) + bfhi(uu.w)); }
        W.NC[(size_t)u * 128 + tid] = sN; }
    if (tid == 0) { W.SC[u * 2] = blast; W.SC[u * 2 + 1] = amax; }
}
constexpr int YK = 4, CONV_Y = YK * 4 * 256;
template <int GRP>
__device__ __forceinline__ void y_phase(Frame& F, const MW& W) {
    for (int base = blockIdx.x * 256; base < 32 * 2048; base += F.G * 256) {
        if (F.tid >= 256) {
            if (base == (int)blockIdx.x * 256 && F.G == 256) {
#pragma unroll 1
                for (int k = 0; k < YK; ++k) conv_item<GRP>(F, (int)blockIdx.x * 4 + (F.wave - 4) + k * 1024);
            }
            continue; }
        const int bh = base >> 11, g = (base & 2047) + F.tid, e = g >> 4, d8 = (g & 15) * 8;
        const float* sc = W.SC + (size_t)bh * 64;
        const size_t off = (size_t)bh * 32 * 16384 + (size_t)e * 128 + d8;
        u32x2 v[32];
#pragma unroll
        for (int c = 0; c < 32; ++c) v[c] = __builtin_nontemporal_load((const u32x2*)(W.CC + off + (size_t)cslot(bh, c) * 16384));
        const bool nsc = (g < 32);
        f32x4 nv[32];
        if (nsc) {
#pragma unroll
            for (int c = 0; c < 32; ++c) nv[c] = *(const f32x4*)(W.NC + ((size_t)bh * 32 + c) * 128 + g * 4); }
        float C[8];
#pragma unroll
        for (int i = 0; i < 8; ++i) C[i] = 0.f;
        float m = 0.f;
#pragma unroll
        for (int c = 0; c < 32; ++c) {
            u32x2 o; o.x = pg8::pack_fp8x4(C[0], C[1], C[2], C[3]); o.y = pg8::pack_fp8x4(C[4], C[5], C[6], C[7]); *(u32x2*)(W.CP + off + (size_t)cslot(bh, c) * 16384) = o;
            const float bl = sc[2 * c], am = sc[2 * c + 1], mn = fmaxf(bl + m, am), dec = __expf(bl + m - mn), inj = __expf(am - mn);
            const auto x0 = __builtin_amdgcn_cvt_pk_f32_fp8((int)v[c].x, false), x1 = __builtin_amdgcn_cvt_pk_f32_fp8((int)v[c].x, true), x2 = __builtin_amdgcn_cvt_pk_f32_fp8((int)v[c].y, false), x3 = __builtin_amdgcn_cvt_pk_f32_fp8((int)v[c].y, true);
            C[0] = C[0] * dec + x0[0] * inj; C[1] = C[1] * dec + x0[1] * inj; C[2] = C[2] * dec + x1[0] * inj; C[3] = C[3] * dec + x1[1] * inj;
            C[4] = C[4] * dec + x2[0] * inj; C[5] = C[5] * dec + x2[1] * inj; C[6] = C[6] * dec + x3[0] * inj; C[7] = C[7] * dec + x3[1] * inj; m = mn; }
        if (nsc) {
            f32x4 N = (f32x4){0.f, 0.f, 0.f, 0.f}; float mm = 0.f;
#pragma unroll
            for (int c = 0; c < 32; ++c) {
                *(f32x4*)(W.NP + ((size_t)bh * 32 + c) * 128 + g * 4) = N; if (g == 0) W.MP[bh * 32 + c] = mm;
                const float bl = sc[2 * c], am = sc[2 * c + 1], mn = fmaxf(bl + mm, am), dec = __expf(bl + mm - mn), inj = __expf(am - mn);
                N = N * dec + nv[c] * inj; mm = mn; }
        }
    }
}
constexpr int QS = 0, QW = 17408, KS = 34816, ZCW = 52224  , VT = 72704, CB = 91136, NS = 125952, CSO = 126464, SSQ = 126720, ZNW = 127744  ;
struct Pre { u32x4 raw[7]; u32x4 vr[2]; float li, lf; };
__device__ __forceinline__ void prefetch(Pre& P, const bf16_t* proj, const float* gates, size_t rb, int c, int h, int tid, int lane) {
    const int cc = tid & 31, rg = tid >> 5;
    const int col = (cc < 16) ? (C_LQ + h * 128 + 8 * cc) : (C_LK + h * 128 + 8 * (cc - 16));
#pragma unroll
    for (int i = 0; i < 7; ++i) { const int pos = c * 64 + 4 * rg - 3 + i;
        if (pos >= 0) P.raw[i] = *(const u32x4*)(proj + (rb + pos) * NIN + col); else P.raw[i] = (u32x4){0u, 0u, 0u, 0u}; }
    const int tp = tid & 31, ec = tid >> 5;
    P.vr[0] = *(const u32x4*)(proj + (rb + c * 64 + 2 * tp) * NIN + C_LV + h * 128 + 8 * ec);
    P.vr[1] = *(const u32x4*)(proj + (rb + c * 64 + 2 * tp + 1) * NIN + C_LV + h * 128 + 8 * ec);
    P.li = gates[(rb + c * 64 + lane) * 8 + h]; P.lf = gates[(rb + c * 64 + lane) * 8 + 4 + h];
}
__device__ __forceinline__ void z_setup(Frame& F, const float* conv_w, const float* conv_b, const float* normw) {
    __syncthreads();
    for (int i = F.tid; i < 5 * 1024; i += NTHR) { const int j = i >> 10, ch = i & 1023; ((LAS float*)(F.lds + ZCW))[i] = (j < 4) ? conv_w[j * 1024 + ch] : conv_b[ch]; }
    ((LAS float*)(F.lds + ZNW))[F.tid] = normw[F.tid];
    __syncthreads();
}
struct ZL { Pre P; u32x4 cpv[2]; float npv, mprev; u32x2 og[4]; };
__device__ __forceinline__ void z_load(ZL& L, const Frame& F, const bf16_t* proj, const float* gates, const MW& W, int u) {
    const int tid = F.tid, lane = F.lane, r32 = lane & 31, hh = lane >> 5, w = F.wave, et = w & 3, tt = w >> 2;
    const int c = u & 31, bh = u >> 5, b = bh >> 2, h = bh & 3; const size_t rb = (size_t)b * SEQ, r0 = rb + (size_t)c * 64; const int trow = 32 * tt + r32;
    prefetch(L.P, proj, gates, rb, c, h, tid, lane);
#pragma unroll
    for (int i = 0; i < 2; ++i) L.cpv[i] = __builtin_nontemporal_load((const u32x4*)(W.CP + (size_t)((u & ~31) + cslot(u >> 5, u & 31)) * 16384 + (size_t)(tid + i * NTHR) * 16));
    L.npv = (tid < 128) ? W.NP[(size_t)u * 128 + tid] : 0.f; L.mprev = W.MP[u];
#pragma unroll
    for (int g = 0; g < 4; ++g) L.og[g] = *(const u32x2*)(proj + (r0 + trow) * NIN + C_LO + h * 128 + 32 * et + 8 * g + 4 * hh);
}
__device__ __forceinline__ void z_unit(Frame& F, const bf16_t* proj, const float* gates, const MW& W, unsigned char* Y, int u, ZL& cur, ZL& nxt, bool has_next, int un) {
    LAS unsigned char* lds = F.lds; const int tid = F.tid, lane = F.lane, r32 = lane & 31, hh = lane >> 5, w = F.wave, et = w & 3, tt = w >> 2;
    const int c = u & 31, bh = u >> 5, b = bh >> 2, h = bh & 3; const size_t rb = (size_t)b * SEQ, r0 = rb + (size_t)c * 64;
    const int trow = 32 * tt + r32;
    const Pre P = cur.P;
    u32x4 cpv[2];
#pragma unroll
    for (int i = 0; i < 2; ++i) cpv[i] = cur.cpv[i];
    const float npv = cur.npv, mprev = cur.mprev;
    u32x2 og[4];
#pragma unroll
    for (int g = 0; g < 4; ++g) og[g] = cur.og[g];
    const float bcs = scan64<false>(P.lf), cs = P.li - bcs, pm = scan64<true>(cs);
    const float il = bcs + mprev, mo = fmaxf(il, bcs + pm), wi = __expf(il - mo);
    const float rt = __shfl(bcs - mo, trow), eo = __shfl(__expf(-mo), trow);
    LBAR();
    if (w == 0) ((LAS float*)(lds + CSO))[lane] = cs;
#pragma unroll
    for (int i = 0; i < 2; ++i) { const int ci = tid + i * NTHR, e = ci >> 3, part = ci & 7;
        unsigned wv[8];
#pragma unroll
        for (int q = 0; q < 4; ++q) { const int uq = (int)cpv[i][q]; const auto lo = __builtin_amdgcn_cvt_pk_f32_fp8(uq, false), hi = __builtin_amdgcn_cvt_pk_f32_fp8(uq, true);
            wv[2 * q] = cvtpk(lo[0] * CSC_INV, lo[1] * CSC_INV); wv[2 * q + 1] = cvtpk(hi[0] * CSC_INV, hi[1] * CSC_INV); }
        u32x4 w0, w1; w0.x = wv[0]; w0.y = wv[1]; w0.z = wv[2]; w0.w = wv[3]; w1.x = wv[4]; w1.y = wv[5]; w1.z = wv[6]; w1.w = wv[7];
        *(LAS u32x4*)(lds + CB + e * RS + part * 32) = w0; *(LAS u32x4*)(lds + CB + e * RS + part * 32 + 16) = w1; }
    if (tid < 128) ((LAS float*)(lds + NS))[tid] = npv;
    {
        const int cc = tid & 31, rg = tid >> 5; const bool isk = cc >= 16; const int dcol = 8 * (cc & 15);
        const LAS float* cw = (const LAS float*)(lds + ZCW) + (isk ? 512 : 0) + h * 128 + dcol;
        const float ksc = isk ? 0.08838834764831845f : 1.f;
#pragma unroll
        for (int r = 0; r < 4; ++r) {
            f32x4 oa = *(const LAS f32x4*)(cw + 4 * 1024), ob = *(const LAS f32x4*)(cw + 4 * 1024 + 4);
#pragma unroll
            for (int j = 0; j < 4; ++j) { const u32x4 uu = P.raw[r + j]; const f32x4 wa4 = *(const LAS f32x4*)(cw + j * 1024), wb4 = *(const LAS f32x4*)(cw + j * 1024 + 4);
                oa += wa4 * (f32x4){bflo(uu.x), bfhi(uu.x), bflo(uu.y), bfhi(uu.y)}; ob += wb4 * (f32x4){bflo(uu.z), bfhi(uu.z), bflo(uu.w), bfhi(uu.w)}; }
#pragma unroll
            for (int i = 0; i < 4; ++i) { oa[i] = fsilu(oa[i]) * ksc; ob[i] = fsilu(ob[i]) * ksc; }
            const int t = 4 * rg + r; const float ws = __shfl(wi, t);
            u32x4 wv; wv.x = cvtpk(oa[0], oa[1]); wv.y = cvtpk(oa[2], oa[3]); wv.z = cvtpk(ob[0], ob[1]); wv.w = cvtpk(ob[2], ob[3]);
            *(LAS u32x4*)(lds + (isk ? KS : QS) + t * RS + dcol * 2) = wv;
            if (!isk) { u32x4 v; v.x = cvtpk(oa[0] * ws, oa[1] * ws); v.y = cvtpk(oa[2] * ws, oa[3] * ws); v.z = cvtpk(ob[0] * ws, ob[1] * ws); v.w = cvtpk(ob[2] * ws, ob[3] * ws);
                *(LAS u32x4*)(lds + QW + t * RS + dcol * 2) = v; }
            asm volatile("" ::: "memory");
        }
        vt_write(lds + VT + (8 * (tid >> 5)) * TS + (2 * (tid & 31)) * 2, P.vr[0], P.vr[1]);
    }
    if (has_next) z_load(nxt, F, proj, gates, W, un);
    LBAR();
    f32x16 acc;
#pragma unroll
    for (int r = 0; r < 16; ++r) acc[r] = 0.f;
    float den = 0.f;
    for (int st = 0; st <= tt; ++st) {
        f32x16 S;
#pragma unroll
        for (int r = 0; r < 16; ++r) S[r] = 0.f;
#pragma unroll
        for (int k = 0; k < 8; ++k) { const bf16x8 a = *(const LAS bf16x8*)(lds + KS + (32 * st + r32) * RS + (16 * k + 8 * hh) * 2); const bf16x8 qk = *(const LAS bf16x8*)(lds + QS + trow * RS + (16 * k + 8 * hh) * 2); S = __builtin_amdgcn_mfma_f32_32x32x16_bf16(a, qk, S, 0, 0, 0); }
        const LAS float* csp = (const LAS float*)(lds + CSO) + 32 * st + 4 * hh;
#pragma unroll
        for (int r = 0; r < 16; ++r) { const int so = (r & 3) + 8 * (r >> 2); const float cv = csp[so];
            const bool ok = (st < tt) || (so + 4 * hh <= r32);
            const float p = ok ? S[r] * __expf(rt + cv) : 0.f; S[r] = p; den += p; }
#pragma unroll
        for (int k2 = 0; k2 < 2; ++k2) {
            u32x4 pw; pw.x = cvtpk(S[8 * k2 + 0], S[8 * k2 + 1]); pw.y = cvtpk(S[8 * k2 + 2], S[8 * k2 + 3]); pw.z = cvtpk(S[8 * k2 + 4], S[8 * k2 + 5]); pw.w = cvtpk(S[8 * k2 + 6], S[8 * k2 + 7]);
            const LAS unsigned char* vp = lds + VT + (32 * et + r32) * TS + (32 * st + 16 * k2 + 4 * hh) * 2;
            const u32x2 lo = *(const LAS u32x2*)vp, hi = *(const LAS u32x2*)(vp + 16); u32x4 aw; aw.x = lo.x; aw.y = lo.y; aw.z = hi.x; aw.w = hi.y;
            acc = __builtin_amdgcn_mfma_f32_32x32x16_bf16(__builtin_bit_cast(bf16x8, aw), __builtin_bit_cast(bf16x8, pw), acc, 0, 0, 0); }
    }
    {
        const LAS float* nsp = (const LAS float*)(lds + NS);
#pragma unroll
        for (int k = 0; k < 8; ++k) {
            const bf16x8 a = *(const LAS bf16x8*)(lds + CB + (32 * et + r32) * RS + (16 * k + 8 * hh) * 2);
            const bf16x8 bq = *(const LAS bf16x8*)(lds + QW + trow * RS + (16 * k + 8 * hh) * 2);
            acc = __builtin_amdgcn_mfma_f32_32x32x16_bf16(a, bq, acc, 0, 0, 0);
            const f32x4 n0 = *(const LAS f32x4*)(nsp + 16 * k + 8 * hh), n1 = *(const LAS f32x4*)(nsp + 16 * k + 8 * hh + 4);
            den += bf1((bf16_t)bq[0]) * n0[0] + bf1((bf16_t)bq[1]) * n0[1] + bf1((bf16_t)bq[2]) * n0[2] + bf1((bf16_t)bq[3]) * n0[3]
                 + bf1((bf16_t)bq[4]) * n1[0] + bf1((bf16_t)bq[5]) * n1[1] + bf1((bf16_t)bq[6]) * n1[2] + bf1((bf16_t)bq[7]) * n1[3]; }
    }
    den += __shfl_xor(den, 32);
    const float hinv = 1.f / fmaxf(fabsf(den), eo);
    float ssq = 0.f;
#pragma unroll
    for (int r = 0; r < 16; ++r) { acc[r] *= hinv; ssq += acc[r] * acc[r]; }
    ssq += __shfl_xor(ssq, 32);
    if (hh == 0) ((LAS float*)(lds + SSQ))[et * 64 + trow] = ssq;
    LBAR();
    {
        const LAS float* sq = (const LAS float*)(lds + SSQ) + trow;
        const float tot = (sq[0] + sq[64]) + (sq[128] + sq[192]);
        const float rn = att::YSC / sqrtf(tot * (1.f / 128.f) + RMS_EPS);
        unsigned char* yrow = Y + (r0 + trow) * D + 512 + h * 128 + 32 * et + 4 * hh;
#pragma unroll
        for (int g = 0; g < 4; ++g) { const f32x4 nwg = *(const LAS f32x4*)(lds + ZNW + (h * 128 + 32 * et + 8 * g + 4 * hh) * 4); const float o0 = bflo(og[g].x), o1 = bfhi(og[g].x), o2 = bflo(og[g].y), o3 = bfhi(og[g].y);
            *(unsigned*)(yrow + 8 * g) = pg8::pack_fp8x4(acc[4 * g] * rn * nwg[0] * sigmoid_f(o0), acc[4 * g + 1] * rn * nwg[1] * sigmoid_f(o1), acc[4 * g + 2] * rn * nwg[2] * sigmoid_f(o2), acc[4 * g + 3] * rn * nwg[3] * sigmoid_f(o3)); }
    }
}
}

__device__ __forceinline__ int wq_pull(Frame& F, unsigned* qctr) {
    volatile LAS int* slot = (volatile LAS int*)(F.lds + LDSCTL_OFF + 256);
    __syncthreads();
    if (F.tid == 0) *slot = (int)__hip_atomic_fetch_add(qctr, 1u, __ATOMIC_RELAXED, __HIP_MEMORY_SCOPE_AGENT);
    __syncthreads();
    return __builtin_amdgcn_readfirstlane(*slot);
}
constexpr int N_PHASES = 18;
constexpr int N_LAUNCHES = MK_N_LAUNCHES;
constexpr int PTAB_OFF = LDSCTL_OFF + 512, MOETAB_OFF = LDSCTL_OFF + 64;
__device__ __forceinline__ const float* inptr(const Frame& F, int i) {
    const LAS unsigned* t = (const LAS unsigned*)(F.lds + PTAB_OFF) + 2 * i;
    const unsigned lo = __builtin_amdgcn_readfirstlane(t[0]), hi = __builtin_amdgcn_readfirstlane(t[1]);
    return (const float*)(((unsigned long long)hi << 32) | lo);
}
#define GRID_BAR() do { if (N_LAUNCHES == 1) xcd_barrier(bar); } while (0)
#define IN(k) (lo <= (k) && (k) < hi)
#define SEAM(k) do { if (IN(k) && IN((k) + 1)) GRID_BAR(); } while (0)
__device__ __forceinline__ void moe_table(Frame& F) {
    LAS int* tab = (LAS int*)(F.lds + MOETAB_OFF);
    __syncthreads();
    if (F.tid == 0) { int cum = 0; for (int e = 0; e < NE; ++e) { const int cn = (int)__hip_atomic_load(F.ctl + CW_CNT + e, __ATOMIC_RELAXED, __HIP_MEMORY_SCOPE_AGENT); tab[e] = cn; tab[8 + e] = cum; cum += (cn + 255) >> 8; } tab[16] = cum; }
    __syncthreads();
}
template <int GRP>
__device__ __forceinline__ void conv_part(Frame& F, int part) {
    constexpr int N = (GRP == 0) ? CONV_N0 : (GRP == 1) ? CONV_N1 : (GRP == 2) ? CONV_N2 : (GRP == 3) ? CONV_N3 : CONV_N4;
    const int niter = (N + F.NGW - 1) / F.NGW, i0 = part * niter / 3, i1 = (part + 1) * niter / 3;
#pragma unroll 1
    for (int i = i0; i < i1; ++i) { const int it = F.gw + i * F.NGW; if (it < N) conv_item<GRP>(F, it); }
}
template <int GRP>
__device__ __forceinline__ void conv_queue(Frame& F, unsigned* qctr) {
    constexpr int N = (GRP == 0) ? CONV_N0 : (GRP == 1) ? CONV_N1 : (GRP == 2) ? CONV_N2 : (GRP == 3) ? CONV_N3 : CONV_N4, BATCH = 32, NBATCH = (N + BATCH - 1) / BATCH;
    volatile LAS int* slot2 = (volatile LAS int*)(F.lds + LDSCTL_OFF + 264);
    int cur = wq_pull(F, qctr), par = 0;
    while (cur < NBATCH) {
        if (F.tid == 0) slot2[par] = (int)__hip_atomic_fetch_add(qctr, 1u, __ATOMIC_RELAXED, __HIP_MEMORY_SCOPE_AGENT);
#pragma unroll 1
        for (int i = F.wave; i < BATCH; i += NWAVES) { const int it = cur * BATCH + i; if (it < N) conv_item<GRP>(F, it); }
        __syncthreads();
        cur = __builtin_amdgcn_readfirstlane(slot2[par]); par ^= 1;
    }
}
constexpr int G0_DEFER = CONV_N0 - 4096, G0_DEFER_AT = CS_WI + CI_WO + CI_FD - G0_DEFER;
static_assert(G0_DEFER > 0 && G0_DEFER <= CI_FD, "group 0 deferral");
constexpr int TAIL_FIRST = 4096, TAIL_N0 = 1456, TAIL_N1 = 2048, SLOT_FIRST0 = TAIL_FIRST + TAIL_N0, SLOT_FIRST1 = TAIL_FIRST + TAIL_N1;
static_assert((CONV_N3 - SLOT_FIRST1) % 2048 == 0 && (M / 256) * (NIN / 256) == 1216, "tail plan");
constexpr int G4_SLACK0 = CONV_N2 - SLOT_FIRST0 - 4 * 2048, G4_TAIL = CONV_N4 - 2048;
static_assert(G4_SLACK0 > 0 && G4_SLACK0 + G4_TAIL <= 2048 && G4_TAIL > 0, "group 4 tail placement");
template <int L>
__device__ __forceinline__ void layer(Frame& F, const XcdBarrier& bar, float* out, const int lo, const int hi) {
    constexpr int pb = 2 + 8 * L;
    unsigned char* ws = F.ws;
    float* mod = (float*)(ws + WS_MOD); float* gates = (float*)(ws + WS_GATES);
    uint4* tok = (uint4*)(ws + WS_TOK); int* idx = (int*)(ws + WS_TOK + 512 * 1024);
    bf16_t* XN = (bf16_t*)(ws + WS_XN); bf16_t* proj = (bf16_t*)(ws + WS_PROJ); unsigned char* ymix = ws + WS_YMIX; bf16_t* act = (bf16_t*)(ws + WS_ACT);
    bf16_t* yb = (bf16_t*)(ws + WS_YB);
    const float* modl = mod + (size_t)L * NB * 6 * D;
    if (IN(pb + 0)) {
        pg8::DenseSched S{(const char*)XN, (const char*)(ws + WS_WIN + (size_t)L * NIN * D), D, M / 256, NIN / 256, F.G, (int)blockIdx.x};
        pg8::EpiInProjI8 E{proj, NIN, (float*)(ws + WS_CTL + KMEAN_OFF + (size_t)L * 131072), (const float*)(ws + WS_ROWMAX), (const float*)(ws + WS_CTL + COLMAX_OFF) + CMX_WIN + L * NIN};
        pg8::gemm_phase<pg8::EpiInProjI8, pg8::DenseSched, true, 2>(F.lds, D, S, E);
        if (F.G == 256 && blockIdx.x >= 192) {
            constexpr int TG = (L == 0) ? 2 : 3, TN = (L == 0) ? TAIL_N0 : TAIL_N1;
            __syncthreads();
            const int wv = ((int)blockIdx.x - 192) * 8 + F.wave;
#pragma unroll 1
            for (int it = wv; it < TN; it += 512) conv_item<TG>(F, TAIL_FIRST + it);
            if (L == 0) {
#pragma unroll 1
                for (int it = wv; it < G0_DEFER; it += 512) conv_item<0>(F, G0_DEFER_AT + it); }
            __syncthreads(); }
    }
    SEAM(pb + 0);
    const mls::MW mw{ws + WS_CC, ws + WS_CP, (float*)(ws + WS_NC), (float*)(ws + WS_NP), (float*)(ws + WS_SC), (float*)(ws + WS_SC + 65536)};
    const float* km = (const float*)(ws + WS_CTL + KMEAN_OFF + (size_t)L * 131072);
    const int cls = (blockIdx.x >> 3) & 3; const bool odd = (cls & 1) != 0;
    if (IN(pb + 1)) {
        mls::x_setup(F, inptr(F, IN_CONVW) + (size_t)L * 4 * 1024, inptr(F, IN_CONVB) + (size_t)L * 1024);
        { int u = blockIdx.x; mls::XL xa; if (u < 1024) mls::x_load(xa, F, proj, gates, u);
          for (; u < 1024; u += F.G) { mls::XL xb; const bool hn = u + F.G < 1024; mls::x_unit(F, proj, gates, mw, u, xa, xb, hn, u + F.G); xa = xb; } }
        __syncthreads();
    }
    SEAM(pb + 1);
    if (IN(pb + 2)) {
        constexpr int GRP = (L == 0) ? 2 : 3;
        mls::y_phase<GRP>(F, mw);
        GRID_BAR();
        if (cls == 0) { conv_all<GRP>(F, (F.G == 256) ? ((L == 0) ? SLOT_FIRST0 : SLOT_FIRST1) : 0); if (L == 0 && F.G == 256) { const int e4 = F.gw - G4_SLACK0; if (e4 >= 0 && e4 < G4_TAIL) conv_item<4>(F, 2048 + e4); } __syncthreads(); }
        if (odd) { for (int p = blockIdx.x; p < 256; p += F.G) { const int bh = p >> 2, jj = p & 3; mob::attn_unit<8>(bh >> 3, bh & 7, 7 - jj, (const mob::bf16*)(proj + C_MQ), (const mob::bf16*)(proj + C_MK), (const mob::bf16*)(proj + C_MV), ymix, km, (char*)F.glds); } }
        __syncthreads();
        if (cls == 1) { conv_all<GRP>(F, (F.G == 256) ? ((L == 0) ? SLOT_FIRST0 : SLOT_FIRST1) : 0); if (L == 0 && F.G == 256) { const int e4 = F.gw - G4_SLACK0; if (e4 >= 0 && e4 < G4_TAIL) conv_item<4>(F, 2048 + e4); } __syncthreads(); }
        mls::z_setup(F, inptr(F, IN_CONVW) + (size_t)L * 4 * 1024, inptr(F, IN_CONVB) + (size_t)L * 1024, inptr(F, IN_MNW) + (size_t)L * 512);
        { int u = blockIdx.x; mls::ZL za; if (u < 1024) mls::z_load(za, F, proj, gates, mw, u);
          for (; u < 1024; u += F.G) { mls::ZL zb; const bool hn = u + F.G < 1024; mls::z_unit(F, proj, gates, mw, ymix, u, za, zb, hn, u + F.G); za = zb; } }
        __syncthreads();
        if (!odd) { for (int p = blockIdx.x; p < 256; p += F.G) { const int bh = p >> 2, jj = p & 3; mob::attn_unit<8>(bh >> 3, bh & 7, 7 - jj, (const mob::bf16*)(proj + C_MQ), (const mob::bf16*)(proj + C_MK), (const mob::bf16*)(proj + C_MV), ymix, km, (char*)F.glds); } }
        __syncthreads();
        if (cls == 2) { conv_all<GRP>(F, (F.G == 256) ? ((L == 0) ? SLOT_FIRST0 : SLOT_FIRST1) : 0); if (L == 0 && F.G == 256) { const int e4 = F.gw - G4_SLACK0; if (e4 >= 0 && e4 < G4_TAIL) conv_item<4>(F, 2048 + e4); } __syncthreads(); }
        for (int p = blockIdx.x; p < 256; p += F.G) { const int bh = p >> 2, jj = p & 3; mob::attn_unit<8>(bh >> 3, bh & 7, jj, (const mob::bf16*)(proj + C_MQ), (const mob::bf16*)(proj + C_MK), (const mob::bf16*)(proj + C_MV), ymix, km, (char*)F.glds); }
        for (int u = blockIdx.x; u < 256; u += F.G) att::swa_unit(F, proj, inptr(F, IN_SINK) + L * 16, ymix, u >> 5, (u >> 4) & 1, u & 15);
        __syncthreads();
        if (cls == 3) { conv_all<GRP>(F, (F.G == 256) ? ((L == 0) ? SLOT_FIRST0 : SLOT_FIRST1) : 0); if (L == 0 && F.G == 256) { const int e4 = F.gw - G4_SLACK0; if (e4 >= 0 && e4 < G4_TAIL) conv_item<4>(F, 2048 + e4); } __syncthreads(); }
    }
    SEAM(pb + 2);
    if (IN(pb + 3)) {
        pg8::DenseSched S{(const char*)ymix, (const char*)(ws + WS_WOUT + (size_t)L * D * D), D, M / 256, D / 256, F.G, (int)blockIdx.x};
        pg8::EpiBf16 E{yb, D, WSC_INV / att::YSC};
        pg8::gemm_phase<pg8::EpiBf16, pg8::DenseSched, true, 1>(F.lds, D, S, E);
    }
    SEAM(pb + 3);
    if (IN(pb + 4)) {
        float* xb = (float*)(ws + WS_XB);
        if constexpr (L == 0) row_phase<1, 0, true, true, false, true>(F, inptr(F, IN_X), xb, yb, inptr(F, IN_GPOSTM) + (size_t)L * D, modl + 2 * D, inptr(F, IN_GPREF) + (size_t)L * D, modl + 4 * D, modl + 3 * D, XN,
                                          nullptr, 0, nullptr, nullptr, nullptr, nullptr, nullptr, nullptr, nullptr, (float*)(ws + WS_ROWMAX));
        else        row_phase<1, 2, true, true, true, true>(F, xb, xb, yb, inptr(F, IN_GPOSTM) + (size_t)L * D, modl + 2 * D, inptr(F, IN_GPREF) + (size_t)L * D, modl + 4 * D, modl + 3 * D, XN,
                                          inptr(F, IN_ROUTER), 8, nullptr, nullptr, nullptr, nullptr, tok, idx, F.ctl + CW_CNT, (float*)(ws + WS_ROWMAX));
    }
    SEAM(pb + 4);
    if constexpr (L == 0) {
        if (IN(pb + 5)) {
            pg8::DenseSched S{(const char*)XN, (const char*)(ws + WS_WGU), D, M / 256, 2 * DFF / 256, F.G, (int)blockIdx.x};
            pg8::EpiSwiGLUI8 E{(unsigned char*)act, DFF, (const float*)(ws + WS_ROWMAX), (const float*)(ws + WS_CTL + COLMAX_OFF), nullptr, nullptr};
            pg8::gemm_phase<pg8::EpiSwiGLUI8, pg8::DenseSched, true, 2>(F.lds, D, S, E);
        }
        SEAM(pb + 5);
        if (IN(pb + 6)) {
            pg8::DenseSched S{(const char*)act, (const char*)(ws + WS_WD), DFF, M / 256, D / 256, F.G, (int)blockIdx.x};
            pg8::EpiBf16 E{yb, D, WSC_INV};
            pg8::gemm_phase<pg8::EpiBf16, pg8::DenseSched, true, 1>(F.lds, DFF, S, E);
        }
        SEAM(pb + 6);
        if (IN(pb + 7)) { float* xb = (float*)(ws + WS_XB); row_phase<1, 1, true, true, true, true>(F, xb, xb, yb, inptr(F, IN_GPOSTF), modl + 5 * D, inptr(F, IN_GPREM) + D, mod + (size_t)NB * 6 * D + 1 * D, mod + (size_t)NB * 6 * D + 0 * D, XN,
                                              inptr(F, IN_WIN) + (size_t)D * NIN_SRC + SRC_GATE, NIN_SRC, inptr(F, IN_IGB) + 4, inptr(F, IN_FGB) + 4, gates, nullptr, nullptr, nullptr, nullptr, (float*)(ws + WS_ROWMAX));
            for (int it = F.gw; it < ((F.G == 256) ? 2048 : CONV_N4); it += F.NGW) conv_item<4>(F, it); }
        SEAM(pb + 7);
    } else {
        if (IN(pb + 5)) {
            moe_table(F);
            const LAS int* tab = (const LAS int*)(F.lds + MOETAB_OFF);
            pg8::MoeSched<true> S; S.A = (const char*)XN; S.W = (const char*)(ws + WS_MGU); S.idx = idx; S.tab = tab; S.KB = D; S.nN = 2 * DFE / 256; S.G = F.G; S.c = (int)blockIdx.x; S.wrows = 2 * DFE; S.ntile = tab[16];
            pg8::EpiSwiGLUI8 E{(unsigned char*)act, DFE, (const float*)(ws + WS_RMSLOT), (const float*)(ws + WS_CTL + COLMAX_OFF) + 2 * DFF, idx, tab};
            pg8::gemm_phase<pg8::EpiSwiGLUI8, pg8::MoeSched<true>, true, 2>(F.lds, D, S, E);
        }
        SEAM(pb + 5);
        if (IN(pb + 6)) {
            moe_table(F);
            const LAS int* tab = (const LAS int*)(F.lds + MOETAB_OFF);
            pg8::MoeSched<false> S; S.A = (const char*)act; S.W = (const char*)(ws + WS_MD); S.idx = idx; S.tab = tab; S.KB = DFE; S.nN = D / 256; S.G = F.G; S.c = (int)blockIdx.x; S.wrows = D; S.ntile = tab[16];
            pg8::EpiBf16 E{yb, D, WSC_INV};
            pg8::gemm_phase<pg8::EpiBf16, pg8::MoeSched<false>, true, 1>(F.lds, DFE, S, E);
        }
        SEAM(pb + 6);
        if (IN(pb + 7)) row_phase<2, 0, false, false, true, false>(F, (const float*)(ws + WS_XB), out, yb, inptr(F, IN_GPOSTF) + D, modl + 5 * D, nullptr, nullptr, nullptr, nullptr,
                                               nullptr, 0, nullptr, nullptr, nullptr, tok, nullptr, nullptr, F.ctl + CW_CNT);
    }
}
__global__ void __launch_bounds__(NTHR, 2) fwd(Args args) {
    extern __shared__ __attribute__((aligned(16))) unsigned char lds[];
    Frame F;
    F.lds = (LAS unsigned char*)lds; F.glds = lds; F.ws = args.ws; F.ctl = (unsigned*)(args.ws + WS_CTL);
    F.tid = threadIdx.x; F.lane = F.tid & 63; F.wave = __builtin_amdgcn_readfirstlane(F.tid >> 6);
    F.G = gridDim.x; F.gw = blockIdx.x * NWAVES + F.wave; F.NGW = F.G * NWAVES;
    volatile LAS unsigned* MISC = (volatile LAS unsigned*)(F.lds + MISC_OFF);
    for (int u = F.tid; u < (LDS_BYTES - LDSCTL_OFF) / 4; u += NTHR) ((LAS unsigned*)(F.lds + LDSCTL_OFF))[u] = 0u;
    __syncthreads();
    if (F.tid < N_INPUTS) { const unsigned long long p = (unsigned long long)args.in[F.tid]; LAS unsigned* t = (LAS unsigned*)(F.lds + PTAB_OFF) + 2 * F.tid; t[0] = (unsigned)p; t[1] = (unsigned)(p >> 32); }
    __syncthreads();
    XcdBarrier bar; bar.bar = F.ctl + CW_BAR; bar.x = 0; bar.st = nullptr;
    if (N_LAUNCHES == 1) bar = xcd_barrier_post(F.ctl + CW_BAR, MISC + 8);
    const int lo = args.ph_lo, hi = args.ph_hi;
    float* out = args.out;
    if (IN(0)) { p0_ada(F, inptr(F, IN_C), inptr(F, IN_ADAW), inptr(F, IN_ADAB), (float*)(F.ws + WS_MOD)); __syncthreads();
        if (F.G == 256) { for (int j = F.gw; j < 4096; j += F.NGW) conv_item<0>(F, j < G0_DEFER_AT ? j : j + G0_DEFER); }
        else conv_all<0>(F); }
    SEAM(0);
    if (IN(1)) { float* mod = (float*)(F.ws + WS_MOD); const float* x = inptr(F, IN_X);
        row_phase<0, 1, true, true>(F, x, (float*)x  , nullptr, nullptr, nullptr, inptr(F, IN_GPREM), mod + 1 * D, mod + 0 * D, (bf16_t*)(F.ws + WS_XN),
                              inptr(F, IN_WIN) + SRC_GATE, NIN_SRC, inptr(F, IN_IGB), inptr(F, IN_FGB), (float*)(F.ws + WS_GATES), nullptr, nullptr, nullptr, nullptr, (float*)(F.ws + WS_ROWMAX));
        conv_all<1>(F); }
    SEAM(1);
    layer<0>(F, bar, out, lo, hi);
    layer<1>(F, bar, out, lo, hi);
}
#undef IN
#undef SEAM
#undef GRID_BAR

extern "C" void kernel_launch(void* const* d_in, const int* in_sizes, int n_in, void* d_out, int out_size, void* d_ws, size_t ws_size, hipStream_t stream) {
    static int grid = 0;
    if (grid == 0) {
        if (n_in != N_INPUTS || in_sizes[0] != M * D || out_size != M * D || ws_size < WS_END) { fprintf(stderr, "kernel_launch: unexpected problem (n_in %d, in0 %d, out %d, ws %zu); nothing launched\n", n_in, n_in > 0 ? in_sizes[0] : -1, out_size, ws_size); grid = -1; return; }
        int dev = 0, cus = 0, per_cu = 0;
        if (hipGetDevice(&dev) != hipSuccess || hipDeviceGetAttribute(&cus, hipDeviceAttributeMultiprocessorCount, dev) != hipSuccess) { grid = -1; return; }
        if (hipFuncSetAttribute((const void*)fwd, hipFuncAttributeMaxDynamicSharedMemorySize, LDS_BYTES) != hipSuccess) { fprintf(stderr, "kernel_launch: hipFuncSetAttribute failed\n"); grid = -1; return; }
        if (hipOccupancyMaxActiveBlocksPerMultiprocessor(&per_cu, (const void*)fwd, NTHR, LDS_BYTES) != hipSuccess || per_cu < 1) fprintf(stderr, "kernel_launch: occupancy query reports %d\n", per_cu);
        (void)hipGetLastError();
        grid = cus;
    }
    if (grid < 0) return;
    if (hipMemsetAsync((char*)d_ws + WS_CTL, 0, CTL_ZERO_BYTES, stream) != hipSuccess) return;
    Args a{};
    for (int i = 0; i < N_INPUTS; ++i) a.in[i] = (const float*)d_in[i];
    a.out = (float*)d_out; a.ws = (unsigned char*)d_ws;
    if (N_LAUNCHES == 1) { a.ph_lo = 0; a.ph_hi = N_PHASES; hipLaunchKernelGGL(fwd, dim3(grid), dim3(NTHR), LDS_BYTES, stream, a); }
    else for (int p = 0; p < N_PHASES; ++p) { a.ph_lo = p; a.ph_hi = p + 1; hipLaunchKernelGGL(fwd, dim3(grid), dim3(NTHR), LDS_BYTES, stream, a); }
}
```
